# Optimizing an MI355X kernel written in HIP

```python
import jax, jax.numpy as jnp
from jax import lax
import numpy as np

D_MODEL = 1024
BATCH = 16
SEQ = 4096
DEPTH = 2

MIX_WIDTH = 1024
SWA_HEADS = 8
SWA_KV_HEADS = 2
SWA_HEAD_DIM = 64
SWA_GROUP = SWA_HEADS // SWA_KV_HEADS
SWA_WIDTH = SWA_HEADS * SWA_HEAD_DIM
SWA_KV_WIDTH = SWA_KV_HEADS * SWA_HEAD_DIM
WINDOW = 128
DN_HEADS = 4
DN_HEAD_DIM = 64
DN_WIDTH = DN_HEADS * DN_HEAD_DIM
DN_CONV = 4
DN_CHUNK = 64
N_MEM = 256
MEM_HEADS = 4
MEM_HEAD_DIM = 64
MEM_WIDTH = MEM_HEADS * MEM_HEAD_DIM

EPS = 1e-6
IN_SIZES = (SWA_WIDTH, SWA_KV_WIDTH, SWA_KV_WIDTH,
            DN_WIDTH, DN_WIDTH, DN_WIDTH, DN_HEADS, DN_HEADS,
            MEM_WIDTH, MIX_WIDTH)
IN_WIDTH = SWA_WIDTH + 2 * SWA_KV_WIDTH + 3 * DN_WIDTH + 2 * DN_HEADS + MEM_WIDTH + MIX_WIDTH

kernel_name = "hybrid_swa_sink_gdn_memory_parallel_heads"


def _split_points(sizes):
    pts, acc = [], 0
    for s in sizes[:-1]:
        acc += s
        pts.append(acc)
    return pts


def rms_norm(x, g):
    xf = x.astype(jnp.float32)
    y = xf * lax.rsqrt(jnp.mean(xf * xf, axis=-1, keepdims=True) + EPS)
    return (y * g.astype(jnp.float32)).astype(x.dtype)


def l2_norm(x):
    xf = x.astype(jnp.float32)
    return xf * lax.rsqrt(jnp.sum(xf * xf, axis=-1, keepdims=True) + EPS)


def swa_sink_attention(q, k, v, sinks):
    B, S = q.shape[0], q.shape[1]
    nb = S // WINDOW
    qb = q.reshape(B, nb, WINDOW, SWA_KV_HEADS, SWA_GROUP, SWA_HEAD_DIM)
    kb = k.reshape(B, nb, WINDOW, SWA_KV_HEADS, SWA_HEAD_DIM)
    vb = v.reshape(B, nb, WINDOW, SWA_KV_HEADS, SWA_HEAD_DIM)

    def with_prev(t):
        prev = jnp.pad(t[:, :-1], ((0, 0), (1, 0), (0, 0), (0, 0), (0, 0)))
        return jnp.concatenate([prev, t], axis=2)

    kk, vv = with_prev(kb), with_prev(vb)
    scale = SWA_HEAD_DIM ** -0.5
    s = jnp.einsum("bnqhgd,bnkhd->bnhgqk", qb, kk).astype(jnp.float32) * scale
    qi = jnp.arange(WINDOW)[:, None]
    kj = jnp.arange(2 * WINDOW)[None, :]
    band = (kj > qi) & (kj <= qi + WINDOW)
    blk = jnp.arange(nb)[:, None, None]
    valid = band[None] & ((kj[None] >= WINDOW) | (blk > 0))
    s = jnp.where(valid[None, :, None, None], s, -jnp.inf)
    sink = sinks.astype(jnp.float32).reshape(1, 1, SWA_KV_HEADS, SWA_GROUP, 1, 1)
    m = jnp.maximum(jnp.max(s, axis=-1, keepdims=True), sink)
    p = jnp.exp(s - m)
    denom = jnp.sum(p, axis=-1, keepdims=True) + jnp.exp(sink - m)
    o = jnp.einsum("bnhgqk,bnkhd->bnqhgd", (p / denom).astype(v.dtype), vv)
    return o.reshape(B, S, SWA_WIDTH)


def causal_depthwise_conv(x, w):
    K, C = w.shape
    return lax.conv_general_dilated(
        x, w[:, None, :].astype(x.dtype), window_strides=(1,), padding=[(K - 1, 0)],
        dimension_numbers=("NWC", "WIO", "NWC"), feature_group_count=C)


def gated_delta_rule(q, k, v, g, beta):
    B, S, H, dk = q.shape
    dv = v.shape[-1]
    C = DN_CHUNK
    N = S // C

    def chunks(t):
        return t.reshape(B, N, C, H, -1).transpose(0, 3, 1, 2, 4)

    q = chunks(q) * (dk ** -0.5)
    k = chunks(k)
    v = chunks(v)
    g = jnp.cumsum(g.reshape(B, N, C, H).transpose(0, 3, 1, 2), axis=-1)
    beta = beta.reshape(B, N, C, H).transpose(0, 3, 1, 2)
    causal = jnp.tril(jnp.ones((C, C), dtype=bool))
    strict = jnp.tril(jnp.ones((C, C), dtype=bool), -1)
    decay = jnp.exp(jnp.where(causal, g[..., :, None] - g[..., None, :], -jnp.inf))
    k_beta = k * beta[..., None]
    v_beta = v * beta[..., None]
    L = jnp.where(strict, jnp.einsum("bhncd,bhnsd->bhncs", k_beta, k) * decay, 0.0)
    a = L + jnp.eye(C, dtype=jnp.float32)
    rhs = jnp.concatenate([v_beta, k_beta * jnp.exp(g)[..., None]], axis=-1)
    sol = lax.linalg.triangular_solve(a, rhs, left_side=True, lower=True, unit_diagonal=True)
    u, w = sol[..., :dv], sol[..., dv:]

    def step(state, inp):
        q_i, k_i, u_i, w_i, g_i, dec_i = inp
        v_new = u_i - jnp.einsum("bhck,bhkv->bhcv", w_i, state)
        intra = jnp.einsum("bhck,bhsk->bhcs", q_i, k_i) * dec_i
        o_i = (jnp.einsum("bhck,bhkv->bhcv", q_i * jnp.exp(g_i)[..., None], state)
               + jnp.einsum("bhcs,bhsv->bhcv", intra, v_new))
        g_last = g_i[..., -1:]
        state = (state * jnp.exp(g_last)[..., None]
                 + jnp.einsum("bhck,bhcv->bhkv", k_i * jnp.exp(g_last - g_i)[..., None], v_new))
        return state, o_i

    xs = tuple(jnp.moveaxis(t, 2, 0) for t in (q, k, u, w, g, decay))
    s0 = jnp.zeros((B, H, dk, dv), jnp.float32)
    _, o = lax.scan(step, s0, xs)
    return o.transpose(1, 0, 3, 2, 4).reshape(B, S, H, dv)


def memory_attention(q, mk, mv):
    s = jnp.einsum("bshd,bmhd->bhsm", q, mk).astype(jnp.float32) * (MEM_HEAD_DIM ** -0.5)
    p = jax.nn.softmax(s, axis=-1).astype(mv.dtype)
    return jnp.einsum("bhsm,bmhd->bshd", p, mv)


def hybrid_layer(x, mem, pre_g, w_in, conv_w, a_log, dt_bias, sinks, dn_norm_g,
                 mem_norm_g, w_mem_kv, w_out, post_g):
    B, S, _ = x.shape
    h = rms_norm(x, pre_g)
    proj = h @ w_in
    sq, sk, sv, dq, dk, dv, dbeta, dalpha, mq, gate = jnp.split(
        proj, _split_points(IN_SIZES), axis=-1)

    a_out = swa_sink_attention(
        sq.reshape(B, S, SWA_HEADS, SWA_HEAD_DIM),
        sk.reshape(B, S, SWA_KV_HEADS, SWA_HEAD_DIM),
        sv.reshape(B, S, SWA_KV_HEADS, SWA_HEAD_DIM), sinks)

    qkv = jax.nn.silu(causal_depthwise_conv(jnp.concatenate([dq, dk, dv], axis=-1), conv_w))
    cq, ck, cv = jnp.split(qkv, [DN_WIDTH, 2 * DN_WIDTH], axis=-1)
    qf = l2_norm(cq.reshape(B, S, DN_HEADS, DN_HEAD_DIM))
    kf = l2_norm(ck.reshape(B, S, DN_HEADS, DN_HEAD_DIM))
    vf = cv.reshape(B, S, DN_HEADS, DN_HEAD_DIM).astype(jnp.float32)
    beta = jax.nn.sigmoid(dbeta.astype(jnp.float32))
    g = -jnp.exp(a_log.astype(jnp.float32)) * jax.nn.softplus(
        dalpha.astype(jnp.float32) + dt_bias.astype(jnp.float32))
    d_out = gated_delta_rule(qf, kf, vf, g, beta)
    d_out = rms_norm(d_out, dn_norm_g).reshape(B, S, DN_WIDTH).astype(x.dtype)

    mkv = rms_norm(mem, mem_norm_g) @ w_mem_kv
    mk, mv = jnp.split(mkv, [MEM_WIDTH], axis=-1)
    Mn = mem.shape[1]
    m_out = memory_attention(
        mq.reshape(B, S, MEM_HEADS, MEM_HEAD_DIM),
        mk.reshape(B, Mn, MEM_HEADS, MEM_HEAD_DIM),
        mv.reshape(B, Mn, MEM_HEADS, MEM_HEAD_DIM)).reshape(B, S, MEM_WIDTH)

    mixed = jnp.concatenate([a_out, d_out, m_out], axis=-1) * jax.nn.silu(gate)
    y = mixed @ w_out
    return x + rms_norm(y, post_g)


def setup_inputs(seed: int = 0) -> dict:
    key = jax.random.key(seed)
    ks = jax.random.split(key, 16)
    f32 = jnp.float32
    x = jax.random.normal(ks[0], (BATCH, SEQ, D_MODEL), f32)
    mem = jax.random.normal(ks[1], (BATCH, N_MEM, D_MODEL), f32)
    pre_norm_g = 1.0 + 0.05 * jax.random.normal(ks[2], (DEPTH, D_MODEL), f32)
    w_in = jax.random.normal(ks[3], (DEPTH, D_MODEL, IN_WIDTH), f32) * D_MODEL ** -0.5
    conv_w = jax.random.normal(ks[4], (DEPTH, DN_CONV, 3 * DN_WIDTH), f32) * DN_CONV ** -0.5
    a_log = jnp.log(jax.random.uniform(ks[5], (DEPTH, DN_HEADS), f32, 1.0, 16.0))
    dt = jnp.exp(jax.random.uniform(ks[6], (DEPTH, DN_HEADS), f32,
                                    float(np.log(1e-3)), float(np.log(1e-1))))
    dt_bias = dt + jnp.log(-jnp.expm1(-dt))
    sinks = 0.5 * jax.random.normal(ks[7], (DEPTH, SWA_HEADS), f32)
    dn_norm_g = 1.0 + 0.05 * jax.random.normal(ks[8], (DEPTH, DN_HEAD_DIM), f32)
    mem_norm_g = 1.0 + 0.05 * jax.random.normal(ks[9], (DEPTH, D_MODEL), f32)
    w_mem_kv = jax.random.normal(ks[10], (DEPTH, D_MODEL, 2 * MEM_WIDTH), f32) * D_MODEL ** -0.5
    w_out = jax.random.normal(ks[11], (DEPTH, MIX_WIDTH, D_MODEL), f32) * MIX_WIDTH ** -0.5
    post_norm_g = 1.0 + 0.05 * jax.random.normal(ks[12], (DEPTH, D_MODEL), f32)
    return {"x": x, "mem": mem, "pre_norm_g": pre_norm_g, "w_in": w_in, "conv_w": conv_w,
            "a_log": a_log, "dt_bias": dt_bias, "sinks": sinks, "dn_norm_g": dn_norm_g,
            "mem_norm_g": mem_norm_g, "w_mem_kv": w_mem_kv, "w_out": w_out,
            "post_norm_g": post_norm_g}


def reference(x, mem, pre_norm_g, w_in, conv_w, a_log, dt_bias, sinks, dn_norm_g,
              mem_norm_g, w_mem_kv, w_out, post_norm_g):
    for l in range(DEPTH):
        x = hybrid_layer(x, mem, pre_norm_g[l], w_in[l], conv_w[l], a_log[l], dt_bias[l],
                         sinks[l], dn_norm_g[l], mem_norm_g[l], w_mem_kv[l], w_out[l],
                         post_norm_g[l])
    return x
```

```cpp
#include <hip/hip_runtime.h>
#include <cstdio>
#include <cstdint>

#define DI __device__ __forceinline__
#define LAS __attribute__((address_space(3)))
typedef unsigned short bf16_t;
typedef float f32x4 __attribute__((ext_vector_type(4)));
typedef unsigned u32x4 __attribute__((ext_vector_type(4)));
typedef unsigned u32x2 __attribute__((ext_vector_type(2)));

constexpr int DM = 1024, NB = 16, SEQ = 4096, NTOK = NB * SEQ, DEPTH = 2;
constexpr int INW = 2824;
constexpr int NIN = 2816;
constexpr int NMEM = 256, MEMROWS = NB * NMEM;
constexpr float EPS = 1e-6f;
constexpr int C_SQ = 0, C_SK = 512, C_SV = 640, C_DQ = 768, C_DK = 1024, C_DV = 1280, C_MQ = 1536, C_GATE = 1792;

constexpr size_t MiB = 1u << 20;
constexpr size_t WS_CTL = 0;
constexpr size_t WS_WIN = 1 * MiB;
constexpr size_t WS_WOUT = 12 * MiB;
constexpr size_t WS_WMKV = 16 * MiB;
constexpr size_t WS_W8 = 18 * MiB;
constexpr size_t WS_MEMN = 19 * MiB;
constexpr size_t WS_MK = 35 * MiB;
constexpr size_t WS_MVT = 39 * MiB;
constexpr size_t WS_BA = 43 * MiB;
constexpr size_t WS_STATS = 45 * MiB;
constexpr size_t WS_SVT = 49 * MiB;
constexpr size_t WS_H = 65 * MiB;
constexpr size_t WS_P = 193 * MiB;
constexpr size_t WS_DN = 545 * MiB;
constexpr size_t WS_END = 801 * MiB;

struct Params {
    const float *x, *mem, *pre_g, *w_in, *conv_w, *a_log, *dt_bias, *sinks, *dn_g, *mem_g, *w_mkv, *w_out, *post_g;
    float* out;
    unsigned char* ws;
};

DI unsigned f2bf(float f) { unsigned u = __float_as_uint(f); return (u + 0x7fffu + ((u >> 16) & 1u)) >> 16; }
DI unsigned pk2(float lo, float hi) { return f2bf(lo) | (f2bf(hi) << 16); }
DI float bf2f(unsigned u) { return __uint_as_float(u << 16); }
DI float bflo(unsigned u) { return __uint_as_float(u << 16); }
DI float bfhi(unsigned u) { return __uint_as_float(u & 0xffff0000u); }
DI float wave_sum(float v) {
#pragma unroll
    for (int o = 1; o < 64; o <<= 1) v += __shfl_xor(v, o);
    return v;
}
DI float sigmoidf_(float x) { return 1.f / (1.f + __expf(-x)); }
DI float siluf_(float x) { return x / (1.f + __expf(-x)); }
DI float softplusf_(float x) { return x > 20.f ? x : log1pf(expf(x)); }

DI void transpose_item(const float* W, int Nsrc, int src_n0, int k0, bf16_t* WT, int K, int dst_n0, LAS float* scr, int lane) {
#pragma unroll 8
    for (int i = 0; i < 32; ++i) { const int kk = 2 * i + (lane >> 5); scr[kk * 33 + (lane & 31)] = W[(size_t)(k0 + kk) * Nsrc + src_n0 + (lane & 31)]; }
    asm volatile("s_waitcnt lgkmcnt(0)" ::: "memory");
    const int c = lane & 7;
#pragma unroll
    for (int j = 0; j < 4; ++j) {
        const int n = (lane >> 3) + 8 * j; const LAS float* s = scr + (8 * c) * 33 + n;
        u32x4 o; o.x = pk2(s[0 * 33], s[1 * 33]); o.y = pk2(s[2 * 33], s[3 * 33]); o.z = pk2(s[4 * 33], s[5 * 33]); o.w = pk2(s[6 * 33], s[7 * 33]);
        *(u32x4*)(WT + (size_t)(dst_n0 + n) * K + k0 + 8 * c) = o;
    }
    asm volatile("s_waitcnt lgkmcnt(0)" ::: "memory");
}

DI void phase_init(const Params& p, LAS unsigned char* lds, int gw, int ngw, int wave, int lane) {
    LAS float* scr = (LAS float*)(lds + wave * 16384);
    constexpr int I_IN = 16 * (NIN / 32), I_OUT = 16 * 32, I_MKV = 16 * 16, I_L = I_IN + I_OUT + I_MKV;
    for (int it = gw; it < DEPTH * I_L; it += ngw) {
        const int l = it / I_L; int r = it % I_L;
        if (r < I_IN) {
            const int kb = r / (NIN / 32), nb = r % (NIN / 32), n0 = nb * 32;
            transpose_item(p.w_in + (size_t)l * DM * INW, INW, n0 + (n0 >= 1536 ? 8 : 0), kb * 64, (bf16_t*)(p.ws + WS_WIN) + (size_t)l * NIN * DM, DM, n0, scr, lane);
        } else if (r < I_IN + I_OUT) {
            r -= I_IN; const int kb = r / 32, nb = r % 32;
            transpose_item(p.w_out + (size_t)l * DM * DM, DM, nb * 32, kb * 64, (bf16_t*)(p.ws + WS_WOUT) + (size_t)l * DM * DM, DM, nb * 32, scr, lane);
        } else {
            r -= I_IN + I_OUT; const int kb = r / 16, nb = r % 16;
            transpose_item(p.w_mkv + (size_t)l * DM * 512, 512, nb * 32, kb * 64, (bf16_t*)(p.ws + WS_WMKV) + (size_t)l * 512 * DM, DM, nb * 32, scr, lane);
        }
    }
    for (int e = gw * 64 + lane; e < DEPTH * 8 * DM; e += ngw * 64) {
        const int l = e / (8 * DM), c = (e / DM) % 8, k = e % DM;
        ((float*)(p.ws + WS_W8))[e] = p.w_in[(size_t)l * DM * INW + (size_t)k * INW + 1536 + c];
    }
    for (int it = gw; it < DEPTH * MEMROWS; it += ngw) {
        const int l = it / MEMROWS, row = it % MEMROWS;
        const f32x4* xr = (const f32x4*)(p.mem + (size_t)row * DM) + lane;
        f32x4 v[4]; float s = 0.f;
#pragma unroll
        for (int j = 0; j < 4; ++j) { v[j] = xr[64 * j]; s += (v[j].x * v[j].x + v[j].y * v[j].y) + (v[j].z * v[j].z + v[j].w * v[j].w); }
        const float r = rsqrtf(wave_sum(s) * (1.f / DM) + EPS);
        const f32x4* gr = (const f32x4*)(p.mem_g + (size_t)l * DM) + lane;
        u32x2* o = (u32x2*)((bf16_t*)(p.ws + WS_MEMN) + ((size_t)l * MEMROWS + row) * DM) + lane;
#pragma unroll
        for (int j = 0; j < 4; ++j) { const f32x4 g = gr[64 * j]; u32x2 w; w.x = pk2(v[j].x * r * g.x, v[j].y * r * g.y); w.y = pk2(v[j].z * r * g.z, v[j].w * r * g.w); o[64 * j] = w; }
    }
}

template <bool L1> DI void prep_row(const Params& p, int l, int row, int lane) {
    const f32x4* xr = (const f32x4*)(p.x + (size_t)row * DM) + lane;
    f32x4 v[4];
#pragma unroll
    for (int j = 0; j < 4; ++j) v[j] = xr[64 * j];
    if (L1) {
        const f32x4* st = (const f32x4*)((const float*)(p.ws + WS_STATS) + (size_t)row * 16);
        const f32x4 s0 = st[0], s1 = st[1], s2 = st[2], s3 = st[3];
        const float ss = ((s0.x + s0.y) + (s0.z + s0.w)) + ((s1.x + s1.y) + (s1.z + s1.w)) + ((s2.x + s2.y) + (s2.z + s2.w)) + ((s3.x + s3.y) + (s3.z + s3.w));
        const float ry = rsqrtf(ss * (1.f / DM) + EPS);
        const u32x2* yr = (const u32x2*)((const bf16_t*)(p.ws + WS_P) + (size_t)row * DM) + lane;
        const f32x4* pg = (const f32x4*)(p.post_g + (size_t)(l - 1) * DM) + lane;
        f32x4* xo = (f32x4*)(p.out + (size_t)row * DM) + lane;
#pragma unroll
        for (int j = 0; j < 4; ++j) {
            const u32x2 y = yr[64 * j]; const f32x4 g = pg[64 * j];
            v[j].x += bflo(y.x) * ry * g.x; v[j].y += bfhi(y.x) * ry * g.y; v[j].z += bflo(y.y) * ry * g.z; v[j].w += bfhi(y.y) * ry * g.w;
            xo[64 * j] = v[j];
        }
    }
    float s = 0.f;
#pragma unroll
    for (int j = 0; j < 4; ++j) s += (v[j].x * v[j].x + v[j].y * v[j].y) + (v[j].z * v[j].z + v[j].w * v[j].w);
    const float r = rsqrtf(wave_sum(s) * (1.f / DM) + EPS);
    const f32x4* gr = (const f32x4*)(p.pre_g + (size_t)l * DM) + lane;
    u32x2* ho = (u32x2*)((bf16_t*)(p.ws + WS_H) + (size_t)row * DM) + lane;
#pragma unroll
    for (int j = 0; j < 4; ++j) {
        const f32x4 g = gr[64 * j];
        v[j].x *= r * g.x; v[j].y *= r * g.y; v[j].z *= r * g.z; v[j].w *= r * g.w;
        u32x2 w; w.x = pk2(v[j].x, v[j].y); w.y = pk2(v[j].z, v[j].w); ho[64 * j] = w;
    }
    const float* W8 = (const float*)(p.ws + WS_W8) + (size_t)l * 8 * DM;
    float mine = 0.f;
#pragma unroll
    for (int c = 0; c < 8; ++c) {
        const f32x4* wr = (const f32x4*)(W8 + c * DM) + lane; float d = 0.f;
#pragma unroll
        for (int j = 0; j < 4; ++j) { const f32x4 w = wr[64 * j]; d += (v[j].x * w.x + v[j].y * w.y) + (v[j].z * w.z + v[j].w * w.w); }
        d = wave_sum(d);
        mine = (lane == c) ? d : mine;
    }
    if (lane < 8) {
        float o;
        if (lane < 4) o = sigmoidf_(mine);
        else { const int h = lane - 4; o = -__expf(p.a_log[l * 4 + h]) * softplusf_(mine + p.dt_bias[l * 4 + h]); }
        ((float*)(p.ws + WS_BA))[(size_t)row * 8 + lane] = o;
    }
}

DI void final_row(const Params& p, int row, int lane) {
    const f32x4* st = (const f32x4*)((const float*)(p.ws + WS_STATS) + (size_t)row * 16);
    const f32x4 s0 = st[0], s1 = st[1], s2 = st[2], s3 = st[3];
    const float ss = ((s0.x + s0.y) + (s0.z + s0.w)) + ((s1.x + s1.y) + (s1.z + s1.w)) + ((s2.x + s2.y) + (s2.z + s2.w)) + ((s3.x + s3.y) + (s3.z + s3.w));
    const float ry = rsqrtf(ss * (1.f / DM) + EPS);
    const u32x2* yr = (const u32x2*)((const bf16_t*)(p.ws + WS_P) + (size_t)row * DM) + lane;
    const f32x4* pg = (const f32x4*)(p.post_g + (size_t)(DEPTH - 1) * DM) + lane;
    f32x4* xo = (f32x4*)(p.out + (size_t)row * DM) + lane;
#pragma unroll
    for (int j = 0; j < 4; ++j) {
        const u32x2 y = yr[64 * j]; const f32x4 g = pg[64 * j]; f32x4 v = xo[64 * j];
        v.x += bflo(y.x) * ry * g.x; v.y += bfhi(y.x) * ry * g.y; v.z += bflo(y.y) * ry * g.z; v.w += bfhi(y.y) * ry * g.w;
        xo[64 * j] = v;
    }
}

enum { K_INIT = 0, K_PREP = 1, K_FINAL = 7 };
__global__ void __launch_bounds__(512, 2) row_phase_kernel(Params p, int kind, int l) {
    extern __shared__ __attribute__((aligned(16))) unsigned char lds_raw[];
    LAS unsigned char* lds = (LAS unsigned char*)lds_raw;
    const int tid = threadIdx.x, lane = tid & 63, wave = __builtin_amdgcn_readfirstlane(tid >> 6);
    const int gw = blockIdx.x * 8 + wave, ngw = gridDim.x * 8;
    if (kind == K_INIT) phase_init(p, lds, gw, ngw, wave, lane);
    else if (kind == K_PREP) {
        if (l == 0) { for (int row = gw; row < NTOK; row += ngw) prep_row<false>(p, 0, row, lane); }
        else { for (int row = gw; row < NTOK; row += ngw) prep_row<true>(p, l, row, lane); }
    } else {
        for (int row = gw; row < NTOK; row += ngw) final_row(p, row, lane);
    }
}

__global__ void __launch_bounds__(256) naive_gemm(const bf16_t* A, const bf16_t* Bt, int M, int N, int K, int mode, bf16_t* O0, bf16_t* O1) {
    __shared__ float sA[32][65], sB[32][65];
    const int tid = threadIdx.x, tx = tid & 15, ty = tid >> 4;
    const int m0 = blockIdx.y * 64, n0 = blockIdx.x * 64;
    float acc[4][4];
#pragma unroll
    for (int i = 0; i < 4; ++i)
#pragma unroll
        for (int j = 0; j < 4; ++j) acc[i][j] = 0.f;
    for (int k0 = 0; k0 < K; k0 += 32) {
        { const int r = tid >> 2, kc = (tid & 3) * 8;
          const u32x4 a = *(const u32x4*)(A + (size_t)(m0 + r) * K + k0 + kc), b = *(const u32x4*)(Bt + (size_t)(n0 + r) * K + k0 + kc);
          sA[kc + 0][r] = bflo(a.x); sA[kc + 1][r] = bfhi(a.x); sA[kc + 2][r] = bflo(a.y); sA[kc + 3][r] = bfhi(a.y); sA[kc + 4][r] = bflo(a.z); sA[kc + 5][r] = bfhi(a.z); sA[kc + 6][r] = bflo(a.w); sA[kc + 7][r] = bfhi(a.w);
          sB[kc + 0][r] = bflo(b.x); sB[kc + 1][r] = bfhi(b.x); sB[kc + 2][r] = bflo(b.y); sB[kc + 3][r] = bfhi(b.y); sB[kc + 4][r] = bflo(b.z); sB[kc + 5][r] = bfhi(b.z); sB[kc + 6][r] = bflo(b.w); sB[kc + 7][r] = bfhi(b.w); }
        __syncthreads();
#pragma unroll 8
        for (int k = 0; k < 32; ++k) {
            float a[4], b[4];
#pragma unroll
            for (int i = 0; i < 4; ++i) { a[i] = sA[k][ty * 4 + i]; b[i] = sB[k][tx * 4 + i]; }
#pragma unroll
            for (int i = 0; i < 4; ++i)
#pragma unroll
                for (int j = 0; j < 4; ++j) acc[i][j] += a[i] * b[j];
        }
        __syncthreads();
    }
#pragma unroll
    for (int i = 0; i < 4; ++i)
#pragma unroll
        for (int j = 0; j < 4; ++j) {
            const int row = m0 + ty * 4 + i, col = n0 + tx * 4 + j; const bf16_t v = (bf16_t)f2bf(acc[i][j]);
            if (mode == 0) {
                O0[(size_t)row * NIN + col] = v;
                if (col >= C_SV && col < C_SV + 128) { const int b = row / SEQ, s = row % SEQ, c = col - C_SV; O1[((size_t)(b * 2 + c / 64) * 64 + (c % 64)) * SEQ + s] = v; }
            } else if (mode == 1) {
                if (col < 256) O0[(size_t)row * 256 + col] = v;
                else { const int b = row / NMEM, m = row % NMEM, c = col - 256; O1[((size_t)(b * 4 + c / 64) * 64 + (c % 64)) * NMEM + m] = v; }
            } else {
                O0[(size_t)row * DM + col] = v;
            }
        }
}
__global__ void __launch_bounds__(256) naive_stats(const bf16_t* Y, float* stats) {
    const int lane = threadIdx.x & 63, row = blockIdx.x * 4 + (threadIdx.x >> 6);
    const u32x2* yr = (const u32x2*)(Y + (size_t)row * DM) + lane; float s = 0.f;
#pragma unroll
    for (int j = 0; j < 4; ++j) { const u32x2 y = yr[64 * j]; const float a = bflo(y.x), b = bfhi(y.x), c = bflo(y.y), d = bfhi(y.y); s += (a * a + b * b) + (c * c + d * d); }
    s = wave_sum(s);
    if (lane < 16) stats[(size_t)row * 16 + lane] = lane == 0 ? s : 0.f;
}
__global__ void __launch_bounds__(256) naive_attn(Params p, int l) {
    const int gid = blockIdx.x * 256 + threadIdx.x; const int row = gid / 12, hh = gid % 12;
    const bf16_t* P = (const bf16_t*)(p.ws + WS_P);
    const int b = row / SEQ, s = row % SEQ;
    float q[64], o[64];
    const bool swa = hh < 8;
    const int qcol = swa ? C_SQ + hh * 64 : C_MQ + (hh - 8) * 64;
#pragma unroll
    for (int d = 0; d < 64; ++d) { q[d] = bf2f(P[(size_t)row * NIN + qcol + d]) * 0.125f; o[d] = 0.f; }
    float m, lsum;
    if (swa) { m = p.sinks[l * 8 + hh]; lsum = 1.f; } else { m = -1e30f; lsum = 0.f; }
    const int nk = swa ? 128 : 256;
    const bf16_t* svT = (const bf16_t*)(p.ws + WS_SVT);
    const bf16_t* mk = (const bf16_t*)(p.ws + WS_MK) + (size_t)l * MEMROWS * 256;
    const bf16_t* mvT = (const bf16_t*)(p.ws + WS_MVT) + (size_t)l * MEMROWS * 256;
    for (int jj = 0; jj < nk; ++jj) {
        const bf16_t* kp; const bf16_t* vp; size_t vstride;
        if (swa) { const int j = s - 127 + jj; if (j < 0) continue; const int kvh = hh >> 2;
            kp = P + (size_t)(b * SEQ + j) * NIN + C_SK + kvh * 64; vp = svT + ((size_t)(b * 2 + kvh) * 64) * SEQ + j; vstride = SEQ; }
        else { const int hm = hh - 8; kp = mk + (size_t)(b * NMEM + jj) * 256 + hm * 64; vp = mvT + ((size_t)(b * 4 + hm) * 64) * NMEM + jj; vstride = NMEM; }
        float sc = 0.f;
#pragma unroll
        for (int d = 0; d < 64; ++d) sc += q[d] * bf2f(kp[d]);
        const float mn = fmaxf(m, sc), f = __expf(m - mn), pe = __expf(sc - mn);
        lsum = lsum * f + pe; m = mn;
#pragma unroll
        for (int d = 0; d < 64; ++d) o[d] = o[d] * f + pe * bf2f(vp[(size_t)d * vstride]);
    }
    const float inv = 1.f / lsum;
    const int mcol = swa ? hh * 64 : 768 + (hh - 8) * 64;
    bf16_t* MIX = (bf16_t*)(p.ws + WS_H);
#pragma unroll
    for (int d = 0; d < 64; ++d) { const float g = bf2f(P[(size_t)row * NIN + C_GATE + mcol + d]); MIX[(size_t)row * DM + mcol + d] = (bf16_t)f2bf(o[d] * inv * siluf_(g)); }
}
__global__ void __launch_bounds__(64) naive_dn(Params p, int l) {
    const int b = blockIdx.x >> 2, h = blockIdx.x & 3, j = threadIdx.x;
    const bf16_t* P = (const bf16_t*)(p.ws + WS_P);
    const float* BA = (const float*)(p.ws + WS_BA);
    bf16_t* MIX = (bf16_t*)(p.ws + WS_H);
    const float* cw = p.conv_w + (size_t)l * 4 * 768;
    float wq[4], wk[4], wv[4];
#pragma unroll
    for (int t = 0; t < 4; ++t) { wq[t] = cw[t * 768 + h * 64 + j]; wk[t] = cw[t * 768 + 256 + h * 64 + j]; wv[t] = cw[t * 768 + 512 + h * 64 + j]; }
    const float gn = p.dn_g[l * 64 + j];
    float S[64];
#pragma unroll
    for (int i = 0; i < 64; ++i) S[i] = 0.f;
    float xq[4] = {0.f, 0.f, 0.f, 0.f}, xk[4] = {0.f, 0.f, 0.f, 0.f}, xv[4] = {0.f, 0.f, 0.f, 0.f};
    for (int t = 0; t < SEQ; ++t) {
        const size_t row = (size_t)b * SEQ + t;
        xq[0] = xq[1]; xq[1] = xq[2]; xq[2] = xq[3]; xq[3] = bf2f(P[row * NIN + C_DQ + h * 64 + j]);
        xk[0] = xk[1]; xk[1] = xk[2]; xk[2] = xk[3]; xk[3] = bf2f(P[row * NIN + C_DK + h * 64 + j]);
        xv[0] = xv[1]; xv[1] = xv[2]; xv[2] = xv[3]; xv[3] = bf2f(P[row * NIN + C_DV + h * 64 + j]);
        float cq = siluf_(wq[0] * xq[0] + wq[1] * xq[1] + wq[2] * xq[2] + wq[3] * xq[3]);
        float ck = siluf_(wk[0] * xk[0] + wk[1] * xk[1] + wk[2] * xk[2] + wk[3] * xk[3]);
        const float cv = siluf_(wv[0] * xv[0] + wv[1] * xv[1] + wv[2] * xv[2] + wv[3] * xv[3]);
        cq *= rsqrtf(wave_sum(cq * cq) + EPS) * 0.125f;
        ck *= rsqrtf(wave_sum(ck * ck) + EPS);
        const float beta = BA[row * 8 + h], a = __expf(BA[row * 8 + 4 + h]);
        float ks = 0.f;
#pragma unroll
        for (int i = 0; i < 64; ++i) ks += __shfl(ck, i) * S[i];
        const float dv = beta * (cv - a * ks);
        float oj = 0.f;
#pragma unroll
        for (int i = 0; i < 64; ++i) { S[i] = a * S[i] + __shfl(ck, i) * dv; oj += __shfl(cq, i) * S[i]; }
        const float r = rsqrtf(wave_sum(oj * oj) * (1.f / 64.f) + EPS);
        const int mcol = 512 + h * 64 + j;
        const float g = bf2f(P[row * NIN + C_GATE + mcol]);
        MIX[row * DM + mcol] = (bf16_t)f2bf(oj * r * gn * siluf_(g));
    }
}

extern "C" void kernel_launch(void* const* d_in, const int* in_sizes, int n_in, void* d_out, int out_size, void* d_ws, size_t ws_size, hipStream_t stream) {
    static int inited = 0;
    constexpr int LDS_BYTES = 147456;
    if (!inited) {
        if (n_in != 13 || ws_size < WS_END) { fprintf(stderr, "kernel_launch: unexpected n_in %d / ws_size %zu\n", n_in, ws_size); inited = -1; return; }
        hipFuncSetAttribute((const void*)row_phase_kernel, hipFuncAttributeMaxDynamicSharedMemorySize, LDS_BYTES);
        inited = 1;
    }
    if (inited < 0) return;
    Params p{};
    p.x = (const float*)d_in[0]; p.mem = (const float*)d_in[1]; p.pre_g = (const float*)d_in[2]; p.w_in = (const float*)d_in[3]; p.conv_w = (const float*)d_in[4];
    p.a_log = (const float*)d_in[5]; p.dt_bias = (const float*)d_in[6]; p.sinks = (const float*)d_in[7]; p.dn_g = (const float*)d_in[8]; p.mem_g = (const float*)d_in[9];
    p.w_mkv = (const float*)d_in[10]; p.w_out = (const float*)d_in[11]; p.post_g = (const float*)d_in[12];
    p.out = (float*)d_out; p.ws = (unsigned char*)d_ws;
    unsigned char* ws = (unsigned char*)d_ws;
    const int G = 256;
    hipLaunchKernelGGL(row_phase_kernel, dim3(G), dim3(512), LDS_BYTES, stream, p, (int)K_INIT, 0);
    hipLaunchKernelGGL(row_phase_kernel, dim3(G), dim3(512), LDS_BYTES, stream, p, (int)K_PREP, 0);
    for (int l = 0; l < DEPTH; ++l) {
        if (l == 0) {
            for (int ll = 0; ll < DEPTH; ++ll)
                hipLaunchKernelGGL(naive_gemm, dim3(512 / 64, MEMROWS / 64), dim3(256), 0, stream, (const bf16_t*)(ws + WS_MEMN) + (size_t)ll * MEMROWS * DM,
                                   (const bf16_t*)(ws + WS_WMKV) + (size_t)ll * 512 * DM, MEMROWS, 512, DM, 1, (bf16_t*)(ws + WS_MK) + (size_t)ll * MEMROWS * 256, (bf16_t*)(ws + WS_MVT) + (size_t)ll * MEMROWS * 256);
        }
        hipLaunchKernelGGL(naive_gemm, dim3(NIN / 64, NTOK / 64), dim3(256), 0, stream, (const bf16_t*)(ws + WS_H), (const bf16_t*)(ws + WS_WIN) + (size_t)l * NIN * DM, NTOK, NIN, DM, 0,
                           (bf16_t*)(ws + WS_P), (bf16_t*)(ws + WS_SVT));
        hipLaunchKernelGGL(naive_attn, dim3(NTOK * 12 / 256), dim3(256), 0, stream, p, l);
        hipLaunchKernelGGL(naive_dn, dim3(NB * 4), dim3(64), 0, stream, p, l);
        hipLaunchKernelGGL(naive_gemm, dim3(DM / 64, NTOK / 64), dim3(256), 0, stream, (const bf16_t*)(ws + WS_H), (const bf16_t*)(ws + WS_WOUT) + (size_t)l * DM * DM, NTOK, DM, DM, 2,
                           (bf16_t*)(ws + WS_P), (bf16_t*)nullptr);
        hipLaunchKernelGGL(naive_stats, dim3(NTOK / 4), dim3(256), 0, stream, (const bf16_t*)(ws + WS_P), (float*)(ws + WS_STATS));
        if (l + 1 < DEPTH) hipLaunchKernelGGL(row_phase_kernel, dim3(G), dim3(512), LDS_BYTES, stream, p, (int)K_PREP, l + 1);
        else hipLaunchKernelGGL(row_phase_kernel, dim3(G), dim3(512), LDS_BYTES, stream, p, (int)K_FINAL, 0);
    }
}
```

```cpp
#include <hip/hip_runtime.h>
#include <cstdio>
#include <cstdint>

#define DI __device__ __forceinline__
#define LAS __attribute__((address_space(3)))
typedef unsigned short bf16_t;
typedef float f32x4 __attribute__((ext_vector_type(4)));
typedef unsigned u32x4 __attribute__((ext_vector_type(4)));
typedef unsigned u32x2 __attribute__((ext_vector_type(2)));

constexpr int DM = 1024, NB = 16, SEQ = 4096, NTOK = NB * SEQ, DEPTH = 2;
constexpr int INW = 2824;
constexpr int NIN = 2816;
constexpr int NMEM = 256, MEMROWS = NB * NMEM;
constexpr float EPS = 1e-6f;
constexpr int C_SQ = 0, C_SK = 512, C_SV = 640, C_DQ = 768, C_DK = 1024, C_DV = 1280, C_MQ = 1536, C_GATE = 1792;

constexpr size_t MiB = 1u << 20;
constexpr size_t WS_CTL = 0;
constexpr size_t WS_WIN = 1 * MiB;
constexpr size_t WS_WOUT = 12 * MiB;
constexpr size_t WS_WMKV = 16 * MiB;
constexpr size_t WS_W8 = 18 * MiB;
constexpr size_t WS_MEMN = 19 * MiB;
constexpr size_t WS_MK = 35 * MiB;
constexpr size_t WS_MVT = 39 * MiB;
constexpr size_t WS_BA = 43 * MiB;
constexpr size_t WS_STATS = 45 * MiB;
constexpr size_t WS_SVT = 49 * MiB;
constexpr size_t WS_H = 65 * MiB;
constexpr size_t WS_P = 193 * MiB;
constexpr size_t WS_DN = 545 * MiB;
constexpr size_t WS_END = 801 * MiB;

struct Params {
    const float *x, *mem, *pre_g, *w_in, *conv_w, *a_log, *dt_bias, *sinks, *dn_g, *mem_g, *w_mkv, *w_out, *post_g;
    float* out;
    unsigned char* ws;
};

DI unsigned f2bf(float f) { unsigned u = __float_as_uint(f); return (u + 0x7fffu + ((u >> 16) & 1u)) >> 16; }
DI unsigned pk2(float lo, float hi) { return f2bf(lo) | (f2bf(hi) << 16); }
DI float bf2f(unsigned u) { return __uint_as_float(u << 16); }
DI float bflo(unsigned u) { return __uint_as_float(u << 16); }
DI float bfhi(unsigned u) { return __uint_as_float(u & 0xffff0000u); }
DI float wave_sum(float v) {
#pragma unroll
    for (int o = 1; o < 64; o <<= 1) v += __shfl_xor(v, o);
    return v;
}
DI float sigmoidf_(float x) { return 1.f / (1.f + __expf(-x)); }
DI float siluf_(float x) { return x / (1.f + __expf(-x)); }
DI float softplusf_(float x) { return x > 20.f ? x : log1pf(expf(x)); }

DI void transpose_item(const float* W, int Nsrc, int src_n0, int k0, bf16_t* WT, int K, int dst_n0, LAS float* scr, int lane) {
#pragma unroll 8
    for (int i = 0; i < 32; ++i) { const int kk = 2 * i + (lane >> 5); scr[kk * 33 + (lane & 31)] = W[(size_t)(k0 + kk) * Nsrc + src_n0 + (lane & 31)]; }
    asm volatile("s_waitcnt lgkmcnt(0)" ::: "memory");
    const int c = lane & 7;
#pragma unroll
    for (int j = 0; j < 4; ++j) {
        const int n = (lane >> 3) + 8 * j; const LAS float* s = scr + (8 * c) * 33 + n;
        u32x4 o; o.x = pk2(s[0 * 33], s[1 * 33]); o.y = pk2(s[2 * 33], s[3 * 33]); o.z = pk2(s[4 * 33], s[5 * 33]); o.w = pk2(s[6 * 33], s[7 * 33]);
        *(u32x4*)(WT + (size_t)(dst_n0 + n) * K + k0 + 8 * c) = o;
    }
    asm volatile("s_waitcnt lgkmcnt(0)" ::: "memory");
}

DI void phase_init(const Params& p, LAS unsigned char* lds, int gw, int ngw, int wave, int lane) {
    LAS float* scr = (LAS float*)(lds + wave * 16384);
    constexpr int I_IN = 16 * (NIN / 32), I_OUT = 16 * 32, I_MKV = 16 * 16, I_L = I_IN + I_OUT + I_MKV;
    for (int it = gw; it < DEPTH * I_L; it += ngw) {
        const int l = it / I_L; int r = it % I_L;
        if (r < I_IN) {
            const int kb = r / (NIN / 32), nb = r % (NIN / 32), n0 = nb * 32;
            transpose_item(p.w_in + (size_t)l * DM * INW, INW, n0 + (n0 >= 1536 ? 8 : 0), kb * 64, (bf16_t*)(p.ws + WS_WIN) + (size_t)l * NIN * DM, DM, n0, scr, lane);
        } else if (r < I_IN + I_OUT) {
            r -= I_IN; const int kb = r / 32, nb = r % 32;
            transpose_item(p.w_out + (size_t)l * DM * DM, DM, nb * 32, kb * 64, (bf16_t*)(p.ws + WS_WOUT) + (size_t)l * DM * DM, DM, nb * 32, scr, lane);
        } else {
            r -= I_IN + I_OUT; const int kb = r / 16, nb = r % 16;
            transpose_item(p.w_mkv + (size_t)l * DM * 512, 512, nb * 32, kb * 64, (bf16_t*)(p.ws + WS_WMKV) + (size_t)l * 512 * DM, DM, nb * 32, scr, lane);
        }
    }
    for (int e = gw * 64 + lane; e < DEPTH * 8 * DM; e += ngw * 64) {
        const int l = e / (8 * DM), c = (e / DM) % 8, k = e % DM;
        ((float*)(p.ws + WS_W8))[e] = p.w_in[(size_t)l * DM * INW + (size_t)k * INW + 1536 + c];
    }
    for (int it = gw; it < DEPTH * MEMROWS; it += ngw) {
        const int l = it / MEMROWS, row = it % MEMROWS;
        const f32x4* xr = (const f32x4*)(p.mem + (size_t)row * DM) + lane;
        f32x4 v[4]; float s = 0.f;
#pragma unroll
        for (int j = 0; j < 4; ++j) { v[j] = xr[64 * j]; s += (v[j].x * v[j].x + v[j].y * v[j].y) + (v[j].z * v[j].z + v[j].w * v[j].w); }
        const float r = rsqrtf(wave_sum(s) * (1.f / DM) + EPS);
        const f32x4* gr = (const f32x4*)(p.mem_g + (size_t)l * DM) + lane;
        u32x2* o = (u32x2*)((bf16_t*)(p.ws + WS_MEMN) + ((size_t)l * MEMROWS + row) * DM) + lane;
#pragma unroll
        for (int j = 0; j < 4; ++j) { const f32x4 g = gr[64 * j]; u32x2 w; w.x = pk2(v[j].x * r * g.x, v[j].y * r * g.y); w.y = pk2(v[j].z * r * g.z, v[j].w * r * g.w); o[64 * j] = w; }
    }
}

template <bool L1> DI void prep_row(const Params& p, int l, int row, int lane) {
    const f32x4* xr = (const f32x4*)(p.x + (size_t)row * DM) + lane;
    f32x4 v[4];
#pragma unroll
    for (int j = 0; j < 4; ++j) v[j] = xr[64 * j];
    if (L1) {
        const f32x4* st = (const f32x4*)((const float*)(p.ws + WS_STATS) + (size_t)row * 16);
        const f32x4 s0 = st[0], s1 = st[1], s2 = st[2], s3 = st[3];
        const float ss = ((s0.x + s0.y) + (s0.z + s0.w)) + ((s1.x + s1.y) + (s1.z + s1.w)) + ((s2.x + s2.y) + (s2.z + s2.w)) + ((s3.x + s3.y) + (s3.z + s3.w));
        const float ry = rsqrtf(ss * (1.f / DM) + EPS);
        const u32x2* yr = (const u32x2*)((const bf16_t*)(p.ws + WS_P) + (size_t)row * DM) + lane;
        const f32x4* pg = (const f32x4*)(p.post_g + (size_t)(l - 1) * DM) + lane;
        f32x4* xo = (f32x4*)(p.out + (size_t)row * DM) + lane;
#pragma unroll
        for (int j = 0; j < 4; ++j) {
            const u32x2 y = yr[64 * j]; const f32x4 g = pg[64 * j];
            v[j].x += bflo(y.x) * ry * g.x; v[j].y += bfhi(y.x) * ry * g.y; v[j].z += bflo(y.y) * ry * g.z; v[j].w += bfhi(y.y) * ry * g.w;
            xo[64 * j] = v[j];
        }
    }
    float s = 0.f;
#pragma unroll
    for (int j = 0; j < 4; ++j) s += (v[j].x * v[j].x + v[j].y * v[j].y) + (v[j].z * v[j].z + v[j].w * v[j].w);
    const float r = rsqrtf(wave_sum(s) * (1.f / DM) + EPS);
    const f32x4* gr = (const f32x4*)(p.pre_g + (size_t)l * DM) + lane;
    u32x2* ho = (u32x2*)((bf16_t*)(p.ws + WS_H) + (size_t)row * DM) + lane;
#pragma unroll
    for (int j = 0; j < 4; ++j) {
        const f32x4 g = gr[64 * j];
        v[j].x *= r * g.x; v[j].y *= r * g.y; v[j].z *= r * g.z; v[j].w *= r * g.w;
        u32x2 w; w.x = pk2(v[j].x, v[j].y); w.y = pk2(v[j].z, v[j].w); ho[64 * j] = w;
    }
    const float* W8 = (const float*)(p.ws + WS_W8) + (size_t)l * 8 * DM;
    float mine = 0.f;
#pragma unroll
    for (int c = 0; c < 8; ++c) {
        const f32x4* wr = (const f32x4*)(W8 + c * DM) + lane; float d = 0.f;
#pragma unroll
        for (int j = 0; j < 4; ++j) { const f32x4 w = wr[64 * j]; d += (v[j].x * w.x + v[j].y * w.y) + (v[j].z * w.z + v[j].w * w.w); }
        d = wave_sum(d);
        mine = (lane == c) ? d : mine;
    }
    if (lane < 8) {
        float o;
        if (lane < 4) o = sigmoidf_(mine);
        else { const int h = lane - 4; o = -__expf(p.a_log[l * 4 + h]) * softplusf_(mine + p.dt_bias[l * 4 + h]); }
        ((float*)(p.ws + WS_BA))[(size_t)row * 8 + lane] = o;
    }
}

DI void final_row(const Params& p, int row, int lane) {
    const f32x4* st = (const f32x4*)((const float*)(p.ws + WS_STATS) + (size_t)row * 16);
    const f32x4 s0 = st[0], s1 = st[1], s2 = st[2], s3 = st[3];
    const float ss = ((s0.x + s0.y) + (s0.z + s0.w)) + ((s1.x + s1.y) + (s1.z + s1.w)) + ((s2.x + s2.y) + (s2.z + s2.w)) + ((s3.x + s3.y) + (s3.z + s3.w));
    const float ry = rsqrtf(ss * (1.f / DM) + EPS);
    const u32x2* yr = (const u32x2*)((const bf16_t*)(p.ws + WS_P) + (size_t)row * DM) + lane;
    const f32x4* pg = (const f32x4*)(p.post_g + (size_t)(DEPTH - 1) * DM) + lane;
    f32x4* xo = (f32x4*)(p.out + (size_t)row * DM) + lane;
#pragma unroll
    for (int j = 0; j < 4; ++j) {
        const u32x2 y = yr[64 * j]; const f32x4 g = pg[64 * j]; f32x4 v = xo[64 * j];
        v.x += bflo(y.x) * ry * g.x; v.y += bfhi(y.x) * ry * g.y; v.z += bflo(y.y) * ry * g.z; v.w += bfhi(y.y) * ry * g.w;
        xo[64 * j] = v;
    }
}


namespace pg8 {
#define PG8_LAS __attribute__((address_space(3)))
typedef unsigned short bf16_t;
typedef short bf16x8 __attribute__((ext_vector_type(8)));
typedef float f32x4 __attribute__((ext_vector_type(4)));
typedef unsigned u32x4 __attribute__((ext_vector_type(4)));
constexpr int BM = 256, BK = 64, HALF = 128, HTB = HALF * BK * 2  , STAGE_BYTES = 8 * HTB, NXCD = 8, WGM = 8;

__host__ __device__ __forceinline__ int lds_byte(int r, int c) { const int st = (r >> 4) * 2 + (c >> 5), rr = r & 15, cc = c & 31, ob = rr * 64 + cc * 2; return st * 1024 + (ob ^ (((ob >> 9) & 1) << 5)); }
__host__ __device__ __forceinline__ void stage_rc(int b, int& R, int& C) { const int st = b / 1024, sb = b % 1024, swz = sb ^ (((sb >> 9) & 1) << 5); R = (st >> 1) * 16 + swz / 64; C = (st & 1) * 32 + (swz % 64) / 2; }
__host__ __device__ __forceinline__ int perm32(int rho) { const int n = rho >> 4, i = rho & 15; return 8 * (i >> 2) + 4 * n + (i & 3); }

struct Unit { int pm, pn; };
struct Gemm { const bf16_t* A; const bf16_t* Bt; int M, N, K; };

struct StaticOrder {
    int nM, nN, nwg, G, c;
    __host__ __device__ void init(int M, int N, int G_, int c_) { nM = M / BM; nN = N / BM; nwg = nM * nN; G = G_; c = c_; }
    __host__ __device__ bool next(int i, Unit& u) const {
        const long L = (long)i * G + c; if (L >= nwg) return false;
        int wgid = (int)L; { const int q = nwg / NXCD, r = nwg % NXCD, xcd = wgid % NXCD, off = wgid / NXCD; wgid = (xcd < r ? xcd * (q + 1) : r * (q + 1) + (xcd - r) * q) + off; }
        const int nig = WGM * nN, gid = wgid / nig, fm = gid * WGM, gsz = (nM - fm) < WGM ? (nM - fm) : WGM;
        u.pm = fm + ((wgid % nig) % gsz); u.pn = (wgid % nig) / gsz; return true;
    }
    __device__ __forceinline__ void a_ready(const Unit&) const {}
    __device__ __forceinline__ void done(const Unit&) const {}
};

__device__ __forceinline__ unsigned cvt_pk_bf16(float lo, float hi) { unsigned r; asm volatile("v_cvt_pk_bf16_f32 %0, %1, %2" : "=v"(r) : "v"(lo), "v"(hi)); return r; }
template <class Epi, class Sched, bool ALIGN_EPI = false, bool SP2 = false>
__device__ __forceinline__ void gemm_phase(PG8_LAS unsigned char* lds, const Gemm g, const Sched& S, const Epi& E) {
    const int tid = threadIdx.x, wid = __builtin_amdgcn_readfirstlane(tid >> 6), lane = tid & 63, wr = wid >> 2, wc = wid & 3, fr = lane & 15, fq = lane >> 4;
    const int K = g.K, nt = K / BK;
    unsigned voffA[2], voffB[2];
#pragma unroll
    for (int i = 0; i < 2; ++i) { int R, C; stage_rc(tid * 16 + i * 8192, R, C); const int Rb = Epi::PERM ? ((R & ~31) + perm32(R & 31)) : R;
        voffA[i] = (unsigned)(R * K + C) * 2u; voffB[i] = (unsigned)(Rb * K + C) * 2u; }
    const size_t kstep = (size_t)(BK * 2);
    const size_t hstep = (size_t)HALF * K * 2;
    const size_t tstep = 2 * hstep;
    const unsigned ldsw = (unsigned)wid * 1024u;
    const int aoff = lds_byte(wr * 64 + fr, fq * 8), boff = lds_byte(wc * 32 + fr, fq * 8);
#define PG8_SA(b, h) (((b) * 2 + (h)) * HTB)
#define PG8_SB(b, h) ((4 + (b) * 2 + (h)) * HTB)
#define PG8_STAGE(bufoff, gbase, voff) do { _Pragma("unroll") for (int _i = 0; _i < 2; ++_i) \
        __builtin_amdgcn_global_load_lds((const unsigned*)((const char*)(gbase) + (voff)[_i]), (PG8_LAS unsigned*)(lds + (bufoff) + ldsw + _i * 8192), 16, 0, 0); } while (0)
#define PG8_LDA(dst, b, h) do { _Pragma("unroll") for (int m = 0; m < 4; ++m) _Pragma("unroll") for (int k = 0; k < 2; ++k) dst[m][k] = *(const PG8_LAS bf16x8*)(lds + PG8_SA(b, h) + aoff + m * 2048 + k * 1024); } while (0)
#define PG8_LDB(dst, b, h) do { _Pragma("unroll") for (int n = 0; n < 2; ++n) _Pragma("unroll") for (int k = 0; k < 2; ++k) dst[n][k] = *(const PG8_LAS bf16x8*)(lds + PG8_SB(b, h) + boff + n * 2048 + k * 1024); } while (0)
#define PG8_MMA(ai, bj, At, Bt) do { __builtin_amdgcn_s_setprio(1); _Pragma("unroll") for (int m = 0; m < 4; ++m) _Pragma("unroll") for (int n = 0; n < 2; ++n) _Pragma("unroll") for (int k = 0; k < 2; ++k) \
        acc[ai][bj][m][n] = __builtin_amdgcn_mfma_f32_16x16x32_bf16(Bt[n][k], At[m][k], acc[ai][bj][m][n], 0, 0, 0); __builtin_amdgcn_s_setprio(0); } while (0)
#define PG8_WAIT_V(n) asm volatile("s_waitcnt vmcnt(" #n ")" ::: "memory")
#define PG8_WAIT_L(n) asm volatile("s_waitcnt lgkmcnt(" #n ")" ::: "memory")
#define PG8_BAR __builtin_amdgcn_s_barrier()
#define PG8_SCHED __builtin_amdgcn_sched_barrier(0)
    Unit cur, nxt; int ui = 0;
    if (!S.next(0, cur)) return;
    f32x4 acc[2][2][4][2];
#pragma unroll
    for (int a = 0; a < 2; ++a)
#pragma unroll
        for (int b = 0; b < 2; ++b)
#pragma unroll
            for (int m = 0; m < 4; ++m)
#pragma unroll
                for (int n = 0; n < 2; ++n) acc[a][b][m][n] = (f32x4){0.f, 0.f, 0.f, 0.f};
    bf16x8 At[4][2], B0[2][2], B1[2][2];
    const char* cA = (const char*)g.A + (size_t)cur.pm * tstep; const char* cB = (const char*)g.Bt + (size_t)cur.pn * tstep;
    S.a_ready(cur);
    if constexpr (SP2) {
        PG8_STAGE(PG8_SB(0, 0), cB, voffB); PG8_STAGE(PG8_SB(0, 1), cB + hstep, voffB); PG8_STAGE(PG8_SA(0, 0), cA, voffA); PG8_STAGE(PG8_SA(0, 1), cA + hstep, voffA);
        if (wr == 1) PG8_BAR;
        PG8_WAIT_V(2); PG8_BAR;
        PG8_STAGE(PG8_SB(1, 0), cB + kstep, voffB); PG8_STAGE(PG8_SA(1, 0), cA + kstep, voffA); PG8_STAGE(PG8_SB(1, 1), cB + hstep + kstep, voffB);
        PG8_WAIT_V(6); PG8_BAR;
    } else {
        PG8_STAGE(PG8_SB(0, 0), cB, voffB); PG8_STAGE(PG8_SA(0, 0), cA, voffA); PG8_STAGE(PG8_SB(0, 1), cB + hstep, voffB); PG8_STAGE(PG8_SA(0, 1), cA + hstep, voffA);
        if (wr == 1) PG8_BAR;
        PG8_WAIT_V(4); PG8_BAR;
        PG8_STAGE(PG8_SB(1, 0), cB + kstep, voffB); PG8_STAGE(PG8_SA(1, 0), cA + kstep, voffA); PG8_STAGE(PG8_SB(1, 1), cB + hstep + kstep, voffB);
        PG8_WAIT_V(6); PG8_BAR;
    }
    for (;;) {
        const bool has_next = S.next(ui + 1, nxt);
        const char* nA = has_next ? (const char*)g.A + (size_t)nxt.pm * tstep : cA; const char* nB = has_next ? (const char*)g.Bt + (size_t)nxt.pn * tstep : cB;
        for (int t = 0; t < nt; t += 2) {
            const bool last = (t == nt - 2);
            const char* a1 = cA + (size_t)(t + 1) * kstep;
            const char* a2 = last ? nA : cA + (size_t)(t + 2) * kstep; const char* b2 = last ? nB : cB + (size_t)(t + 2) * kstep;
            const char* a3 = a2 + kstep; const char* b3 = b2 + kstep;
            if (last && has_next) S.a_ready(nxt);
            if constexpr (SP2) {
            PG8_LDB(B0, 0, 0); PG8_LDB(B1, 0, 1); PG8_SCHED; PG8_LDA(At, 0, 0); PG8_STAGE(PG8_SA(1, 1), a1 + hstep, voffA);
            PG8_WAIT_V(8); PG8_WAIT_L(0); PG8_BAR; PG8_MMA(0, 0, At, B0); PG8_MMA(0, 1, At, B1); PG8_BAR; PG8_SCHED;
            PG8_LDA(At, 0, 1); PG8_STAGE(PG8_SB(0, 0), b2, voffB); PG8_STAGE(PG8_SB(0, 1), b2 + hstep, voffB); PG8_STAGE(PG8_SA(0, 0), a2, voffA);
            PG8_WAIT_V(8); PG8_WAIT_L(0); PG8_BAR; PG8_MMA(1, 0, At, B0); PG8_MMA(1, 1, At, B1); PG8_BAR; PG8_SCHED;
            PG8_LDB(B0, 1, 0); PG8_LDB(B1, 1, 1); PG8_SCHED; PG8_LDA(At, 1, 0); PG8_STAGE(PG8_SA(0, 1), a2 + hstep, voffA);
            PG8_WAIT_V(8); PG8_WAIT_L(0); PG8_BAR; PG8_MMA(0, 0, At, B0); PG8_MMA(0, 1, At, B1); PG8_BAR; PG8_SCHED;
            PG8_LDA(At, 1, 1); PG8_STAGE(PG8_SB(1, 0), b3, voffB); PG8_STAGE(PG8_SB(1, 1), b3 + hstep, voffB); PG8_STAGE(PG8_SA(1, 0), a3, voffA);
            PG8_WAIT_V(8); PG8_WAIT_L(0); PG8_BAR; PG8_MMA(1, 0, At, B0); PG8_MMA(1, 1, At, B1); PG8_BAR; PG8_SCHED;
            } else {
            PG8_LDB(B0, 0, 0); PG8_SCHED; PG8_LDA(At, 0, 0); PG8_STAGE(PG8_SA(1, 1), a1 + hstep, voffA);
            PG8_WAIT_L(8); PG8_BAR; PG8_WAIT_L(0); PG8_MMA(0, 0, At, B0); PG8_BAR; PG8_SCHED;
            PG8_LDB(B1, 0, 1); PG8_STAGE(PG8_SB(0, 0), b2, voffB);
            PG8_BAR; PG8_WAIT_L(0); PG8_MMA(0, 1, At, B1); PG8_BAR;
            PG8_LDA(At, 0, 1); PG8_STAGE(PG8_SA(0, 0), a2, voffA);
            PG8_BAR; PG8_WAIT_L(0); PG8_MMA(1, 0, At, B0); PG8_BAR; PG8_SCHED;
            PG8_STAGE(PG8_SB(0, 1), b2 + hstep, voffB);
            PG8_WAIT_V(6); PG8_BAR; PG8_MMA(1, 1, At, B1); PG8_BAR;
            PG8_LDB(B0, 1, 0); PG8_SCHED; PG8_LDA(At, 1, 0); PG8_STAGE(PG8_SA(0, 1), a2 + hstep, voffA);
            PG8_WAIT_L(8); PG8_BAR; PG8_WAIT_L(0); PG8_MMA(0, 0, At, B0); PG8_BAR; PG8_SCHED;
            PG8_LDB(B1, 1, 1); PG8_STAGE(PG8_SB(1, 0), b3, voffB);
            PG8_BAR; PG8_WAIT_L(0); PG8_MMA(0, 1, At, B1); PG8_BAR;
            PG8_LDA(At, 1, 1); PG8_STAGE(PG8_SA(1, 0), a3, voffA);
            PG8_BAR; PG8_WAIT_L(0); PG8_MMA(1, 0, At, B0); PG8_BAR; PG8_SCHED;
            PG8_STAGE(PG8_SB(1, 1), b3 + hstep, voffB);
            PG8_WAIT_V(6); PG8_BAR; PG8_MMA(1, 1, At, B1); PG8_BAR;
            }
        }
        if constexpr (ALIGN_EPI) { if (wr == 0) PG8_BAR; }
        if constexpr (!Epi::AFTER_DRAIN) { E(acc, cur, wr, wc, fr, fq); S.done(cur); }
        if (!has_next) break;
#pragma unroll
        for (int a = 0; a < 2; ++a)
#pragma unroll
            for (int b = 0; b < 2; ++b)
#pragma unroll
                for (int m = 0; m < 4; ++m)
#pragma unroll
                    for (int n = 0; n < 2; ++n) acc[a][b][m][n] = (f32x4){0.f, 0.f, 0.f, 0.f};
        cur = nxt; cA = nA; cB = nB; ++ui;
        if constexpr (ALIGN_EPI) { if (wr == 1) PG8_BAR; }
    }
    PG8_WAIT_V(0);
    if constexpr (!ALIGN_EPI) { if (wr == 0) PG8_BAR; }
    PG8_BAR;
    if constexpr (Epi::AFTER_DRAIN) { E.fused(acc, cur, wr, wc, fr, fq, lds, wid, lane); S.done(cur); }
#undef PG8_SA
#undef PG8_SB
#undef PG8_STAGE
#undef PG8_LDA
#undef PG8_LDB
#undef PG8_MMA
#undef PG8_WAIT_V
#undef PG8_WAIT_L
#undef PG8_BAR
#undef PG8_SCHED
}
}
using pg8::cvt_pk_bf16;
struct EpiProj {
    static constexpr bool PERM = true, AFTER_DRAIN = false;
    bf16_t* O; bf16_t* svT;
    DI void operator()(const f32x4 (&acc)[2][2][4][2], const pg8::Unit& u, int wr, int wc, int fr, int fq) const {
        const int row0 = u.pm * 256 + wr * 64 + fr, col0 = u.pn * 256 + wc * 32 + 8 * fq;
#pragma unroll
        for (int ai = 0; ai < 2; ++ai)
#pragma unroll
            for (int m = 0; m < 4; ++m) { bf16_t* rowp = O + (size_t)(row0 + ai * 128 + m * 16) * NIN + col0;
#pragma unroll
                for (int bj = 0; bj < 2; ++bj) { const f32x4 v0 = acc[ai][bj][m][0], v1 = acc[ai][bj][m][1];
                    u32x4 w; w.x = cvt_pk_bf16(v0[0], v0[1]); w.y = cvt_pk_bf16(v0[2], v0[3]); w.z = cvt_pk_bf16(v1[0], v1[1]); w.w = cvt_pk_bf16(v1[2], v1[3]);
                    *(u32x4*)(rowp + bj * 128) = w; } }
        if (u.pn == 2) {
#pragma unroll
            for (int ai = 0; ai < 2; ++ai)
#pragma unroll
                for (int m = 0; m < 4; ++m) { const int row = row0 + ai * 128 + m * 16, b = row >> 12, s = row & (SEQ - 1);
#pragma unroll
                    for (int n = 0; n < 2; ++n)
#pragma unroll
                        for (int e = 0; e < 4; ++e) { const int c = wc * 32 + 8 * fq + 4 * n + e;
                            svT[((size_t)(b * 2 + (c >> 6)) * 64 + (c & 63)) * SEQ + s] = (bf16_t)f2bf(acc[ai][1][m][n][e]); } }
        }
    }
};
struct EpiMkv {
    static constexpr bool PERM = true, AFTER_DRAIN = false;
    bf16_t* mk; bf16_t* mvT;
    DI void operator()(const f32x4 (&acc)[2][2][4][2], const pg8::Unit& u, int wr, int wc, int fr, int fq) const {
        const int row0 = u.pm * 256 + wr * 64 + fr;
#pragma unroll
        for (int ai = 0; ai < 2; ++ai)
#pragma unroll
            for (int m = 0; m < 4; ++m) { const int row = row0 + ai * 128 + m * 16;
                if (u.pn == 0) {
#pragma unroll
                    for (int bj = 0; bj < 2; ++bj) { const f32x4 v0 = acc[ai][bj][m][0], v1 = acc[ai][bj][m][1];
                        u32x4 w; w.x = cvt_pk_bf16(v0[0], v0[1]); w.y = cvt_pk_bf16(v0[2], v0[3]); w.z = cvt_pk_bf16(v1[0], v1[1]); w.w = cvt_pk_bf16(v1[2], v1[3]);
                        *(u32x4*)(mk + (size_t)row * 256 + bj * 128 + wc * 32 + 8 * fq) = w; }
                } else { const int b = row >> 8, mm = row & 255;
#pragma unroll
                    for (int bj = 0; bj < 2; ++bj)
#pragma unroll
                        for (int n = 0; n < 2; ++n)
#pragma unroll
                            for (int e = 0; e < 4; ++e) { const int c = bj * 128 + wc * 32 + 8 * fq + 4 * n + e;
                                mvT[((size_t)(b * 4 + (c >> 6)) * 64 + (c & 63)) * NMEM + mm] = (bf16_t)f2bf(acc[ai][bj][m][n][e]); } }
            }
    }
};
struct EpiY {
    static constexpr bool PERM = true, AFTER_DRAIN = false;
    bf16_t* Y; float* stats;
    DI void operator()(const f32x4 (&acc)[2][2][4][2], const pg8::Unit& u, int wr, int wc, int fr, int fq) const {
        const int row0 = u.pm * 256 + wr * 64 + fr, col0 = u.pn * 256 + wc * 32 + 8 * fq;
#pragma unroll
        for (int ai = 0; ai < 2; ++ai)
#pragma unroll
            for (int m = 0; m < 4; ++m) { const int row = row0 + ai * 128 + m * 16; bf16_t* rowp = Y + (size_t)row * DM + col0; float ss = 0.f;
#pragma unroll
                for (int bj = 0; bj < 2; ++bj) { const f32x4 v0 = acc[ai][bj][m][0], v1 = acc[ai][bj][m][1];
                    ss += (v0[0] * v0[0] + v0[1] * v0[1]) + (v0[2] * v0[2] + v0[3] * v0[3]) + (v1[0] * v1[0] + v1[1] * v1[1]) + (v1[2] * v1[2] + v1[3] * v1[3]);
                    u32x4 w; w.x = cvt_pk_bf16(v0[0], v0[1]); w.y = cvt_pk_bf16(v0[2], v0[3]); w.z = cvt_pk_bf16(v1[0], v1[1]); w.w = cvt_pk_bf16(v1[2], v1[3]);
                    *(u32x4*)(rowp + bj * 128) = w; }
                ss += __shfl_xor(ss, 16); ss += __shfl_xor(ss, 32);
                if (fq == 0) stats[(size_t)row * 16 + u.pn * 4 + wc] = ss; }
    }
};

enum { K_INIT = 0, K_PREP = 1, K_INPROJ = 2, K_DNPREP = 3, K_ATTN = 4, K_DNOUT = 5, K_OUTPROJ = 6, K_FINAL = 7 };
__global__ void __launch_bounds__(512, 2) mega(Params p, int kind, int l) {
    extern __shared__ __attribute__((aligned(16))) unsigned char lds_raw[];
    LAS unsigned char* lds = (LAS unsigned char*)lds_raw;
    const int tid = threadIdx.x, lane = tid & 63, wave = __builtin_amdgcn_readfirstlane(tid >> 6);
    const int G = gridDim.x;
    const int gw = blockIdx.x * 8 + wave, ngw = G * 8;
    unsigned char* ws = p.ws;
    if (kind == K_INIT) phase_init(p, lds, gw, ngw, wave, lane);
    else if (kind == K_PREP) {
        if (l == 0) { for (int row = gw; row < NTOK; row += ngw) prep_row<false>(p, 0, row, lane); }
        else { for (int row = gw; row < NTOK; row += ngw) prep_row<true>(p, l, row, lane); }
    } else if (kind == K_INPROJ) {
        { pg8::Gemm g{(const bf16_t*)(ws + WS_H), (const bf16_t*)(ws + WS_WIN) + (size_t)l * NIN * DM, NTOK, NIN, DM};
          pg8::StaticOrder S; S.init(NTOK, NIN, G, (int)blockIdx.x);
          EpiProj E{(bf16_t*)(ws + WS_P), (bf16_t*)(ws + WS_SVT)};
          pg8::gemm_phase<EpiProj, pg8::StaticOrder, true, true>(lds, g, S, E); }
        if (l == 0) {
            for (int ll = 0; ll < DEPTH; ++ll) {
                pg8::Gemm g{(const bf16_t*)(ws + WS_MEMN) + (size_t)ll * MEMROWS * DM, (const bf16_t*)(ws + WS_WMKV) + (size_t)ll * 512 * DM, MEMROWS, 512, DM};
                pg8::StaticOrder S; S.init(MEMROWS, 512, G, (int)((blockIdx.x + G - 32 * ll) % G));
                EpiMkv E{(bf16_t*)(ws + WS_MK) + (size_t)ll * MEMROWS * 256, (bf16_t*)(ws + WS_MVT) + (size_t)ll * MEMROWS * 256};
                pg8::gemm_phase<EpiMkv, pg8::StaticOrder, true, true>(lds, g, S, E);
            }
        }
    } else if (kind == K_OUTPROJ) {
        pg8::Gemm g{(const bf16_t*)(ws + WS_H), (const bf16_t*)(ws + WS_WOUT) + (size_t)l * DM * DM, NTOK, DM, DM};
        pg8::StaticOrder S; S.init(NTOK, DM, G, (int)blockIdx.x);
        EpiY E{(bf16_t*)(ws + WS_P), (float*)(ws + WS_STATS)};
        pg8::gemm_phase<EpiY, pg8::StaticOrder, true, true>(lds, g, S, E);
    } else if (kind == K_FINAL) {
        for (int row = gw; row < NTOK; row += ngw) final_row(p, row, lane);
    }
}

__global__ void __launch_bounds__(256) naive_gemm(const bf16_t* A, const bf16_t* Bt, int M, int N, int K, int mode, bf16_t* O0, bf16_t* O1) {
    __shared__ float sA[32][65], sB[32][65];
    const int tid = threadIdx.x, tx = tid & 15, ty = tid >> 4;
    const int m0 = blockIdx.y * 64, n0 = blockIdx.x * 64;
    float acc[4][4];
#pragma unroll
    for (int i = 0; i < 4; ++i)
#pragma unroll
        for (int j = 0; j < 4; ++j) acc[i][j] = 0.f;
    for (int k0 = 0; k0 < K; k0 += 32) {
        { const int r = tid >> 2, kc = (tid & 3) * 8;
          const u32x4 a = *(const u32x4*)(A + (size_t)(m0 + r) * K + k0 + kc), b = *(const u32x4*)(Bt + (size_t)(n0 + r) * K + k0 + kc);
          sA[kc + 0][r] = bflo(a.x); sA[kc + 1][r] = bfhi(a.x); sA[kc + 2][r] = bflo(a.y); sA[kc + 3][r] = bfhi(a.y); sA[kc + 4][r] = bflo(a.z); sA[kc + 5][r] = bfhi(a.z); sA[kc + 6][r] = bflo(a.w); sA[kc + 7][r] = bfhi(a.w);
          sB[kc + 0][r] = bflo(b.x); sB[kc + 1][r] = bfhi(b.x); sB[kc + 2][r] = bflo(b.y); sB[kc + 3][r] = bfhi(b.y); sB[kc + 4][r] = bflo(b.z); sB[kc + 5][r] = bfhi(b.z); sB[kc + 6][r] = bflo(b.w); sB[kc + 7][r] = bfhi(b.w); }
        __syncthreads();
#pragma unroll 8
        for (int k = 0; k < 32; ++k) {
            float a[4], b[4];
#pragma unroll
            for (int i = 0; i < 4; ++i) { a[i] = sA[k][ty * 4 + i]; b[i] = sB[k][tx * 4 + i]; }
#pragma unroll
            for (int i = 0; i < 4; ++i)
#pragma unroll
                for (int j = 0; j < 4; ++j) acc[i][j] += a[i] * b[j];
        }
        __syncthreads();
    }
#pragma unroll
    for (int i = 0; i < 4; ++i)
#pragma unroll
        for (int j = 0; j < 4; ++j) {
            const int row = m0 + ty * 4 + i, col = n0 + tx * 4 + j; const bf16_t v = (bf16_t)f2bf(acc[i][j]);
            if (mode == 0) {
                O0[(size_t)row * NIN + col] = v;
                if (col >= C_SV && col < C_SV + 128) { const int b = row / SEQ, s = row % SEQ, c = col - C_SV; O1[((size_t)(b * 2 + c / 64) * 64 + (c % 64)) * SEQ + s] = v; }
            } else if (mode == 1) {
                if (col < 256) O0[(size_t)row * 256 + col] = v;
                else { const int b = row / NMEM, m = row % NMEM, c = col - 256; O1[((size_t)(b * 4 + c / 64) * 64 + (c % 64)) * NMEM + m] = v; }
            } else {
                O0[(size_t)row * DM + col] = v;
            }
        }
}
__global__ void __launch_bounds__(256) naive_stats(const bf16_t* Y, float* stats) {
    const int lane = threadIdx.x & 63, row = blockIdx.x * 4 + (threadIdx.x >> 6);
    const u32x2* yr = (const u32x2*)(Y + (size_t)row * DM) + lane; float s = 0.f;
#pragma unroll
    for (int j = 0; j < 4; ++j) { const u32x2 y = yr[64 * j]; const float a = bflo(y.x), b = bfhi(y.x), c = bflo(y.y), d = bfhi(y.y); s += (a * a + b * b) + (c * c + d * d); }
    s = wave_sum(s);
    if (lane < 16) stats[(size_t)row * 16 + lane] = lane == 0 ? s : 0.f;
}
__global__ void __launch_bounds__(256) naive_attn(Params p, int l) {
    const int gid = blockIdx.x * 256 + threadIdx.x; const int row = gid / 12, hh = gid % 12;
    const bf16_t* P = (const bf16_t*)(p.ws + WS_P);
    const int b = row / SEQ, s = row % SEQ;
    float q[64], o[64];
    const bool swa = hh < 8;
    const int qcol = swa ? C_SQ + hh * 64 : C_MQ + (hh - 8) * 64;
#pragma unroll
    for (int d = 0; d < 64; ++d) { q[d] = bf2f(P[(size_t)row * NIN + qcol + d]) * 0.125f; o[d] = 0.f; }
    float m, lsum;
    if (swa) { m = p.sinks[l * 8 + hh]; lsum = 1.f; } else { m = -1e30f; lsum = 0.f; }
    const int nk = swa ? 128 : 256;
    const bf16_t* svT = (const bf16_t*)(p.ws + WS_SVT);
    const bf16_t* mk = (const bf16_t*)(p.ws + WS_MK) + (size_t)l * MEMROWS * 256;
    const bf16_t* mvT = (const bf16_t*)(p.ws + WS_MVT) + (size_t)l * MEMROWS * 256;
    for (int jj = 0; jj < nk; ++jj) {
        const bf16_t* kp; const bf16_t* vp; size_t vstride;
        if (swa) { const int j = s - 127 + jj; if (j < 0) continue; const int kvh = hh >> 2;
            kp = P + (size_t)(b * SEQ + j) * NIN + C_SK + kvh * 64; vp = svT + ((size_t)(b * 2 + kvh) * 64) * SEQ + j; vstride = SEQ; }
        else { const int hm = hh - 8; kp = mk + (size_t)(b * NMEM + jj) * 256 + hm * 64; vp = mvT + ((size_t)(b * 4 + hm) * 64) * NMEM + jj; vstride = NMEM; }
        float sc = 0.f;
#pragma unroll
        for (int d = 0; d < 64; ++d) sc += q[d] * bf2f(kp[d]);
        const float mn = fmaxf(m, sc), f = __expf(m - mn), pe = __expf(sc - mn);
        lsum = lsum * f + pe; m = mn;
#pragma unroll
        for (int d = 0; d < 64; ++d) o[d] = o[d] * f + pe * bf2f(vp[(size_t)d * vstride]);
    }
    const float inv = 1.f / lsum;
    const int mcol = swa ? hh * 64 : 768 + (hh - 8) * 64;
    bf16_t* MIX = (bf16_t*)(p.ws + WS_H);
#pragma unroll
    for (int d = 0; d < 64; ++d) { const float g = bf2f(P[(size_t)row * NIN + C_GATE + mcol + d]); MIX[(size_t)row * DM + mcol + d] = (bf16_t)f2bf(o[d] * inv * siluf_(g)); }
}
__global__ void __launch_bounds__(64) naive_dn(Params p, int l) {
    const int b = blockIdx.x >> 2, h = blockIdx.x & 3, j = threadIdx.x;
    const bf16_t* P = (const bf16_t*)(p.ws + WS_P);
    const float* BA = (const float*)(p.ws + WS_BA);
    bf16_t* MIX = (bf16_t*)(p.ws + WS_H);
    const float* cw = p.conv_w + (size_t)l * 4 * 768;
    float wq[4], wk[4], wv[4];
#pragma unroll
    for (int t = 0; t < 4; ++t) { wq[t] = cw[t * 768 + h * 64 + j]; wk[t] = cw[t * 768 + 256 + h * 64 + j]; wv[t] = cw[t * 768 + 512 + h * 64 + j]; }
    const float gn = p.dn_g[l * 64 + j];
    float S[64];
#pragma unroll
    for (int i = 0; i < 64; ++i) S[i] = 0.f;
    float xq[4] = {0.f, 0.f, 0.f, 0.f}, xk[4] = {0.f, 0.f, 0.f, 0.f}, xv[4] = {0.f, 0.f, 0.f, 0.f};
    for (int t = 0; t < SEQ; ++t) {
        const size_t row = (size_t)b * SEQ + t;
        xq[0] = xq[1]; xq[1] = xq[2]; xq[2] = xq[3]; xq[3] = bf2f(P[row * NIN + C_DQ + h * 64 + j]);
        xk[0] = xk[1]; xk[1] = xk[2]; xk[2] = xk[3]; xk[3] = bf2f(P[row * NIN + C_DK + h * 64 + j]);
        xv[0] = xv[1]; xv[1] = xv[2]; xv[2] = xv[3]; xv[3] = bf2f(P[row * NIN + C_DV + h * 64 + j]);
        float cq = siluf_(wq[0] * xq[0] + wq[1] * xq[1] + wq[2] * xq[2] + wq[3] * xq[3]);
        float ck = siluf_(wk[0] * xk[0] + wk[1] * xk[1] + wk[2] * xk[2] + wk[3] * xk[3]);
        const float cv = siluf_(wv[0] * xv[0] + wv[1] * xv[1] + wv[2] * xv[2] + wv[3] * xv[3]);
        cq *= rsqrtf(wave_sum(cq * cq) + EPS) * 0.125f;
        ck *= rsqrtf(wave_sum(ck * ck) + EPS);
        const float beta = BA[row * 8 + h], a = __expf(BA[row * 8 + 4 + h]);
        float ks = 0.f;
#pragma unroll
        for (int i = 0; i < 64; ++i) ks += __shfl(ck, i) * S[i];
        const float dv = beta * (cv - a * ks);
        float oj = 0.f;
#pragma unroll
        for (int i = 0; i < 64; ++i) { S[i] = a * S[i] + __shfl(ck, i) * dv; oj += __shfl(cq, i) * S[i]; }
        const float r = rsqrtf(wave_sum(oj * oj) * (1.f / 64.f) + EPS);
        const int mcol = 512 + h * 64 + j;
        const float g = bf2f(P[row * NIN + C_GATE + mcol]);
        MIX[row * DM + mcol] = (bf16_t)f2bf(oj * r * gn * siluf_(g));
    }
}

extern "C" void kernel_launch(void* const* d_in, const int* in_sizes, int n_in, void* d_out, int out_size, void* d_ws, size_t ws_size, hipStream_t stream) {
    static int inited = 0;
    constexpr int LDS_BYTES = 147456;
    if (!inited) {
        if (n_in != 13 || ws_size < WS_END) { fprintf(stderr, "kernel_launch: unexpected n_in %d / ws_size %zu\n", n_in, ws_size); inited = -1; return; }
        (void)hipFuncSetAttribute((const void*)mega, hipFuncAttributeMaxDynamicSharedMemorySize, LDS_BYTES);
        inited = 1;
    }
    if (inited < 0) return;
    Params p{};
    p.x = (const float*)d_in[0]; p.mem = (const float*)d_in[1]; p.pre_g = (const float*)d_in[2]; p.w_in = (const float*)d_in[3]; p.conv_w = (const float*)d_in[4];
    p.a_log = (const float*)d_in[5]; p.dt_bias = (const float*)d_in[6]; p.sinks = (const float*)d_in[7]; p.dn_g = (const float*)d_in[8]; p.mem_g = (const float*)d_in[9];
    p.w_mkv = (const float*)d_in[10]; p.w_out = (const float*)d_in[11]; p.post_g = (const float*)d_in[12];
    p.out = (float*)d_out; p.ws = (unsigned char*)d_ws;
    const int G = 256;
#define PH(kind, l) hipLaunchKernelGGL(mega, dim3(G), dim3(512), LDS_BYTES, stream, p, (int)(kind), (int)(l))
    PH(K_INIT, 0);
    PH(K_PREP, 0);
    for (int l = 0; l < DEPTH; ++l) {
        PH(K_INPROJ, l);
        hipLaunchKernelGGL(naive_attn, dim3(NTOK * 12 / 256), dim3(256), 0, stream, p, l);
        hipLaunchKernelGGL(naive_dn, dim3(NB * 4), dim3(64), 0, stream, p, l);
        PH(K_OUTPROJ, l);
        if (l + 1 < DEPTH) PH(K_PREP, l + 1); else PH(K_FINAL, 0);
    }
#undef PH
}
```

```cpp
#include <hip/hip_runtime.h>
#include <cstdio>
#include <cstdint>

#define DI __device__ __forceinline__
#define LAS __attribute__((address_space(3)))
typedef unsigned short bf16_t;
typedef float f32x4 __attribute__((ext_vector_type(4)));
typedef unsigned u32x4 __attribute__((ext_vector_type(4)));
typedef unsigned u32x2 __attribute__((ext_vector_type(2)));

constexpr int DM = 1024, NB = 16, SEQ = 4096, NTOK = NB * SEQ, DEPTH = 2;
constexpr int INW = 2824;
constexpr int NIN = 2816;
constexpr int NMEM = 256, MEMROWS = NB * NMEM;
constexpr float EPS = 1e-6f;
constexpr int C_SQ = 0, C_SK = 512, C_SV = 640, C_DQ = 768, C_DK = 1024, C_DV = 1280, C_MQ = 1536, C_GATE = 1792;

constexpr size_t MiB = 1u << 20;
constexpr size_t WS_CTL = 0;
constexpr size_t WS_WIN = 1 * MiB;
constexpr size_t WS_WOUT = 12 * MiB;
constexpr size_t WS_WMKV = 16 * MiB;
constexpr size_t WS_W8 = 18 * MiB;
constexpr size_t WS_MEMN = 19 * MiB;
constexpr size_t WS_MK = 35 * MiB;
constexpr size_t WS_MVT = 39 * MiB;
constexpr size_t WS_BA = 43 * MiB;
constexpr size_t WS_STATS = 45 * MiB;
constexpr size_t WS_SVT = 49 * MiB;
constexpr size_t WS_H = 65 * MiB;
constexpr size_t WS_P = 193 * MiB;
constexpr size_t WS_DN = 545 * MiB;
constexpr size_t WS_END = 801 * MiB;

struct Params {
    const float *x, *mem, *pre_g, *w_in, *conv_w, *a_log, *dt_bias, *sinks, *dn_g, *mem_g, *w_mkv, *w_out, *post_g;
    float* out;
    unsigned char* ws;
};

DI unsigned f2bf(float f) { unsigned u = __float_as_uint(f); return (u + 0x7fffu + ((u >> 16) & 1u)) >> 16; }
DI unsigned pk2(float lo, float hi) { return f2bf(lo) | (f2bf(hi) << 16); }
DI float bf2f(unsigned u) { return __uint_as_float(u << 16); }
DI float bflo(unsigned u) { return __uint_as_float(u << 16); }
DI float bfhi(unsigned u) { return __uint_as_float(u & 0xffff0000u); }
DI float wave_sum(float v) {
#pragma unroll
    for (int o = 1; o < 64; o <<= 1) v += __shfl_xor(v, o);
    return v;
}
DI float sigmoidf_(float x) { return 1.f / (1.f + __expf(-x)); }
DI float siluf_(float x) { return x / (1.f + __expf(-x)); }
DI float softplusf_(float x) { return x > 20.f ? x : log1pf(expf(x)); }

DI void transpose_item(const float* W, int Nsrc, int src_n0, int k0, bf16_t* WT, int K, int dst_n0, LAS float* scr, int lane) {
#pragma unroll 8
    for (int i = 0; i < 32; ++i) { const int kk = 2 * i + (lane >> 5); scr[kk * 33 + (lane & 31)] = W[(size_t)(k0 + kk) * Nsrc + src_n0 + (lane & 31)]; }
    asm volatile("s_waitcnt lgkmcnt(0)" ::: "memory");
    const int c = lane & 7;
#pragma unroll
    for (int j = 0; j < 4; ++j) {
        const int n = (lane >> 3) + 8 * j; const LAS float* s = scr + (8 * c) * 33 + n;
        u32x4 o; o.x = pk2(s[0 * 33], s[1 * 33]); o.y = pk2(s[2 * 33], s[3 * 33]); o.z = pk2(s[4 * 33], s[5 * 33]); o.w = pk2(s[6 * 33], s[7 * 33]);
        *(u32x4*)(WT + (size_t)(dst_n0 + n) * K + k0 + 8 * c) = o;
    }
    asm volatile("s_waitcnt lgkmcnt(0)" ::: "memory");
}

DI void phase_init(const Params& p, LAS unsigned char* lds, int gw, int ngw, int wave, int lane) {
    LAS float* scr = (LAS float*)(lds + wave * 16384);
    constexpr int I_IN = 16 * (NIN / 32), I_OUT = 16 * 32, I_MKV = 16 * 16, I_L = I_IN + I_OUT + I_MKV;
    for (int it = gw; it < DEPTH * I_L; it += ngw) {
        const int l = it / I_L; int r = it % I_L;
        if (r < I_IN) {
            const int kb = r / (NIN / 32), nb = r % (NIN / 32), n0 = nb * 32;
            transpose_item(p.w_in + (size_t)l * DM * INW, INW, n0 + (n0 >= 1536 ? 8 : 0), kb * 64, (bf16_t*)(p.ws + WS_WIN) + (size_t)l * NIN * DM, DM, n0, scr, lane);
        } else if (r < I_IN + I_OUT) {
            r -= I_IN; const int kb = r / 32, nb = r % 32;
            transpose_item(p.w_out + (size_t)l * DM * DM, DM, nb * 32, kb * 64, (bf16_t*)(p.ws + WS_WOUT) + (size_t)l * DM * DM, DM, nb * 32, scr, lane);
        } else {
            r -= I_IN + I_OUT; const int kb = r / 16, nb = r % 16;
            transpose_item(p.w_mkv + (size_t)l * DM * 512, 512, nb * 32, kb * 64, (bf16_t*)(p.ws + WS_WMKV) + (size_t)l * 512 * DM, DM, nb * 32, scr, lane);
        }
    }
    for (int e = gw * 64 + lane; e < DEPTH * 8 * DM; e += ngw * 64) {
        const int l = e / (8 * DM), c = (e / DM) % 8, k = e % DM;
        ((float*)(p.ws + WS_W8))[e] = p.w_in[(size_t)l * DM * INW + (size_t)k * INW + 1536 + c];
    }
    for (int it = gw; it < DEPTH * MEMROWS; it += ngw) {
        const int l = it / MEMROWS, row = it % MEMROWS;
        const f32x4* xr = (const f32x4*)(p.mem + (size_t)row * DM) + lane;
        f32x4 v[4]; float s = 0.f;
#pragma unroll
        for (int j = 0; j < 4; ++j) { v[j] = xr[64 * j]; s += (v[j].x * v[j].x + v[j].y * v[j].y) + (v[j].z * v[j].z + v[j].w * v[j].w); }
        const float r = rsqrtf(wave_sum(s) * (1.f / DM) + EPS);
        const f32x4* gr = (const f32x4*)(p.mem_g + (size_t)l * DM) + lane;
        u32x2* o = (u32x2*)((bf16_t*)(p.ws + WS_MEMN) + ((size_t)l * MEMROWS + row) * DM) + lane;
#pragma unroll
        for (int j = 0; j < 4; ++j) { const f32x4 g = gr[64 * j]; u32x2 w; w.x = pk2(v[j].x * r * g.x, v[j].y * r * g.y); w.y = pk2(v[j].z * r * g.z, v[j].w * r * g.w); o[64 * j] = w; }
    }
}

template <bool L1> DI void prep_row(const Params& p, int l, int row, int lane) {
    const f32x4* xr = (const f32x4*)(p.x + (size_t)row * DM) + lane;
    f32x4 v[4];
#pragma unroll
    for (int j = 0; j < 4; ++j) v[j] = xr[64 * j];
    if (L1) {
        const f32x4* st = (const f32x4*)((const float*)(p.ws + WS_STATS) + (size_t)row * 16);
        const f32x4 s0 = st[0], s1 = st[1], s2 = st[2], s3 = st[3];
        const float ss = ((s0.x + s0.y) + (s0.z + s0.w)) + ((s1.x + s1.y) + (s1.z + s1.w)) + ((s2.x + s2.y) + (s2.z + s2.w)) + ((s3.x + s3.y) + (s3.z + s3.w));
        const float ry = rsqrtf(ss * (1.f / DM) + EPS);
        const u32x2* yr = (const u32x2*)((const bf16_t*)(p.ws + WS_P) + (size_t)row * DM) + lane;
        const f32x4* pg = (const f32x4*)(p.post_g + (size_t)(l - 1) * DM) + lane;
        f32x4* xo = (f32x4*)(p.out + (size_t)row * DM) + lane;
#pragma unroll
        for (int j = 0; j < 4; ++j) {
            const u32x2 y = yr[64 * j]; const f32x4 g = pg[64 * j];
            v[j].x += bflo(y.x) * ry * g.x; v[j].y += bfhi(y.x) * ry * g.y; v[j].z += bflo(y.y) * ry * g.z; v[j].w += bfhi(y.y) * ry * g.w;
            xo[64 * j] = v[j];
        }
    }
    float s = 0.f;
#pragma unroll
    for (int j = 0; j < 4; ++j) s += (v[j].x * v[j].x + v[j].y * v[j].y) + (v[j].z * v[j].z + v[j].w * v[j].w);
    const float r = rsqrtf(wave_sum(s) * (1.f / DM) + EPS);
    const f32x4* gr = (const f32x4*)(p.pre_g + (size_t)l * DM) + lane;
    u32x2* ho = (u32x2*)((bf16_t*)(p.ws + WS_H) + (size_t)row * DM) + lane;
#pragma unroll
    for (int j = 0; j < 4; ++j) {
        const f32x4 g = gr[64 * j];
        v[j].x *= r * g.x; v[j].y *= r * g.y; v[j].z *= r * g.z; v[j].w *= r * g.w;
        u32x2 w; w.x = pk2(v[j].x, v[j].y); w.y = pk2(v[j].z, v[j].w); ho[64 * j] = w;
    }
    const float* W8 = (const float*)(p.ws + WS_W8) + (size_t)l * 8 * DM;
    float mine = 0.f;
#pragma unroll
    for (int c = 0; c < 8; ++c) {
        const f32x4* wr = (const f32x4*)(W8 + c * DM) + lane; float d = 0.f;
#pragma unroll
        for (int j = 0; j < 4; ++j) { const f32x4 w = wr[64 * j]; d += (v[j].x * w.x + v[j].y * w.y) + (v[j].z * w.z + v[j].w * w.w); }
        d = wave_sum(d);
        mine = (lane == c) ? d : mine;
    }
    if (lane < 8) {
        float o;
        if (lane < 4) o = sigmoidf_(mine);
        else { const int h = lane - 4; o = -__expf(p.a_log[l * 4 + h]) * softplusf_(mine + p.dt_bias[l * 4 + h]); }
        ((float*)(p.ws + WS_BA))[(size_t)row * 8 + lane] = o;
    }
}

DI void final_row(const Params& p, int row, int lane) {
    const f32x4* st = (const f32x4*)((const float*)(p.ws + WS_STATS) + (size_t)row * 16);
    const f32x4 s0 = st[0], s1 = st[1], s2 = st[2], s3 = st[3];
    const float ss = ((s0.x + s0.y) + (s0.z + s0.w)) + ((s1.x + s1.y) + (s1.z + s1.w)) + ((s2.x + s2.y) + (s2.z + s2.w)) + ((s3.x + s3.y) + (s3.z + s3.w));
    const float ry = rsqrtf(ss * (1.f / DM) + EPS);
    const u32x2* yr = (const u32x2*)((const bf16_t*)(p.ws + WS_P) + (size_t)row * DM) + lane;
    const f32x4* pg = (const f32x4*)(p.post_g + (size_t)(DEPTH - 1) * DM) + lane;
    f32x4* xo = (f32x4*)(p.out + (size_t)row * DM) + lane;
#pragma unroll
    for (int j = 0; j < 4; ++j) {
        const u32x2 y = yr[64 * j]; const f32x4 g = pg[64 * j]; f32x4 v = xo[64 * j];
        v.x += bflo(y.x) * ry * g.x; v.y += bfhi(y.x) * ry * g.y; v.z += bflo(y.y) * ry * g.z; v.w += bfhi(y.y) * ry * g.w;
        xo[64 * j] = v;
    }
}


namespace pg8 {
#define PG8_LAS __attribute__((address_space(3)))
typedef unsigned short bf16_t;
typedef short bf16x8 __attribute__((ext_vector_type(8)));
typedef float f32x4 __attribute__((ext_vector_type(4)));
typedef unsigned u32x4 __attribute__((ext_vector_type(4)));
constexpr int BM = 256, BK = 64, HALF = 128, HTB = HALF * BK * 2  , STAGE_BYTES = 8 * HTB, NXCD = 8, WGM = 8;

__host__ __device__ __forceinline__ int lds_byte(int r, int c) { const int st = (r >> 4) * 2 + (c >> 5), rr = r & 15, cc = c & 31, ob = rr * 64 + cc * 2; return st * 1024 + (ob ^ (((ob >> 9) & 1) << 5)); }
__host__ __device__ __forceinline__ void stage_rc(int b, int& R, int& C) { const int st = b / 1024, sb = b % 1024, swz = sb ^ (((sb >> 9) & 1) << 5); R = (st >> 1) * 16 + swz / 64; C = (st & 1) * 32 + (swz % 64) / 2; }
__host__ __device__ __forceinline__ int perm32(int rho) { const int n = rho >> 4, i = rho & 15; return 8 * (i >> 2) + 4 * n + (i & 3); }

struct Unit { int pm, pn; };
struct Gemm { const bf16_t* A; const bf16_t* Bt; int M, N, K; };

struct StaticOrder {
    int nM, nN, nwg, G, c;
    __host__ __device__ void init(int M, int N, int G_, int c_) { nM = M / BM; nN = N / BM; nwg = nM * nN; G = G_; c = c_; }
    __host__ __device__ bool next(int i, Unit& u) const {
        const long L = (long)i * G + c; if (L >= nwg) return false;
        int wgid = (int)L; { const int q = nwg / NXCD, r = nwg % NXCD, xcd = wgid % NXCD, off = wgid / NXCD; wgid = (xcd < r ? xcd * (q + 1) : r * (q + 1) + (xcd - r) * q) + off; }
        const int nig = WGM * nN, gid = wgid / nig, fm = gid * WGM, gsz = (nM - fm) < WGM ? (nM - fm) : WGM;
        u.pm = fm + ((wgid % nig) % gsz); u.pn = (wgid % nig) / gsz; return true;
    }
    __device__ __forceinline__ void a_ready(const Unit&) const {}
    __device__ __forceinline__ void done(const Unit&) const {}
};

__device__ __forceinline__ unsigned cvt_pk_bf16(float lo, float hi) { unsigned r; asm volatile("v_cvt_pk_bf16_f32 %0, %1, %2" : "=v"(r) : "v"(lo), "v"(hi)); return r; }
template <class Epi, class Sched, bool ALIGN_EPI = false, bool SP2 = false>
__device__ __forceinline__ void gemm_phase(PG8_LAS unsigned char* lds, const Gemm g, const Sched& S, const Epi& E) {
    const int tid = threadIdx.x, wid = __builtin_amdgcn_readfirstlane(tid >> 6), lane = tid & 63, wr = wid >> 2, wc = wid & 3, fr = lane & 15, fq = lane >> 4;
    const int K = g.K, nt = K / BK;
    unsigned voffA[2], voffB[2];
#pragma unroll
    for (int i = 0; i < 2; ++i) { int R, C; stage_rc(tid * 16 + i * 8192, R, C); const int Rb = Epi::PERM ? ((R & ~31) + perm32(R & 31)) : R;
        voffA[i] = (unsigned)(R * K + C) * 2u; voffB[i] = (unsigned)(Rb * K + C) * 2u; }
    const size_t kstep = (size_t)(BK * 2);
    const size_t hstep = (size_t)HALF * K * 2;
    const size_t tstep = 2 * hstep;
    const unsigned ldsw = (unsigned)wid * 1024u;
    const int aoff = lds_byte(wr * 64 + fr, fq * 8), boff = lds_byte(wc * 32 + fr, fq * 8);
#define PG8_SA(b, h) (((b) * 2 + (h)) * HTB)
#define PG8_SB(b, h) ((4 + (b) * 2 + (h)) * HTB)
#define PG8_STAGE(bufoff, gbase, voff) do { _Pragma("unroll") for (int _i = 0; _i < 2; ++_i) \
        __builtin_amdgcn_global_load_lds((const unsigned*)((const char*)(gbase) + (voff)[_i]), (PG8_LAS unsigned*)(lds + (bufoff) + ldsw + _i * 8192), 16, 0, 0); } while (0)
#define PG8_LDA(dst, b, h) do { _Pragma("unroll") for (int m = 0; m < 4; ++m) _Pragma("unroll") for (int k = 0; k < 2; ++k) dst[m][k] = *(const PG8_LAS bf16x8*)(lds + PG8_SA(b, h) + aoff + m * 2048 + k * 1024); } while (0)
#define PG8_LDB(dst, b, h) do { _Pragma("unroll") for (int n = 0; n < 2; ++n) _Pragma("unroll") for (int k = 0; k < 2; ++k) dst[n][k] = *(const PG8_LAS bf16x8*)(lds + PG8_SB(b, h) + boff + n * 2048 + k * 1024); } while (0)
#define PG8_MMA(ai, bj, At, Bt) do { __builtin_amdgcn_s_setprio(1); _Pragma("unroll") for (int m = 0; m < 4; ++m) _Pragma("unroll") for (int n = 0; n < 2; ++n) _Pragma("unroll") for (int k = 0; k < 2; ++k) \
        acc[ai][bj][m][n] = __builtin_amdgcn_mfma_f32_16x16x32_bf16(Bt[n][k], At[m][k], acc[ai][bj][m][n], 0, 0, 0); __builtin_amdgcn_s_setprio(0); } while (0)
#define PG8_WAIT_V(n) asm volatile("s_waitcnt vmcnt(" #n ")" ::: "memory")
#define PG8_WAIT_L(n) asm volatile("s_waitcnt lgkmcnt(" #n ")" ::: "memory")
#define PG8_BAR __builtin_amdgcn_s_barrier()
#define PG8_SCHED __builtin_amdgcn_sched_barrier(0)
    Unit cur, nxt; int ui = 0;
    if (!S.next(0, cur)) return;
    f32x4 acc[2][2][4][2];
#pragma unroll
    for (int a = 0; a < 2; ++a)
#pragma unroll
        for (int b = 0; b < 2; ++b)
#pragma unroll
            for (int m = 0; m < 4; ++m)
#pragma unroll
                for (int n = 0; n < 2; ++n) acc[a][b][m][n] = (f32x4){0.f, 0.f, 0.f, 0.f};
    bf16x8 At[4][2], B0[2][2], B1[2][2];
    const char* cA = (const char*)g.A + (size_t)cur.pm * tstep; const char* cB = (const char*)g.Bt + (size_t)cur.pn * tstep;
    S.a_ready(cur);
    if constexpr (SP2) {
        PG8_STAGE(PG8_SB(0, 0), cB, voffB); PG8_STAGE(PG8_SB(0, 1), cB + hstep, voffB); PG8_STAGE(PG8_SA(0, 0), cA, voffA); PG8_STAGE(PG8_SA(0, 1), cA + hstep, voffA);
        if (wr == 1) PG8_BAR;
        PG8_WAIT_V(2); PG8_BAR;
        PG8_STAGE(PG8_SB(1, 0), cB + kstep, voffB); PG8_STAGE(PG8_SA(1, 0), cA + kstep, voffA); PG8_STAGE(PG8_SB(1, 1), cB + hstep + kstep, voffB);
        PG8_WAIT_V(6); PG8_BAR;
    } else {
        PG8_STAGE(PG8_SB(0, 0), cB, voffB); PG8_STAGE(PG8_SA(0, 0), cA, voffA); PG8_STAGE(PG8_SB(0, 1), cB + hstep, voffB); PG8_STAGE(PG8_SA(0, 1), cA + hstep, voffA);
        if (wr == 1) PG8_BAR;
        PG8_WAIT_V(4); PG8_BAR;
        PG8_STAGE(PG8_SB(1, 0), cB + kstep, voffB); PG8_STAGE(PG8_SA(1, 0), cA + kstep, voffA); PG8_STAGE(PG8_SB(1, 1), cB + hstep + kstep, voffB);
        PG8_WAIT_V(6); PG8_BAR;
    }
    for (;;) {
        const bool has_next = S.next(ui + 1, nxt);
        const char* nA = has_next ? (const char*)g.A + (size_t)nxt.pm * tstep : cA; const char* nB = has_next ? (const char*)g.Bt + (size_t)nxt.pn * tstep : cB;
        for (int t = 0; t < nt; t += 2) {
            const bool last = (t == nt - 2);
            const char* a1 = cA + (size_t)(t + 1) * kstep;
            const char* a2 = last ? nA : cA + (size_t)(t + 2) * kstep; const char* b2 = last ? nB : cB + (size_t)(t + 2) * kstep;
            const char* a3 = a2 + kstep; const char* b3 = b2 + kstep;
            if (last && has_next) S.a_ready(nxt);
            if constexpr (SP2) {
            PG8_LDB(B0, 0, 0); PG8_LDB(B1, 0, 1); PG8_SCHED; PG8_LDA(At, 0, 0); PG8_STAGE(PG8_SA(1, 1), a1 + hstep, voffA);
            PG8_WAIT_V(8); PG8_WAIT_L(0); PG8_BAR; PG8_MMA(0, 0, At, B0); PG8_MMA(0, 1, At, B1); PG8_BAR; PG8_SCHED;
            PG8_LDA(At, 0, 1); PG8_STAGE(PG8_SB(0, 0), b2, voffB); PG8_STAGE(PG8_SB(0, 1), b2 + hstep, voffB); PG8_STAGE(PG8_SA(0, 0), a2, voffA);
            PG8_WAIT_V(8); PG8_WAIT_L(0); PG8_BAR; PG8_MMA(1, 0, At, B0); PG8_MMA(1, 1, At, B1); PG8_BAR; PG8_SCHED;
            PG8_LDB(B0, 1, 0); PG8_LDB(B1, 1, 1); PG8_SCHED; PG8_LDA(At, 1, 0); PG8_STAGE(PG8_SA(0, 1), a2 + hstep, voffA);
            PG8_WAIT_V(8); PG8_WAIT_L(0); PG8_BAR; PG8_MMA(0, 0, At, B0); PG8_MMA(0, 1, At, B1); PG8_BAR; PG8_SCHED;
            PG8_LDA(At, 1, 1); PG8_STAGE(PG8_SB(1, 0), b3, voffB); PG8_STAGE(PG8_SB(1, 1), b3 + hstep, voffB); PG8_STAGE(PG8_SA(1, 0), a3, voffA);
            PG8_WAIT_V(8); PG8_WAIT_L(0); PG8_BAR; PG8_MMA(1, 0, At, B0); PG8_MMA(1, 1, At, B1); PG8_BAR; PG8_SCHED;
            } else {
            PG8_LDB(B0, 0, 0); PG8_SCHED; PG8_LDA(At, 0, 0); PG8_STAGE(PG8_SA(1, 1), a1 + hstep, voffA);
            PG8_WAIT_L(8); PG8_BAR; PG8_WAIT_L(0); PG8_MMA(0, 0, At, B0); PG8_BAR; PG8_SCHED;
            PG8_LDB(B1, 0, 1); PG8_STAGE(PG8_SB(0, 0), b2, voffB);
            PG8_BAR; PG8_WAIT_L(0); PG8_MMA(0, 1, At, B1); PG8_BAR;
            PG8_LDA(At, 0, 1); PG8_STAGE(PG8_SA(0, 0), a2, voffA);
            PG8_BAR; PG8_WAIT_L(0); PG8_MMA(1, 0, At, B0); PG8_BAR; PG8_SCHED;
            PG8_STAGE(PG8_SB(0, 1), b2 + hstep, voffB);
            PG8_WAIT_V(6); PG8_BAR; PG8_MMA(1, 1, At, B1); PG8_BAR;
            PG8_LDB(B0, 1, 0); PG8_SCHED; PG8_LDA(At, 1, 0); PG8_STAGE(PG8_SA(0, 1), a2 + hstep, voffA);
            PG8_WAIT_L(8); PG8_BAR; PG8_WAIT_L(0); PG8_MMA(0, 0, At, B0); PG8_BAR; PG8_SCHED;
            PG8_LDB(B1, 1, 1); PG8_STAGE(PG8_SB(1, 0), b3, voffB);
            PG8_BAR; PG8_WAIT_L(0); PG8_MMA(0, 1, At, B1); PG8_BAR;
            PG8_LDA(At, 1, 1); PG8_STAGE(PG8_SA(1, 0), a3, voffA);
            PG8_BAR; PG8_WAIT_L(0); PG8_MMA(1, 0, At, B0); PG8_BAR; PG8_SCHED;
            PG8_STAGE(PG8_SB(1, 1), b3 + hstep, voffB);
            PG8_WAIT_V(6); PG8_BAR; PG8_MMA(1, 1, At, B1); PG8_BAR;
            }
        }
        if constexpr (ALIGN_EPI) { if (wr == 0) PG8_BAR; }
        if constexpr (!Epi::AFTER_DRAIN) { E(acc, cur, wr, wc, fr, fq); S.done(cur); }
        if (!has_next) break;
#pragma unroll
        for (int a = 0; a < 2; ++a)
#pragma unroll
            for (int b = 0; b < 2; ++b)
#pragma unroll
                for (int m = 0; m < 4; ++m)
#pragma unroll
                    for (int n = 0; n < 2; ++n) acc[a][b][m][n] = (f32x4){0.f, 0.f, 0.f, 0.f};
        cur = nxt; cA = nA; cB = nB; ++ui;
        if constexpr (ALIGN_EPI) { if (wr == 1) PG8_BAR; }
    }
    PG8_WAIT_V(0);
    if constexpr (!ALIGN_EPI) { if (wr == 0) PG8_BAR; }
    PG8_BAR;
    if constexpr (Epi::AFTER_DRAIN) { E.fused(acc, cur, wr, wc, fr, fq, lds, wid, lane); S.done(cur); }
#undef PG8_SA
#undef PG8_SB
#undef PG8_STAGE
#undef PG8_LDA
#undef PG8_LDB
#undef PG8_MMA
#undef PG8_WAIT_V
#undef PG8_WAIT_L
#undef PG8_BAR
#undef PG8_SCHED
}
}
using pg8::cvt_pk_bf16;
struct EpiProj {
    static constexpr bool PERM = true, AFTER_DRAIN = false;
    bf16_t* O; bf16_t* svT;
    DI void operator()(const f32x4 (&acc)[2][2][4][2], const pg8::Unit& u, int wr, int wc, int fr, int fq) const {
        const int row0 = u.pm * 256 + wr * 64 + fr, col0 = u.pn * 256 + wc * 32 + 8 * fq;
#pragma unroll
        for (int ai = 0; ai < 2; ++ai)
#pragma unroll
            for (int m = 0; m < 4; ++m) { bf16_t* rowp = O + (size_t)(row0 + ai * 128 + m * 16) * NIN + col0;
#pragma unroll
                for (int bj = 0; bj < 2; ++bj) { const f32x4 v0 = acc[ai][bj][m][0], v1 = acc[ai][bj][m][1];
                    u32x4 w; w.x = cvt_pk_bf16(v0[0], v0[1]); w.y = cvt_pk_bf16(v0[2], v0[3]); w.z = cvt_pk_bf16(v1[0], v1[1]); w.w = cvt_pk_bf16(v1[2], v1[3]);
                    *(u32x4*)(rowp + bj * 128) = w; } }
        if (u.pn == 2) {
#pragma unroll
            for (int ai = 0; ai < 2; ++ai)
#pragma unroll
                for (int m = 0; m < 4; ++m) { const int row = row0 + ai * 128 + m * 16, b = row >> 12, s = row & (SEQ - 1);
#pragma unroll
                    for (int n = 0; n < 2; ++n)
#pragma unroll
                        for (int e = 0; e < 4; ++e) { const int c = wc * 32 + 8 * fq + 4 * n + e;
                            svT[((size_t)(b * 2 + (c >> 6)) * 64 + (c & 63)) * SEQ + s] = (bf16_t)f2bf(acc[ai][1][m][n][e]); } }
        }
    }
};
struct EpiMkv {
    static constexpr bool PERM = true, AFTER_DRAIN = false;
    bf16_t* mk; bf16_t* mvT;
    DI void operator()(const f32x4 (&acc)[2][2][4][2], const pg8::Unit& u, int wr, int wc, int fr, int fq) const {
        const int row0 = u.pm * 256 + wr * 64 + fr;
#pragma unroll
        for (int ai = 0; ai < 2; ++ai)
#pragma unroll
            for (int m = 0; m < 4; ++m) { const int row = row0 + ai * 128 + m * 16;
                if (u.pn == 0) {
#pragma unroll
                    for (int bj = 0; bj < 2; ++bj) { const f32x4 v0 = acc[ai][bj][m][0], v1 = acc[ai][bj][m][1];
                        u32x4 w; w.x = cvt_pk_bf16(v0[0], v0[1]); w.y = cvt_pk_bf16(v0[2], v0[3]); w.z = cvt_pk_bf16(v1[0], v1[1]); w.w = cvt_pk_bf16(v1[2], v1[3]);
                        *(u32x4*)(mk + (size_t)row * 256 + bj * 128 + wc * 32 + 8 * fq) = w; }
                } else { const int b = row >> 8, mm = row & 255;
#pragma unroll
                    for (int bj = 0; bj < 2; ++bj)
#pragma unroll
                        for (int n = 0; n < 2; ++n)
#pragma unroll
                            for (int e = 0; e < 4; ++e) { const int c = bj * 128 + wc * 32 + 8 * fq + 4 * n + e;
                                mvT[((size_t)(b * 4 + (c >> 6)) * 64 + (c & 63)) * NMEM + mm] = (bf16_t)f2bf(acc[ai][bj][m][n][e]); } }
            }
    }
};
struct EpiY {
    static constexpr bool PERM = true, AFTER_DRAIN = false;
    bf16_t* Y; float* stats;
    DI void operator()(const f32x4 (&acc)[2][2][4][2], const pg8::Unit& u, int wr, int wc, int fr, int fq) const {
        const int row0 = u.pm * 256 + wr * 64 + fr, col0 = u.pn * 256 + wc * 32 + 8 * fq;
#pragma unroll
        for (int ai = 0; ai < 2; ++ai)
#pragma unroll
            for (int m = 0; m < 4; ++m) { const int row = row0 + ai * 128 + m * 16; bf16_t* rowp = Y + (size_t)row * DM + col0; float ss = 0.f;
#pragma unroll
                for (int bj = 0; bj < 2; ++bj) { const f32x4 v0 = acc[ai][bj][m][0], v1 = acc[ai][bj][m][1];
                    ss += (v0[0] * v0[0] + v0[1] * v0[1]) + (v0[2] * v0[2] + v0[3] * v0[3]) + (v1[0] * v1[0] + v1[1] * v1[1]) + (v1[2] * v1[2] + v1[3] * v1[3]);
                    u32x4 w; w.x = cvt_pk_bf16(v0[0], v0[1]); w.y = cvt_pk_bf16(v0[2], v0[3]); w.z = cvt_pk_bf16(v1[0], v1[1]); w.w = cvt_pk_bf16(v1[2], v1[3]);
                    *(u32x4*)(rowp + bj * 128) = w; }
                ss += __shfl_xor(ss, 16); ss += __shfl_xor(ss, 32);
                if (fq == 0) stats[(size_t)row * 16 + u.pn * 4 + wc] = ss; }
    }
};

typedef short bf16x8 __attribute__((ext_vector_type(8)));
typedef short s16x4 __attribute__((ext_vector_type(4)));
typedef float f32x16 __attribute__((ext_vector_type(16)));
typedef float f32x2_t __attribute__((ext_vector_type(2)));
typedef __bf16 bf16x2_t __attribute__((ext_vector_type(2)));
DI unsigned cvtpk(float lo, float hi) { f32x2_t v = {lo, hi}; bf16x2_t b = __builtin_convertvector(v, bf16x2_t); return __builtin_bit_cast(unsigned, b); }
#define MFMA32(a, b, c) __builtin_amdgcn_mfma_f32_32x32x16_bf16((a), (b), (c), 0, 0, 0)
#define MFMA16(a, b, c) __builtin_amdgcn_mfma_f32_16x16x32_bf16((a), (b), (c), 0, 0, 0)
constexpr int N_SWA_UNITS = NB * 2 * 128 * 4, N_MEM_UNITS = NB * 128 * 4, N_ATTN_UNITS = N_SWA_UNITS + N_MEM_UNITS;
DI void attn_unit(const Params& p, int l, int u, int lane) {
    const int r = lane & 31, h = lane >> 5;
    const bf16_t* P = (const bf16_t*)(p.ws + WS_P);
    const bf16_t *Qrow, *Kbase, *VTb; int kstride, vstride, kbase, kt0, nkt, mcol; float m, lsum; size_t row0;
    const bool swa = u < N_SWA_UNITS;
    if (swa) {
        const int g = u & 3, qt = (u >> 2) & 127, bk = u >> 9, b = bk >> 1, kvh = bk & 1, head = kvh * 4 + g;
        row0 = (size_t)b * SEQ + qt * 32;
        Qrow = P + row0 * NIN + C_SQ + head * 64;
        Kbase = P + (size_t)b * SEQ * NIN + C_SK + kvh * 64; kstride = NIN;
        VTb = (const bf16_t*)(p.ws + WS_SVT) + (size_t)(b * 2 + kvh) * 64 * SEQ; vstride = SEQ;
        kbase = qt * 32 - 128; kt0 = qt < 4 ? 4 - qt : 0; nkt = 5; mcol = head * 64;
        m = p.sinks[l * 8 + head] * 1.4426950408889634f; lsum = h == 0 ? 1.f : 0.f;
    } else {
        const int v = u - N_SWA_UNITS, hm = v & 3, qt = (v >> 2) & 127, b = v >> 9;
        row0 = (size_t)b * SEQ + qt * 32;
        Qrow = P + row0 * NIN + C_MQ + hm * 64;
        Kbase = (const bf16_t*)(p.ws + WS_MK) + (size_t)l * MEMROWS * 256 + (size_t)b * NMEM * 256 + hm * 64; kstride = 256;
        VTb = (const bf16_t*)(p.ws + WS_MVT) + (size_t)l * MEMROWS * 256 + (size_t)(b * 4 + hm) * 64 * NMEM; vstride = NMEM;
        kbase = 0; kt0 = 0; nkt = 8; mcol = 768 + hm * 64;
        m = -1e30f; lsum = 0.f;
    }
    bf16x8 qf[4];
#pragma unroll
    for (int ks = 0; ks < 4; ++ks) qf[ks] = *(const bf16x8*)(Qrow + (size_t)r * NIN + 16 * ks + 8 * h);
    f32x16 o0, o1;
#pragma unroll
    for (int i = 0; i < 16; ++i) { o0[i] = 0.f; o1[i] = 0.f; }
    constexpr float SC = 0.125f * 1.4426950408889634f;
    for (int kt = kt0; kt < nkt; ++kt) {
        const int key0 = kbase + 32 * kt;
        const bf16_t* kp = Kbase + (size_t)(key0 + r) * kstride + 8 * h;
        bf16x8 kf[4];
#pragma unroll
        for (int ks = 0; ks < 4; ++ks) kf[ks] = *(const bf16x8*)(kp + 16 * ks);
        const bf16_t* vp = VTb + (size_t)r * vstride + key0 + 4 * h;
        s16x4 va[2][2][2];
#pragma unroll
        for (int dt = 0; dt < 2; ++dt)
#pragma unroll
            for (int ss = 0; ss < 2; ++ss)
#pragma unroll
                for (int hf = 0; hf < 2; ++hf) va[dt][ss][hf] = *(const s16x4*)(vp + (size_t)dt * 32 * vstride + 16 * ss + 8 * hf);
        f32x16 s;
#pragma unroll
        for (int i = 0; i < 16; ++i) s[i] = 0.f;
#pragma unroll
        for (int ks = 0; ks < 4; ++ks) s = MFMA32(kf[ks], qf[ks], s);
        const bool mlo = swa && kt == 0, mhi = swa && kt == 4;
        float tm = -1e30f;
#pragma unroll
        for (int i = 0; i < 16; ++i) {
            const int c = (i & 3) + 8 * (i >> 2) + 4 * h;
            float v = s[i] * SC;
            if (mlo && !(c > r)) v = -1e30f;
            if (mhi && !(c <= r)) v = -1e30f;
            s[i] = v; tm = fmaxf(tm, v);
        }
        tm = fmaxf(tm, __shfl_xor(tm, 32));
        const float mn = fmaxf(m, tm), alpha = __builtin_amdgcn_exp2f(m - mn);
        m = mn;
        float ps = 0.f;
#pragma unroll
        for (int i = 0; i < 16; ++i) { s[i] = __builtin_amdgcn_exp2f(s[i] - mn); ps += s[i]; }
        lsum = lsum * alpha + ps;
#pragma unroll
        for (int i = 0; i < 16; ++i) { o0[i] *= alpha; o1[i] *= alpha; }
#pragma unroll
        for (int ss = 0; ss < 2; ++ss) {
            u32x4 pw; pw.x = cvtpk(s[8 * ss + 0], s[8 * ss + 1]); pw.y = cvtpk(s[8 * ss + 2], s[8 * ss + 3]); pw.z = cvtpk(s[8 * ss + 4], s[8 * ss + 5]); pw.w = cvtpk(s[8 * ss + 6], s[8 * ss + 7]);
            const bf16x8 pf = __builtin_bit_cast(bf16x8, pw);
            const bf16x8 v0 = __builtin_shufflevector(va[0][ss][0], va[0][ss][1], 0, 1, 2, 3, 4, 5, 6, 7);
            const bf16x8 v1 = __builtin_shufflevector(va[1][ss][0], va[1][ss][1], 0, 1, 2, 3, 4, 5, 6, 7);
            o0 = MFMA32(v0, pf, o0); o1 = MFMA32(v1, pf, o1);
        }
    }
    lsum += __shfl_xor(lsum, 32);
    const float inv = 1.f / lsum;
    const bf16_t* gp = P + (row0 + r) * NIN + C_GATE + mcol + 4 * h;
    bf16_t* op = (bf16_t*)(p.ws + WS_H) + (row0 + r) * DM + mcol + 4 * h;
#pragma unroll
    for (int dt = 0; dt < 2; ++dt)
#pragma unroll
        for (int g4 = 0; g4 < 4; ++g4) {
            const u32x2 gt = *(const u32x2*)(gp + 32 * dt + 8 * g4);
            const float a0 = (dt ? o1[4 * g4 + 0] : o0[4 * g4 + 0]) * inv * siluf_(bflo(gt.x)), a1 = (dt ? o1[4 * g4 + 1] : o0[4 * g4 + 1]) * inv * siluf_(bfhi(gt.x));
            const float a2 = (dt ? o1[4 * g4 + 2] : o0[4 * g4 + 2]) * inv * siluf_(bflo(gt.y)), a3 = (dt ? o1[4 * g4 + 3] : o0[4 * g4 + 3]) * inv * siluf_(bfhi(gt.y));
            u32x2 w; w.x = cvtpk(a0, a1); w.y = cvtpk(a2, a3);
            *(u32x2*)(op + 32 * dt + 8 * g4) = w;
        }
}

enum { K_INIT = 0, K_PREP = 1, K_INPROJ = 2, K_DNPREP = 3, K_ATTN = 4, K_DNOUT = 5, K_OUTPROJ = 6, K_FINAL = 7 };
__global__ void __launch_bounds__(512, 2) mega(Params p, int kind, int l) {
    extern __shared__ __attribute__((aligned(16))) unsigned char lds_raw[];
    LAS unsigned char* lds = (LAS unsigned char*)lds_raw;
    const int tid = threadIdx.x, lane = tid & 63, wave = __builtin_amdgcn_readfirstlane(tid >> 6);
    const int G = gridDim.x;
    const int gw = blockIdx.x * 8 + wave, ngw = G * 8;
    unsigned char* ws = p.ws;
    if (kind == K_INIT) phase_init(p, lds, gw, ngw, wave, lane);
    else if (kind == K_PREP) {
        if (l == 0) { for (int row = gw; row < NTOK; row += ngw) prep_row<false>(p, 0, row, lane); }
        else { for (int row = gw; row < NTOK; row += ngw) prep_row<true>(p, l, row, lane); }
    } else if (kind == K_INPROJ) {
        { pg8::Gemm g{(const bf16_t*)(ws + WS_H), (const bf16_t*)(ws + WS_WIN) + (size_t)l * NIN * DM, NTOK, NIN, DM};
          pg8::StaticOrder S; S.init(NTOK, NIN, G, (int)blockIdx.x);
          EpiProj E{(bf16_t*)(ws + WS_P), (bf16_t*)(ws + WS_SVT)};
          pg8::gemm_phase<EpiProj, pg8::StaticOrder, true, true>(lds, g, S, E); }
        if (l == 0) {
            for (int ll = 0; ll < DEPTH; ++ll) {
                pg8::Gemm g{(const bf16_t*)(ws + WS_MEMN) + (size_t)ll * MEMROWS * DM, (const bf16_t*)(ws + WS_WMKV) + (size_t)ll * 512 * DM, MEMROWS, 512, DM};
                pg8::StaticOrder S; S.init(MEMROWS, 512, G, (int)((blockIdx.x + G - 32 * ll) % G));
                EpiMkv E{(bf16_t*)(ws + WS_MK) + (size_t)ll * MEMROWS * 256, (bf16_t*)(ws + WS_MVT) + (size_t)ll * MEMROWS * 256};
                pg8::gemm_phase<EpiMkv, pg8::StaticOrder, true, true>(lds, g, S, E);
            }
        }
    } else if (kind == K_ATTN) {
        for (int u = gw; u < N_ATTN_UNITS; u += ngw) attn_unit(p, l, u, lane);
    } else if (kind == K_OUTPROJ) {
        pg8::Gemm g{(const bf16_t*)(ws + WS_H), (const bf16_t*)(ws + WS_WOUT) + (size_t)l * DM * DM, NTOK, DM, DM};
        pg8::StaticOrder S; S.init(NTOK, DM, G, (int)blockIdx.x);
        EpiY E{(bf16_t*)(ws + WS_P), (float*)(ws + WS_STATS)};
        pg8::gemm_phase<EpiY, pg8::StaticOrder, true, true>(lds, g, S, E);
    } else if (kind == K_FINAL) {
        for (int row = gw; row < NTOK; row += ngw) final_row(p, row, lane);
    }
}

__global__ void __launch_bounds__(256) naive_gemm(const bf16_t* A, const bf16_t* Bt, int M, int N, int K, int mode, bf16_t* O0, bf16_t* O1) {
    __shared__ float sA[32][65], sB[32][65];
    const int tid = threadIdx.x, tx = tid & 15, ty = tid >> 4;
    const int m0 = blockIdx.y * 64, n0 = blockIdx.x * 64;
    float acc[4][4];
#pragma unroll
    for (int i = 0; i < 4; ++i)
#pragma unroll
        for (int j = 0; j < 4; ++j) acc[i][j] = 0.f;
    for (int k0 = 0; k0 < K; k0 += 32) {
        { const int r = tid >> 2, kc = (tid & 3) * 8;
          const u32x4 a = *(const u32x4*)(A + (size_t)(m0 + r) * K + k0 + kc), b = *(const u32x4*)(Bt + (size_t)(n0 + r) * K + k0 + kc);
          sA[kc + 0][r] = bflo(a.x); sA[kc + 1][r] = bfhi(a.x); sA[kc + 2][r] = bflo(a.y); sA[kc + 3][r] = bfhi(a.y); sA[kc + 4][r] = bflo(a.z); sA[kc + 5][r] = bfhi(a.z); sA[kc + 6][r] = bflo(a.w); sA[kc + 7][r] = bfhi(a.w);
          sB[kc + 0][r] = bflo(b.x); sB[kc + 1][r] = bfhi(b.x); sB[kc + 2][r] = bflo(b.y); sB[kc + 3][r] = bfhi(b.y); sB[kc + 4][r] = bflo(b.z); sB[kc + 5][r] = bfhi(b.z); sB[kc + 6][r] = bflo(b.w); sB[kc + 7][r] = bfhi(b.w); }
        __syncthreads();
#pragma unroll 8
        for (int k = 0; k < 32; ++k) {
            float a[4], b[4];
#pragma unroll
            for (int i = 0; i < 4; ++i) { a[i] = sA[k][ty * 4 + i]; b[i] = sB[k][tx * 4 + i]; }
#pragma unroll
            for (int i = 0; i < 4; ++i)
#pragma unroll
                for (int j = 0; j < 4; ++j) acc[i][j] += a[i] * b[j];
        }
        __syncthreads();
    }
#pragma unroll
    for (int i = 0; i < 4; ++i)
#pragma unroll
        for (int j = 0; j < 4; ++j) {
            const int row = m0 + ty * 4 + i, col = n0 + tx * 4 + j; const bf16_t v = (bf16_t)f2bf(acc[i][j]);
            if (mode == 0) {
                O0[(size_t)row * NIN + col] = v;
                if (col >= C_SV && col < C_SV + 128) { const int b = row / SEQ, s = row % SEQ, c = col - C_SV; O1[((size_t)(b * 2 + c / 64) * 64 + (c % 64)) * SEQ + s] = v; }
            } else if (mode == 1) {
                if (col < 256) O0[(size_t)row * 256 + col] = v;
                else { const int b = row / NMEM, m = row % NMEM, c = col - 256; O1[((size_t)(b * 4 + c / 64) * 64 + (c % 64)) * NMEM + m] = v; }
            } else {
                O0[(size_t)row * DM + col] = v;
            }
        }
}
__global__ void __launch_bounds__(256) naive_stats(const bf16_t* Y, float* stats) {
    const int lane = threadIdx.x & 63, row = blockIdx.x * 4 + (threadIdx.x >> 6);
    const u32x2* yr = (const u32x2*)(Y + (size_t)row * DM) + lane; float s = 0.f;
#pragma unroll
    for (int j = 0; j < 4; ++j) { const u32x2 y = yr[64 * j]; const float a = bflo(y.x), b = bfhi(y.x), c = bflo(y.y), d = bfhi(y.y); s += (a * a + b * b) + (c * c + d * d); }
    s = wave_sum(s);
    if (lane < 16) stats[(size_t)row * 16 + lane] = lane == 0 ? s : 0.f;
}
__global__ void __launch_bounds__(256) naive_attn(Params p, int l) {
    const int gid = blockIdx.x * 256 + threadIdx.x; const int row = gid / 12, hh = gid % 12;
    const bf16_t* P = (const bf16_t*)(p.ws + WS_P);
    const int b = row / SEQ, s = row % SEQ;
    float q[64], o[64];
    const bool swa = hh < 8;
    const int qcol = swa ? C_SQ + hh * 64 : C_MQ + (hh - 8) * 64;
#pragma unroll
    for (int d = 0; d < 64; ++d) { q[d] = bf2f(P[(size_t)row * NIN + qcol + d]) * 0.125f; o[d] = 0.f; }
    float m, lsum;
    if (swa) { m = p.sinks[l * 8 + hh]; lsum = 1.f; } else { m = -1e30f; lsum = 0.f; }
    const int nk = swa ? 128 : 256;
    const bf16_t* svT = (const bf16_t*)(p.ws + WS_SVT);
    const bf16_t* mk = (const bf16_t*)(p.ws + WS_MK) + (size_t)l * MEMROWS * 256;
    const bf16_t* mvT = (const bf16_t*)(p.ws + WS_MVT) + (size_t)l * MEMROWS * 256;
    for (int jj = 0; jj < nk; ++jj) {
        const bf16_t* kp; const bf16_t* vp; size_t vstride;
        if (swa) { const int j = s - 127 + jj; if (j < 0) continue; const int kvh = hh >> 2;
            kp = P + (size_t)(b * SEQ + j) * NIN + C_SK + kvh * 64; vp = svT + ((size_t)(b * 2 + kvh) * 64) * SEQ + j; vstride = SEQ; }
        else { const int hm = hh - 8; kp = mk + (size_t)(b * NMEM + jj) * 256 + hm * 64; vp = mvT + ((size_t)(b * 4 + hm) * 64) * NMEM + jj; vstride = NMEM; }
        float sc = 0.f;
#pragma unroll
        for (int d = 0; d < 64; ++d) sc += q[d] * bf2f(kp[d]);
        const float mn = fmaxf(m, sc), f = __expf(m - mn), pe = __expf(sc - mn);
        lsum = lsum * f + pe; m = mn;
#pragma unroll
        for (int d = 0; d < 64; ++d) o[d] = o[d] * f + pe * bf2f(vp[(size_t)d * vstride]);
    }
    const float inv = 1.f / lsum;
    const int mcol = swa ? hh * 64 : 768 + (hh - 8) * 64;
    bf16_t* MIX = (bf16_t*)(p.ws + WS_H);
#pragma unroll
    for (int d = 0; d < 64; ++d) { const float g = bf2f(P[(size_t)row * NIN + C_GATE + mcol + d]); MIX[(size_t)row * DM + mcol + d] = (bf16_t)f2bf(o[d] * inv * siluf_(g)); }
}
__global__ void __launch_bounds__(64) naive_dn(Params p, int l) {
    const int b = blockIdx.x >> 2, h = blockIdx.x & 3, j = threadIdx.x;
    const bf16_t* P = (const bf16_t*)(p.ws + WS_P);
    const float* BA = (const float*)(p.ws + WS_BA);
    bf16_t* MIX = (bf16_t*)(p.ws + WS_H);
    const float* cw = p.conv_w + (size_t)l * 4 * 768;
    float wq[4], wk[4], wv[4];
#pragma unroll
    for (int t = 0; t < 4; ++t) { wq[t] = cw[t * 768 + h * 64 + j]; wk[t] = cw[t * 768 + 256 + h * 64 + j]; wv[t] = cw[t * 768 + 512 + h * 64 + j]; }
    const float gn = p.dn_g[l * 64 + j];
    float S[64];
#pragma unroll
    for (int i = 0; i < 64; ++i) S[i] = 0.f;
    float xq[4] = {0.f, 0.f, 0.f, 0.f}, xk[4] = {0.f, 0.f, 0.f, 0.f}, xv[4] = {0.f, 0.f, 0.f, 0.f};
    for (int t = 0; t < SEQ; ++t) {
        const size_t row = (size_t)b * SEQ + t;
        xq[0] = xq[1]; xq[1] = xq[2]; xq[2] = xq[3]; xq[3] = bf2f(P[row * NIN + C_DQ + h * 64 + j]);
        xk[0] = xk[1]; xk[1] = xk[2]; xk[2] = xk[3]; xk[3] = bf2f(P[row * NIN + C_DK + h * 64 + j]);
        xv[0] = xv[1]; xv[1] = xv[2]; xv[2] = xv[3]; xv[3] = bf2f(P[row * NIN + C_DV + h * 64 + j]);
        float cq = siluf_(wq[0] * xq[0] + wq[1] * xq[1] + wq[2] * xq[2] + wq[3] * xq[3]);
        float ck = siluf_(wk[0] * xk[0] + wk[1] * xk[1] + wk[2] * xk[2] + wk[3] * xk[3]);
        const float cv = siluf_(wv[0] * xv[0] + wv[1] * xv[1] + wv[2] * xv[2] + wv[3] * xv[3]);
        cq *= rsqrtf(wave_sum(cq * cq) + EPS) * 0.125f;
        ck *= rsqrtf(wave_sum(ck * ck) + EPS);
        const float beta = BA[row * 8 + h], a = __expf(BA[row * 8 + 4 + h]);
        float ks = 0.f;
#pragma unroll
        for (int i = 0; i < 64; ++i) ks += __shfl(ck, i) * S[i];
        const float dv = beta * (cv - a * ks);
        float oj = 0.f;
#pragma unroll
        for (int i = 0; i < 64; ++i) { S[i] = a * S[i] + __shfl(ck, i) * dv; oj += __shfl(cq, i) * S[i]; }
        const float r = rsqrtf(wave_sum(oj * oj) * (1.f / 64.f) + EPS);
        const int mcol = 512 + h * 64 + j;
        const float g = bf2f(P[row * NIN + C_GATE + mcol]);
        MIX[row * DM + mcol] = (bf16_t)f2bf(oj * r * gn * siluf_(g));
    }
}

extern "C" void kernel_launch(void* const* d_in, const int* in_sizes, int n_in, void* d_out, int out_size, void* d_ws, size_t ws_size, hipStream_t stream) {
    static int inited = 0;
    constexpr int LDS_BYTES = 147456;
    if (!inited) {
        if (n_in != 13 || ws_size < WS_END) { fprintf(stderr, "kernel_launch: unexpected n_in %d / ws_size %zu\n", n_in, ws_size); inited = -1; return; }
        (void)hipFuncSetAttribute((const void*)mega, hipFuncAttributeMaxDynamicSharedMemorySize, LDS_BYTES);
        inited = 1;
    }
    if (inited < 0) return;
    Params p{};
    p.x = (const float*)d_in[0]; p.mem = (const float*)d_in[1]; p.pre_g = (const float*)d_in[2]; p.w_in = (const float*)d_in[3]; p.conv_w = (const float*)d_in[4];
    p.a_log = (const float*)d_in[5]; p.dt_bias = (const float*)d_in[6]; p.sinks = (const float*)d_in[7]; p.dn_g = (const float*)d_in[8]; p.mem_g = (const float*)d_in[9];
    p.w_mkv = (const float*)d_in[10]; p.w_out = (const float*)d_in[11]; p.post_g = (const float*)d_in[12];
    p.out = (float*)d_out; p.ws = (unsigned char*)d_ws;
    const int G = 256;
#define PH(kind, l) hipLaunchKernelGGL(mega, dim3(G), dim3(512), LDS_BYTES, stream, p, (int)(kind), (int)(l))
    PH(K_INIT, 0);
    PH(K_PREP, 0);
    for (int l = 0; l < DEPTH; ++l) {
        PH(K_INPROJ, l);
        PH(K_ATTN, l);
        hipLaunchKernelGGL(naive_dn, dim3(NB * 4), dim3(64), 0, stream, p, l);
        PH(K_OUTPROJ, l);
        if (l + 1 < DEPTH) PH(K_PREP, l + 1); else PH(K_FINAL, 0);
    }
#undef PH
}
```

```cpp
#include <hip/hip_runtime.h>
#include <cstdio>
#include <cstdint>

#define DI __device__ __forceinline__
#define LAS __attribute__((address_space(3)))
typedef unsigned short bf16_t;
typedef float f32x4 __attribute__((ext_vector_type(4)));
typedef unsigned u32x4 __attribute__((ext_vector_type(4)));
typedef unsigned u32x2 __attribute__((ext_vector_type(2)));

constexpr int DM = 1024, NB = 16, SEQ = 4096, NTOK = NB * SEQ, DEPTH = 2;
constexpr int INW = 2824;
constexpr int NIN = 2816;
constexpr int NMEM = 256, MEMROWS = NB * NMEM;
constexpr float EPS = 1e-6f;
constexpr int C_SQ = 0, C_SK = 512, C_SV = 640, C_DQ = 768, C_DK = 1024, C_DV = 1280, C_MQ = 1536, C_GATE = 1792;

constexpr size_t MiB = 1u << 20;
constexpr size_t WS_CTL = 0;
constexpr size_t WS_WIN = 1 * MiB;
constexpr size_t WS_WOUT = 12 * MiB;
constexpr size_t WS_WMKV = 16 * MiB;
constexpr size_t WS_W8 = 18 * MiB;
constexpr size_t WS_MEMN = 19 * MiB;
constexpr size_t WS_MK = 35 * MiB;
constexpr size_t WS_MVT = 39 * MiB;
constexpr size_t WS_BA = 43 * MiB;
constexpr size_t WS_STATS = 45 * MiB;
constexpr size_t WS_SVT = 49 * MiB;
constexpr size_t WS_H = 65 * MiB;
constexpr size_t WS_P = 193 * MiB;
constexpr size_t WS_DN = 545 * MiB;
constexpr size_t WS_END = 801 * MiB;

struct Params {
    const float *x, *mem, *pre_g, *w_in, *conv_w, *a_log, *dt_bias, *sinks, *dn_g, *mem_g, *w_mkv, *w_out, *post_g;
    float* out;
    unsigned char* ws;
};

DI unsigned f2bf(float f) { unsigned u = __float_as_uint(f); return (u + 0x7fffu + ((u >> 16) & 1u)) >> 16; }
DI unsigned pk2(float lo, float hi) { return f2bf(lo) | (f2bf(hi) << 16); }
DI float bf2f(unsigned u) { return __uint_as_float(u << 16); }
DI float bflo(unsigned u) { return __uint_as_float(u << 16); }
DI float bfhi(unsigned u) { return __uint_as_float(u & 0xffff0000u); }
DI float wave_sum(float v) {
#pragma unroll
    for (int o = 1; o < 64; o <<= 1) v += __shfl_xor(v, o);
    return v;
}
DI float sigmoidf_(float x) { return 1.f / (1.f + __expf(-x)); }
DI float siluf_(float x) { return x / (1.f + __expf(-x)); }
DI float softplusf_(float x) { return x > 20.f ? x : log1pf(expf(x)); }

DI void transpose_item(const float* W, int Nsrc, int src_n0, int k0, bf16_t* WT, int K, int dst_n0, LAS float* scr, int lane) {
#pragma unroll 8
    for (int i = 0; i < 32; ++i) { const int kk = 2 * i + (lane >> 5); scr[kk * 33 + (lane & 31)] = W[(size_t)(k0 + kk) * Nsrc + src_n0 + (lane & 31)]; }
    asm volatile("s_waitcnt lgkmcnt(0)" ::: "memory");
    const int c = lane & 7;
#pragma unroll
    for (int j = 0; j < 4; ++j) {
        const int n = (lane >> 3) + 8 * j; const LAS float* s = scr + (8 * c) * 33 + n;
        u32x4 o; o.x = pk2(s[0 * 33], s[1 * 33]); o.y = pk2(s[2 * 33], s[3 * 33]); o.z = pk2(s[4 * 33], s[5 * 33]); o.w = pk2(s[6 * 33], s[7 * 33]);
        *(u32x4*)(WT + (size_t)(dst_n0 + n) * K + k0 + 8 * c) = o;
    }
    asm volatile("s_waitcnt lgkmcnt(0)" ::: "memory");
}

DI void phase_init(const Params& p, LAS unsigned char* lds, int gw, int ngw, int wave, int lane) {
    LAS float* scr = (LAS float*)(lds + wave * 16384);
    constexpr int I_IN = 16 * (NIN / 32), I_OUT = 16 * 32, I_MKV = 16 * 16, I_L = I_IN + I_OUT + I_MKV;
    for (int it = gw; it < DEPTH * I_L; it += ngw) {
        const int l = it / I_L; int r = it % I_L;
        if (r < I_IN) {
            const int kb = r / (NIN / 32), nb = r % (NIN / 32), n0 = nb * 32;
            transpose_item(p.w_in + (size_t)l * DM * INW, INW, n0 + (n0 >= 1536 ? 8 : 0), kb * 64, (bf16_t*)(p.ws + WS_WIN) + (size_t)l * NIN * DM, DM, n0, scr, lane);
        } else if (r < I_IN + I_OUT) {
            r -= I_IN; const int kb = r / 32, nb = r % 32;
            transpose_item(p.w_out + (size_t)l * DM * DM, DM, nb * 32, kb * 64, (bf16_t*)(p.ws + WS_WOUT) + (size_t)l * DM * DM, DM, nb * 32, scr, lane);
        } else {
            r -= I_IN + I_OUT; const int kb = r / 16, nb = r % 16;
            transpose_item(p.w_mkv + (size_t)l * DM * 512, 512, nb * 32, kb * 64, (bf16_t*)(p.ws + WS_WMKV) + (size_t)l * 512 * DM, DM, nb * 32, scr, lane);
        }
    }
    for (int e = gw * 64 + lane; e < DEPTH * 8 * DM; e += ngw * 64) {
        const int l = e / (8 * DM), c = (e / DM) % 8, k = e % DM;
        ((float*)(p.ws + WS_W8))[e] = p.w_in[(size_t)l * DM * INW + (size_t)k * INW + 1536 + c];
    }
    for (int it = gw; it < DEPTH * MEMROWS; it += ngw) {
        const int l = it / MEMROWS, row = it % MEMROWS;
        const f32x4* xr = (const f32x4*)(p.mem + (size_t)row * DM) + lane;
        f32x4 v[4]; float s = 0.f;
#pragma unroll
        for (int j = 0; j < 4; ++j) { v[j] = xr[64 * j]; s += (v[j].x * v[j].x + v[j].y * v[j].y) + (v[j].z * v[j].z + v[j].w * v[j].w); }
        const float r = rsqrtf(wave_sum(s) * (1.f / DM) + EPS);
        const f32x4* gr = (const f32x4*)(p.mem_g + (size_t)l * DM) + lane;
        u32x2* o = (u32x2*)((bf16_t*)(p.ws + WS_MEMN) + ((size_t)l * MEMROWS + row) * DM) + lane;
#pragma unroll
        for (int j = 0; j < 4; ++j) { const f32x4 g = gr[64 * j]; u32x2 w; w.x = pk2(v[j].x * r * g.x, v[j].y * r * g.y); w.y = pk2(v[j].z * r * g.z, v[j].w * r * g.w); o[64 * j] = w; }
    }
}

template <bool L1> DI void prep_row(const Params& p, int l, int row, int lane) {
    const f32x4* xr = (const f32x4*)(p.x + (size_t)row * DM) + lane;
    f32x4 v[4];
#pragma unroll
    for (int j = 0; j < 4; ++j) v[j] = xr[64 * j];
    if (L1) {
        const f32x4* st = (const f32x4*)((const float*)(p.ws + WS_STATS) + (size_t)row * 16);
        const f32x4 s0 = st[0], s1 = st[1], s2 = st[2], s3 = st[3];
        const float ss = ((s0.x + s0.y) + (s0.z + s0.w)) + ((s1.x + s1.y) + (s1.z + s1.w)) + ((s2.x + s2.y) + (s2.z + s2.w)) + ((s3.x + s3.y) + (s3.z + s3.w));
        const float ry = rsqrtf(ss * (1.f / DM) + EPS);
        const u32x2* yr = (const u32x2*)((const bf16_t*)(p.ws + WS_P) + (size_t)row * DM) + lane;
        const f32x4* pg = (const f32x4*)(p.post_g + (size_t)(l - 1) * DM) + lane;
        f32x4* xo = (f32x4*)(p.out + (size_t)row * DM) + lane;
#pragma unroll
        for (int j = 0; j < 4; ++j) {
            const u32x2 y = yr[64 * j]; const f32x4 g = pg[64 * j];
            v[j].x += bflo(y.x) * ry * g.x; v[j].y += bfhi(y.x) * ry * g.y; v[j].z += bflo(y.y) * ry * g.z; v[j].w += bfhi(y.y) * ry * g.w;
            xo[64 * j] = v[j];
        }
    }
    float s = 0.f;
#pragma unroll
    for (int j = 0; j < 4; ++j) s += (v[j].x * v[j].x + v[j].y * v[j].y) + (v[j].z * v[j].z + v[j].w * v[j].w);
    const float r = rsqrtf(wave_sum(s) * (1.f / DM) + EPS);
    const f32x4* gr = (const f32x4*)(p.pre_g + (size_t)l * DM) + lane;
    u32x2* ho = (u32x2*)((bf16_t*)(p.ws + WS_H) + (size_t)row * DM) + lane;
#pragma unroll
    for (int j = 0; j < 4; ++j) {
        const f32x4 g = gr[64 * j];
        v[j].x *= r * g.x; v[j].y *= r * g.y; v[j].z *= r * g.z; v[j].w *= r * g.w;
        u32x2 w; w.x = pk2(v[j].x, v[j].y); w.y = pk2(v[j].z, v[j].w); ho[64 * j] = w;
    }
    const float* W8 = (const float*)(p.ws + WS_W8) + (size_t)l * 8 * DM;
    float mine = 0.f;
#pragma unroll
    for (int c = 0; c < 8; ++c) {
        const f32x4* wr = (const f32x4*)(W8 + c * DM) + lane; float d = 0.f;
#pragma unroll
        for (int j = 0; j < 4; ++j) { const f32x4 w = wr[64 * j]; d += (v[j].x * w.x + v[j].y * w.y) + (v[j].z * w.z + v[j].w * w.w); }
        d = wave_sum(d);
        mine = (lane == c) ? d : mine;
    }
    if (lane < 8) {
        float o;
        if (lane < 4) o = sigmoidf_(mine);
        else { const int h = lane - 4; o = -__expf(p.a_log[l * 4 + h]) * softplusf_(mine + p.dt_bias[l * 4 + h]); }
        ((float*)(p.ws + WS_BA))[(size_t)row * 8 + lane] = o;
    }
}

DI void final_row(const Params& p, int row, int lane) {
    const f32x4* st = (const f32x4*)((const float*)(p.ws + WS_STATS) + (size_t)row * 16);
    const f32x4 s0 = st[0], s1 = st[1], s2 = st[2], s3 = st[3];
    const float ss = ((s0.x + s0.y) + (s0.z + s0.w)) + ((s1.x + s1.y) + (s1.z + s1.w)) + ((s2.x + s2.y) + (s2.z + s2.w)) + ((s3.x + s3.y) + (s3.z + s3.w));
    const float ry = rsqrtf(ss * (1.f / DM) + EPS);
    const u32x2* yr = (const u32x2*)((const bf16_t*)(p.ws + WS_P) + (size_t)row * DM) + lane;
    const f32x4* pg = (const f32x4*)(p.post_g + (size_t)(DEPTH - 1) * DM) + lane;
    f32x4* xo = (f32x4*)(p.out + (size_t)row * DM) + lane;
#pragma unroll
    for (int j = 0; j < 4; ++j) {
        const u32x2 y = yr[64 * j]; const f32x4 g = pg[64 * j]; f32x4 v = xo[64 * j];
        v.x += bflo(y.x) * ry * g.x; v.y += bfhi(y.x) * ry * g.y; v.z += bflo(y.y) * ry * g.z; v.w += bfhi(y.y) * ry * g.w;
        xo[64 * j] = v;
    }
}


namespace pg8 {
#define PG8_LAS __attribute__((address_space(3)))
typedef unsigned short bf16_t;
typedef short bf16x8 __attribute__((ext_vector_type(8)));
typedef float f32x4 __attribute__((ext_vector_type(4)));
typedef unsigned u32x4 __attribute__((ext_vector_type(4)));
constexpr int BM = 256, BK = 64, HALF = 128, HTB = HALF * BK * 2  , STAGE_BYTES = 8 * HTB, NXCD = 8, WGM = 8;

__host__ __device__ __forceinline__ int lds_byte(int r, int c) { const int st = (r >> 4) * 2 + (c >> 5), rr = r & 15, cc = c & 31, ob = rr * 64 + cc * 2; return st * 1024 + (ob ^ (((ob >> 9) & 1) << 5)); }
__host__ __device__ __forceinline__ void stage_rc(int b, int& R, int& C) { const int st = b / 1024, sb = b % 1024, swz = sb ^ (((sb >> 9) & 1) << 5); R = (st >> 1) * 16 + swz / 64; C = (st & 1) * 32 + (swz % 64) / 2; }
__host__ __device__ __forceinline__ int perm32(int rho) { const int n = rho >> 4, i = rho & 15; return 8 * (i >> 2) + 4 * n + (i & 3); }

struct Unit { int pm, pn; };
struct Gemm { const bf16_t* A; const bf16_t* Bt; int M, N, K; };

struct StaticOrder {
    int nM, nN, nwg, G, c;
    __host__ __device__ void init(int M, int N, int G_, int c_) { nM = M / BM; nN = N / BM; nwg = nM * nN; G = G_; c = c_; }
    __host__ __device__ bool next(int i, Unit& u) const {
        const long L = (long)i * G + c; if (L >= nwg) return false;
        int wgid = (int)L; { const int q = nwg / NXCD, r = nwg % NXCD, xcd = wgid % NXCD, off = wgid / NXCD; wgid = (xcd < r ? xcd * (q + 1) : r * (q + 1) + (xcd - r) * q) + off; }
        const int nig = WGM * nN, gid = wgid / nig, fm = gid * WGM, gsz = (nM - fm) < WGM ? (nM - fm) : WGM;
        u.pm = fm + ((wgid % nig) % gsz); u.pn = (wgid % nig) / gsz; return true;
    }
    __device__ __forceinline__ void a_ready(const Unit&) const {}
    __device__ __forceinline__ void done(const Unit&) const {}
};

__device__ __forceinline__ unsigned cvt_pk_bf16(float lo, float hi) { unsigned r; asm volatile("v_cvt_pk_bf16_f32 %0, %1, %2" : "=v"(r) : "v"(lo), "v"(hi)); return r; }
template <class Epi, class Sched, bool ALIGN_EPI = false, bool SP2 = false>
__device__ __forceinline__ void gemm_phase(PG8_LAS unsigned char* lds, const Gemm g, const Sched& S, const Epi& E) {
    const int tid = threadIdx.x, wid = __builtin_amdgcn_readfirstlane(tid >> 6), lane = tid & 63, wr = wid >> 2, wc = wid & 3, fr = lane & 15, fq = lane >> 4;
    const int K = g.K, nt = K / BK;
    unsigned voffA[2], voffB[2];
#pragma unroll
    for (int i = 0; i < 2; ++i) { int R, C; stage_rc(tid * 16 + i * 8192, R, C); const int Rb = Epi::PERM ? ((R & ~31) + perm32(R & 31)) : R;
        voffA[i] = (unsigned)(R * K + C) * 2u; voffB[i] = (unsigned)(Rb * K + C) * 2u; }
    const size_t kstep = (size_t)(BK * 2);
    const size_t hstep = (size_t)HALF * K * 2;
    const size_t tstep = 2 * hstep;
    const unsigned ldsw = (unsigned)wid * 1024u;
    const int aoff = lds_byte(wr * 64 + fr, fq * 8), boff = lds_byte(wc * 32 + fr, fq * 8);
#define PG8_SA(b, h) (((b) * 2 + (h)) * HTB)
#define PG8_SB(b, h) ((4 + (b) * 2 + (h)) * HTB)
#define PG8_STAGE(bufoff, gbase, voff) do { _Pragma("unroll") for (int _i = 0; _i < 2; ++_i) \
        __builtin_amdgcn_global_load_lds((const unsigned*)((const char*)(gbase) + (voff)[_i]), (PG8_LAS unsigned*)(lds + (bufoff) + ldsw + _i * 8192), 16, 0, 0); } while (0)
#define PG8_LDA(dst, b, h) do { _Pragma("unroll") for (int m = 0; m < 4; ++m) _Pragma("unroll") for (int k = 0; k < 2; ++k) dst[m][k] = *(const PG8_LAS bf16x8*)(lds + PG8_SA(b, h) + aoff + m * 2048 + k * 1024); } while (0)
#define PG8_LDB(dst, b, h) do { _Pragma("unroll") for (int n = 0; n < 2; ++n) _Pragma("unroll") for (int k = 0; k < 2; ++k) dst[n][k] = *(const PG8_LAS bf16x8*)(lds + PG8_SB(b, h) + boff + n * 2048 + k * 1024); } while (0)
#define PG8_MMA(ai, bj, At, Bt) do { __builtin_amdgcn_s_setprio(1); _Pragma("unroll") for (int m = 0; m < 4; ++m) _Pragma("unroll") for (int n = 0; n < 2; ++n) _Pragma("unroll") for (int k = 0; k < 2; ++k) \
        acc[ai][bj][m][n] = __builtin_amdgcn_mfma_f32_16x16x32_bf16(Bt[n][k], At[m][k], acc[ai][bj][m][n], 0, 0, 0); __builtin_amdgcn_s_setprio(0); } while (0)
#define PG8_WAIT_V(n) asm volatile("s_waitcnt vmcnt(" #n ")" ::: "memory")
#define PG8_WAIT_L(n) asm volatile("s_waitcnt lgkmcnt(" #n ")" ::: "memory")
#define PG8_BAR __builtin_amdgcn_s_barrier()
#define PG8_SCHED __builtin_amdgcn_sched_barrier(0)
    Unit cur, nxt; int ui = 0;
    if (!S.next(0, cur)) return;
    f32x4 acc[2][2][4][2];
#pragma unroll
    for (int a = 0; a < 2; ++a)
#pragma unroll
        for (int b = 0; b < 2; ++b)
#pragma unroll
            for (int m = 0; m < 4; ++m)
#pragma unroll
                for (int n = 0; n < 2; ++n) acc[a][b][m][n] = (f32x4){0.f, 0.f, 0.f, 0.f};
    bf16x8 At[4][2], B0[2][2], B1[2][2];
    const char* cA = (const char*)g.A + (size_t)cur.pm * tstep; const char* cB = (const char*)g.Bt + (size_t)cur.pn * tstep;
    S.a_ready(cur);
    if constexpr (SP2) {
        PG8_STAGE(PG8_SB(0, 0), cB, voffB); PG8_STAGE(PG8_SB(0, 1), cB + hstep, voffB); PG8_STAGE(PG8_SA(0, 0), cA, voffA); PG8_STAGE(PG8_SA(0, 1), cA + hstep, voffA);
        if (wr == 1) PG8_BAR;
        PG8_WAIT_V(2); PG8_BAR;
        PG8_STAGE(PG8_SB(1, 0), cB + kstep, voffB); PG8_STAGE(PG8_SA(1, 0), cA + kstep, voffA); PG8_STAGE(PG8_SB(1, 1), cB + hstep + kstep, voffB);
        PG8_WAIT_V(6); PG8_BAR;
    } else {
        PG8_STAGE(PG8_SB(0, 0), cB, voffB); PG8_STAGE(PG8_SA(0, 0), cA, voffA); PG8_STAGE(PG8_SB(0, 1), cB + hstep, voffB); PG8_STAGE(PG8_SA(0, 1), cA + hstep, voffA);
        if (wr == 1) PG8_BAR;
        PG8_WAIT_V(4); PG8_BAR;
        PG8_STAGE(PG8_SB(1, 0), cB + kstep, voffB); PG8_STAGE(PG8_SA(1, 0), cA + kstep, voffA); PG8_STAGE(PG8_SB(1, 1), cB + hstep + kstep, voffB);
        PG8_WAIT_V(6); PG8_BAR;
    }
    for (;;) {
        const bool has_next = S.next(ui + 1, nxt);
        const char* nA = has_next ? (const char*)g.A + (size_t)nxt.pm * tstep : cA; const char* nB = has_next ? (const char*)g.Bt + (size_t)nxt.pn * tstep : cB;
        for (int t = 0; t < nt; t += 2) {
            const bool last = (t == nt - 2);
            const char* a1 = cA + (size_t)(t + 1) * kstep;
            const char* a2 = last ? nA : cA + (size_t)(t + 2) * kstep; const char* b2 = last ? nB : cB + (size_t)(t + 2) * kstep;
            const char* a3 = a2 + kstep; const char* b3 = b2 + kstep;
            if (last && has_next) S.a_ready(nxt);
            if constexpr (SP2) {
            PG8_LDB(B0, 0, 0); PG8_LDB(B1, 0, 1); PG8_SCHED; PG8_LDA(At, 0, 0); PG8_STAGE(PG8_SA(1, 1), a1 + hstep, voffA);
            PG8_WAIT_V(8); PG8_WAIT_L(0); PG8_BAR; PG8_MMA(0, 0, At, B0); PG8_MMA(0, 1, At, B1); PG8_BAR; PG8_SCHED;
            PG8_LDA(At, 0, 1); PG8_STAGE(PG8_SB(0, 0), b2, voffB); PG8_STAGE(PG8_SB(0, 1), b2 + hstep, voffB); PG8_STAGE(PG8_SA(0, 0), a2, voffA);
            PG8_WAIT_V(8); PG8_WAIT_L(0); PG8_BAR; PG8_MMA(1, 0, At, B0); PG8_MMA(1, 1, At, B1); PG8_BAR; PG8_SCHED;
            PG8_LDB(B0, 1, 0); PG8_LDB(B1, 1, 1); PG8_SCHED; PG8_LDA(At, 1, 0); PG8_STAGE(PG8_SA(0, 1), a2 + hstep, voffA);
            PG8_WAIT_V(8); PG8_WAIT_L(0); PG8_BAR; PG8_MMA(0, 0, At, B0); PG8_MMA(0, 1, At, B1); PG8_BAR; PG8_SCHED;
            PG8_LDA(At, 1, 1); PG8_STAGE(PG8_SB(1, 0), b3, voffB); PG8_STAGE(PG8_SB(1, 1), b3 + hstep, voffB); PG8_STAGE(PG8_SA(1, 0), a3, voffA);
            PG8_WAIT_V(8); PG8_WAIT_L(0); PG8_BAR; PG8_MMA(1, 0, At, B0); PG8_MMA(1, 1, At, B1); PG8_BAR; PG8_SCHED;
            } else {
            PG8_LDB(B0, 0, 0); PG8_SCHED; PG8_LDA(At, 0, 0); PG8_STAGE(PG8_SA(1, 1), a1 + hstep, voffA);
            PG8_WAIT_L(8); PG8_BAR; PG8_WAIT_L(0); PG8_MMA(0, 0, At, B0); PG8_BAR; PG8_SCHED;
            PG8_LDB(B1, 0, 1); PG8_STAGE(PG8_SB(0, 0), b2, voffB);
            PG8_BAR; PG8_WAIT_L(0); PG8_MMA(0, 1, At, B1); PG8_BAR;
            PG8_LDA(At, 0, 1); PG8_STAGE(PG8_SA(0, 0), a2, voffA);
            PG8_BAR; PG8_WAIT_L(0); PG8_MMA(1, 0, At, B0); PG8_BAR; PG8_SCHED;
            PG8_STAGE(PG8_SB(0, 1), b2 + hstep, voffB);
            PG8_WAIT_V(6); PG8_BAR; PG8_MMA(1, 1, At, B1); PG8_BAR;
            PG8_LDB(B0, 1, 0); PG8_SCHED; PG8_LDA(At, 1, 0); PG8_STAGE(PG8_SA(0, 1), a2 + hstep, voffA);
            PG8_WAIT_L(8); PG8_BAR; PG8_WAIT_L(0); PG8_MMA(0, 0, At, B0); PG8_BAR; PG8_SCHED;
            PG8_LDB(B1, 1, 1); PG8_STAGE(PG8_SB(1, 0), b3, voffB);
            PG8_BAR; PG8_WAIT_L(0); PG8_MMA(0, 1, At, B1); PG8_BAR;
            PG8_LDA(At, 1, 1); PG8_STAGE(PG8_SA(1, 0), a3, voffA);
            PG8_BAR; PG8_WAIT_L(0); PG8_MMA(1, 0, At, B0); PG8_BAR; PG8_SCHED;
            PG8_STAGE(PG8_SB(1, 1), b3 + hstep, voffB);
            PG8_WAIT_V(6); PG8_BAR; PG8_MMA(1, 1, At, B1); PG8_BAR;
            }
        }
        if constexpr (ALIGN_EPI) { if (wr == 0) PG8_BAR; }
        if constexpr (!Epi::AFTER_DRAIN) { E(acc, cur, wr, wc, fr, fq); S.done(cur); }
        if (!has_next) break;
#pragma unroll
        for (int a = 0; a < 2; ++a)
#pragma unroll
            for (int b = 0; b < 2; ++b)
#pragma unroll
                for (int m = 0; m < 4; ++m)
#pragma unroll
                    for (int n = 0; n < 2; ++n) acc[a][b][m][n] = (f32x4){0.f, 0.f, 0.f, 0.f};
        cur = nxt; cA = nA; cB = nB; ++ui;
        if constexpr (ALIGN_EPI) { if (wr == 1) PG8_BAR; }
    }
    PG8_WAIT_V(0);
    if constexpr (!ALIGN_EPI) { if (wr == 0) PG8_BAR; }
    PG8_BAR;
    if constexpr (Epi::AFTER_DRAIN) { E.fused(acc, cur, wr, wc, fr, fq, lds, wid, lane); S.done(cur); }
#undef PG8_SA
#undef PG8_SB
#undef PG8_STAGE
#undef PG8_LDA
#undef PG8_LDB
#undef PG8_MMA
#undef PG8_WAIT_V
#undef PG8_WAIT_L
#undef PG8_BAR
#undef PG8_SCHED
}
}
using pg8::cvt_pk_bf16;
struct EpiProj {
    static constexpr bool PERM = true, AFTER_DRAIN = false;
    bf16_t* O; bf16_t* svT;
    DI void operator()(const f32x4 (&acc)[2][2][4][2], const pg8::Unit& u, int wr, int wc, int fr, int fq) const {
        const int row0 = u.pm * 256 + wr * 64 + fr, col0 = u.pn * 256 + wc * 32 + 8 * fq;
#pragma unroll
        for (int ai = 0; ai < 2; ++ai)
#pragma unroll
            for (int m = 0; m < 4; ++m) { bf16_t* rowp = O + (size_t)(row0 + ai * 128 + m * 16) * NIN + col0;
#pragma unroll
                for (int bj = 0; bj < 2; ++bj) { const f32x4 v0 = acc[ai][bj][m][0], v1 = acc[ai][bj][m][1];
                    u32x4 w; w.x = cvt_pk_bf16(v0[0], v0[1]); w.y = cvt_pk_bf16(v0[2], v0[3]); w.z = cvt_pk_bf16(v1[0], v1[1]); w.w = cvt_pk_bf16(v1[2], v1[3]);
                    *(u32x4*)(rowp + bj * 128) = w; } }
        if (u.pn == 2) {
#pragma unroll
            for (int ai = 0; ai < 2; ++ai)
#pragma unroll
                for (int m = 0; m < 4; ++m) { const int row = row0 + ai * 128 + m * 16, b = row >> 12, s = row & (SEQ - 1);
#pragma unroll
                    for (int n = 0; n < 2; ++n)
#pragma unroll
                        for (int e = 0; e < 4; ++e) { const int c = wc * 32 + 8 * fq + 4 * n + e;
                            svT[((size_t)(b * 2 + (c >> 6)) * 64 + (c & 63)) * SEQ + s] = (bf16_t)f2bf(acc[ai][1][m][n][e]); } }
        }
    }
};
struct EpiMkv {
    static constexpr bool PERM = true, AFTER_DRAIN = false;
    bf16_t* mk; bf16_t* mvT;
    DI void operator()(const f32x4 (&acc)[2][2][4][2], const pg8::Unit& u, int wr, int wc, int fr, int fq) const {
        const int row0 = u.pm * 256 + wr * 64 + fr;
#pragma unroll
        for (int ai = 0; ai < 2; ++ai)
#pragma unroll
            for (int m = 0; m < 4; ++m) { const int row = row0 + ai * 128 + m * 16;
                if (u.pn == 0) {
#pragma unroll
                    for (int bj = 0; bj < 2; ++bj) { const f32x4 v0 = acc[ai][bj][m][0], v1 = acc[ai][bj][m][1];
                        u32x4 w; w.x = cvt_pk_bf16(v0[0], v0[1]); w.y = cvt_pk_bf16(v0[2], v0[3]); w.z = cvt_pk_bf16(v1[0], v1[1]); w.w = cvt_pk_bf16(v1[2], v1[3]);
                        *(u32x4*)(mk + (size_t)row * 256 + bj * 128 + wc * 32 + 8 * fq) = w; }
                } else { const int b = row >> 8, mm = row & 255;
#pragma unroll
                    for (int bj = 0; bj < 2; ++bj)
#pragma unroll
                        for (int n = 0; n < 2; ++n)
#pragma unroll
                            for (int e = 0; e < 4; ++e) { const int c = bj * 128 + wc * 32 + 8 * fq + 4 * n + e;
                                mvT[((size_t)(b * 4 + (c >> 6)) * 64 + (c & 63)) * NMEM + mm] = (bf16_t)f2bf(acc[ai][bj][m][n][e]); } }
            }
    }
};
struct EpiY {
    static constexpr bool PERM = true, AFTER_DRAIN = false;
    bf16_t* Y; float* stats;
    DI void operator()(const f32x4 (&acc)[2][2][4][2], const pg8::Unit& u, int wr, int wc, int fr, int fq) const {
        const int row0 = u.pm * 256 + wr * 64 + fr, col0 = u.pn * 256 + wc * 32 + 8 * fq;
#pragma unroll
        for (int ai = 0; ai < 2; ++ai)
#pragma unroll
            for (int m = 0; m < 4; ++m) { const int row = row0 + ai * 128 + m * 16; bf16_t* rowp = Y + (size_t)row * DM + col0; float ss = 0.f;
#pragma unroll
                for (int bj = 0; bj < 2; ++bj) { const f32x4 v0 = acc[ai][bj][m][0], v1 = acc[ai][bj][m][1];
                    ss += (v0[0] * v0[0] + v0[1] * v0[1]) + (v0[2] * v0[2] + v0[3] * v0[3]) + (v1[0] * v1[0] + v1[1] * v1[1]) + (v1[2] * v1[2] + v1[3] * v1[3]);
                    u32x4 w; w.x = cvt_pk_bf16(v0[0], v0[1]); w.y = cvt_pk_bf16(v0[2], v0[3]); w.z = cvt_pk_bf16(v1[0], v1[1]); w.w = cvt_pk_bf16(v1[2], v1[3]);
                    *(u32x4*)(rowp + bj * 128) = w; }
                ss += __shfl_xor(ss, 16); ss += __shfl_xor(ss, 32);
                if (fq == 0) stats[(size_t)row * 16 + u.pn * 4 + wc] = ss; }
    }
};

typedef short bf16x8 __attribute__((ext_vector_type(8)));
typedef short s16x4 __attribute__((ext_vector_type(4)));
typedef float f32x16 __attribute__((ext_vector_type(16)));
typedef float f32x2_t __attribute__((ext_vector_type(2)));
typedef __bf16 bf16x2_t __attribute__((ext_vector_type(2)));
DI unsigned cvtpk(float lo, float hi) { f32x2_t v = {lo, hi}; bf16x2_t b = __builtin_convertvector(v, bf16x2_t); return __builtin_bit_cast(unsigned, b); }
#define MFMA32(a, b, c) __builtin_amdgcn_mfma_f32_32x32x16_bf16((a), (b), (c), 0, 0, 0)
#define MFMA16(a, b, c) __builtin_amdgcn_mfma_f32_16x16x32_bf16((a), (b), (c), 0, 0, 0)
constexpr int N_SWA_UNITS = NB * 2 * 128 * 4, N_MEM_UNITS = NB * 128 * 4, N_ATTN_UNITS = N_SWA_UNITS + N_MEM_UNITS;
DI void attn_unit(const Params& p, int l, int u, int lane) {
    const int r = lane & 31, h = lane >> 5;
    const bf16_t* P = (const bf16_t*)(p.ws + WS_P);
    const bf16_t *Qrow, *Kbase, *VTb; int kstride, vstride, kbase, kt0, nkt, mcol; float m, lsum; size_t row0;
    const bool swa = u < N_SWA_UNITS;
    if (swa) {
        const int g = u & 3, qt = (u >> 2) & 127, bk = u >> 9, b = bk >> 1, kvh = bk & 1, head = kvh * 4 + g;
        row0 = (size_t)b * SEQ + qt * 32;
        Qrow = P + row0 * NIN + C_SQ + head * 64;
        Kbase = P + (size_t)b * SEQ * NIN + C_SK + kvh * 64; kstride = NIN;
        VTb = (const bf16_t*)(p.ws + WS_SVT) + (size_t)(b * 2 + kvh) * 64 * SEQ; vstride = SEQ;
        kbase = qt * 32 - 128; kt0 = qt < 4 ? 4 - qt : 0; nkt = 5; mcol = head * 64;
        m = p.sinks[l * 8 + head] * 1.4426950408889634f; lsum = h == 0 ? 1.f : 0.f;
    } else {
        const int v = u - N_SWA_UNITS, hm = v & 3, qt = (v >> 2) & 127, b = v >> 9;
        row0 = (size_t)b * SEQ + qt * 32;
        Qrow = P + row0 * NIN + C_MQ + hm * 64;
        Kbase = (const bf16_t*)(p.ws + WS_MK) + (size_t)l * MEMROWS * 256 + (size_t)b * NMEM * 256 + hm * 64; kstride = 256;
        VTb = (const bf16_t*)(p.ws + WS_MVT) + (size_t)l * MEMROWS * 256 + (size_t)(b * 4 + hm) * 64 * NMEM; vstride = NMEM;
        kbase = 0; kt0 = 0; nkt = 8; mcol = 768 + hm * 64;
        m = -1e30f; lsum = 0.f;
    }
    bf16x8 qf[4];
#pragma unroll
    for (int ks = 0; ks < 4; ++ks) qf[ks] = *(const bf16x8*)(Qrow + (size_t)r * NIN + 16 * ks + 8 * h);
    f32x16 o0, o1;
#pragma unroll
    for (int i = 0; i < 16; ++i) { o0[i] = 0.f; o1[i] = 0.f; }
    constexpr float SC = 0.125f * 1.4426950408889634f;
    for (int kt = kt0; kt < nkt; ++kt) {
        const int key0 = kbase + 32 * kt;
        const bf16_t* kp = Kbase + (size_t)(key0 + r) * kstride + 8 * h;
        bf16x8 kf[4];
#pragma unroll
        for (int ks = 0; ks < 4; ++ks) kf[ks] = *(const bf16x8*)(kp + 16 * ks);
        const bf16_t* vp = VTb + (size_t)r * vstride + key0 + 4 * h;
        s16x4 va[2][2][2];
#pragma unroll
        for (int dt = 0; dt < 2; ++dt)
#pragma unroll
            for (int ss = 0; ss < 2; ++ss)
#pragma unroll
                for (int hf = 0; hf < 2; ++hf) va[dt][ss][hf] = *(const s16x4*)(vp + (size_t)dt * 32 * vstride + 16 * ss + 8 * hf);
        f32x16 s;
#pragma unroll
        for (int i = 0; i < 16; ++i) s[i] = 0.f;
#pragma unroll
        for (int ks = 0; ks < 4; ++ks) s = MFMA32(kf[ks], qf[ks], s);
        const bool mlo = swa && kt == 0, mhi = swa && kt == 4;
        float tm = -1e30f;
#pragma unroll
        for (int i = 0; i < 16; ++i) {
            const int c = (i & 3) + 8 * (i >> 2) + 4 * h;
            float v = s[i] * SC;
            if (mlo && !(c > r)) v = -1e30f;
            if (mhi && !(c <= r)) v = -1e30f;
            s[i] = v; tm = fmaxf(tm, v);
        }
        tm = fmaxf(tm, __shfl_xor(tm, 32));
        const float mn = fmaxf(m, tm), alpha = __builtin_amdgcn_exp2f(m - mn);
        m = mn;
        float ps = 0.f;
#pragma unroll
        for (int i = 0; i < 16; ++i) { s[i] = __builtin_amdgcn_exp2f(s[i] - mn); ps += s[i]; }
        lsum = lsum * alpha + ps;
#pragma unroll
        for (int i = 0; i < 16; ++i) { o0[i] *= alpha; o1[i] *= alpha; }
#pragma unroll
        for (int ss = 0; ss < 2; ++ss) {
            u32x4 pw; pw.x = cvtpk(s[8 * ss + 0], s[8 * ss + 1]); pw.y = cvtpk(s[8 * ss + 2], s[8 * ss + 3]); pw.z = cvtpk(s[8 * ss + 4], s[8 * ss + 5]); pw.w = cvtpk(s[8 * ss + 6], s[8 * ss + 7]);
            const bf16x8 pf = __builtin_bit_cast(bf16x8, pw);
            const bf16x8 v0 = __builtin_shufflevector(va[0][ss][0], va[0][ss][1], 0, 1, 2, 3, 4, 5, 6, 7);
            const bf16x8 v1 = __builtin_shufflevector(va[1][ss][0], va[1][ss][1], 0, 1, 2, 3, 4, 5, 6, 7);
            o0 = MFMA32(v0, pf, o0); o1 = MFMA32(v1, pf, o1);
        }
    }
    lsum += __shfl_xor(lsum, 32);
    const float inv = 1.f / lsum;
    const bf16_t* gp = P + (row0 + r) * NIN + C_GATE + mcol + 4 * h;
    bf16_t* op = (bf16_t*)(p.ws + WS_H) + (row0 + r) * DM + mcol + 4 * h;
#pragma unroll
    for (int dt = 0; dt < 2; ++dt)
#pragma unroll
        for (int g4 = 0; g4 < 4; ++g4) {
            const u32x2 gt = *(const u32x2*)(gp + 32 * dt + 8 * g4);
            const float a0 = (dt ? o1[4 * g4 + 0] : o0[4 * g4 + 0]) * inv * siluf_(bflo(gt.x)), a1 = (dt ? o1[4 * g4 + 1] : o0[4 * g4 + 1]) * inv * siluf_(bfhi(gt.x));
            const float a2 = (dt ? o1[4 * g4 + 2] : o0[4 * g4 + 2]) * inv * siluf_(bflo(gt.y)), a3 = (dt ? o1[4 * g4 + 3] : o0[4 * g4 + 3]) * inv * siluf_(bfhi(gt.y));
            u32x2 w; w.x = cvtpk(a0, a1); w.y = cvtpk(a2, a3);
            *(u32x2*)(op + 32 * dt + 8 * g4) = w;
        }
}

constexpr size_t DN_M = WS_DN;
constexpr size_t DN_NT = WS_DN + 32 * MiB;
constexpr size_t DN_UT = WS_DN + 96 * MiB;
constexpr size_t DN_W = WS_DN + 128 * MiB;
constexpr size_t DN_QG = WS_DN + 160 * MiB;
constexpr size_t DN_IN = WS_DN + 192 * MiB;
constexpr size_t DN_ST = WS_DN + 224 * MiB;
constexpr int LDK = 72;

DI void mm16x64(f32x4 (&acc)[4], const LAS bf16_t* A, int r0, const LAS bf16_t* Bt, int fr, int fq) {
    bf16x8 a[2];
#pragma unroll
    for (int ks = 0; ks < 2; ++ks) a[ks] = *(const LAS bf16x8*)(A + (r0 + fr) * LDK + 32 * ks + 8 * fq);
#pragma unroll
    for (int nt = 0; nt < 4; ++nt)
#pragma unroll
        for (int ks = 0; ks < 2; ++ks) { const bf16x8 b = *(const LAS bf16x8*)(Bt + (16 * nt + fr) * LDK + 32 * ks + 8 * fq); acc[nt] = MFMA16(a[ks], b, acc[nt]); }
}
DI void conv16(float (&out)[16], const bf16_t* Pcol, size_t rowb, int s0, const float* cw) {
#pragma unroll
    for (int e = 0; e < 16; ++e) out[e] = 0.f;
#pragma unroll
    for (int j = 0; j < 4; ++j) {
        const int s = s0 + j;
        if (s >= 0) {
            const u32x4 x0 = *(const u32x4*)(Pcol + (rowb + s) * NIN), x1 = *(const u32x4*)(Pcol + (rowb + s) * NIN + 8);
            const f32x4 w0 = *(const f32x4*)(cw + j * 768), w1 = *(const f32x4*)(cw + j * 768 + 4), w2 = *(const f32x4*)(cw + j * 768 + 8), w3 = *(const f32x4*)(cw + j * 768 + 12);
            out[0] += w0.x * bflo(x0.x); out[1] += w0.y * bfhi(x0.x); out[2] += w0.z * bflo(x0.y); out[3] += w0.w * bfhi(x0.y);
            out[4] += w1.x * bflo(x0.z); out[5] += w1.y * bfhi(x0.z); out[6] += w1.z * bflo(x0.w); out[7] += w1.w * bfhi(x0.w);
            out[8] += w2.x * bflo(x1.x); out[9] += w2.y * bfhi(x1.x); out[10] += w2.z * bflo(x1.y); out[11] += w2.w * bfhi(x1.y);
            out[12] += w3.x * bflo(x1.z); out[13] += w3.y * bfhi(x1.z); out[14] += w3.z * bflo(x1.w); out[15] += w3.w * bfhi(x1.w);
        }
    }
#pragma unroll
    for (int e = 0; e < 16; ++e) out[e] = siluf_(out[e]);
}
DI u32x4 pack8(const float* v) { u32x4 w; w.x = cvtpk(v[0], v[1]); w.y = cvtpk(v[2], v[3]); w.z = cvtpk(v[4], v[5]); w.w = cvtpk(v[6], v[7]); return w; }
DI u32x2 pack4(const f32x4 v) { u32x2 w; w.x = cvtpk(v[0], v[1]); w.y = cvtpk(v[2], v[3]); return w; }

DI void dn_prep_phase(const Params& p, int l, LAS unsigned char* lds, int tid, int G) {
    const int sg = tid >> 8, ts = tid & 255, lane = tid & 63, wsg = (tid >> 6) & 3, fr = lane & 15, fq = lane >> 4;
    LAS unsigned char* base = lds + sg * 65536;
    LAS bf16_t* qs = (LAS bf16_t*)(base); LAS bf16_t* Tm = qs;
    LAS bf16_t* ks = (LAS bf16_t*)(base + 9216); LAS bf16_t* uT = ks;
    LAS bf16_t* kdT = (LAS bf16_t*)(base + 18432);
    LAS bf16_t* kbgT = (LAS bf16_t*)(base + 27648);
    LAS bf16_t* vbT = (LAS bf16_t*)(base + 36864);
    LAS float* Lf = (LAS float*)(base + 46080); LAS bf16_t* wT = (LAS bf16_t*)(base + 46080);
    LAS float* gcs = (LAS float*)(base + 63488); LAS float* betas = gcs + 64;
    const bf16_t* P = (const bf16_t*)(p.ws + WS_P);
    const float* BA = (const float*)(p.ws + WS_BA);
    const float* cwl = p.conv_w + (size_t)l * 4 * 768;
    const int t = ts >> 2, seg = ts & 3;
    for (int it = blockIdx.x; it < 2048; it += G) {
        const int ch = 2 * it + sg, b = ch >> 8, h = (ch >> 6) & 3, n = ch & 63;
        const size_t rowb = (size_t)b * SEQ, row = rowb + n * 64 + t; const int s0 = n * 64 + t - 3;
        float cq[16], ck[16], cv[16];
        conv16(cq, P + C_DQ + h * 64 + 16 * seg, rowb, s0, cwl + h * 64 + 16 * seg);
        conv16(ck, P + C_DK + h * 64 + 16 * seg, rowb, s0, cwl + 256 + h * 64 + 16 * seg);
        conv16(cv, P + C_DV + h * 64 + 16 * seg, rowb, s0, cwl + 512 + h * 64 + 16 * seg);
        float sq = 0.f, sk = 0.f;
#pragma unroll
        for (int e = 0; e < 16; ++e) { sq += cq[e] * cq[e]; sk += ck[e] * ck[e]; }
        sq += __shfl_xor(sq, 1); sq += __shfl_xor(sq, 2); sk += __shfl_xor(sk, 1); sk += __shfl_xor(sk, 2);
        const float rq = rsqrtf(sq + EPS) * 0.125f, rk = rsqrtf(sk + EPS);
#pragma unroll
        for (int e = 0; e < 16; ++e) { cq[e] *= rq; ck[e] *= rk; }
        const float beta = BA[row * 8 + h], g = BA[row * 8 + 4 + h];
        *(LAS u32x4*)(qs + t * LDK + 16 * seg) = pack8(cq); *(LAS u32x4*)(qs + t * LDK + 16 * seg + 8) = pack8(cq + 8);
        *(LAS u32x4*)(ks + t * LDK + 16 * seg) = pack8(ck); *(LAS u32x4*)(ks + t * LDK + 16 * seg + 8) = pack8(ck + 8);
        if (seg == 0) { gcs[t] = g; betas[t] = beta; }
        __syncthreads();
        float x = gcs[lane];
#pragma unroll
        for (int o = 1; o < 64; o <<= 1) { const float y = __shfl_up(x, o); if (lane >= o) x += y; }
        const float gc_t = __shfl(x, t), gl = __shfl(x, 63);
        __syncthreads();
        if (wsg == 0) gcs[lane] = x;
        const float eg = __expf(gc_t), ed = __expf(gl - gc_t);
#pragma unroll
        for (int e = 0; e < 16; ++e) { const int i = 16 * seg + e;
            kdT[i * LDK + t] = (bf16_t)f2bf(ck[e] * ed); kbgT[i * LDK + t] = (bf16_t)f2bf(ck[e] * beta * eg); vbT[i * LDK + t] = (bf16_t)f2bf(cv[e] * beta); }
        { float qg[16];
#pragma unroll
          for (int e = 0; e < 16; ++e) qg[e] = cq[e] * eg;
          bf16_t* dst = (bf16_t*)(p.ws + DN_QG) + (size_t)ch * 4096 + t * 64 + 16 * seg;
          *(u32x4*)dst = pack8(qg); *(u32x4*)(dst + 8) = pack8(qg + 8); }
        __syncthreads();
        {
            f32x4 acc[4], acc2[4];
#pragma unroll
            for (int nt = 0; nt < 4; ++nt) { acc[nt] = (f32x4){0.f, 0.f, 0.f, 0.f}; acc2[nt] = (f32x4){0.f, 0.f, 0.f, 0.f}; }
            mm16x64(acc, ks, 16 * wsg, ks, fr, fq);
            mm16x64(acc2, ks, 16 * wsg, qs, fr, fq);
            const int r0 = 16 * wsg + 4 * fq;
            float gr[4], br[4];
#pragma unroll
            for (int r = 0; r < 4; ++r) { gr[r] = gcs[r0 + r]; br[r] = betas[r0 + r]; }
#pragma unroll
            for (int nt = 0; nt < 4; ++nt) { const int cc = 16 * nt + fr; const float gcol = gcs[cc];
#pragma unroll
                for (int r = 0; r < 4; ++r) { const int c = r0 + r;
                    Lf[c * 68 + cc] = (cc < c) ? br[r] * acc[nt][r] * __expf(gr[r] - gcol) : 0.f; }
                f32x4 iv;
#pragma unroll
                for (int r = 0; r < 4; ++r) { const int s = r0 + r;
                    iv[r] = (s <= cc) ? acc2[nt][r] * __expf(gcol - gr[r]) : 0.f; }
                *(u32x2*)((bf16_t*)(p.ws + DN_IN) + (size_t)ch * 4096 + cc * 64 + r0) = pack4(iv); }
        }
        __syncthreads();
        if (wsg == 0) {
            float T[64];
#pragma unroll
            for (int c = 0; c < 64; ++c) T[c] = 0.f;
#pragma unroll
            for (int c = 0; c < 64; ++c) {
                float a0 = (lane == c) ? 1.f : 0.f, a1 = 0.f, a2 = 0.f, a3 = 0.f;
#pragma unroll
                for (int s4 = 0; s4 < (c + 3) / 4; ++s4) { const f32x4 Lv = *(const LAS f32x4*)(Lf + c * 68 + 4 * s4);
                    a0 -= Lv.x * T[4 * s4]; a1 -= Lv.y * T[4 * s4 + 1]; a2 -= Lv.z * T[4 * s4 + 2]; a3 -= Lv.w * T[4 * s4 + 3]; }
                T[c] = (a0 + a1) + (a2 + a3);
            }
#pragma unroll
            for (int c = 0; c < 64; ++c) Tm[c * LDK + lane] = (bf16_t)f2bf(T[c]);
        }
        __syncthreads();
        {   f32x4 au[4], aw[4], awr[4];
#pragma unroll
            for (int nt = 0; nt < 4; ++nt) { au[nt] = (f32x4){0.f, 0.f, 0.f, 0.f}; aw[nt] = au[nt]; awr[nt] = au[nt]; }
            mm16x64(au, Tm, 16 * wsg, vbT, fr, fq);
            mm16x64(aw, Tm, 16 * wsg, kbgT, fr, fq);
            mm16x64(awr, kbgT, 16 * wsg, Tm, fr, fq);
            const int r0 = 16 * wsg + 4 * fq;
#pragma unroll
            for (int nt = 0; nt < 4; ++nt) { const int cc = 16 * nt + fr;
                const u32x2 pu = pack4(au[nt]);
                *(LAS u32x2*)(uT + cc * LDK + r0) = pu; *(u32x2*)((bf16_t*)(p.ws + DN_UT) + (size_t)ch * 4096 + cc * 64 + r0) = pu;
                *(LAS u32x2*)(wT + cc * LDK + r0) = pack4(aw[nt]);
                *(u32x2*)((bf16_t*)(p.ws + DN_W) + (size_t)ch * 4096 + cc * 64 + r0) = pack4(awr[nt]); }
        }
        __syncthreads();
        {   f32x4 am[4], an[4];
#pragma unroll
            for (int nt = 0; nt < 4; ++nt) { am[nt] = (f32x4){0.f, 0.f, 0.f, 0.f}; an[nt] = am[nt]; }
            mm16x64(am, wT, 16 * wsg, kdT, fr, fq);
            mm16x64(an, kdT, 16 * wsg, uT, fr, fq);
            const int r0 = 16 * wsg + 4 * fq; const float egl = __expf(gl);
#pragma unroll
            for (int nt = 0; nt < 4; ++nt) { const int cc = 16 * nt + fr; f32x4 mv;
#pragma unroll
                for (int r = 0; r < 4; ++r) mv[r] = ((r0 + r) == cc ? egl : 0.f) - am[nt][r];
                *(u32x2*)((bf16_t*)(p.ws + DN_M) + (size_t)ch * 4096 + cc * 64 + r0) = pack4(mv);
                *(f32x4*)((float*)(p.ws + DN_NT) + (size_t)ch * 4096 + cc * 64 + r0) = an[nt]; }
        }
        __syncthreads();
    }
}
DI void dn_scan_item(const Params& p, int item, int lane) {
    const int bh = item >> 2, js = item & 3, fr = lane & 15, fq = lane >> 4, j = 16 * js + fr;
    f32x4 S[4];
#pragma unroll
    for (int mt = 0; mt < 4; ++mt) S[mt] = (f32x4){0.f, 0.f, 0.f, 0.f};
    const bf16_t* Mb = (const bf16_t*)(p.ws + DN_M) + (size_t)bh * 64 * 4096;
    const float* Nb = (const float*)(p.ws + DN_NT) + (size_t)bh * 64 * 4096;
    bf16_t* Sb = (bf16_t*)(p.ws + DN_ST) + (size_t)bh * 64 * 4096;
    s16x4 an[4][2][2]; f32x4 cn[4];
#pragma unroll
    for (int mt = 0; mt < 4; ++mt) { cn[mt] = *(const f32x4*)(Nb + j * 64 + 16 * mt + 4 * fq);
#pragma unroll
        for (int ks = 0; ks < 2; ++ks) { an[mt][ks][0] = *(const s16x4*)(Mb + (16 * mt + fr) * 64 + 32 * ks + 4 * fq); an[mt][ks][1] = *(const s16x4*)(Mb + (16 * mt + fr) * 64 + 32 * ks + 16 + 4 * fq); } }
    for (int n = 0; n < 64; ++n) {
        s16x4 ac[4][2][2]; f32x4 cc[4];
#pragma unroll
        for (int mt = 0; mt < 4; ++mt) { cc[mt] = cn[mt];
#pragma unroll
            for (int ks = 0; ks < 2; ++ks) { ac[mt][ks][0] = an[mt][ks][0]; ac[mt][ks][1] = an[mt][ks][1]; } }
        if (n + 1 < 63) { const bf16_t* M = Mb + (size_t)(n + 1) * 4096; const float* N = Nb + (size_t)(n + 1) * 4096;
#pragma unroll
            for (int mt = 0; mt < 4; ++mt) { cn[mt] = *(const f32x4*)(N + j * 64 + 16 * mt + 4 * fq);
#pragma unroll
                for (int ks = 0; ks < 2; ++ks) { an[mt][ks][0] = *(const s16x4*)(M + (16 * mt + fr) * 64 + 32 * ks + 4 * fq); an[mt][ks][1] = *(const s16x4*)(M + (16 * mt + fr) * 64 + 32 * ks + 16 + 4 * fq); } } }
        bf16_t* ST = Sb + (size_t)n * 4096;
#pragma unroll
        for (int mt = 0; mt < 4; ++mt) *(u32x2*)(ST + j * 64 + 16 * mt + 4 * fq) = pack4(S[mt]);
        if (n == 63) break;
        bf16x8 bfr[2];
#pragma unroll
        for (int ks = 0; ks < 2; ++ks) { u32x4 w; const u32x2 lo = pack4(S[2 * ks]), hi = pack4(S[2 * ks + 1]); w.x = lo.x; w.y = lo.y; w.z = hi.x; w.w = hi.y; bfr[ks] = __builtin_bit_cast(bf16x8, w); }
#pragma unroll
        for (int mt = 0; mt < 4; ++mt) { f32x4 a = cc[mt];
#pragma unroll
            for (int ks = 0; ks < 2; ++ks) a = MFMA16(__builtin_shufflevector(ac[mt][ks][0], ac[mt][ks][1], 0, 1, 2, 3, 4, 5, 6, 7), bfr[ks], a);
            S[mt] = a; }
    }
}
DI void dn_out_phase(const Params& p, int l, LAS unsigned char* lds, int tid, int G) {
    const int sg = tid >> 8, lane = tid & 63, js = (tid >> 6) & 3, fr = lane & 15, fq = lane >> 4, j = 16 * js + fr;
    LAS float* ssb = (LAS float*)lds + sg * 256;
    const bf16_t* P = (const bf16_t*)(p.ws + WS_P);
    bf16_t* MIX = (bf16_t*)(p.ws + WS_H);
    const float gn = p.dn_g[l * 64 + j];
    for (int it = blockIdx.x; it < 2048; it += G) {
        const int ch = 2 * it + sg, b = ch >> 8, h = (ch >> 6) & 3, n = ch & 63;
        const bf16_t* W = (const bf16_t*)(p.ws + DN_W) + (size_t)ch * 4096; const bf16_t* QG = (const bf16_t*)(p.ws + DN_QG) + (size_t)ch * 4096;
        const bf16_t* IN = (const bf16_t*)(p.ws + DN_IN) + (size_t)ch * 4096; const bf16_t* ST = (const bf16_t*)(p.ws + DN_ST) + (size_t)ch * 4096;
        const bf16_t* UT = (const bf16_t*)(p.ws + DN_UT) + (size_t)ch * 4096;
        bf16x8 bS[2];
#pragma unroll
        for (int ks = 0; ks < 2; ++ks) bS[ks] = *(const bf16x8*)(ST + j * 64 + 32 * ks + 8 * fq);
        f32x4 vn[4], o[4];
#pragma unroll
        for (int mt = 0; mt < 4; ++mt) { f32x4 tt = (f32x4){0.f, 0.f, 0.f, 0.f};
#pragma unroll
            for (int ks = 0; ks < 2; ++ks) tt = MFMA16(*(const bf16x8*)(W + (16 * mt + fr) * 64 + 32 * ks + 8 * fq), bS[ks], tt);
            const u32x2 uu = *(const u32x2*)(UT + j * 64 + 16 * mt + 4 * fq);
            vn[mt] = (f32x4){bflo(uu.x) - tt[0], bfhi(uu.x) - tt[1], bflo(uu.y) - tt[2], bfhi(uu.y) - tt[3]}; }
        bf16x8 bV[2];
#pragma unroll
        for (int ks = 0; ks < 2; ++ks) { u32x4 w; const u32x2 lo = pack4(vn[2 * ks]), hi = pack4(vn[2 * ks + 1]); w.x = lo.x; w.y = lo.y; w.z = hi.x; w.w = hi.y; bV[ks] = __builtin_bit_cast(bf16x8, w); }
#pragma unroll
        for (int mt = 0; mt < 4; ++mt) { f32x4 a = (f32x4){0.f, 0.f, 0.f, 0.f};
#pragma unroll
            for (int ks = 0; ks < 2; ++ks) a = MFMA16(*(const bf16x8*)(QG + (16 * mt + fr) * 64 + 32 * ks + 8 * fq), bS[ks], a);
#pragma unroll
            for (int ks = 0; ks < 2; ++ks) { const s16x4 lo = *(const s16x4*)(IN + (16 * mt + fr) * 64 + 32 * ks + 4 * fq), hi = *(const s16x4*)(IN + (16 * mt + fr) * 64 + 32 * ks + 16 + 4 * fq);
                a = MFMA16(__builtin_shufflevector(lo, hi, 0, 1, 2, 3, 4, 5, 6, 7), bV[ks], a); }
            o[mt] = a; }
#pragma unroll
        for (int mt = 0; mt < 4; ++mt)
#pragma unroll
            for (int r = 0; r < 4; ++r) { float q = o[mt][r] * o[mt][r]; q += __shfl_xor(q, 1); q += __shfl_xor(q, 2); q += __shfl_xor(q, 4); q += __shfl_xor(q, 8);
                if (fr == 0) ssb[js * 64 + 16 * mt + 4 * fq + r] = q; }
        __syncthreads();
#pragma unroll
        for (int mt = 0; mt < 4; ++mt)
#pragma unroll
            for (int r = 0; r < 4; ++r) { const int c = 16 * mt + 4 * fq + r; const float tot = (ssb[c] + ssb[64 + c]) + (ssb[128 + c] + ssb[192 + c]);
                const float rinv = rsqrtf(tot * (1.f / 64.f) + EPS);
                const size_t row = (size_t)b * SEQ + n * 64 + c; const int mcol = 512 + h * 64 + j;
                const float gt = bf2f(P[row * NIN + C_GATE + mcol]);
                MIX[row * DM + mcol] = (bf16_t)f2bf(o[mt][r] * rinv * gn * siluf_(gt)); }
        __syncthreads();
    }
}

enum { K_INIT = 0, K_PREP = 1, K_INPROJ = 2, K_DNPREP = 3, K_ATTN = 4, K_DNOUT = 5, K_OUTPROJ = 6, K_FINAL = 7 };
__global__ void __launch_bounds__(512, 2) mega(Params p, int kind, int l) {
    extern __shared__ __attribute__((aligned(16))) unsigned char lds_raw[];
    LAS unsigned char* lds = (LAS unsigned char*)lds_raw;
    const int tid = threadIdx.x, lane = tid & 63, wave = __builtin_amdgcn_readfirstlane(tid >> 6);
    const int G = gridDim.x;
    const int gw = blockIdx.x * 8 + wave, ngw = G * 8;
    unsigned char* ws = p.ws;
    if (kind == K_INIT) phase_init(p, lds, gw, ngw, wave, lane);
    else if (kind == K_PREP) {
        if (l == 0) { for (int row = gw; row < NTOK; row += ngw) prep_row<false>(p, 0, row, lane); }
        else { for (int row = gw; row < NTOK; row += ngw) prep_row<true>(p, l, row, lane); }
    } else if (kind == K_INPROJ) {
        { pg8::Gemm g{(const bf16_t*)(ws + WS_H), (const bf16_t*)(ws + WS_WIN) + (size_t)l * NIN * DM, NTOK, NIN, DM};
          pg8::StaticOrder S; S.init(NTOK, NIN, G, (int)blockIdx.x);
          EpiProj E{(bf16_t*)(ws + WS_P), (bf16_t*)(ws + WS_SVT)};
          pg8::gemm_phase<EpiProj, pg8::StaticOrder, true, true>(lds, g, S, E); }
        if (l == 0) {
            for (int ll = 0; ll < DEPTH; ++ll) {
                pg8::Gemm g{(const bf16_t*)(ws + WS_MEMN) + (size_t)ll * MEMROWS * DM, (const bf16_t*)(ws + WS_WMKV) + (size_t)ll * 512 * DM, MEMROWS, 512, DM};
                pg8::StaticOrder S; S.init(MEMROWS, 512, G, (int)((blockIdx.x + G - 32 * ll) % G));
                EpiMkv E{(bf16_t*)(ws + WS_MK) + (size_t)ll * MEMROWS * 256, (bf16_t*)(ws + WS_MVT) + (size_t)ll * MEMROWS * 256};
                pg8::gemm_phase<EpiMkv, pg8::StaticOrder, true, true>(lds, g, S, E);
            }
        }
    } else if (kind == K_DNPREP) {
        dn_prep_phase(p, l, lds, tid, G);
    } else if (kind == K_ATTN) {
        if (wave == 0) for (int item = blockIdx.x; item < 256; item += G) dn_scan_item(p, item, lane);
        for (int u = gw; u < N_ATTN_UNITS; u += ngw) attn_unit(p, l, u, lane);
    } else if (kind == K_DNOUT) {
        dn_out_phase(p, l, lds, tid, G);
    } else if (kind == K_OUTPROJ) {
        pg8::Gemm g{(const bf16_t*)(ws + WS_H), (const bf16_t*)(ws + WS_WOUT) + (size_t)l * DM * DM, NTOK, DM, DM};
        pg8::StaticOrder S; S.init(NTOK, DM, G, (int)blockIdx.x);
        EpiY E{(bf16_t*)(ws + WS_P), (float*)(ws + WS_STATS)};
        pg8::gemm_phase<EpiY, pg8::StaticOrder, true, true>(lds, g, S, E);
    } else if (kind == K_FINAL) {
        for (int row = gw; row < NTOK; row += ngw) final_row(p, row, lane);
    }
}

__global__ void __launch_bounds__(256) naive_gemm(const bf16_t* A, const bf16_t* Bt, int M, int N, int K, int mode, bf16_t* O0, bf16_t* O1) {
    __shared__ float sA[32][65], sB[32][65];
    const int tid = threadIdx.x, tx = tid & 15, ty = tid >> 4;
    const int m0 = blockIdx.y * 64, n0 = blockIdx.x * 64;
    float acc[4][4];
#pragma unroll
    for (int i = 0; i < 4; ++i)
#pragma unroll
        for (int j = 0; j < 4; ++j) acc[i][j] = 0.f;
    for (int k0 = 0; k0 < K; k0 += 32) {
        { const int r = tid >> 2, kc = (tid & 3) * 8;
          const u32x4 a = *(const u32x4*)(A + (size_t)(m0 + r) * K + k0 + kc), b = *(const u32x4*)(Bt + (size_t)(n0 + r) * K + k0 + kc);
          sA[kc + 0][r] = bflo(a.x); sA[kc + 1][r] = bfhi(a.x); sA[kc + 2][r] = bflo(a.y); sA[kc + 3][r] = bfhi(a.y); sA[kc + 4][r] = bflo(a.z); sA[kc + 5][r] = bfhi(a.z); sA[kc + 6][r] = bflo(a.w); sA[kc + 7][r] = bfhi(a.w);
          sB[kc + 0][r] = bflo(b.x); sB[kc + 1][r] = bfhi(b.x); sB[kc + 2][r] = bflo(b.y); sB[kc + 3][r] = bfhi(b.y); sB[kc + 4][r] = bflo(b.z); sB[kc + 5][r] = bfhi(b.z); sB[kc + 6][r] = bflo(b.w); sB[kc + 7][r] = bfhi(b.w); }
        __syncthreads();
#pragma unroll 8
        for (int k = 0; k < 32; ++k) {
            float a[4], b[4];
#pragma unroll
            for (int i = 0; i < 4; ++i) { a[i] = sA[k][ty * 4 + i]; b[i] = sB[k][tx * 4 + i]; }
#pragma unroll
            for (int i = 0; i < 4; ++i)
#pragma unroll
                for (int j = 0; j < 4; ++j) acc[i][j] += a[i] * b[j];
        }
        __syncthreads();
    }
#pragma unroll
    for (int i = 0; i < 4; ++i)
#pragma unroll
        for (int j = 0; j < 4; ++j) {
            const int row = m0 + ty * 4 + i, col = n0 + tx * 4 + j; const bf16_t v = (bf16_t)f2bf(acc[i][j]);
            if (mode == 0) {
                O0[(size_t)row * NIN + col] = v;
                if (col >= C_SV && col < C_SV + 128) { const int b = row / SEQ, s = row % SEQ, c = col - C_SV; O1[((size_t)(b * 2 + c / 64) * 64 + (c % 64)) * SEQ + s] = v; }
            } else if (mode == 1) {
                if (col < 256) O0[(size_t)row * 256 + col] = v;
                else { const int b = row / NMEM, m = row % NMEM, c = col - 256; O1[((size_t)(b * 4 + c / 64) * 64 + (c % 64)) * NMEM + m] = v; }
            } else {
                O0[(size_t)row * DM + col] = v;
            }
        }
}
__global__ void __launch_bounds__(256) naive_stats(const bf16_t* Y, float* stats) {
    const int lane = threadIdx.x & 63, row = blockIdx.x * 4 + (threadIdx.x >> 6);
    const u32x2* yr = (const u32x2*)(Y + (size_t)row * DM) + lane; float s = 0.f;
#pragma unroll
    for (int j = 0; j < 4; ++j) { const u32x2 y = yr[64 * j]; const float a = bflo(y.x), b = bfhi(y.x), c = bflo(y.y), d = bfhi(y.y); s += (a * a + b * b) + (c * c + d * d); }
    s = wave_sum(s);
    if (lane < 16) stats[(size_t)row * 16 + lane] = lane == 0 ? s : 0.f;
}
__global__ void __launch_bounds__(256) naive_attn(Params p, int l) {
    const int gid = blockIdx.x * 256 + threadIdx.x; const int row = gid / 12, hh = gid % 12;
    const bf16_t* P = (const bf16_t*)(p.ws + WS_P);
    const int b = row / SEQ, s = row % SEQ;
    float q[64], o[64];
    const bool swa = hh < 8;
    const int qcol = swa ? C_SQ + hh * 64 : C_MQ + (hh - 8) * 64;
#pragma unroll
    for (int d = 0; d < 64; ++d) { q[d] = bf2f(P[(size_t)row * NIN + qcol + d]) * 0.125f; o[d] = 0.f; }
    float m, lsum;
    if (swa) { m = p.sinks[l * 8 + hh]; lsum = 1.f; } else { m = -1e30f; lsum = 0.f; }
    const int nk = swa ? 128 : 256;
    const bf16_t* svT = (const bf16_t*)(p.ws + WS_SVT);
    const bf16_t* mk = (const bf16_t*)(p.ws + WS_MK) + (size_t)l * MEMROWS * 256;
    const bf16_t* mvT = (const bf16_t*)(p.ws + WS_MVT) + (size_t)l * MEMROWS * 256;
    for (int jj = 0; jj < nk; ++jj) {
        const bf16_t* kp; const bf16_t* vp; size_t vstride;
        if (swa) { const int j = s - 127 + jj; if (j < 0) continue; const int kvh = hh >> 2;
            kp = P + (size_t)(b * SEQ + j) * NIN + C_SK + kvh * 64; vp = svT + ((size_t)(b * 2 + kvh) * 64) * SEQ + j; vstride = SEQ; }
        else { const int hm = hh - 8; kp = mk + (size_t)(b * NMEM + jj) * 256 + hm * 64; vp = mvT + ((size_t)(b * 4 + hm) * 64) * NMEM + jj; vstride = NMEM; }
        float sc = 0.f;
#pragma unroll
        for (int d = 0; d < 64; ++d) sc += q[d] * bf2f(kp[d]);
        const float mn = fmaxf(m, sc), f = __expf(m - mn), pe = __expf(sc - mn);
        lsum = lsum * f + pe; m = mn;
#pragma unroll
        for (int d = 0; d < 64; ++d) o[d] = o[d] * f + pe * bf2f(vp[(size_t)d * vstride]);
    }
    const float inv = 1.f / lsum;
    const int mcol = swa ? hh * 64 : 768 + (hh - 8) * 64;
    bf16_t* MIX = (bf16_t*)(p.ws + WS_H);
#pragma unroll
    for (int d = 0; d < 64; ++d) { const float g = bf2f(P[(size_t)row * NIN + C_GATE + mcol + d]); MIX[(size_t)row * DM + mcol + d] = (bf16_t)f2bf(o[d] * inv * siluf_(g)); }
}
__global__ void __launch_bounds__(64) naive_dn(Params p, int l) {
    const int b = blockIdx.x >> 2, h = blockIdx.x & 3, j = threadIdx.x;
    const bf16_t* P = (const bf16_t*)(p.ws + WS_P);
    const float* BA = (const float*)(p.ws + WS_BA);
    bf16_t* MIX = (bf16_t*)(p.ws + WS_H);
    const float* cw = p.conv_w + (size_t)l * 4 * 768;
    float wq[4], wk[4], wv[4];
#pragma unroll
    for (int t = 0; t < 4; ++t) { wq[t] = cw[t * 768 + h * 64 + j]; wk[t] = cw[t * 768 + 256 + h * 64 + j]; wv[t] = cw[t * 768 + 512 + h * 64 + j]; }
    const float gn = p.dn_g[l * 64 + j];
    float S[64];
#pragma unroll
    for (int i = 0; i < 64; ++i) S[i] = 0.f;
    float xq[4] = {0.f, 0.f, 0.f, 0.f}, xk[4] = {0.f, 0.f, 0.f, 0.f}, xv[4] = {0.f, 0.f, 0.f, 0.f};
    for (int t = 0; t < SEQ; ++t) {
        const size_t row = (size_t)b * SEQ + t;
        xq[0] = xq[1]; xq[1] = xq[2]; xq[2] = xq[3]; xq[3] = bf2f(P[row * NIN + C_DQ + h * 64 + j]);
        xk[0] = xk[1]; xk[1] = xk[2]; xk[2] = xk[3]; xk[3] = bf2f(P[row * NIN + C_DK + h * 64 + j]);
        xv[0] = xv[1]; xv[1] = xv[2]; xv[2] = xv[3]; xv[3] = bf2f(P[row * NIN + C_DV + h * 64 + j]);
        float cq = siluf_(wq[0] * xq[0] + wq[1] * xq[1] + wq[2] * xq[2] + wq[3] * xq[3]);
        float ck = siluf_(wk[0] * xk[0] + wk[1] * xk[1] + wk[2] * xk[2] + wk[3] * xk[3]);
        const float cv = siluf_(wv[0] * xv[0] + wv[1] * xv[1] + wv[2] * xv[2] + wv[3] * xv[3]);
        cq *= rsqrtf(wave_sum(cq * cq) + EPS) * 0.125f;
        ck *= rsqrtf(wave_sum(ck * ck) + EPS);
        const float beta = BA[row * 8 + h], a = __expf(BA[row * 8 + 4 + h]);
        float ks = 0.f;
#pragma unroll
        for (int i = 0; i < 64; ++i) ks += __shfl(ck, i) * S[i];
        const float dv = beta * (cv - a * ks);
        float oj = 0.f;
#pragma unroll
        for (int i = 0; i < 64; ++i) { S[i] = a * S[i] + __shfl(ck, i) * dv; oj += __shfl(cq, i) * S[i]; }
        const float r = rsqrtf(wave_sum(oj * oj) * (1.f / 64.f) + EPS);
        const int mcol = 512 + h * 64 + j;
        const float g = bf2f(P[row * NIN + C_GATE + mcol]);
        MIX[row * DM + mcol] = (bf16_t)f2bf(oj * r * gn * siluf_(g));
    }
}

extern "C" void kernel_launch(void* const* d_in, const int* in_sizes, int n_in, void* d_out, int out_size, void* d_ws, size_t ws_size, hipStream_t stream) {
    static int inited = 0;
    constexpr int LDS_BYTES = 147456;
    if (!inited) {
        if (n_in != 13 || ws_size < WS_END) { fprintf(stderr, "kernel_launch: unexpected n_in %d / ws_size %zu\n", n_in, ws_size); inited = -1; return; }
        (void)hipFuncSetAttribute((const void*)mega, hipFuncAttributeMaxDynamicSharedMemorySize, LDS_BYTES);
        inited = 1;
    }
    if (inited < 0) return;
    Params p{};
    p.x = (const float*)d_in[0]; p.mem = (const float*)d_in[1]; p.pre_g = (const float*)d_in[2]; p.w_in = (const float*)d_in[3]; p.conv_w = (const float*)d_in[4];
    p.a_log = (const float*)d_in[5]; p.dt_bias = (const float*)d_in[6]; p.sinks = (const float*)d_in[7]; p.dn_g = (const float*)d_in[8]; p.mem_g = (const float*)d_in[9];
    p.w_mkv = (const float*)d_in[10]; p.w_out = (const float*)d_in[11]; p.post_g = (const float*)d_in[12];
    p.out = (float*)d_out; p.ws = (unsigned char*)d_ws;
    const int G = 256;
#define PH(kind, l) hipLaunchKernelGGL(mega, dim3(G), dim3(512), LDS_BYTES, stream, p, (int)(kind), (int)(l))
    PH(K_INIT, 0);
    PH(K_PREP, 0);
    for (int l = 0; l < DEPTH; ++l) {
        PH(K_INPROJ, l);
        PH(K_DNPREP, l);
        PH(K_ATTN, l);
        PH(K_DNOUT, l);
        PH(K_OUTPROJ, l);
        if (l + 1 < DEPTH) PH(K_PREP, l + 1); else PH(K_FINAL, 0);
    }
#undef PH
}
```

```cpp
#include <hip/hip_runtime.h>
#include <hip/hip_cooperative_groups.h>
#include <cstdio>
#include <cstdint>

#define DI __device__ __forceinline__
#define LAS __attribute__((address_space(3)))
typedef unsigned short bf16_t;
typedef float f32x4 __attribute__((ext_vector_type(4)));
typedef unsigned u32x4 __attribute__((ext_vector_type(4)));
typedef unsigned u32x2 __attribute__((ext_vector_type(2)));

constexpr int DM = 1024, NB = 16, SEQ = 4096, NTOK = NB * SEQ, DEPTH = 2;
constexpr int INW = 2824;
constexpr int NIN = 2816;
constexpr int NMEM = 256, MEMROWS = NB * NMEM;
constexpr float EPS = 1e-6f;
constexpr int C_SQ = 0, C_SK = 512, C_SV = 640, C_DQ = 768, C_DK = 1024, C_DV = 1280, C_MQ = 1536, C_GATE = 1792;

constexpr size_t MiB = 1u << 20;
constexpr size_t WS_CTL = 0;
constexpr size_t WS_WIN = 1 * MiB;
constexpr size_t WS_WOUT = 12 * MiB;
constexpr size_t WS_WMKV = 16 * MiB;
constexpr size_t WS_W8 = 18 * MiB;
constexpr size_t WS_MEMN = 19 * MiB;
constexpr size_t WS_MK = 35 * MiB;
constexpr size_t WS_MVT = 39 * MiB;
constexpr size_t WS_BA = 43 * MiB;
constexpr size_t WS_STATS = 45 * MiB;
constexpr size_t WS_SVT = 49 * MiB;
constexpr size_t WS_H = 65 * MiB;
constexpr size_t WS_P = 193 * MiB;
constexpr size_t WS_DN = 545 * MiB;
constexpr size_t WS_END = 801 * MiB;

struct Params {
    const float *x, *mem, *pre_g, *w_in, *conv_w, *a_log, *dt_bias, *sinks, *dn_g, *mem_g, *w_mkv, *w_out, *post_g;
    float* out;
    unsigned char* ws;
};

DI unsigned f2bf(float f) { unsigned u = __float_as_uint(f); return (u + 0x7fffu + ((u >> 16) & 1u)) >> 16; }
DI unsigned pk2(float lo, float hi) { return f2bf(lo) | (f2bf(hi) << 16); }
DI float bf2f(unsigned u) { return __uint_as_float(u << 16); }
DI float bflo(unsigned u) { return __uint_as_float(u << 16); }
DI float bfhi(unsigned u) { return __uint_as_float(u & 0xffff0000u); }
DI float wave_sum(float v) {
#pragma unroll
    for (int o = 1; o < 64; o <<= 1) v += __shfl_xor(v, o);
    return v;
}
DI float sigmoidf_(float x) { return 1.f / (1.f + __expf(-x)); }
DI float siluf_(float x) { return x / (1.f + __expf(-x)); }
DI float softplusf_(float x) { return x > 20.f ? x : log1pf(expf(x)); }

DI void transpose_item(const float* W, int Nsrc, int src_n0, int k0, bf16_t* WT, int K, int dst_n0, LAS float* scr, int lane) {
#pragma unroll 8
    for (int i = 0; i < 32; ++i) { const int kk = 2 * i + (lane >> 5); scr[kk * 33 + (lane & 31)] = W[(size_t)(k0 + kk) * Nsrc + src_n0 + (lane & 31)]; }
    asm volatile("s_waitcnt lgkmcnt(0)" ::: "memory");
    const int c = lane & 7;
#pragma unroll
    for (int j = 0; j < 4; ++j) {
        const int n = (lane >> 3) + 8 * j; const LAS float* s = scr + (8 * c) * 33 + n;
        u32x4 o; o.x = pk2(s[0 * 33], s[1 * 33]); o.y = pk2(s[2 * 33], s[3 * 33]); o.z = pk2(s[4 * 33], s[5 * 33]); o.w = pk2(s[6 * 33], s[7 * 33]);
        *(u32x4*)(WT + (size_t)(dst_n0 + n) * K + k0 + 8 * c) = o;
    }
    asm volatile("s_waitcnt lgkmcnt(0)" ::: "memory");
}

DI void phase_init(const Params& p, LAS unsigned char* lds, int gw, int ngw, int wave, int lane) {
    LAS float* scr = (LAS float*)(lds + wave * 16384);
    constexpr int I_IN = 16 * (NIN / 32), I_OUT = 16 * 32, I_MKV = 16 * 16, I_L = I_IN + I_OUT + I_MKV;
    for (int it = gw; it < DEPTH * I_L; it += ngw) {
        const int l = it / I_L; int r = it % I_L;
        if (r < I_IN) {
            const int kb = r / (NIN / 32), nb = r % (NIN / 32), n0 = nb * 32;
            transpose_item(p.w_in + (size_t)l * DM * INW, INW, n0 + (n0 >= 1536 ? 8 : 0), kb * 64, (bf16_t*)(p.ws + WS_WIN) + (size_t)l * NIN * DM, DM, n0, scr, lane);
        } else if (r < I_IN + I_OUT) {
            r -= I_IN; const int kb = r / 32, nb = r % 32;
            transpose_item(p.w_out + (size_t)l * DM * DM, DM, nb * 32, kb * 64, (bf16_t*)(p.ws + WS_WOUT) + (size_t)l * DM * DM, DM, nb * 32, scr, lane);
        } else {
            r -= I_IN + I_OUT; const int kb = r / 16, nb = r % 16;
            transpose_item(p.w_mkv + (size_t)l * DM * 512, 512, nb * 32, kb * 64, (bf16_t*)(p.ws + WS_WMKV) + (size_t)l * 512 * DM, DM, nb * 32, scr, lane);
        }
    }
    for (int it = gw; it < DEPTH * MEMROWS; it += ngw) {
        const int l = it / MEMROWS, row = it % MEMROWS;
        const f32x4* xr = (const f32x4*)(p.mem + (size_t)row * DM) + lane;
        f32x4 v[4]; float s = 0.f;
#pragma unroll
        for (int j = 0; j < 4; ++j) { v[j] = xr[64 * j]; s += (v[j].x * v[j].x + v[j].y * v[j].y) + (v[j].z * v[j].z + v[j].w * v[j].w); }
        const float r = rsqrtf(wave_sum(s) * (1.f / DM) + EPS);
        const f32x4* gr = (const f32x4*)(p.mem_g + (size_t)l * DM) + lane;
        u32x2* o = (u32x2*)((bf16_t*)(p.ws + WS_MEMN) + ((size_t)l * MEMROWS + row) * DM) + lane;
#pragma unroll
        for (int j = 0; j < 4; ++j) { const f32x4 g = gr[64 * j]; u32x2 w; w.x = pk2(v[j].x * r * g.x, v[j].y * r * g.y); w.y = pk2(v[j].z * r * g.z, v[j].w * r * g.w); o[64 * j] = w; }
    }
}

template <bool L1> DI void prep_row(const Params& p, int l, int row, int lane, const LAS float* W8) {
    const f32x4* xr = (const f32x4*)(p.x + (size_t)row * DM) + lane;
    f32x4 v[4];
#pragma unroll
    for (int j = 0; j < 4; ++j) v[j] = xr[64 * j];
    if (L1) {
        const f32x4* st = (const f32x4*)((const float*)(p.ws + WS_STATS) + (size_t)row * 16);
        const f32x4 s0 = st[0], s1 = st[1], s2 = st[2], s3 = st[3];
        const float ss = ((s0.x + s0.y) + (s0.z + s0.w)) + ((s1.x + s1.y) + (s1.z + s1.w)) + ((s2.x + s2.y) + (s2.z + s2.w)) + ((s3.x + s3.y) + (s3.z + s3.w));
        const float ry = rsqrtf(ss * (1.f / DM) + EPS);
        const u32x2* yr = (const u32x2*)((const bf16_t*)(p.ws + WS_P) + (size_t)row * DM) + lane;
        const f32x4* pg = (const f32x4*)(p.post_g + (size_t)(l - 1) * DM) + lane;
        f32x4* xo = (f32x4*)(p.out + (size_t)row * DM) + lane;
#pragma unroll
        for (int j = 0; j < 4; ++j) {
            const u32x2 y = yr[64 * j]; const f32x4 g = pg[64 * j];
            v[j].x += bflo(y.x) * ry * g.x; v[j].y += bfhi(y.x) * ry * g.y; v[j].z += bflo(y.y) * ry * g.z; v[j].w += bfhi(y.y) * ry * g.w;
            xo[64 * j] = v[j];
        }
    }
    float s = 0.f;
#pragma unroll
    for (int j = 0; j < 4; ++j) s += (v[j].x * v[j].x + v[j].y * v[j].y) + (v[j].z * v[j].z + v[j].w * v[j].w);
    const float r = rsqrtf(wave_sum(s) * (1.f / DM) + EPS);
    const f32x4* gr = (const f32x4*)(p.pre_g + (size_t)l * DM) + lane;
    u32x2* ho = (u32x2*)((bf16_t*)(p.ws + WS_H) + (size_t)row * DM) + lane;
#pragma unroll
    for (int j = 0; j < 4; ++j) {
        const f32x4 g = gr[64 * j];
        v[j].x *= r * g.x; v[j].y *= r * g.y; v[j].z *= r * g.z; v[j].w *= r * g.w;
        u32x2 w; w.x = pk2(v[j].x, v[j].y); w.y = pk2(v[j].z, v[j].w); ho[64 * j] = w;
    }
    float mine = 0.f;
#pragma unroll
    for (int c = 0; c < 8; ++c) {
        const LAS f32x4* wr = (const LAS f32x4*)(W8 + c * DM) + lane; float d = 0.f;
#pragma unroll
        for (int j = 0; j < 4; ++j) { const f32x4 w = wr[64 * j]; d += (v[j].x * w.x + v[j].y * w.y) + (v[j].z * w.z + v[j].w * w.w); }
        d = wave_sum(d);
        mine = (lane == c) ? d : mine;
    }
    if (lane < 8) {
        float o;
        if (lane < 4) o = sigmoidf_(mine);
        else { const int h = lane - 4; o = -__expf(p.a_log[l * 4 + h]) * softplusf_(mine + p.dt_bias[l * 4 + h]); }
        ((float*)(p.ws + WS_BA))[(size_t)row * 8 + lane] = o;
    }
}

DI void final_row(const Params& p, int row, int lane) {
    const f32x4* st = (const f32x4*)((const float*)(p.ws + WS_STATS) + (size_t)row * 16);
    const f32x4 s0 = st[0], s1 = st[1], s2 = st[2], s3 = st[3];
    const float ss = ((s0.x + s0.y) + (s0.z + s0.w)) + ((s1.x + s1.y) + (s1.z + s1.w)) + ((s2.x + s2.y) + (s2.z + s2.w)) + ((s3.x + s3.y) + (s3.z + s3.w));
    const float ry = rsqrtf(ss * (1.f / DM) + EPS);
    const u32x2* yr = (const u32x2*)((const bf16_t*)(p.ws + WS_P) + (size_t)row * DM) + lane;
    const f32x4* pg = (const f32x4*)(p.post_g + (size_t)(DEPTH - 1) * DM) + lane;
    f32x4* xo = (f32x4*)(p.out + (size_t)row * DM) + lane;
#pragma unroll
    for (int j = 0; j < 4; ++j) {
        const u32x2 y = yr[64 * j]; const f32x4 g = pg[64 * j]; f32x4 v = xo[64 * j];
        v.x += bflo(y.x) * ry * g.x; v.y += bfhi(y.x) * ry * g.y; v.z += bflo(y.y) * ry * g.z; v.w += bfhi(y.y) * ry * g.w;
        xo[64 * j] = v;
    }
}


namespace pg8 {
#define PG8_LAS __attribute__((address_space(3)))
typedef unsigned short bf16_t;
typedef short bf16x8 __attribute__((ext_vector_type(8)));
typedef float f32x4 __attribute__((ext_vector_type(4)));
typedef unsigned u32x4 __attribute__((ext_vector_type(4)));
constexpr int BM = 256, BK = 64, HALF = 128, HTB = HALF * BK * 2  , STAGE_BYTES = 8 * HTB, NXCD = 8, WGM = 8;

__host__ __device__ __forceinline__ int lds_byte(int r, int c) { const int st = (r >> 4) * 2 + (c >> 5), rr = r & 15, cc = c & 31, ob = rr * 64 + cc * 2; return st * 1024 + (ob ^ (((ob >> 9) & 1) << 5)); }
__host__ __device__ __forceinline__ void stage_rc(int b, int& R, int& C) { const int st = b / 1024, sb = b % 1024, swz = sb ^ (((sb >> 9) & 1) << 5); R = (st >> 1) * 16 + swz / 64; C = (st & 1) * 32 + (swz % 64) / 2; }
__host__ __device__ __forceinline__ int perm32(int rho) { const int n = rho >> 4, i = rho & 15; return 8 * (i >> 2) + 4 * n + (i & 3); }

struct Unit { int pm, pn; };
struct Gemm { const bf16_t* A; const bf16_t* Bt; int M, N, K; };

struct StaticOrder {
    int nM, nN, nwg, G, c;
    __host__ __device__ void init(int M, int N, int G_, int c_) { nM = M / BM; nN = N / BM; nwg = nM * nN; G = G_; c = c_; }
    __host__ __device__ bool next(int i, Unit& u) const {
        const long L = (long)i * G + c; if (L >= nwg) return false;
        int wgid = (int)L; { const int q = nwg / NXCD, r = nwg % NXCD, xcd = wgid % NXCD, off = wgid / NXCD; wgid = (xcd < r ? xcd * (q + 1) : r * (q + 1) + (xcd - r) * q) + off; }
        const int nig = WGM * nN, gid = wgid / nig, fm = gid * WGM, gsz = (nM - fm) < WGM ? (nM - fm) : WGM;
        u.pm = fm + ((wgid % nig) % gsz); u.pn = (wgid % nig) / gsz; return true;
    }
    __device__ __forceinline__ void a_ready(const Unit&) const {}
    __device__ __forceinline__ void done(const Unit&) const {}
};

__device__ __forceinline__ unsigned cvt_pk_bf16(float lo, float hi) { unsigned r; asm volatile("v_cvt_pk_bf16_f32 %0, %1, %2" : "=v"(r) : "v"(lo), "v"(hi)); return r; }
template <class Epi, class Sched, bool ALIGN_EPI = false, bool SP2 = false>
__device__ __forceinline__ void gemm_phase(PG8_LAS unsigned char* lds, const Gemm g, const Sched& S, const Epi& E) {
    int tid = threadIdx.x; asm volatile("" : "+v"(tid));
    const int wid = __builtin_amdgcn_readfirstlane(tid >> 6), lane = tid & 63, wr = wid >> 2, wc = wid & 3, fr = lane & 15, fq = lane >> 4;
    const int K = g.K, nt = K / BK;
    unsigned voffA[2], voffB[2];
#pragma unroll
    for (int i = 0; i < 2; ++i) { int R, C; stage_rc(tid * 16 + i * 8192, R, C); const int Rb = Epi::PERM ? ((R & ~31) + perm32(R & 31)) : R;
        voffA[i] = (unsigned)(R * K + C) * 2u; voffB[i] = (unsigned)(Rb * K + C) * 2u; }
    const size_t kstep = (size_t)(BK * 2);
    const size_t hstep = (size_t)HALF * K * 2;
    const size_t tstep = 2 * hstep;
    const unsigned ldsw = (unsigned)wid * 1024u;
    const int aoff = lds_byte(wr * 64 + fr, fq * 8), boff = lds_byte(wc * 32 + fr, fq * 8);
#define PG8_SA(b, h) (((b) * 2 + (h)) * HTB)
#define PG8_SB(b, h) ((4 + (b) * 2 + (h)) * HTB)
#define PG8_STAGE(bufoff, gbase, voff) do { _Pragma("unroll") for (int _i = 0; _i < 2; ++_i) \
        __builtin_amdgcn_global_load_lds((const unsigned*)((const char*)(gbase) + (voff)[_i]), (PG8_LAS unsigned*)(lds + (bufoff) + ldsw + _i * 8192), 16, 0, 0); } while (0)
#define PG8_LDA(dst, b, h) do { _Pragma("unroll") for (int m = 0; m < 4; ++m) _Pragma("unroll") for (int k = 0; k < 2; ++k) dst[m][k] = *(const PG8_LAS bf16x8*)(lds + PG8_SA(b, h) + aoff + m * 2048 + k * 1024); } while (0)
#define PG8_LDB(dst, b, h) do { _Pragma("unroll") for (int n = 0; n < 2; ++n) _Pragma("unroll") for (int k = 0; k < 2; ++k) dst[n][k] = *(const PG8_LAS bf16x8*)(lds + PG8_SB(b, h) + boff + n * 2048 + k * 1024); } while (0)
#define PG8_MMA(ai, bj, At, Bt) do { __builtin_amdgcn_s_setprio(1); _Pragma("unroll") for (int m = 0; m < 4; ++m) _Pragma("unroll") for (int n = 0; n < 2; ++n) _Pragma("unroll") for (int k = 0; k < 2; ++k) \
        acc[ai][bj][m][n] = __builtin_amdgcn_mfma_f32_16x16x32_bf16(Bt[n][k], At[m][k], acc[ai][bj][m][n], 0, 0, 0); __builtin_amdgcn_s_setprio(0); } while (0)
#define PG8_WAIT_V(n) asm volatile("s_waitcnt vmcnt(" #n ")" ::: "memory")
#define PG8_WAIT_L(n) asm volatile("s_waitcnt lgkmcnt(" #n ")" ::: "memory")
#define PG8_BAR __builtin_amdgcn_s_barrier()
#define PG8_SCHED __builtin_amdgcn_sched_barrier(0)
    Unit cur, nxt; int ui = 0;
    if (!S.next(0, cur)) return;
    f32x4 acc[2][2][4][2];
#pragma unroll
    for (int a = 0; a < 2; ++a)
#pragma unroll
        for (int b = 0; b < 2; ++b)
#pragma unroll
            for (int m = 0; m < 4; ++m)
#pragma unroll
                for (int n = 0; n < 2; ++n) acc[a][b][m][n] = (f32x4){0.f, 0.f, 0.f, 0.f};
    bf16x8 At[4][2], B0[2][2], B1[2][2];
    const char* cA = (const char*)g.A + (size_t)cur.pm * tstep; const char* cB = (const char*)g.Bt + (size_t)cur.pn * tstep;
    S.a_ready(cur);
    if constexpr (SP2) {
        PG8_STAGE(PG8_SB(0, 0), cB, voffB); PG8_STAGE(PG8_SB(0, 1), cB + hstep, voffB); PG8_STAGE(PG8_SA(0, 0), cA, voffA); PG8_STAGE(PG8_SA(0, 1), cA + hstep, voffA);
        if (wr == 1) PG8_BAR;
        PG8_WAIT_V(2); PG8_BAR;
        PG8_STAGE(PG8_SB(1, 0), cB + kstep, voffB); PG8_STAGE(PG8_SA(1, 0), cA + kstep, voffA); PG8_STAGE(PG8_SB(1, 1), cB + hstep + kstep, voffB);
        PG8_WAIT_V(6); PG8_BAR;
    } else {
        PG8_STAGE(PG8_SB(0, 0), cB, voffB); PG8_STAGE(PG8_SA(0, 0), cA, voffA); PG8_STAGE(PG8_SB(0, 1), cB + hstep, voffB); PG8_STAGE(PG8_SA(0, 1), cA + hstep, voffA);
        if (wr == 1) PG8_BAR;
        PG8_WAIT_V(4); PG8_BAR;
        PG8_STAGE(PG8_SB(1, 0), cB + kstep, voffB); PG8_STAGE(PG8_SA(1, 0), cA + kstep, voffA); PG8_STAGE(PG8_SB(1, 1), cB + hstep + kstep, voffB);
        PG8_WAIT_V(6); PG8_BAR;
    }
    for (;;) {
        const bool has_next = S.next(ui + 1, nxt);
        const char* nA = has_next ? (const char*)g.A + (size_t)nxt.pm * tstep : cA; const char* nB = has_next ? (const char*)g.Bt + (size_t)nxt.pn * tstep : cB;
        for (int t = 0; t < nt; t += 2) {
            const bool last = (t == nt - 2);
            const char* a1 = cA + (size_t)(t + 1) * kstep;
            const char* a2 = last ? nA : cA + (size_t)(t + 2) * kstep; const char* b2 = last ? nB : cB + (size_t)(t + 2) * kstep;
            const char* a3 = a2 + kstep; const char* b3 = b2 + kstep;
            if (last && has_next) S.a_ready(nxt);
            if constexpr (SP2) {
            PG8_LDB(B0, 0, 0); PG8_LDB(B1, 0, 1); PG8_SCHED; PG8_LDA(At, 0, 0); PG8_STAGE(PG8_SA(1, 1), a1 + hstep, voffA);
            PG8_WAIT_V(8); PG8_WAIT_L(0); PG8_BAR; PG8_MMA(0, 0, At, B0); PG8_MMA(0, 1, At, B1); PG8_BAR; PG8_SCHED;
            PG8_LDA(At, 0, 1); PG8_STAGE(PG8_SB(0, 0), b2, voffB); PG8_STAGE(PG8_SB(0, 1), b2 + hstep, voffB); PG8_STAGE(PG8_SA(0, 0), a2, voffA);
            PG8_WAIT_V(8); PG8_WAIT_L(0); PG8_BAR; PG8_MMA(1, 0, At, B0); PG8_MMA(1, 1, At, B1); PG8_BAR; PG8_SCHED;
            PG8_LDB(B0, 1, 0); PG8_LDB(B1, 1, 1); PG8_SCHED; PG8_LDA(At, 1, 0); PG8_STAGE(PG8_SA(0, 1), a2 + hstep, voffA);
            PG8_WAIT_V(8); PG8_WAIT_L(0); PG8_BAR; PG8_MMA(0, 0, At, B0); PG8_MMA(0, 1, At, B1); PG8_BAR; PG8_SCHED;
            PG8_LDA(At, 1, 1); PG8_STAGE(PG8_SB(1, 0), b3, voffB); PG8_STAGE(PG8_SB(1, 1), b3 + hstep, voffB); PG8_STAGE(PG8_SA(1, 0), a3, voffA);
            PG8_WAIT_V(8); PG8_WAIT_L(0); PG8_BAR; PG8_MMA(1, 0, At, B0); PG8_MMA(1, 1, At, B1); PG8_BAR; PG8_SCHED;
            } else {
            PG8_LDB(B0, 0, 0); PG8_SCHED; PG8_LDA(At, 0, 0); PG8_STAGE(PG8_SA(1, 1), a1 + hstep, voffA);
            PG8_WAIT_L(8); PG8_BAR; PG8_WAIT_L(0); PG8_MMA(0, 0, At, B0); PG8_BAR; PG8_SCHED;
            PG8_LDB(B1, 0, 1); PG8_STAGE(PG8_SB(0, 0), b2, voffB);
            PG8_BAR; PG8_WAIT_L(0); PG8_MMA(0, 1, At, B1); PG8_BAR;
            PG8_LDA(At, 0, 1); PG8_STAGE(PG8_SA(0, 0), a2, voffA);
            PG8_BAR; PG8_WAIT_L(0); PG8_MMA(1, 0, At, B0); PG8_BAR; PG8_SCHED;
            PG8_STAGE(PG8_SB(0, 1), b2 + hstep, voffB);
            PG8_WAIT_V(6); PG8_BAR; PG8_MMA(1, 1, At, B1); PG8_BAR;
            PG8_LDB(B0, 1, 0); PG8_SCHED; PG8_LDA(At, 1, 0); PG8_STAGE(PG8_SA(0, 1), a2 + hstep, voffA);
            PG8_WAIT_L(8); PG8_BAR; PG8_WAIT_L(0); PG8_MMA(0, 0, At, B0); PG8_BAR; PG8_SCHED;
            PG8_LDB(B1, 1, 1); PG8_STAGE(PG8_SB(1, 0), b3, voffB);
            PG8_BAR; PG8_WAIT_L(0); PG8_MMA(0, 1, At, B1); PG8_BAR;
            PG8_LDA(At, 1, 1); PG8_STAGE(PG8_SA(1, 0), a3, voffA);
            PG8_BAR; PG8_WAIT_L(0); PG8_MMA(1, 0, At, B0); PG8_BAR; PG8_SCHED;
            PG8_STAGE(PG8_SB(1, 1), b3 + hstep, voffB);
            PG8_WAIT_V(6); PG8_BAR; PG8_MMA(1, 1, At, B1); PG8_BAR;
            }
        }
        if constexpr (ALIGN_EPI) { if (wr == 0) PG8_BAR; }
        if constexpr (!Epi::AFTER_DRAIN) { E(acc, cur, wr, wc, fr, fq); S.done(cur); }
        if (!has_next) break;
#pragma unroll
        for (int a = 0; a < 2; ++a)
#pragma unroll
            for (int b = 0; b < 2; ++b)
#pragma unroll
                for (int m = 0; m < 4; ++m)
#pragma unroll
                    for (int n = 0; n < 2; ++n) acc[a][b][m][n] = (f32x4){0.f, 0.f, 0.f, 0.f};
        cur = nxt; cA = nA; cB = nB; ++ui;
        if constexpr (ALIGN_EPI) { if (wr == 1) PG8_BAR; }
    }
    PG8_WAIT_V(0);
    if constexpr (!ALIGN_EPI) { if (wr == 0) PG8_BAR; }
    PG8_BAR;
    if constexpr (Epi::AFTER_DRAIN) { E.fused(acc, cur, wr, wc, fr, fq, lds, wid, lane); S.done(cur); }
#undef PG8_SA
#undef PG8_SB
#undef PG8_STAGE
#undef PG8_LDA
#undef PG8_LDB
#undef PG8_MMA
#undef PG8_WAIT_V
#undef PG8_WAIT_L
#undef PG8_BAR
#undef PG8_SCHED
}
}
using pg8::cvt_pk_bf16;
struct EpiProj {
    static constexpr bool PERM = true, AFTER_DRAIN = false;
    bf16_t* O; bf16_t* svT;
    DI void operator()(const f32x4 (&acc)[2][2][4][2], const pg8::Unit& u, int wr, int wc, int fr, int fq) const {
        const int row0 = u.pm * 256 + wr * 64 + fr, col0 = u.pn * 256 + wc * 32 + 8 * fq;
#pragma unroll
        for (int ai = 0; ai < 2; ++ai)
#pragma unroll
            for (int m = 0; m < 4; ++m) { bf16_t* rowp = O + (size_t)(row0 + ai * 128 + m * 16) * NIN + col0;
#pragma unroll
                for (int bj = 0; bj < 2; ++bj) { const f32x4 v0 = acc[ai][bj][m][0], v1 = acc[ai][bj][m][1];
                    u32x4 w; w.x = cvt_pk_bf16(v0[0], v0[1]); w.y = cvt_pk_bf16(v0[2], v0[3]); w.z = cvt_pk_bf16(v1[0], v1[1]); w.w = cvt_pk_bf16(v1[2], v1[3]);
                    *(u32x4*)(rowp + bj * 128) = w; } }
        if (u.pn == 2) {
#pragma unroll
            for (int ai = 0; ai < 2; ++ai)
#pragma unroll
                for (int m = 0; m < 4; ++m) { const int row = row0 + ai * 128 + m * 16, b = row >> 12, s = row & (SEQ - 1);
#pragma unroll
                    for (int n = 0; n < 2; ++n)
#pragma unroll
                        for (int e = 0; e < 4; ++e) { const int c = wc * 32 + 8 * fq + 4 * n + e;
                            svT[((size_t)(b * 2 + (c >> 6)) * 64 + (c & 63)) * SEQ + s] = (bf16_t)f2bf(acc[ai][1][m][n][e]); } }
        }
    }
};
struct EpiMkv {
    static constexpr bool PERM = true, AFTER_DRAIN = false;
    bf16_t* mk; bf16_t* mvT;
    DI void operator()(const f32x4 (&acc)[2][2][4][2], const pg8::Unit& u, int wr, int wc, int fr, int fq) const {
        const int row0 = u.pm * 256 + wr * 64 + fr;
#pragma unroll
        for (int ai = 0; ai < 2; ++ai)
#pragma unroll
            for (int m = 0; m < 4; ++m) { const int row = row0 + ai * 128 + m * 16;
                if (u.pn == 0) {
#pragma unroll
                    for (int bj = 0; bj < 2; ++bj) { const f32x4 v0 = acc[ai][bj][m][0], v1 = acc[ai][bj][m][1];
                        u32x4 w; w.x = cvt_pk_bf16(v0[0], v0[1]); w.y = cvt_pk_bf16(v0[2], v0[3]); w.z = cvt_pk_bf16(v1[0], v1[1]); w.w = cvt_pk_bf16(v1[2], v1[3]);
                        *(u32x4*)(mk + (size_t)row * 256 + bj * 128 + wc * 32 + 8 * fq) = w; }
                } else { const int b = row >> 8, mm = row & 255;
#pragma unroll
                    for (int bj = 0; bj < 2; ++bj)
#pragma unroll
                        for (int n = 0; n < 2; ++n)
#pragma unroll
                            for (int e = 0; e < 4; ++e) { const int c = bj * 128 + wc * 32 + 8 * fq + 4 * n + e;
                                mvT[((size_t)(b * 4 + (c >> 6)) * 64 + (c & 63)) * NMEM + mm] = (bf16_t)f2bf(acc[ai][bj][m][n][e]); } }
            }
    }
};
struct EpiY {
    static constexpr bool PERM = true, AFTER_DRAIN = false;
    bf16_t* Y; float* stats;
    DI void operator()(const f32x4 (&acc)[2][2][4][2], const pg8::Unit& u, int wr, int wc, int fr, int fq) const {
        const int row0 = u.pm * 256 + wr * 64 + fr, col0 = u.pn * 256 + wc * 32 + 8 * fq;
#pragma unroll
        for (int ai = 0; ai < 2; ++ai)
#pragma unroll
            for (int m = 0; m < 4; ++m) { const int row = row0 + ai * 128 + m * 16; bf16_t* rowp = Y + (size_t)row * DM + col0; float ss = 0.f;
#pragma unroll
                for (int bj = 0; bj < 2; ++bj) { const f32x4 v0 = acc[ai][bj][m][0], v1 = acc[ai][bj][m][1];
                    ss += (v0[0] * v0[0] + v0[1] * v0[1]) + (v0[2] * v0[2] + v0[3] * v0[3]) + (v1[0] * v1[0] + v1[1] * v1[1]) + (v1[2] * v1[2] + v1[3] * v1[3]);
                    u32x4 w; w.x = cvt_pk_bf16(v0[0], v0[1]); w.y = cvt_pk_bf16(v0[2], v0[3]); w.z = cvt_pk_bf16(v1[0], v1[1]); w.w = cvt_pk_bf16(v1[2], v1[3]);
                    *(u32x4*)(rowp + bj * 128) = w; }
                ss += __shfl_xor(ss, 16); ss += __shfl_xor(ss, 32);
                if (fq == 0) stats[(size_t)row * 16 + u.pn * 4 + wc] = ss; }
    }
};

typedef short bf16x8 __attribute__((ext_vector_type(8)));
typedef short s16x4 __attribute__((ext_vector_type(4)));
typedef float f32x16 __attribute__((ext_vector_type(16)));
typedef float f32x2_t __attribute__((ext_vector_type(2)));
typedef __bf16 bf16x2_t __attribute__((ext_vector_type(2)));
DI unsigned cvtpk(float lo, float hi) { f32x2_t v = {lo, hi}; bf16x2_t b = __builtin_convertvector(v, bf16x2_t); return __builtin_bit_cast(unsigned, b); }
#define MFMA32(a, b, c) __builtin_amdgcn_mfma_f32_32x32x16_bf16((a), (b), (c), 0, 0, 0)
#define MFMA16(a, b, c) __builtin_amdgcn_mfma_f32_16x16x32_bf16((a), (b), (c), 0, 0, 0)
constexpr int N_SWA_UNITS = NB * 2 * 128 * 4, N_MEM_UNITS = NB * 128 * 4, N_ATTN_UNITS = N_SWA_UNITS + N_MEM_UNITS;
DI void attn_unit(const Params& p, int l, int u, int lane) {
    const int r = lane & 31, h = lane >> 5;
    const bf16_t* P = (const bf16_t*)(p.ws + WS_P);
    const bf16_t *Qrow, *Kbase, *VTb; int kstride, vstride, kbase, kt0, nkt, mcol; float m, lsum; size_t row0;
    const bool swa = u < N_SWA_UNITS;
    if (swa) {
        const int g = u & 3, qt = (u >> 2) & 127, bk = u >> 9, b = bk >> 1, kvh = bk & 1, head = kvh * 4 + g;
        row0 = (size_t)b * SEQ + qt * 32;
        Qrow = P + row0 * NIN + C_SQ + head * 64;
        Kbase = P + (size_t)b * SEQ * NIN + C_SK + kvh * 64; kstride = NIN;
        VTb = (const bf16_t*)(p.ws + WS_SVT) + (size_t)(b * 2 + kvh) * 64 * SEQ; vstride = SEQ;
        kbase = qt * 32 - 128; kt0 = qt < 4 ? 4 - qt : 0; nkt = 5; mcol = head * 64;
        m = p.sinks[l * 8 + head] * 1.4426950408889634f; lsum = h == 0 ? 1.f : 0.f;
    } else {
        const int v = u - N_SWA_UNITS, hm = v & 3, qt = (v >> 2) & 127, b = v >> 9;
        row0 = (size_t)b * SEQ + qt * 32;
        Qrow = P + row0 * NIN + C_MQ + hm * 64;
        Kbase = (const bf16_t*)(p.ws + WS_MK) + (size_t)l * MEMROWS * 256 + (size_t)b * NMEM * 256 + hm * 64; kstride = 256;
        VTb = (const bf16_t*)(p.ws + WS_MVT) + (size_t)l * MEMROWS * 256 + (size_t)(b * 4 + hm) * 64 * NMEM; vstride = NMEM;
        kbase = 0; kt0 = 0; nkt = 8; mcol = 768 + hm * 64;
        m = -1e30f; lsum = 0.f;
    }
    bf16x8 qf[4];
#pragma unroll
    for (int ks = 0; ks < 4; ++ks) qf[ks] = *(const bf16x8*)(Qrow + (size_t)r * NIN + 16 * ks + 8 * h);
    f32x16 o0, o1;
#pragma unroll
    for (int i = 0; i < 16; ++i) { o0[i] = 0.f; o1[i] = 0.f; }
    constexpr float SC = 0.125f * 1.4426950408889634f;
    for (int kt = kt0; kt < nkt; ++kt) {
        const int key0 = kbase + 32 * kt;
        const bf16_t* kp = Kbase + (size_t)(key0 + r) * kstride + 8 * h;
        bf16x8 kf[4];
#pragma unroll
        for (int ks = 0; ks < 4; ++ks) kf[ks] = *(const bf16x8*)(kp + 16 * ks);
        const bf16_t* vp = VTb + (size_t)r * vstride + key0 + 4 * h;
        s16x4 va[2][2][2];
#pragma unroll
        for (int dt = 0; dt < 2; ++dt)
#pragma unroll
            for (int ss = 0; ss < 2; ++ss)
#pragma unroll
                for (int hf = 0; hf < 2; ++hf) va[dt][ss][hf] = *(const s16x4*)(vp + (size_t)dt * 32 * vstride + 16 * ss + 8 * hf);
        f32x16 s;
#pragma unroll
        for (int i = 0; i < 16; ++i) s[i] = 0.f;
#pragma unroll
        for (int ks = 0; ks < 4; ++ks) s = MFMA32(kf[ks], qf[ks], s);
        const bool mlo = swa && kt == 0, mhi = swa && kt == 4;
        float tm = -1e30f;
#pragma unroll
        for (int i = 0; i < 16; ++i) {
            const int c = (i & 3) + 8 * (i >> 2) + 4 * h;
            float v = s[i] * SC;
            if (mlo && !(c > r)) v = -1e30f;
            if (mhi && !(c <= r)) v = -1e30f;
            s[i] = v; tm = fmaxf(tm, v);
        }
        tm = fmaxf(tm, __shfl_xor(tm, 32));
        const float mn = fmaxf(m, tm), alpha = __builtin_amdgcn_exp2f(m - mn);
        m = mn;
        float ps = 0.f;
#pragma unroll
        for (int i = 0; i < 16; ++i) { s[i] = __builtin_amdgcn_exp2f(s[i] - mn); ps += s[i]; }
        lsum = lsum * alpha + ps;
#pragma unroll
        for (int i = 0; i < 16; ++i) { o0[i] *= alpha; o1[i] *= alpha; }
#pragma unroll
        for (int ss = 0; ss < 2; ++ss) {
            u32x4 pw; pw.x = cvtpk(s[8 * ss + 0], s[8 * ss + 1]); pw.y = cvtpk(s[8 * ss + 2], s[8 * ss + 3]); pw.z = cvtpk(s[8 * ss + 4], s[8 * ss + 5]); pw.w = cvtpk(s[8 * ss + 6], s[8 * ss + 7]);
            const bf16x8 pf = __builtin_bit_cast(bf16x8, pw);
            const bf16x8 v0 = __builtin_shufflevector(va[0][ss][0], va[0][ss][1], 0, 1, 2, 3, 4, 5, 6, 7);
            const bf16x8 v1 = __builtin_shufflevector(va[1][ss][0], va[1][ss][1], 0, 1, 2, 3, 4, 5, 6, 7);
            o0 = MFMA32(v0, pf, o0); o1 = MFMA32(v1, pf, o1);
        }
    }
    lsum += __shfl_xor(lsum, 32);
    const float inv = 1.f / lsum;
    const bf16_t* gp = P + (row0 + r) * NIN + C_GATE + mcol + 4 * h;
    bf16_t* op = (bf16_t*)(p.ws + WS_H) + (row0 + r) * DM + mcol + 4 * h;
#pragma unroll
    for (int dt = 0; dt < 2; ++dt)
#pragma unroll
        for (int g4 = 0; g4 < 4; ++g4) {
            const u32x2 gt = *(const u32x2*)(gp + 32 * dt + 8 * g4);
            const float a0 = (dt ? o1[4 * g4 + 0] : o0[4 * g4 + 0]) * inv * siluf_(bflo(gt.x)), a1 = (dt ? o1[4 * g4 + 1] : o0[4 * g4 + 1]) * inv * siluf_(bfhi(gt.x));
            const float a2 = (dt ? o1[4 * g4 + 2] : o0[4 * g4 + 2]) * inv * siluf_(bflo(gt.y)), a3 = (dt ? o1[4 * g4 + 3] : o0[4 * g4 + 3]) * inv * siluf_(bfhi(gt.y));
            u32x2 w; w.x = cvtpk(a0, a1); w.y = cvtpk(a2, a3);
            *(u32x2*)(op + 32 * dt + 8 * g4) = w;
        }
}

constexpr size_t DN_M = WS_DN;
constexpr size_t DN_NT = WS_DN + 32 * MiB;
constexpr size_t DN_UT = WS_DN + 96 * MiB;
constexpr size_t DN_W = WS_DN + 128 * MiB;
constexpr size_t DN_QG = WS_DN + 160 * MiB;
constexpr size_t DN_IN = WS_DN + 192 * MiB;
constexpr size_t DN_ST = WS_DN + 224 * MiB;
constexpr int LDK = 72;

DI void mm16x64(f32x4 (&acc)[4], const LAS bf16_t* A, int r0, const LAS bf16_t* Bt, int fr, int fq) {
    bf16x8 a[2];
#pragma unroll
    for (int ks = 0; ks < 2; ++ks) a[ks] = *(const LAS bf16x8*)(A + (r0 + fr) * LDK + 32 * ks + 8 * fq);
#pragma unroll
    for (int nt = 0; nt < 4; ++nt)
#pragma unroll
        for (int ks = 0; ks < 2; ++ks) { const bf16x8 b = *(const LAS bf16x8*)(Bt + (16 * nt + fr) * LDK + 32 * ks + 8 * fq); acc[nt] = MFMA16(a[ks], b, acc[nt]); }
}
DI void conv16(float (&out)[16], const bf16_t* Pcol, size_t rowb, int s0, const float* cw) {
#pragma unroll
    for (int e = 0; e < 16; ++e) out[e] = 0.f;
#pragma unroll
    for (int j = 0; j < 4; ++j) {
        const int s = s0 + j;
        if (s >= 0) {
            const u32x4 x0 = *(const u32x4*)(Pcol + (rowb + s) * NIN), x1 = *(const u32x4*)(Pcol + (rowb + s) * NIN + 8);
            const f32x4 w0 = *(const f32x4*)(cw + j * 768), w1 = *(const f32x4*)(cw + j * 768 + 4), w2 = *(const f32x4*)(cw + j * 768 + 8), w3 = *(const f32x4*)(cw + j * 768 + 12);
            out[0] += w0.x * bflo(x0.x); out[1] += w0.y * bfhi(x0.x); out[2] += w0.z * bflo(x0.y); out[3] += w0.w * bfhi(x0.y);
            out[4] += w1.x * bflo(x0.z); out[5] += w1.y * bfhi(x0.z); out[6] += w1.z * bflo(x0.w); out[7] += w1.w * bfhi(x0.w);
            out[8] += w2.x * bflo(x1.x); out[9] += w2.y * bfhi(x1.x); out[10] += w2.z * bflo(x1.y); out[11] += w2.w * bfhi(x1.y);
            out[12] += w3.x * bflo(x1.z); out[13] += w3.y * bfhi(x1.z); out[14] += w3.z * bflo(x1.w); out[15] += w3.w * bfhi(x1.w);
        }
    }
#pragma unroll
    for (int e = 0; e < 16; ++e) out[e] = siluf_(out[e]);
}
DI u32x4 pack8(const float* v) { u32x4 w; w.x = cvtpk(v[0], v[1]); w.y = cvtpk(v[2], v[3]); w.z = cvtpk(v[4], v[5]); w.w = cvtpk(v[6], v[7]); return w; }
DI u32x2 pack4(const f32x4 v) { u32x2 w; w.x = cvtpk(v[0], v[1]); w.y = cvtpk(v[2], v[3]); return w; }

DI void dn_prep_phase(const Params& p, int l, LAS unsigned char* lds, int tid, int G) {
    const int sg = tid >> 8, ts = tid & 255, lane = tid & 63, wsg = (tid >> 6) & 3, fr = lane & 15, fq = lane >> 4;
    LAS unsigned char* base = lds + sg * 65536;
    LAS bf16_t* qs = (LAS bf16_t*)(base); LAS bf16_t* Tm = qs;
    LAS bf16_t* ks = (LAS bf16_t*)(base + 9216); LAS bf16_t* uT = ks;
    LAS bf16_t* kdT = (LAS bf16_t*)(base + 18432);
    LAS bf16_t* kbgT = (LAS bf16_t*)(base + 27648);
    LAS bf16_t* vbT = (LAS bf16_t*)(base + 36864);
    LAS float* Lf = (LAS float*)(base + 46080); LAS bf16_t* wT = (LAS bf16_t*)(base + 46080);
    LAS float* gcs = (LAS float*)(base + 63488); LAS float* betas = gcs + 64;
    const bf16_t* P = (const bf16_t*)(p.ws + WS_P);
    const float* BA = (const float*)(p.ws + WS_BA);
    const float* cwl = p.conv_w + (size_t)l * 4 * 768;
    const int t = ts >> 2, seg = ts & 3;
    for (int it = blockIdx.x; it < 2048; it += G) {
        const int ch = 2 * it + sg, b = ch >> 8, h = (ch >> 6) & 3, n = ch & 63;
        const size_t rowb = (size_t)b * SEQ, row = rowb + n * 64 + t; const int s0 = n * 64 + t - 3;
        float cq[16], ck[16], cv[16];
        conv16(cq, P + C_DQ + h * 64 + 16 * seg, rowb, s0, cwl + h * 64 + 16 * seg);
        conv16(ck, P + C_DK + h * 64 + 16 * seg, rowb, s0, cwl + 256 + h * 64 + 16 * seg);
        conv16(cv, P + C_DV + h * 64 + 16 * seg, rowb, s0, cwl + 512 + h * 64 + 16 * seg);
        float sq = 0.f, sk = 0.f;
#pragma unroll
        for (int e = 0; e < 16; ++e) { sq += cq[e] * cq[e]; sk += ck[e] * ck[e]; }
        sq += __shfl_xor(sq, 1); sq += __shfl_xor(sq, 2); sk += __shfl_xor(sk, 1); sk += __shfl_xor(sk, 2);
        const float rq = rsqrtf(sq + EPS) * 0.125f, rk = rsqrtf(sk + EPS);
#pragma unroll
        for (int e = 0; e < 16; ++e) { cq[e] *= rq; ck[e] *= rk; }
        const float beta = BA[row * 8 + h], g = BA[row * 8 + 4 + h];
        *(LAS u32x4*)(qs + t * LDK + 16 * seg) = pack8(cq); *(LAS u32x4*)(qs + t * LDK + 16 * seg + 8) = pack8(cq + 8);
        *(LAS u32x4*)(ks + t * LDK + 16 * seg) = pack8(ck); *(LAS u32x4*)(ks + t * LDK + 16 * seg + 8) = pack8(ck + 8);
        if (seg == 0) { gcs[t] = g; betas[t] = beta; }
        __syncthreads();
        float x = gcs[lane];
#pragma unroll
        for (int o = 1; o < 64; o <<= 1) { const float y = __shfl_up(x, o); if (lane >= o) x += y; }
        const float gc_t = __shfl(x, t), gl = __shfl(x, 63);
        __syncthreads();
        if (wsg == 0) gcs[lane] = x;
        const float eg = __expf(gc_t), ed = __expf(gl - gc_t);
#pragma unroll
        for (int e = 0; e < 16; ++e) { const int i = 16 * seg + e;
            kdT[i * LDK + t] = (bf16_t)f2bf(ck[e] * ed); kbgT[i * LDK + t] = (bf16_t)f2bf(ck[e] * beta * eg); vbT[i * LDK + t] = (bf16_t)f2bf(cv[e] * beta); }
        { float qg[16];
#pragma unroll
          for (int e = 0; e < 16; ++e) qg[e] = cq[e] * eg;
          bf16_t* dst = (bf16_t*)(p.ws + DN_QG) + (size_t)ch * 4096 + t * 64 + 16 * seg;
          *(u32x4*)dst = pack8(qg); *(u32x4*)(dst + 8) = pack8(qg + 8); }
        __syncthreads();
        {
            f32x4 acc[4], acc2[4];
#pragma unroll
            for (int nt = 0; nt < 4; ++nt) { acc[nt] = (f32x4){0.f, 0.f, 0.f, 0.f}; acc2[nt] = (f32x4){0.f, 0.f, 0.f, 0.f}; }
            mm16x64(acc, ks, 16 * wsg, ks, fr, fq);
            mm16x64(acc2, ks, 16 * wsg, qs, fr, fq);
            const int r0 = 16 * wsg + 4 * fq;
            float gr[4], br[4];
#pragma unroll
            for (int r = 0; r < 4; ++r) { gr[r] = gcs[r0 + r]; br[r] = betas[r0 + r]; }
#pragma unroll
            for (int nt = 0; nt < 4; ++nt) { const int cc = 16 * nt + fr; const float gcol = gcs[cc];
#pragma unroll
                for (int r = 0; r < 4; ++r) { const int c = r0 + r;
                    Lf[c * 68 + cc] = (cc < c) ? br[r] * acc[nt][r] * __expf(gr[r] - gcol) : 0.f; }
                f32x4 iv;
#pragma unroll
                for (int r = 0; r < 4; ++r) { const int s = r0 + r;
                    iv[r] = (s <= cc) ? acc2[nt][r] * __expf(gcol - gr[r]) : 0.f; }
                *(u32x2*)((bf16_t*)(p.ws + DN_IN) + (size_t)ch * 4096 + cc * 64 + r0) = pack4(iv); }
        }
        __syncthreads();
        if (wsg == 0) {
            float T[64];
#pragma unroll
            for (int c = 0; c < 64; ++c) T[c] = 0.f;
            const float lanef = (float)lane;
#pragma unroll
            for (int c = 0; c < 64; ++c) {
                float d = lanef; if (c > 0) asm volatile("" : "+v"(d) : "v"(T[c - 1]));
                float a0 = fmaxf(0.f, 1.f - fabsf(d - (float)c)), a1 = 0.f, a2 = 0.f, a3 = 0.f;
#pragma unroll
                for (int s4 = 0; s4 < (c + 3) / 4; ++s4) { const f32x4 Lv = *(const LAS f32x4*)(Lf + c * 68 + 4 * s4);
                    a0 -= Lv.x * T[4 * s4]; a1 -= Lv.y * T[4 * s4 + 1]; a2 -= Lv.z * T[4 * s4 + 2]; a3 -= Lv.w * T[4 * s4 + 3]; }
                T[c] = (a0 + a1) + (a2 + a3);
            }
#pragma unroll
            for (int c = 0; c < 64; ++c) Tm[c * LDK + lane] = (bf16_t)f2bf(T[c]);
        }
        __syncthreads();
        {   f32x4 au[4], aw[4], awr[4];
#pragma unroll
            for (int nt = 0; nt < 4; ++nt) { au[nt] = (f32x4){0.f, 0.f, 0.f, 0.f}; aw[nt] = au[nt]; awr[nt] = au[nt]; }
            mm16x64(au, Tm, 16 * wsg, vbT, fr, fq);
            mm16x64(aw, Tm, 16 * wsg, kbgT, fr, fq);
            mm16x64(awr, kbgT, 16 * wsg, Tm, fr, fq);
            const int r0 = 16 * wsg + 4 * fq;
#pragma unroll
            for (int nt = 0; nt < 4; ++nt) { const int cc = 16 * nt + fr;
                const u32x2 pu = pack4(au[nt]);
                *(LAS u32x2*)(uT + cc * LDK + r0) = pu; *(u32x2*)((bf16_t*)(p.ws + DN_UT) + (size_t)ch * 4096 + cc * 64 + r0) = pu;
                *(LAS u32x2*)(wT + cc * LDK + r0) = pack4(aw[nt]);
                *(u32x2*)((bf16_t*)(p.ws + DN_W) + (size_t)ch * 4096 + cc * 64 + r0) = pack4(awr[nt]); }
        }
        __syncthreads();
        {   f32x4 am[4], an[4];
#pragma unroll
            for (int nt = 0; nt < 4; ++nt) { am[nt] = (f32x4){0.f, 0.f, 0.f, 0.f}; an[nt] = am[nt]; }
            mm16x64(am, wT, 16 * wsg, kdT, fr, fq);
            mm16x64(an, kdT, 16 * wsg, uT, fr, fq);
            const int r0 = 16 * wsg + 4 * fq; const float egl = __expf(gl);
#pragma unroll
            for (int nt = 0; nt < 4; ++nt) { const int cc = 16 * nt + fr; f32x4 mv;
#pragma unroll
                for (int r = 0; r < 4; ++r) mv[r] = ((r0 + r) == cc ? egl : 0.f) - am[nt][r];
                *(u32x2*)((bf16_t*)(p.ws + DN_M) + (size_t)ch * 4096 + cc * 64 + r0) = pack4(mv);
                *(f32x4*)((float*)(p.ws + DN_NT) + (size_t)ch * 4096 + cc * 64 + r0) = an[nt]; }
        }
        __syncthreads();
    }
}
DI void dn_scan_item(const Params& p, int item, int lane) {
    const int bh = item >> 2, js = item & 3, fr = lane & 15, fq = lane >> 4, j = 16 * js + fr;
    f32x4 S[4];
#pragma unroll
    for (int mt = 0; mt < 4; ++mt) S[mt] = (f32x4){0.f, 0.f, 0.f, 0.f};
    const bf16_t* Mb = (const bf16_t*)(p.ws + DN_M) + (size_t)bh * 64 * 4096;
    const float* Nb = (const float*)(p.ws + DN_NT) + (size_t)bh * 64 * 4096;
    bf16_t* Sb = (bf16_t*)(p.ws + DN_ST) + (size_t)bh * 64 * 4096;
    s16x4 an[4][2][2]; f32x4 cn[4];
#pragma unroll
    for (int mt = 0; mt < 4; ++mt) { cn[mt] = *(const f32x4*)(Nb + j * 64 + 16 * mt + 4 * fq);
#pragma unroll
        for (int ks = 0; ks < 2; ++ks) { an[mt][ks][0] = *(const s16x4*)(Mb + (16 * mt + fr) * 64 + 32 * ks + 4 * fq); an[mt][ks][1] = *(const s16x4*)(Mb + (16 * mt + fr) * 64 + 32 * ks + 16 + 4 * fq); } }
    for (int n = 0; n < 64; ++n) {
        s16x4 ac[4][2][2]; f32x4 cc[4];
#pragma unroll
        for (int mt = 0; mt < 4; ++mt) { cc[mt] = cn[mt];
#pragma unroll
            for (int ks = 0; ks < 2; ++ks) { ac[mt][ks][0] = an[mt][ks][0]; ac[mt][ks][1] = an[mt][ks][1]; } }
        if (n + 1 < 63) { const bf16_t* M = Mb + (size_t)(n + 1) * 4096; const float* N = Nb + (size_t)(n + 1) * 4096;
#pragma unroll
            for (int mt = 0; mt < 4; ++mt) { cn[mt] = *(const f32x4*)(N + j * 64 + 16 * mt + 4 * fq);
#pragma unroll
                for (int ks = 0; ks < 2; ++ks) { an[mt][ks][0] = *(const s16x4*)(M + (16 * mt + fr) * 64 + 32 * ks + 4 * fq); an[mt][ks][1] = *(const s16x4*)(M + (16 * mt + fr) * 64 + 32 * ks + 16 + 4 * fq); } } }
        bf16_t* ST = Sb + (size_t)n * 4096;
#pragma unroll
        for (int mt = 0; mt < 4; ++mt) *(u32x2*)(ST + j * 64 + 16 * mt + 4 * fq) = pack4(S[mt]);
        if (n == 63) break;
        bf16x8 bfr[2];
#pragma unroll
        for (int ks = 0; ks < 2; ++ks) { u32x4 w; const u32x2 lo = pack4(S[2 * ks]), hi = pack4(S[2 * ks + 1]); w.x = lo.x; w.y = lo.y; w.z = hi.x; w.w = hi.y; bfr[ks] = __builtin_bit_cast(bf16x8, w); }
#pragma unroll
        for (int mt = 0; mt < 4; ++mt) { f32x4 a = cc[mt];
#pragma unroll
            for (int ks = 0; ks < 2; ++ks) a = MFMA16(__builtin_shufflevector(ac[mt][ks][0], ac[mt][ks][1], 0, 1, 2, 3, 4, 5, 6, 7), bfr[ks], a);
            S[mt] = a; }
    }
}
DI void dn_out_phase(const Params& p, int l, LAS unsigned char* lds, int tid, int G) {
    const int sg = tid >> 8, lane = tid & 63, js = (tid >> 6) & 3, fr = lane & 15, fq = lane >> 4, j = 16 * js + fr;
    LAS float* ssb = (LAS float*)lds + sg * 256;
    const bf16_t* P = (const bf16_t*)(p.ws + WS_P);
    bf16_t* MIX = (bf16_t*)(p.ws + WS_H);
    const float gn = p.dn_g[l * 64 + j];
    for (int it = blockIdx.x; it < 2048; it += G) {
        const int ch = 2 * it + sg, b = ch >> 8, h = (ch >> 6) & 3, n = ch & 63;
        const bf16_t* W = (const bf16_t*)(p.ws + DN_W) + (size_t)ch * 4096; const bf16_t* QG = (const bf16_t*)(p.ws + DN_QG) + (size_t)ch * 4096;
        const bf16_t* IN = (const bf16_t*)(p.ws + DN_IN) + (size_t)ch * 4096; const bf16_t* ST = (const bf16_t*)(p.ws + DN_ST) + (size_t)ch * 4096;
        const bf16_t* UT = (const bf16_t*)(p.ws + DN_UT) + (size_t)ch * 4096;
        bf16x8 bS[2];
#pragma unroll
        for (int ks = 0; ks < 2; ++ks) bS[ks] = *(const bf16x8*)(ST + j * 64 + 32 * ks + 8 * fq);
        f32x4 vn[4], o[4];
#pragma unroll
        for (int mt = 0; mt < 4; ++mt) { f32x4 tt = (f32x4){0.f, 0.f, 0.f, 0.f};
#pragma unroll
            for (int ks = 0; ks < 2; ++ks) tt = MFMA16(*(const bf16x8*)(W + (16 * mt + fr) * 64 + 32 * ks + 8 * fq), bS[ks], tt);
            const u32x2 uu = *(const u32x2*)(UT + j * 64 + 16 * mt + 4 * fq);
            vn[mt] = (f32x4){bflo(uu.x) - tt[0], bfhi(uu.x) - tt[1], bflo(uu.y) - tt[2], bfhi(uu.y) - tt[3]}; }
        bf16x8 bV[2];
#pragma unroll
        for (int ks = 0; ks < 2; ++ks) { u32x4 w; const u32x2 lo = pack4(vn[2 * ks]), hi = pack4(vn[2 * ks + 1]); w.x = lo.x; w.y = lo.y; w.z = hi.x; w.w = hi.y; bV[ks] = __builtin_bit_cast(bf16x8, w); }
#pragma unroll
        for (int mt = 0; mt < 4; ++mt) { f32x4 a = (f32x4){0.f, 0.f, 0.f, 0.f};
#pragma unroll
            for (int ks = 0; ks < 2; ++ks) a = MFMA16(*(const bf16x8*)(QG + (16 * mt + fr) * 64 + 32 * ks + 8 * fq), bS[ks], a);
#pragma unroll
            for (int ks = 0; ks < 2; ++ks) { const s16x4 lo = *(const s16x4*)(IN + (16 * mt + fr) * 64 + 32 * ks + 4 * fq), hi = *(const s16x4*)(IN + (16 * mt + fr) * 64 + 32 * ks + 16 + 4 * fq);
                a = MFMA16(__builtin_shufflevector(lo, hi, 0, 1, 2, 3, 4, 5, 6, 7), bV[ks], a); }
            o[mt] = a; }
#pragma unroll
        for (int mt = 0; mt < 4; ++mt)
#pragma unroll
            for (int r = 0; r < 4; ++r) { float q = o[mt][r] * o[mt][r]; q += __shfl_xor(q, 1); q += __shfl_xor(q, 2); q += __shfl_xor(q, 4); q += __shfl_xor(q, 8);
                if (fr == 0) ssb[js * 64 + 16 * mt + 4 * fq + r] = q; }
        __syncthreads();
#pragma unroll
        for (int mt = 0; mt < 4; ++mt)
#pragma unroll
            for (int r = 0; r < 4; ++r) { const int c = 16 * mt + 4 * fq + r; const float tot = (ssb[c] + ssb[64 + c]) + (ssb[128 + c] + ssb[192 + c]);
                const float rinv = rsqrtf(tot * (1.f / 64.f) + EPS);
                const size_t row = (size_t)b * SEQ + n * 64 + c; const int mcol = 512 + h * 64 + j;
                const float gt = bf2f(P[row * NIN + C_GATE + mcol]);
                MIX[row * DM + mcol] = (bf16_t)f2bf(o[mt][r] * rinv * gn * siluf_(gt)); }
        __syncthreads();
    }
}

enum { K_PREP = 0, K_INPROJ = 1, K_DNPREP = 2, K_ATTN = 3, K_DNOUT = 4, K_OUTPROJ = 5 };
constexpr int N_PHASES = 13;
namespace cg = cooperative_groups;
__global__ void __launch_bounds__(512, 2) mega(Params p, int ph_lo, int ph_hi) {
    extern __shared__ __attribute__((aligned(16))) unsigned char lds_raw[];
    LAS unsigned char* lds = (LAS unsigned char*)lds_raw;
    cg::grid_group grid = cg::this_grid();
    const int G = gridDim.x;
    for (int ph = ph_lo; ph < ph_hi; ++ph) {
        const int l = ph / 6, kind = ph % 6;
#define PHASE_IDS int tid = threadIdx.x; asm volatile("" : "+v"(tid)); const int lane = tid & 63, wave = __builtin_amdgcn_readfirstlane(tid >> 6); \
        const int gw = blockIdx.x * 8 + wave, ngw = G * 8; unsigned char* ws = p.ws; (void)lane; (void)wave; (void)gw; (void)ngw; (void)ws;
        if (ph == 12) { PHASE_IDS
            for (int row = gw; row < NTOK; row += ngw) final_row(p, row, lane);
        } else if (kind == K_PREP) { PHASE_IDS
            if (l == 0) { phase_init(p, lds, gw, ngw, wave, lane); __syncthreads(); }
            LAS float* w8s = (LAS float*)lds;
            for (int e = tid; e < 8 * DM; e += 512) { const int c = e & 7, kk = e >> 3; w8s[c * DM + kk] = p.w_in[(size_t)l * DM * INW + (size_t)kk * INW + 1536 + c]; }
            __syncthreads();
            if (l == 0) { for (int row = gw; row < NTOK; row += ngw) prep_row<false>(p, 0, row, lane, w8s); }
            else { for (int row = gw; row < NTOK; row += ngw) prep_row<true>(p, l, row, lane, w8s); }
            __syncthreads();
        } else if (kind == K_INPROJ) { PHASE_IDS
            { pg8::Gemm g{(const bf16_t*)(ws + WS_H), (const bf16_t*)(ws + WS_WIN) + (size_t)l * NIN * DM, NTOK, NIN, DM};
              pg8::StaticOrder S; S.init(NTOK, NIN, G, (int)blockIdx.x);
              EpiProj E{(bf16_t*)(ws + WS_P), (bf16_t*)(ws + WS_SVT)};
              pg8::gemm_phase<EpiProj, pg8::StaticOrder, true, true>(lds, g, S, E); }
            if (l == 0) {
                for (int ll = 0; ll < DEPTH; ++ll) {
                    pg8::Gemm g{(const bf16_t*)(ws + WS_MEMN) + (size_t)ll * MEMROWS * DM, (const bf16_t*)(ws + WS_WMKV) + (size_t)ll * 512 * DM, MEMROWS, 512, DM};
                    pg8::StaticOrder S; S.init(MEMROWS, 512, G, (int)((blockIdx.x + G - 32 * ll) % G));
                    EpiMkv E{(bf16_t*)(ws + WS_MK) + (size_t)ll * MEMROWS * 256, (bf16_t*)(ws + WS_MVT) + (size_t)ll * MEMROWS * 256};
                    pg8::gemm_phase<EpiMkv, pg8::StaticOrder, true, true>(lds, g, S, E);
                }
            }
        } else if (kind == K_DNPREP) { PHASE_IDS
            dn_prep_phase(p, l, lds, tid, G);
        } else if (kind == K_ATTN) { PHASE_IDS
            if (wave == 0) for (int item = blockIdx.x; item < 256; item += G) dn_scan_item(p, item, lane);
            for (int u = gw; u < N_ATTN_UNITS; u += ngw) attn_unit(p, l, u, lane);
        } else if (kind == K_DNOUT) { PHASE_IDS
            dn_out_phase(p, l, lds, tid, G);
        } else { PHASE_IDS
            pg8::Gemm g{(const bf16_t*)(ws + WS_H), (const bf16_t*)(ws + WS_WOUT) + (size_t)l * DM * DM, NTOK, DM, DM};
            pg8::StaticOrder S; S.init(NTOK, DM, G, (int)blockIdx.x);
            EpiY E{(bf16_t*)(ws + WS_P), (float*)(ws + WS_STATS)};
            pg8::gemm_phase<EpiY, pg8::StaticOrder, true, true>(lds, g, S, E);
        }
        if (ph + 1 < ph_hi) grid.sync();
    }
}

#ifndef MK_MULTI
#define MK_MULTI 0
#endif
extern "C" void kernel_launch(void* const* d_in, const int* in_sizes, int n_in, void* d_out, int out_size, void* d_ws, size_t ws_size, hipStream_t stream) {
    static int grid = 0;
    constexpr int LDS_BYTES = 147456;
    if (grid == 0) {
        if (n_in != 13 || ws_size < WS_END || out_size != NTOK * DM) { fprintf(stderr, "kernel_launch: unexpected n_in %d / ws_size %zu / out_size %d\n", n_in, ws_size, out_size); grid = -1; return; }
        int dev = 0, cus = 0, per_cu = 0;
        if (hipGetDevice(&dev) != hipSuccess || hipDeviceGetAttribute(&cus, hipDeviceAttributeMultiprocessorCount, dev) != hipSuccess) { grid = -1; return; }
        if (hipFuncSetAttribute((const void*)mega, hipFuncAttributeMaxDynamicSharedMemorySize, LDS_BYTES) != hipSuccess) { fprintf(stderr, "kernel_launch: hipFuncSetAttribute failed\n"); grid = -1; return; }
        if (hipOccupancyMaxActiveBlocksPerMultiprocessor(&per_cu, (const void*)mega, 512, LDS_BYTES) != hipSuccess || per_cu < 1) { fprintf(stderr, "kernel_launch: occupancy query failed (%d)\n", per_cu); grid = -1; return; }
        grid = cus * 1;
    }
    if (grid < 0) return;
    Params p{};
    p.x = (const float*)d_in[0]; p.mem = (const float*)d_in[1]; p.pre_g = (const float*)d_in[2]; p.w_in = (const float*)d_in[3]; p.conv_w = (const float*)d_in[4];
    p.a_log = (const float*)d_in[5]; p.dt_bias = (const float*)d_in[6]; p.sinks = (const float*)d_in[7]; p.dn_g = (const float*)d_in[8]; p.mem_g = (const float*)d_in[9];
    p.w_mkv = (const float*)d_in[10]; p.w_out = (const float*)d_in[11]; p.post_g = (const float*)d_in[12];
    p.out = (float*)d_out; p.ws = (unsigned char*)d_ws;
#if MK_MULTI
    for (int ph = 0; ph < N_PHASES; ++ph) hipLaunchKernelGGL(mega, dim3(grid), dim3(512), LDS_BYTES, stream, p, ph, ph + 1);
#else
    int lo = 0, hi = N_PHASES;
    void* args[] = {&p, &lo, &hi};
    const hipError_t e = hipLaunchCooperativeKernel((const void*)mega, dim3(grid), dim3(512), args, LDS_BYTES, stream);
    if (e != hipSuccess) fprintf(stderr, "kernel_launch: cooperative launch failed: %s (grid %d)\n", hipGetErrorString(e), grid);
#endif
}
```

```cpp
#include <hip/hip_runtime.h>
#include <hip/hip_cooperative_groups.h>
#include <cstdio>
#include <cstdint>

#define DI __device__ __forceinline__
#define LAS __attribute__((address_space(3)))
typedef unsigned short bf16_t;
typedef float f32x4 __attribute__((ext_vector_type(4)));
typedef unsigned u32x4 __attribute__((ext_vector_type(4)));
typedef unsigned u32x2 __attribute__((ext_vector_type(2)));

constexpr int DM = 1024, NB = 16, SEQ = 4096, NTOK = NB * SEQ, DEPTH = 2;
constexpr int INW = 2824;
constexpr int NIN = 2816;
constexpr int NMEM = 256, MEMROWS = NB * NMEM;
constexpr float EPS = 1e-6f;
constexpr int C_SQ = 0, C_SK = 512, C_SV = 640, C_DQ = 768, C_DK = 1024, C_DV = 1280, C_MQ = 1536, C_GATE = 1792;

constexpr size_t MiB = 1u << 20;
constexpr size_t WS_CTL = 0;
constexpr size_t WS_WIN = 1 * MiB;
constexpr size_t WS_WOUT = 12 * MiB;
constexpr size_t WS_WMKV = 16 * MiB;
constexpr size_t WS_W8 = 18 * MiB;
constexpr size_t WS_MEMN = 19 * MiB;
constexpr size_t WS_MK = 35 * MiB;
constexpr size_t WS_MVT = 39 * MiB;
constexpr size_t WS_BA = 43 * MiB;
constexpr size_t WS_STATS = 45 * MiB;
constexpr size_t WS_SVT = 49 * MiB;
constexpr size_t WS_H = 65 * MiB;
constexpr size_t WS_P = 193 * MiB;
constexpr size_t WS_DN = 545 * MiB;
constexpr size_t WS_END = 801 * MiB;

struct Params {
    const float *x, *mem, *pre_g, *w_in, *conv_w, *a_log, *dt_bias, *sinks, *dn_g, *mem_g, *w_mkv, *w_out, *post_g;
    float* out;
    unsigned char* ws;
};

DI unsigned f2bf(float f) { unsigned u = __float_as_uint(f); return (u + 0x7fffu + ((u >> 16) & 1u)) >> 16; }
DI unsigned pk2(float lo, float hi) { return f2bf(lo) | (f2bf(hi) << 16); }
DI float bf2f(unsigned u) { return __uint_as_float(u << 16); }
DI float bflo(unsigned u) { return __uint_as_float(u << 16); }
DI float bfhi(unsigned u) { return __uint_as_float(u & 0xffff0000u); }
DI float wave_sum(float v) {
#pragma unroll
    for (int o = 1; o < 64; o <<= 1) v += __shfl_xor(v, o);
    return v;
}
DI float sigmoidf_(float x) { return 1.f / (1.f + __expf(-x)); }
DI float siluf_(float x) { return x / (1.f + __expf(-x)); }
DI float softplusf_(float x) { return x > 20.f ? x : log1pf(expf(x)); }

DI void transpose_item(const float* W, int Nsrc, int src_n0, int k0, bf16_t* WT, int K, int dst_n0, LAS float* scr, int lane) {
#pragma unroll 8
    for (int i = 0; i < 32; ++i) { const int kk = 2 * i + (lane >> 5); scr[kk * 33 + (lane & 31)] = W[(size_t)(k0 + kk) * Nsrc + src_n0 + (lane & 31)]; }
    asm volatile("s_waitcnt lgkmcnt(0)" ::: "memory");
    const int c = lane & 7;
#pragma unroll
    for (int j = 0; j < 4; ++j) {
        const int n = (lane >> 3) + 8 * j; const LAS float* s = scr + (8 * c) * 33 + n;
        u32x4 o; o.x = pk2(s[0 * 33], s[1 * 33]); o.y = pk2(s[2 * 33], s[3 * 33]); o.z = pk2(s[4 * 33], s[5 * 33]); o.w = pk2(s[6 * 33], s[7 * 33]);
        *(u32x4*)(WT + (size_t)(dst_n0 + n) * K + k0 + 8 * c) = o;
    }
    asm volatile("s_waitcnt lgkmcnt(0)" ::: "memory");
}

DI void phase_init(const Params& p, LAS unsigned char* lds, int gw, int ngw, int wave, int lane) {
    LAS float* scr = (LAS float*)(lds + wave * 16384);
    constexpr int I_IN = 16 * (NIN / 32), I_OUT = 16 * 32, I_MKV = 16 * 16, I_L = I_IN + I_OUT + I_MKV;
    for (int it = gw; it < DEPTH * I_L; it += ngw) {
        const int l = it / I_L; int r = it % I_L;
        if (r < I_IN) {
            const int kb = r / (NIN / 32), nb = r % (NIN / 32), n0 = nb * 32;
            transpose_item(p.w_in + (size_t)l * DM * INW, INW, n0 + (n0 >= 1536 ? 8 : 0), kb * 64, (bf16_t*)(p.ws + WS_WIN) + (size_t)l * NIN * DM, DM, n0, scr, lane);
        } else if (r < I_IN + I_OUT) {
            r -= I_IN; const int kb = r / 32, nb = r % 32;
            transpose_item(p.w_out + (size_t)l * DM * DM, DM, nb * 32, kb * 64, (bf16_t*)(p.ws + WS_WOUT) + (size_t)l * DM * DM, DM, nb * 32, scr, lane);
        } else {
            r -= I_IN + I_OUT; const int kb = r / 16, nb = r % 16;
            transpose_item(p.w_mkv + (size_t)l * DM * 512, 512, nb * 32, kb * 64, (bf16_t*)(p.ws + WS_WMKV) + (size_t)l * 512 * DM, DM, nb * 32, scr, lane);
        }
    }
    for (int it = gw; it < DEPTH * MEMROWS; it += ngw) {
        const int l = it / MEMROWS, row = it % MEMROWS;
        const f32x4* xr = (const f32x4*)(p.mem + (size_t)row * DM) + lane;
        f32x4 v[4]; float s = 0.f;
#pragma unroll
        for (int j = 0; j < 4; ++j) { v[j] = xr[64 * j]; s += (v[j].x * v[j].x + v[j].y * v[j].y) + (v[j].z * v[j].z + v[j].w * v[j].w); }
        const float r = rsqrtf(wave_sum(s) * (1.f / DM) + EPS);
        const f32x4* gr = (const f32x4*)(p.mem_g + (size_t)l * DM) + lane;
        u32x2* o = (u32x2*)((bf16_t*)(p.ws + WS_MEMN) + ((size_t)l * MEMROWS + row) * DM) + lane;
#pragma unroll
        for (int j = 0; j < 4; ++j) { const f32x4 g = gr[64 * j]; u32x2 w; w.x = pk2(v[j].x * r * g.x, v[j].y * r * g.y); w.y = pk2(v[j].z * r * g.z, v[j].w * r * g.w); o[64 * j] = w; }
    }
}

template <bool L1> DI void prep_row(const Params& p, int l, int row, int lane, const LAS float* W8) {
    const f32x4* xr = (const f32x4*)(p.x + (size_t)row * DM) + lane;
    f32x4 v[4];
#pragma unroll
    for (int j = 0; j < 4; ++j) v[j] = xr[64 * j];
    if (L1) {
        const f32x4* st = (const f32x4*)((const float*)(p.ws + WS_STATS) + (size_t)row * 16);
        const f32x4 s0 = st[0], s1 = st[1], s2 = st[2], s3 = st[3];
        const float ss = ((s0.x + s0.y) + (s0.z + s0.w)) + ((s1.x + s1.y) + (s1.z + s1.w)) + ((s2.x + s2.y) + (s2.z + s2.w)) + ((s3.x + s3.y) + (s3.z + s3.w));
        const float ry = rsqrtf(ss * (1.f / DM) + EPS);
        const u32x2* yr = (const u32x2*)((const bf16_t*)(p.ws + WS_P) + (size_t)row * DM) + lane;
        const f32x4* pg = (const f32x4*)(p.post_g + (size_t)(l - 1) * DM) + lane;
        f32x4* xo = (f32x4*)(p.out + (size_t)row * DM) + lane;
#pragma unroll
        for (int j = 0; j < 4; ++j) {
            const u32x2 y = yr[64 * j]; const f32x4 g = pg[64 * j];
            v[j].x += bflo(y.x) * ry * g.x; v[j].y += bfhi(y.x) * ry * g.y; v[j].z += bflo(y.y) * ry * g.z; v[j].w += bfhi(y.y) * ry * g.w;
            xo[64 * j] = v[j];
        }
    }
    float s = 0.f;
#pragma unroll
    for (int j = 0; j < 4; ++j) s += (v[j].x * v[j].x + v[j].y * v[j].y) + (v[j].z * v[j].z + v[j].w * v[j].w);
    const float r = rsqrtf(wave_sum(s) * (1.f / DM) + EPS);
    const f32x4* gr = (const f32x4*)(p.pre_g + (size_t)l * DM) + lane;
    u32x2* ho = (u32x2*)((bf16_t*)(p.ws + WS_H) + (size_t)row * DM) + lane;
#pragma unroll
    for (int j = 0; j < 4; ++j) {
        const f32x4 g = gr[64 * j];
        v[j].x *= r * g.x; v[j].y *= r * g.y; v[j].z *= r * g.z; v[j].w *= r * g.w;
        u32x2 w; w.x = pk2(v[j].x, v[j].y); w.y = pk2(v[j].z, v[j].w); ho[64 * j] = w;
    }
    float mine = 0.f;
#pragma unroll
    for (int c = 0; c < 8; ++c) {
        const LAS f32x4* wr = (const LAS f32x4*)(W8 + c * DM) + lane; float d = 0.f;
#pragma unroll
        for (int j = 0; j < 4; ++j) { const f32x4 w = wr[64 * j]; d += (v[j].x * w.x + v[j].y * w.y) + (v[j].z * w.z + v[j].w * w.w); }
        d = wave_sum(d);
        mine = (lane == c) ? d : mine;
    }
    if (lane < 8) {
        float o;
        if (lane < 4) o = sigmoidf_(mine);
        else { const int h = lane - 4; o = -__expf(p.a_log[l * 4 + h]) * softplusf_(mine + p.dt_bias[l * 4 + h]); }
        ((float*)(p.ws + WS_BA))[(size_t)row * 8 + lane] = o;
    }
}

DI void final_row(const Params& p, int row, int lane) {
    const f32x4* st = (const f32x4*)((const float*)(p.ws + WS_STATS) + (size_t)row * 16);
    const f32x4 s0 = st[0], s1 = st[1], s2 = st[2], s3 = st[3];
    const float ss = ((s0.x + s0.y) + (s0.z + s0.w)) + ((s1.x + s1.y) + (s1.z + s1.w)) + ((s2.x + s2.y) + (s2.z + s2.w)) + ((s3.x + s3.y) + (s3.z + s3.w));
    const float ry = rsqrtf(ss * (1.f / DM) + EPS);
    const u32x2* yr = (const u32x2*)((const bf16_t*)(p.ws + WS_P) + (size_t)row * DM) + lane;
    const f32x4* pg = (const f32x4*)(p.post_g + (size_t)(DEPTH - 1) * DM) + lane;
    f32x4* xo = (f32x4*)(p.out + (size_t)row * DM) + lane;
#pragma unroll
    for (int j = 0; j < 4; ++j) {
        const u32x2 y = yr[64 * j]; const f32x4 g = pg[64 * j]; f32x4 v = xo[64 * j];
        v.x += bflo(y.x) * ry * g.x; v.y += bfhi(y.x) * ry * g.y; v.z += bflo(y.y) * ry * g.z; v.w += bfhi(y.y) * ry * g.w;
        xo[64 * j] = v;
    }
}


namespace pg8 {
#define PG8_LAS __attribute__((address_space(3)))
typedef unsigned short bf16_t;
typedef short bf16x8 __attribute__((ext_vector_type(8)));
typedef float f32x4 __attribute__((ext_vector_type(4)));
typedef unsigned u32x4 __attribute__((ext_vector_type(4)));
constexpr int BM = 256, BK = 64, HALF = 128, HTB = HALF * BK * 2  , STAGE_BYTES = 8 * HTB, NXCD = 8, WGM = 8;

__host__ __device__ __forceinline__ int lds_byte(int r, int c) { const int st = (r >> 4) * 2 + (c >> 5), rr = r & 15, cc = c & 31, ob = rr * 64 + cc * 2; return st * 1024 + (ob ^ (((ob >> 9) & 1) << 5)); }
__host__ __device__ __forceinline__ void stage_rc(int b, int& R, int& C) { const int st = b / 1024, sb = b % 1024, swz = sb ^ (((sb >> 9) & 1) << 5); R = (st >> 1) * 16 + swz / 64; C = (st & 1) * 32 + (swz % 64) / 2; }
__host__ __device__ __forceinline__ int perm32(int rho) { const int n = rho >> 4, i = rho & 15; return 8 * (i >> 2) + 4 * n + (i & 3); }

struct Unit { int pm, pn; };
struct Gemm { const bf16_t* A; const bf16_t* Bt; int M, N, K; };

struct StaticOrder {
    int nM, nN, nwg, G, c;
    __host__ __device__ void init(int M, int N, int G_, int c_) { nM = M / BM; nN = N / BM; nwg = nM * nN; G = G_; c = c_; }
    __host__ __device__ bool next(int i, Unit& u) const {
        const long L = (long)i * G + c; if (L >= nwg) return false;
        int wgid = (int)L; { const int q = nwg / NXCD, r = nwg % NXCD, xcd = wgid % NXCD, off = wgid / NXCD; wgid = (xcd < r ? xcd * (q + 1) : r * (q + 1) + (xcd - r) * q) + off; }
        const int nig = WGM * nN, gid = wgid / nig, fm = gid * WGM, gsz = (nM - fm) < WGM ? (nM - fm) : WGM;
        u.pm = fm + ((wgid % nig) % gsz); u.pn = (wgid % nig) / gsz; return true;
    }
    __device__ __forceinline__ void a_ready(const Unit&) const {}
    __device__ __forceinline__ void done(const Unit&) const {}
};

__device__ __forceinline__ unsigned cvt_pk_bf16(float lo, float hi) { unsigned r; asm volatile("v_cvt_pk_bf16_f32 %0, %1, %2" : "=v"(r) : "v"(lo), "v"(hi)); return r; }
template <class Epi, class Sched, bool ALIGN_EPI = false, bool SP2 = false>
__device__ __forceinline__ void gemm_phase(PG8_LAS unsigned char* lds, const Gemm g, const Sched& S, const Epi& E) {
    int tid = threadIdx.x; asm volatile("" : "+v"(tid));
    const int wid = __builtin_amdgcn_readfirstlane(tid >> 6), lane = tid & 63, wr = wid >> 2, wc = wid & 3, fr = lane & 15, fq = lane >> 4;
    const int K = g.K, nt = K / BK;
    unsigned voffA[2], voffB[2];
#pragma unroll
    for (int i = 0; i < 2; ++i) { int R, C; stage_rc(tid * 16 + i * 8192, R, C); const int Rb = Epi::PERM ? ((R & ~31) + perm32(R & 31)) : R;
        voffA[i] = (unsigned)(R * K + C) * 2u; voffB[i] = (unsigned)(Rb * K + C) * 2u; }
    const size_t kstep = (size_t)(BK * 2);
    const size_t hstep = (size_t)HALF * K * 2;
    const size_t tstep = 2 * hstep;
    const unsigned ldsw = (unsigned)wid * 1024u;
    const int aoff = lds_byte(wr * 64 + fr, fq * 8), boff = lds_byte(wc * 32 + fr, fq * 8);
#define PG8_SA(b, h) (((b) * 2 + (h)) * HTB)
#define PG8_SB(b, h) ((4 + (b) * 2 + (h)) * HTB)
#define PG8_STAGE(bufoff, gbase, voff) do { _Pragma("unroll") for (int _i = 0; _i < 2; ++_i) \
        __builtin_amdgcn_global_load_lds((const unsigned*)((const char*)(gbase) + (voff)[_i]), (PG8_LAS unsigned*)(lds + (bufoff) + ldsw + _i * 8192), 16, 0, 0); } while (0)
#define PG8_LDA(dst, b, h) do { _Pragma("unroll") for (int m = 0; m < 4; ++m) _Pragma("unroll") for (int k = 0; k < 2; ++k) dst[m][k] = *(const PG8_LAS bf16x8*)(lds + PG8_SA(b, h) + aoff + m * 2048 + k * 1024); } while (0)
#define PG8_LDB(dst, b, h) do { _Pragma("unroll") for (int n = 0; n < 2; ++n) _Pragma("unroll") for (int k = 0; k < 2; ++k) dst[n][k] = *(const PG8_LAS bf16x8*)(lds + PG8_SB(b, h) + boff + n * 2048 + k * 1024); } while (0)
#define PG8_MMA(ai, bj, At, Bt) do { __builtin_amdgcn_s_setprio(1); _Pragma("unroll") for (int m = 0; m < 4; ++m) _Pragma("unroll") for (int n = 0; n < 2; ++n) _Pragma("unroll") for (int k = 0; k < 2; ++k) \
        acc[ai][bj][m][n] = __builtin_amdgcn_mfma_f32_16x16x32_bf16(Bt[n][k], At[m][k], acc[ai][bj][m][n], 0, 0, 0); __builtin_amdgcn_s_setprio(0); } while (0)
#define PG8_WAIT_V(n) asm volatile("s_waitcnt vmcnt(" #n ")" ::: "memory")
#define PG8_WAIT_L(n) asm volatile("s_waitcnt lgkmcnt(" #n ")" ::: "memory")
#define PG8_BAR __builtin_amdgcn_s_barrier()
#define PG8_SCHED __builtin_amdgcn_sched_barrier(0)
    Unit cur, nxt; int ui = 0;
    if (!S.next(0, cur)) return;
    f32x4 acc[2][2][4][2];
#pragma unroll
    for (int a = 0; a < 2; ++a)
#pragma unroll
        for (int b = 0; b < 2; ++b)
#pragma unroll
            for (int m = 0; m < 4; ++m)
#pragma unroll
                for (int n = 0; n < 2; ++n) acc[a][b][m][n] = (f32x4){0.f, 0.f, 0.f, 0.f};
    bf16x8 At[4][2], B0[2][2], B1[2][2];
    const char* cA = (const char*)g.A + (size_t)cur.pm * tstep; const char* cB = (const char*)g.Bt + (size_t)cur.pn * tstep;
    S.a_ready(cur);
    if constexpr (SP2) {
        PG8_STAGE(PG8_SB(0, 0), cB, voffB); PG8_STAGE(PG8_SB(0, 1), cB + hstep, voffB); PG8_STAGE(PG8_SA(0, 0), cA, voffA); PG8_STAGE(PG8_SA(0, 1), cA + hstep, voffA);
        if (wr == 1) PG8_BAR;
        PG8_WAIT_V(2); PG8_BAR;
        PG8_STAGE(PG8_SB(1, 0), cB + kstep, voffB); PG8_STAGE(PG8_SA(1, 0), cA + kstep, voffA); PG8_STAGE(PG8_SB(1, 1), cB + hstep + kstep, voffB);
        PG8_WAIT_V(6); PG8_BAR;
    } else {
        PG8_STAGE(PG8_SB(0, 0), cB, voffB); PG8_STAGE(PG8_SA(0, 0), cA, voffA); PG8_STAGE(PG8_SB(0, 1), cB + hstep, voffB); PG8_STAGE(PG8_SA(0, 1), cA + hstep, voffA);
        if (wr == 1) PG8_BAR;
        PG8_WAIT_V(4); PG8_BAR;
        PG8_STAGE(PG8_SB(1, 0), cB + kstep, voffB); PG8_STAGE(PG8_SA(1, 0), cA + kstep, voffA); PG8_STAGE(PG8_SB(1, 1), cB + hstep + kstep, voffB);
        PG8_WAIT_V(6); PG8_BAR;
    }
    for (;;) {
        const bool has_next = S.next(ui + 1, nxt);
        const char* nA = has_next ? (const char*)g.A + (size_t)nxt.pm * tstep : cA; const char* nB = has_next ? (const char*)g.Bt + (size_t)nxt.pn * tstep : cB;
        for (int t = 0; t < nt; t += 2) {
            const bool last = (t == nt - 2);
            const char* a1 = cA + (size_t)(t + 1) * kstep;
            const char* a2 = last ? nA : cA + (size_t)(t + 2) * kstep; const char* b2 = last ? nB : cB + (size_t)(t + 2) * kstep;
            const char* a3 = a2 + kstep; const char* b3 = b2 + kstep;
            if (last && has_next) S.a_ready(nxt);
            if constexpr (SP2) {
            PG8_LDB(B0, 0, 0); PG8_LDB(B1, 0, 1); PG8_SCHED; PG8_LDA(At, 0, 0); PG8_STAGE(PG8_SA(1, 1), a1 + hstep, voffA);
            PG8_WAIT_V(8); PG8_WAIT_L(0); PG8_BAR; PG8_MMA(0, 0, At, B0); PG8_MMA(0, 1, At, B1); PG8_BAR; PG8_SCHED;
            PG8_LDA(At, 0, 1); PG8_STAGE(PG8_SB(0, 0), b2, voffB); PG8_STAGE(PG8_SB(0, 1), b2 + hstep, voffB); PG8_STAGE(PG8_SA(0, 0), a2, voffA);
            PG8_WAIT_V(8); PG8_WAIT_L(0); PG8_BAR; PG8_MMA(1, 0, At, B0); PG8_MMA(1, 1, At, B1); PG8_BAR; PG8_SCHED;
            PG8_LDB(B0, 1, 0); PG8_LDB(B1, 1, 1); PG8_SCHED; PG8_LDA(At, 1, 0); PG8_STAGE(PG8_SA(0, 1), a2 + hstep, voffA);
            PG8_WAIT_V(8); PG8_WAIT_L(0); PG8_BAR; PG8_MMA(0, 0, At, B0); PG8_MMA(0, 1, At, B1); PG8_BAR; PG8_SCHED;
            PG8_LDA(At, 1, 1); PG8_STAGE(PG8_SB(1, 0), b3, voffB); PG8_STAGE(PG8_SB(1, 1), b3 + hstep, voffB); PG8_STAGE(PG8_SA(1, 0), a3, voffA);
            PG8_WAIT_V(8); PG8_WAIT_L(0); PG8_BAR; PG8_MMA(1, 0, At, B0); PG8_MMA(1, 1, At, B1); PG8_BAR; PG8_SCHED;
            } else {
            PG8_LDB(B0, 0, 0); PG8_SCHED; PG8_LDA(At, 0, 0); PG8_STAGE(PG8_SA(1, 1), a1 + hstep, voffA);
            PG8_WAIT_L(8); PG8_BAR; PG8_WAIT_L(0); PG8_MMA(0, 0, At, B0); PG8_BAR; PG8_SCHED;
            PG8_LDB(B1, 0, 1); PG8_STAGE(PG8_SB(0, 0), b2, voffB);
            PG8_BAR; PG8_WAIT_L(0); PG8_MMA(0, 1, At, B1); PG8_BAR;
            PG8_LDA(At, 0, 1); PG8_STAGE(PG8_SA(0, 0), a2, voffA);
            PG8_BAR; PG8_WAIT_L(0); PG8_MMA(1, 0, At, B0); PG8_BAR; PG8_SCHED;
            PG8_STAGE(PG8_SB(0, 1), b2 + hstep, voffB);
            PG8_WAIT_V(6); PG8_BAR; PG8_MMA(1, 1, At, B1); PG8_BAR;
            PG8_LDB(B0, 1, 0); PG8_SCHED; PG8_LDA(At, 1, 0); PG8_STAGE(PG8_SA(0, 1), a2 + hstep, voffA);
            PG8_WAIT_L(8); PG8_BAR; PG8_WAIT_L(0); PG8_MMA(0, 0, At, B0); PG8_BAR; PG8_SCHED;
            PG8_LDB(B1, 1, 1); PG8_STAGE(PG8_SB(1, 0), b3, voffB);
            PG8_BAR; PG8_WAIT_L(0); PG8_MMA(0, 1, At, B1); PG8_BAR;
            PG8_LDA(At, 1, 1); PG8_STAGE(PG8_SA(1, 0), a3, voffA);
            PG8_BAR; PG8_WAIT_L(0); PG8_MMA(1, 0, At, B0); PG8_BAR; PG8_SCHED;
            PG8_STAGE(PG8_SB(1, 1), b3 + hstep, voffB);
            PG8_WAIT_V(6); PG8_BAR; PG8_MMA(1, 1, At, B1); PG8_BAR;
            }
        }
        if constexpr (ALIGN_EPI) { if (wr == 0) PG8_BAR; }
        if constexpr (!Epi::AFTER_DRAIN) { E(acc, cur, wr, wc, fr, fq); S.done(cur); }
        if (!has_next) break;
#pragma unroll
        for (int a = 0; a < 2; ++a)
#pragma unroll
            for (int b = 0; b < 2; ++b)
#pragma unroll
                for (int m = 0; m < 4; ++m)
#pragma unroll
                    for (int n = 0; n < 2; ++n) acc[a][b][m][n] = (f32x4){0.f, 0.f, 0.f, 0.f};
        cur = nxt; cA = nA; cB = nB; ++ui;
        if constexpr (ALIGN_EPI) { if (wr == 1) PG8_BAR; }
    }
    PG8_WAIT_V(0);
    if constexpr (!ALIGN_EPI) { if (wr == 0) PG8_BAR; }
    PG8_BAR;
    if constexpr (Epi::AFTER_DRAIN) { E.fused(acc, cur, wr, wc, fr, fq, lds, wid, lane); S.done(cur); }
#undef PG8_SA
#undef PG8_SB
#undef PG8_STAGE
#undef PG8_LDA
#undef PG8_LDB
#undef PG8_MMA
#undef PG8_WAIT_V
#undef PG8_WAIT_L
#undef PG8_BAR
#undef PG8_SCHED
}
}
using pg8::cvt_pk_bf16;
struct EpiProj {
    static constexpr bool PERM = true, AFTER_DRAIN = false;
    bf16_t* O; bf16_t* svT;
    DI void operator()(const f32x4 (&acc)[2][2][4][2], const pg8::Unit& u, int wr, int wc, int fr, int fq) const {
        const int row0 = u.pm * 256 + wr * 64 + fr, col0 = u.pn * 256 + wc * 32 + 8 * fq;
#pragma unroll
        for (int ai = 0; ai < 2; ++ai)
#pragma unroll
            for (int m = 0; m < 4; ++m) { bf16_t* rowp = O + (size_t)(row0 + ai * 128 + m * 16) * NIN + col0;
#pragma unroll
                for (int bj = 0; bj < 2; ++bj) { const f32x4 v0 = acc[ai][bj][m][0], v1 = acc[ai][bj][m][1];
                    u32x4 w; w.x = cvt_pk_bf16(v0[0], v0[1]); w.y = cvt_pk_bf16(v0[2], v0[3]); w.z = cvt_pk_bf16(v1[0], v1[1]); w.w = cvt_pk_bf16(v1[2], v1[3]);
                    *(u32x4*)(rowp + bj * 128) = w; } }
        if (u.pn == 2) {
#pragma unroll
            for (int ai = 0; ai < 2; ++ai)
#pragma unroll
                for (int m = 0; m < 4; ++m) { const int row = row0 + ai * 128 + m * 16, b = row >> 12, s = row & (SEQ - 1);
#pragma unroll
                    for (int n = 0; n < 2; ++n)
#pragma unroll
                        for (int e = 0; e < 4; ++e) { const int c = wc * 32 + 8 * fq + 4 * n + e;
                            svT[((size_t)(b * 2 + (c >> 6)) * 64 + (c & 63)) * SEQ + s] = (bf16_t)f2bf(acc[ai][1][m][n][e]); } }
        }
    }
};
struct EpiMkv {
    static constexpr bool PERM = true, AFTER_DRAIN = false;
    bf16_t* mk; bf16_t* mvT;
    DI void operator()(const f32x4 (&acc)[2][2][4][2], const pg8::Unit& u, int wr, int wc, int fr, int fq) const {
        const int row0 = u.pm * 256 + wr * 64 + fr;
#pragma unroll
        for (int ai = 0; ai < 2; ++ai)
#pragma unroll
            for (int m = 0; m < 4; ++m) { const int row = row0 + ai * 128 + m * 16;
                if (u.pn == 0) {
#pragma unroll
                    for (int bj = 0; bj < 2; ++bj) { const f32x4 v0 = acc[ai][bj][m][0], v1 = acc[ai][bj][m][1];
                        u32x4 w; w.x = cvt_pk_bf16(v0[0], v0[1]); w.y = cvt_pk_bf16(v0[2], v0[3]); w.z = cvt_pk_bf16(v1[0], v1[1]); w.w = cvt_pk_bf16(v1[2], v1[3]);
                        *(u32x4*)(mk + (size_t)row * 256 + bj * 128 + wc * 32 + 8 * fq) = w; }
                } else { const int b = row >> 8, mm = row & 255;
#pragma unroll
                    for (int bj = 0; bj < 2; ++bj)
#pragma unroll
                        for (int n = 0; n < 2; ++n)
#pragma unroll
                            for (int e = 0; e < 4; ++e) { const int c = bj * 128 + wc * 32 + 8 * fq + 4 * n + e;
                                mvT[((size_t)(b * 4 + (c >> 6)) * 64 + (c & 63)) * NMEM + mm] = (bf16_t)f2bf(acc[ai][bj][m][n][e]); } }
            }
    }
};
struct EpiY {
    static constexpr bool PERM = true, AFTER_DRAIN = false;
    bf16_t* Y; float* stats;
    DI void operator()(const f32x4 (&acc)[2][2][4][2], const pg8::Unit& u, int wr, int wc, int fr, int fq) const {
        const int row0 = u.pm * 256 + wr * 64 + fr, col0 = u.pn * 256 + wc * 32 + 8 * fq;
#pragma unroll
        for (int ai = 0; ai < 2; ++ai)
#pragma unroll
            for (int m = 0; m < 4; ++m) { const int row = row0 + ai * 128 + m * 16; bf16_t* rowp = Y + (size_t)row * DM + col0; float ss = 0.f;
#pragma unroll
                for (int bj = 0; bj < 2; ++bj) { const f32x4 v0 = acc[ai][bj][m][0], v1 = acc[ai][bj][m][1];
                    ss += (v0[0] * v0[0] + v0[1] * v0[1]) + (v0[2] * v0[2] + v0[3] * v0[3]) + (v1[0] * v1[0] + v1[1] * v1[1]) + (v1[2] * v1[2] + v1[3] * v1[3]);
                    u32x4 w; w.x = cvt_pk_bf16(v0[0], v0[1]); w.y = cvt_pk_bf16(v0[2], v0[3]); w.z = cvt_pk_bf16(v1[0], v1[1]); w.w = cvt_pk_bf16(v1[2], v1[3]);
                    *(u32x4*)(rowp + bj * 128) = w; }
                ss += __shfl_xor(ss, 16); ss += __shfl_xor(ss, 32);
                if (fq == 0) stats[(size_t)row * 16 + u.pn * 4 + wc] = ss; }
    }
};

typedef short bf16x8 __attribute__((ext_vector_type(8)));
typedef short s16x4 __attribute__((ext_vector_type(4)));
typedef float f32x16 __attribute__((ext_vector_type(16)));
typedef float f32x2_t __attribute__((ext_vector_type(2)));
typedef __bf16 bf16x2_t __attribute__((ext_vector_type(2)));
DI unsigned cvtpk(float lo, float hi) { f32x2_t v = {lo, hi}; bf16x2_t b = __builtin_convertvector(v, bf16x2_t); return __builtin_bit_cast(unsigned, b); }
#define MFMA32(a, b, c) __builtin_amdgcn_mfma_f32_32x32x16_bf16((a), (b), (c), 0, 0, 0)
#define MFMA16(a, b, c) __builtin_amdgcn_mfma_f32_16x16x32_bf16((a), (b), (c), 0, 0, 0)
constexpr int N_SWA_UNITS = NB * 2 * 128 * 4, N_MEM_UNITS = NB * 128 * 4, N_ATTN_UNITS = N_SWA_UNITS + N_MEM_UNITS;
DI void attn_unit(const Params& p, int l, int u, int lane) {
    const int r = lane & 31, h = lane >> 5;
    const bf16_t* P = (const bf16_t*)(p.ws + WS_P);
    const bf16_t *Qrow, *Kbase, *VTb; int kstride, vstride, kbase, kt0, nkt, mcol; float m, lsum; size_t row0;
    const bool swa = u < N_SWA_UNITS;
    if (swa) {
        const int g = u & 3, qt = (u >> 2) & 127, bk = u >> 9, b = bk >> 1, kvh = bk & 1, head = kvh * 4 + g;
        row0 = (size_t)b * SEQ + qt * 32;
        Qrow = P + row0 * NIN + C_SQ + head * 64;
        Kbase = P + (size_t)b * SEQ * NIN + C_SK + kvh * 64; kstride = NIN;
        VTb = (const bf16_t*)(p.ws + WS_SVT) + (size_t)(b * 2 + kvh) * 64 * SEQ; vstride = SEQ;
        kbase = qt * 32 - 128; kt0 = qt < 4 ? 4 - qt : 0; nkt = 5; mcol = head * 64;
        m = p.sinks[l * 8 + head] * 1.4426950408889634f; lsum = h == 0 ? 1.f : 0.f;
    } else {
        const int v = u - N_SWA_UNITS, hm = v & 3, qt = (v >> 2) & 127, b = v >> 9;
        row0 = (size_t)b * SEQ + qt * 32;
        Qrow = P + row0 * NIN + C_MQ + hm * 64;
        Kbase = (const bf16_t*)(p.ws + WS_MK) + (size_t)l * MEMROWS * 256 + (size_t)b * NMEM * 256 + hm * 64; kstride = 256;
        VTb = (const bf16_t*)(p.ws + WS_MVT) + (size_t)l * MEMROWS * 256 + (size_t)(b * 4 + hm) * 64 * NMEM; vstride = NMEM;
        kbase = 0; kt0 = 0; nkt = 8; mcol = 768 + hm * 64;
        m = -1e30f; lsum = 0.f;
    }
    bf16x8 qf[4];
#pragma unroll
    for (int ks = 0; ks < 4; ++ks) qf[ks] = *(const bf16x8*)(Qrow + (size_t)r * NIN + 16 * ks + 8 * h);
    f32x16 o0, o1;
#pragma unroll
    for (int i = 0; i < 16; ++i) { o0[i] = 0.f; o1[i] = 0.f; }
    constexpr float SC = 0.125f * 1.4426950408889634f;
    for (int kt = kt0; kt < nkt; ++kt) {
        const int key0 = kbase + 32 * kt;
        const bf16_t* kp = Kbase + (size_t)(key0 + r) * kstride + 8 * h;
        bf16x8 kf[4];
#pragma unroll
        for (int ks = 0; ks < 4; ++ks) kf[ks] = *(const bf16x8*)(kp + 16 * ks);
        const bf16_t* vp = VTb + (size_t)r * vstride + key0 + 4 * h;
        s16x4 va[2][2][2];
#pragma unroll
        for (int dt = 0; dt < 2; ++dt)
#pragma unroll
            for (int ss = 0; ss < 2; ++ss)
#pragma unroll
                for (int hf = 0; hf < 2; ++hf) va[dt][ss][hf] = *(const s16x4*)(vp + (size_t)dt * 32 * vstride + 16 * ss + 8 * hf);
        f32x16 s;
#pragma unroll
        for (int i = 0; i < 16; ++i) s[i] = 0.f;
#pragma unroll
        for (int ks = 0; ks < 4; ++ks) s = MFMA32(kf[ks], qf[ks], s);
        const bool mlo = swa && kt == 0, mhi = swa && kt == 4;
        float tm = -1e30f;
#pragma unroll
        for (int i = 0; i < 16; ++i) {
            const int c = (i & 3) + 8 * (i >> 2) + 4 * h;
            float v = s[i] * SC;
            if (mlo && !(c > r)) v = -1e30f;
            if (mhi && !(c <= r)) v = -1e30f;
            s[i] = v; tm = fmaxf(tm, v);
        }
        tm = fmaxf(tm, __shfl_xor(tm, 32));
        const float mn = fmaxf(m, tm), alpha = __builtin_amdgcn_exp2f(m - mn);
        m = mn;
        float ps = 0.f;
#pragma unroll
        for (int i = 0; i < 16; ++i) { s[i] = __builtin_amdgcn_exp2f(s[i] - mn); ps += s[i]; }
        lsum = lsum * alpha + ps;
#pragma unroll
        for (int i = 0; i < 16; ++i) { o0[i] *= alpha; o1[i] *= alpha; }
#pragma unroll
        for (int ss = 0; ss < 2; ++ss) {
            u32x4 pw; pw.x = cvtpk(s[8 * ss + 0], s[8 * ss + 1]); pw.y = cvtpk(s[8 * ss + 2], s[8 * ss + 3]); pw.z = cvtpk(s[8 * ss + 4], s[8 * ss + 5]); pw.w = cvtpk(s[8 * ss + 6], s[8 * ss + 7]);
            const bf16x8 pf = __builtin_bit_cast(bf16x8, pw);
            const bf16x8 v0 = __builtin_shufflevector(va[0][ss][0], va[0][ss][1], 0, 1, 2, 3, 4, 5, 6, 7);
            const bf16x8 v1 = __builtin_shufflevector(va[1][ss][0], va[1][ss][1], 0, 1, 2, 3, 4, 5, 6, 7);
            o0 = MFMA32(v0, pf, o0); o1 = MFMA32(v1, pf, o1);
        }
    }
    lsum += __shfl_xor(lsum, 32);
    const float inv = 1.f / lsum;
    const bf16_t* gp = P + (row0 + r) * NIN + C_GATE + mcol + 4 * h;
    bf16_t* op = (bf16_t*)(p.ws + WS_H) + (row0 + r) * DM + mcol + 4 * h;
#pragma unroll
    for (int dt = 0; dt < 2; ++dt)
#pragma unroll
        for (int g4 = 0; g4 < 4; ++g4) {
            const u32x2 gt = *(const u32x2*)(gp + 32 * dt + 8 * g4);
            const float a0 = (dt ? o1[4 * g4 + 0] : o0[4 * g4 + 0]) * inv * siluf_(bflo(gt.x)), a1 = (dt ? o1[4 * g4 + 1] : o0[4 * g4 + 1]) * inv * siluf_(bfhi(gt.x));
            const float a2 = (dt ? o1[4 * g4 + 2] : o0[4 * g4 + 2]) * inv * siluf_(bflo(gt.y)), a3 = (dt ? o1[4 * g4 + 3] : o0[4 * g4 + 3]) * inv * siluf_(bfhi(gt.y));
            u32x2 w; w.x = cvtpk(a0, a1); w.y = cvtpk(a2, a3);
            *(u32x2*)(op + 32 * dt + 8 * g4) = w;
        }
}

constexpr size_t DN_M = WS_DN;
constexpr size_t DN_NT = WS_DN + 32 * MiB;
constexpr size_t DN_UT = WS_DN + 96 * MiB;
constexpr size_t DN_W = WS_DN + 128 * MiB;
constexpr size_t DN_QG = WS_DN + 160 * MiB;
constexpr size_t DN_IN = WS_DN + 192 * MiB;
constexpr size_t DN_ST = WS_DN + 224 * MiB;
constexpr int LDK = 72;

DI void mm16x64(f32x4 (&acc)[4], const LAS bf16_t* A, int r0, const LAS bf16_t* Bt, int fr, int fq) {
    bf16x8 a[2];
#pragma unroll
    for (int ks = 0; ks < 2; ++ks) a[ks] = *(const LAS bf16x8*)(A + (r0 + fr) * LDK + 32 * ks + 8 * fq);
#pragma unroll
    for (int nt = 0; nt < 4; ++nt)
#pragma unroll
        for (int ks = 0; ks < 2; ++ks) { const bf16x8 b = *(const LAS bf16x8*)(Bt + (16 * nt + fr) * LDK + 32 * ks + 8 * fq); acc[nt] = MFMA16(a[ks], b, acc[nt]); }
}
DI void conv16(float (&out)[16], const bf16_t* Pcol, size_t rowb, int s0, const float* cw) {
#pragma unroll
    for (int e = 0; e < 16; ++e) out[e] = 0.f;
#pragma unroll
    for (int j = 0; j < 4; ++j) {
        const int s = s0 + j;
        if (s >= 0) {
            const u32x4 x0 = *(const u32x4*)(Pcol + (rowb + s) * NIN), x1 = *(const u32x4*)(Pcol + (rowb + s) * NIN + 8);
            const f32x4 w0 = *(const f32x4*)(cw + j * 768), w1 = *(const f32x4*)(cw + j * 768 + 4), w2 = *(const f32x4*)(cw + j * 768 + 8), w3 = *(const f32x4*)(cw + j * 768 + 12);
            out[0] += w0.x * bflo(x0.x); out[1] += w0.y * bfhi(x0.x); out[2] += w0.z * bflo(x0.y); out[3] += w0.w * bfhi(x0.y);
            out[4] += w1.x * bflo(x0.z); out[5] += w1.y * bfhi(x0.z); out[6] += w1.z * bflo(x0.w); out[7] += w1.w * bfhi(x0.w);
            out[8] += w2.x * bflo(x1.x); out[9] += w2.y * bfhi(x1.x); out[10] += w2.z * bflo(x1.y); out[11] += w2.w * bfhi(x1.y);
            out[12] += w3.x * bflo(x1.z); out[13] += w3.y * bfhi(x1.z); out[14] += w3.z * bflo(x1.w); out[15] += w3.w * bfhi(x1.w);
        }
    }
#pragma unroll
    for (int e = 0; e < 16; ++e) out[e] = siluf_(out[e]);
}
DI u32x4 pack8(const float* v) { u32x4 w; w.x = cvtpk(v[0], v[1]); w.y = cvtpk(v[2], v[3]); w.z = cvtpk(v[4], v[5]); w.w = cvtpk(v[6], v[7]); return w; }
DI u32x2 pack4(const f32x4 v) { u32x2 w; w.x = cvtpk(v[0], v[1]); w.y = cvtpk(v[2], v[3]); return w; }

DI void dn_prep_phase(const Params& p, int l, LAS unsigned char* lds, int tid, int G) {
    const int sg = tid >> 8, ts = tid & 255, lane = tid & 63, wsg = (tid >> 6) & 3, fr = lane & 15, fq = lane >> 4;
    LAS unsigned char* base = lds + sg * 65536;
    LAS bf16_t* qs = (LAS bf16_t*)(base); LAS bf16_t* Tm = qs;
    LAS bf16_t* ks = (LAS bf16_t*)(base + 9216); LAS bf16_t* uT = ks;
    LAS bf16_t* kdT = (LAS bf16_t*)(base + 18432);
    LAS bf16_t* kbgT = (LAS bf16_t*)(base + 27648);
    LAS bf16_t* vbT = (LAS bf16_t*)(base + 36864);
    LAS float* Lf = (LAS float*)(base + 46080); LAS bf16_t* wT = (LAS bf16_t*)(base + 46080);
    LAS float* gcs = (LAS float*)(base + 63488); LAS float* betas = gcs + 64;
    const bf16_t* P = (const bf16_t*)(p.ws + WS_P);
    const float* BA = (const float*)(p.ws + WS_BA);
    const float* cwl = p.conv_w + (size_t)l * 4 * 768;
    const int t = ts >> 2, seg = ts & 3;
    for (int it = blockIdx.x; it < 2048; it += G) {
        const int ch = 2 * it + sg, b = ch >> 8, h = (ch >> 6) & 3, n = ch & 63;
        const size_t rowb = (size_t)b * SEQ, row = rowb + n * 64 + t; const int s0 = n * 64 + t - 3;
        float cq[16], ck[16], cv[16];
        conv16(cq, P + C_DQ + h * 64 + 16 * seg, rowb, s0, cwl + h * 64 + 16 * seg);
        conv16(ck, P + C_DK + h * 64 + 16 * seg, rowb, s0, cwl + 256 + h * 64 + 16 * seg);
        conv16(cv, P + C_DV + h * 64 + 16 * seg, rowb, s0, cwl + 512 + h * 64 + 16 * seg);
        float sq = 0.f, sk = 0.f;
#pragma unroll
        for (int e = 0; e < 16; ++e) { sq += cq[e] * cq[e]; sk += ck[e] * ck[e]; }
        sq += __shfl_xor(sq, 1); sq += __shfl_xor(sq, 2); sk += __shfl_xor(sk, 1); sk += __shfl_xor(sk, 2);
        const float rq = rsqrtf(sq + EPS) * 0.125f, rk = rsqrtf(sk + EPS);
#pragma unroll
        for (int e = 0; e < 16; ++e) { cq[e] *= rq; ck[e] *= rk; }
        const float beta = BA[row * 8 + h], g = BA[row * 8 + 4 + h];
        *(LAS u32x4*)(qs + t * LDK + 16 * seg) = pack8(cq); *(LAS u32x4*)(qs + t * LDK + 16 * seg + 8) = pack8(cq + 8);
        *(LAS u32x4*)(ks + t * LDK + 16 * seg) = pack8(ck); *(LAS u32x4*)(ks + t * LDK + 16 * seg + 8) = pack8(ck + 8);
        if (seg == 0) { gcs[t] = g; betas[t] = beta; }
        __syncthreads();
        float x = gcs[lane];
#pragma unroll
        for (int o = 1; o < 64; o <<= 1) { const float y = __shfl_up(x, o); if (lane >= o) x += y; }
        const float gc_t = __shfl(x, t), gl = __shfl(x, 63);
        __syncthreads();
        if (wsg == 0) gcs[lane] = x;
        const float eg = __expf(gc_t), ed = __expf(gl - gc_t);
#pragma unroll
        for (int e = 0; e < 16; ++e) { const int i = 16 * seg + e;
            kdT[i * LDK + t] = (bf16_t)f2bf(ck[e] * ed); kbgT[i * LDK + t] = (bf16_t)f2bf(ck[e] * beta * eg); vbT[i * LDK + t] = (bf16_t)f2bf(cv[e] * beta); }
        { float qg[16];
#pragma unroll
          for (int e = 0; e < 16; ++e) qg[e] = cq[e] * eg;
          bf16_t* dst = (bf16_t*)(p.ws + DN_QG) + (size_t)ch * 4096 + t * 64 + 16 * seg;
          *(u32x4*)dst = pack8(qg); *(u32x4*)(dst + 8) = pack8(qg + 8); }
        __syncthreads();
        {
            f32x4 acc[4], acc2[4];
#pragma unroll
            for (int nt = 0; nt < 4; ++nt) { acc[nt] = (f32x4){0.f, 0.f, 0.f, 0.f}; acc2[nt] = (f32x4){0.f, 0.f, 0.f, 0.f}; }
            mm16x64(acc, ks, 16 * wsg, ks, fr, fq);
            mm16x64(acc2, ks, 16 * wsg, qs, fr, fq);
            const int r0 = 16 * wsg + 4 * fq;
            float gr[4], br[4];
#pragma unroll
            for (int r = 0; r < 4; ++r) { gr[r] = gcs[r0 + r]; br[r] = betas[r0 + r]; }
#pragma unroll
            for (int nt = 0; nt < 4; ++nt) { const int cc = 16 * nt + fr; const float gcol = gcs[cc];
#pragma unroll
                for (int r = 0; r < 4; ++r) { const int c = r0 + r;
                    Lf[c * 68 + cc] = (cc < c) ? br[r] * acc[nt][r] * __expf(gr[r] - gcol) : 0.f; }
                f32x4 iv;
#pragma unroll
                for (int r = 0; r < 4; ++r) { const int s = r0 + r;
                    iv[r] = (s <= cc) ? acc2[nt][r] * __expf(gcol - gr[r]) : 0.f; }
                *(u32x2*)((bf16_t*)(p.ws + DN_IN) + (size_t)ch * 4096 + cc * 64 + r0) = pack4(iv); }
        }
        __syncthreads();
        if (wsg == 0) {
            float T[64];
#pragma unroll
            for (int c = 0; c < 64; ++c) T[c] = 0.f;
            const float lanef = (float)lane;
#pragma unroll
            for (int c = 0; c < 64; ++c) {
                float d = lanef; if (c > 0) asm volatile("" : "+v"(d) : "v"(T[c - 1]));
                float a0 = fmaxf(0.f, 1.f - fabsf(d - (float)c)), a1 = 0.f, a2 = 0.f, a3 = 0.f;
#pragma unroll
                for (int s4 = 0; s4 < (c + 3) / 4; ++s4) { const f32x4 Lv = *(const LAS f32x4*)(Lf + c * 68 + 4 * s4);
                    a0 -= Lv.x * T[4 * s4]; a1 -= Lv.y * T[4 * s4 + 1]; a2 -= Lv.z * T[4 * s4 + 2]; a3 -= Lv.w * T[4 * s4 + 3]; }
                T[c] = (a0 + a1) + (a2 + a3);
            }
#pragma unroll
            for (int c = 0; c < 64; ++c) Tm[c * LDK + lane] = (bf16_t)f2bf(T[c]);
        }
        __syncthreads();
        {   f32x4 au[4], aw[4], awr[4];
#pragma unroll
            for (int nt = 0; nt < 4; ++nt) { au[nt] = (f32x4){0.f, 0.f, 0.f, 0.f}; aw[nt] = au[nt]; awr[nt] = au[nt]; }
            mm16x64(au, Tm, 16 * wsg, vbT, fr, fq);
            mm16x64(aw, Tm, 16 * wsg, kbgT, fr, fq);
            mm16x64(awr, kbgT, 16 * wsg, Tm, fr, fq);
            const int r0 = 16 * wsg + 4 * fq;
#pragma unroll
            for (int nt = 0; nt < 4; ++nt) { const int cc = 16 * nt + fr;
                const u32x2 pu = pack4(au[nt]);
                *(LAS u32x2*)(uT + cc * LDK + r0) = pu; *(u32x2*)((bf16_t*)(p.ws + DN_UT) + (size_t)ch * 4096 + cc * 64 + r0) = pu;
                *(LAS u32x2*)(wT + cc * LDK + r0) = pack4(aw[nt]);
                *(u32x2*)((bf16_t*)(p.ws + DN_W) + (size_t)ch * 4096 + cc * 64 + r0) = pack4(awr[nt]); }
        }
        __syncthreads();
        {   f32x4 am[4], an[4];
#pragma unroll
            for (int nt = 0; nt < 4; ++nt) { am[nt] = (f32x4){0.f, 0.f, 0.f, 0.f}; an[nt] = am[nt]; }
            mm16x64(am, wT, 16 * wsg, kdT, fr, fq);
            mm16x64(an, kdT, 16 * wsg, uT, fr, fq);
            const int r0 = 16 * wsg + 4 * fq; const float egl = __expf(gl);
#pragma unroll
            for (int nt = 0; nt < 4; ++nt) { const int cc = 16 * nt + fr; f32x4 mv;
#pragma unroll
                for (int r = 0; r < 4; ++r) mv[r] = ((r0 + r) == cc ? egl : 0.f) - am[nt][r];
                *(u32x2*)((bf16_t*)(p.ws + DN_M) + (size_t)ch * 4096 + cc * 64 + r0) = pack4(mv);
                *(f32x4*)((float*)(p.ws + DN_NT) + (size_t)ch * 4096 + cc * 64 + r0) = an[nt]; }
        }
        __syncthreads();
    }
}
DI void dn_scan_item(const Params& p, int item, int lane) {
    const int bh = item >> 2, js = item & 3, fr = lane & 15, fq = lane >> 4, j = 16 * js + fr;
    f32x4 S[4];
#pragma unroll
    for (int mt = 0; mt < 4; ++mt) S[mt] = (f32x4){0.f, 0.f, 0.f, 0.f};
    const bf16_t* Mb = (const bf16_t*)(p.ws + DN_M) + (size_t)bh * 64 * 4096;
    const float* Nb = (const float*)(p.ws + DN_NT) + (size_t)bh * 64 * 4096;
    bf16_t* Sb = (bf16_t*)(p.ws + DN_ST) + (size_t)bh * 64 * 4096;
    s16x4 an[4][2][2]; f32x4 cn[4];
#pragma unroll
    for (int mt = 0; mt < 4; ++mt) { cn[mt] = *(const f32x4*)(Nb + j * 64 + 16 * mt + 4 * fq);
#pragma unroll
        for (int ks = 0; ks < 2; ++ks) { an[mt][ks][0] = *(const s16x4*)(Mb + (16 * mt + fr) * 64 + 32 * ks + 4 * fq); an[mt][ks][1] = *(const s16x4*)(Mb + (16 * mt + fr) * 64 + 32 * ks + 16 + 4 * fq); } }
    for (int n = 0; n < 64; ++n) {
        s16x4 ac[4][2][2]; f32x4 cc[4];
#pragma unroll
        for (int mt = 0; mt < 4; ++mt) { cc[mt] = cn[mt];
#pragma unroll
            for (int ks = 0; ks < 2; ++ks) { ac[mt][ks][0] = an[mt][ks][0]; ac[mt][ks][1] = an[mt][ks][1]; } }
        if (n + 1 < 63) { const bf16_t* M = Mb + (size_t)(n + 1) * 4096; const float* N = Nb + (size_t)(n + 1) * 4096;
#pragma unroll
            for (int mt = 0; mt < 4; ++mt) { cn[mt] = *(const f32x4*)(N + j * 64 + 16 * mt + 4 * fq);
#pragma unroll
                for (int ks = 0; ks < 2; ++ks) { an[mt][ks][0] = *(const s16x4*)(M + (16 * mt + fr) * 64 + 32 * ks + 4 * fq); an[mt][ks][1] = *(const s16x4*)(M + (16 * mt + fr) * 64 + 32 * ks + 16 + 4 * fq); } } }
        bf16_t* ST = Sb + (size_t)n * 4096;
#pragma unroll
        for (int mt = 0; mt < 4; ++mt) *(u32x2*)(ST + j * 64 + 16 * mt + 4 * fq) = pack4(S[mt]);
        if (n == 63) break;
        bf16x8 bfr[2];
#pragma unroll
        for (int ks = 0; ks < 2; ++ks) { u32x4 w; const u32x2 lo = pack4(S[2 * ks]), hi = pack4(S[2 * ks + 1]); w.x = lo.x; w.y = lo.y; w.z = hi.x; w.w = hi.y; bfr[ks] = __builtin_bit_cast(bf16x8, w); }
#pragma unroll
        for (int mt = 0; mt < 4; ++mt) { f32x4 a = cc[mt];
#pragma unroll
            for (int ks = 0; ks < 2; ++ks) a = MFMA16(__builtin_shufflevector(ac[mt][ks][0], ac[mt][ks][1], 0, 1, 2, 3, 4, 5, 6, 7), bfr[ks], a);
            S[mt] = a; }
    }
}
DI void dn_out_phase(const Params& p, int l, LAS unsigned char* lds, int tid, int G) {
    const int sg = tid >> 8, lane = tid & 63, js = (tid >> 6) & 3, fr = lane & 15, fq = lane >> 4, j = 16 * js + fr;
    LAS float* ssb = (LAS float*)lds + sg * 256;
    const bf16_t* P = (const bf16_t*)(p.ws + WS_P);
    bf16_t* MIX = (bf16_t*)(p.ws + WS_H);
    const float gn = p.dn_g[l * 64 + j];
    for (int it = blockIdx.x; it < 2048; it += G) {
        const int ch = 2 * it + sg, b = ch >> 8, h = (ch >> 6) & 3, n = ch & 63;
        const bf16_t* W = (const bf16_t*)(p.ws + DN_W) + (size_t)ch * 4096; const bf16_t* QG = (const bf16_t*)(p.ws + DN_QG) + (size_t)ch * 4096;
        const bf16_t* IN = (const bf16_t*)(p.ws + DN_IN) + (size_t)ch * 4096; const bf16_t* ST = (const bf16_t*)(p.ws + DN_ST) + (size_t)ch * 4096;
        const bf16_t* UT = (const bf16_t*)(p.ws + DN_UT) + (size_t)ch * 4096;
        bf16x8 bS[2];
#pragma unroll
        for (int ks = 0; ks < 2; ++ks) bS[ks] = *(const bf16x8*)(ST + j * 64 + 32 * ks + 8 * fq);
        f32x4 vn[4], o[4];
#pragma unroll
        for (int mt = 0; mt < 4; ++mt) { f32x4 tt = (f32x4){0.f, 0.f, 0.f, 0.f};
#pragma unroll
            for (int ks = 0; ks < 2; ++ks) tt = MFMA16(*(const bf16x8*)(W + (16 * mt + fr) * 64 + 32 * ks + 8 * fq), bS[ks], tt);
            const u32x2 uu = *(const u32x2*)(UT + j * 64 + 16 * mt + 4 * fq);
            vn[mt] = (f32x4){bflo(uu.x) - tt[0], bfhi(uu.x) - tt[1], bflo(uu.y) - tt[2], bfhi(uu.y) - tt[3]}; }
        bf16x8 bV[2];
#pragma unroll
        for (int ks = 0; ks < 2; ++ks) { u32x4 w; const u32x2 lo = pack4(vn[2 * ks]), hi = pack4(vn[2 * ks + 1]); w.x = lo.x; w.y = lo.y; w.z = hi.x; w.w = hi.y; bV[ks] = __builtin_bit_cast(bf16x8, w); }
#pragma unroll
        for (int mt = 0; mt < 4; ++mt) { f32x4 a = (f32x4){0.f, 0.f, 0.f, 0.f};
#pragma unroll
            for (int ks = 0; ks < 2; ++ks) a = MFMA16(*(const bf16x8*)(QG + (16 * mt + fr) * 64 + 32 * ks + 8 * fq), bS[ks], a);
#pragma unroll
            for (int ks = 0; ks < 2; ++ks) { const s16x4 lo = *(const s16x4*)(IN + (16 * mt + fr) * 64 + 32 * ks + 4 * fq), hi = *(const s16x4*)(IN + (16 * mt + fr) * 64 + 32 * ks + 16 + 4 * fq);
                a = MFMA16(__builtin_shufflevector(lo, hi, 0, 1, 2, 3, 4, 5, 6, 7), bV[ks], a); }
            o[mt] = a; }
#pragma unroll
        for (int mt = 0; mt < 4; ++mt)
#pragma unroll
            for (int r = 0; r < 4; ++r) { float q = o[mt][r] * o[mt][r]; q += __shfl_xor(q, 1); q += __shfl_xor(q, 2); q += __shfl_xor(q, 4); q += __shfl_xor(q, 8);
                if (fr == 0) ssb[js * 64 + 16 * mt + 4 * fq + r] = q; }
        __syncthreads();
#pragma unroll
        for (int mt = 0; mt < 4; ++mt)
#pragma unroll
            for (int r = 0; r < 4; ++r) { const int c = 16 * mt + 4 * fq + r; const float tot = (ssb[c] + ssb[64 + c]) + (ssb[128 + c] + ssb[192 + c]);
                const float rinv = rsqrtf(tot * (1.f / 64.f) + EPS);
                const size_t row = (size_t)b * SEQ + n * 64 + c; const int mcol = 512 + h * 64 + j;
                const float gt = bf2f(P[row * NIN + C_GATE + mcol]);
                MIX[row * DM + mcol] = (bf16_t)f2bf(o[mt][r] * rinv * gn * siluf_(gt)); }
        __syncthreads();
    }
}

typedef __attribute__((address_space(1))) unsigned gu32;
#define XB_TMO      128
#define XB_XCNT(j)  (256  + 64 * (j))
#define XB_XSUB(j)  (1280 + 64 * (j))
#define XB_XGEN(j)  (2304 + 64 * (j))
#define XB_TOP      3328
#define XB_TOPGEN   3392
#define XCD_BAR_WORDS 3456
#define XB_SPIN_CAP (1u << 18)

__device__ __forceinline__ unsigned xb_ld(unsigned* p)              { return __hip_atomic_load(p, __ATOMIC_RELAXED, __HIP_MEMORY_SCOPE_AGENT); }
__device__ __forceinline__ unsigned xb_add(unsigned* p, unsigned v) { return __hip_atomic_fetch_add(p, v, __ATOMIC_RELAXED, __HIP_MEMORY_SCOPE_AGENT); }
__device__ __forceinline__ unsigned xb_xcc_id() { return (unsigned)__builtin_amdgcn_s_getreg((3 << 11) | 20) & 0xFu; }
#define XB_SPIN(cond, bar) do { unsigned _sp = 0; while (cond) { __builtin_amdgcn_s_sleep(1); \
    if ((++_sp & 255u) == 0u) { if (xb_ld(&(bar)[XB_TMO])) break; if (_sp > XB_SPIN_CAP) { atomicAdd(&(bar)[XB_TMO], 1u); break; } } } } while (0)

struct XcdBarrier {
    unsigned* bar; unsigned x;
    volatile LAS unsigned* st;
};

__device__ __forceinline__ XcdBarrier xcd_barrier_post(unsigned* bar, volatile LAS unsigned* st) {
    XcdBarrier b; b.bar = bar; b.x = xb_xcc_id(); b.st = st;
    if (threadIdx.x == 0) (void)xb_add(&bar[XB_XCNT(b.x)], 1u);
    return b;
}
__device__ __forceinline__ void xcd_barrier_complete(unsigned* bar, unsigned x, unsigned& nloc, unsigned& nx) {
    const unsigned G = gridDim.x * gridDim.y * gridDim.z;
    unsigned sum, cnt, mine, sp = 0u;
    for (;;) {
        sum = 0u; cnt = 0u; mine = 0u;
#pragma unroll
        for (unsigned j = 0; j < 16; ++j) { const unsigned c = xb_ld(&bar[XB_XCNT(j)]); sum += c; cnt += (c > 0u) ? 1u : 0u; mine = (j == x) ? c : mine; }
        if (sum == G) break;
        __builtin_amdgcn_s_sleep(1);
        if ((++sp & 255u) == 0u) { if (xb_ld(&bar[XB_TMO])) break; if (sp > XB_SPIN_CAP) { atomicAdd(&bar[XB_TMO], 1u); break; } }
    }
    nloc = mine > 0u ? mine : 1u; nx = cnt > 0u ? cnt : 1u;
}

__device__ __forceinline__ void xcd_barrier(const XcdBarrier& b) {
    asm volatile("s_waitcnt vmcnt(0)" ::: "memory");
    __syncthreads();
    if (threadIdx.x == 0) {
        unsigned* bar = b.bar;
        __builtin_amdgcn_s_waitcnt(0);
        unsigned nloc = b.st[0], nx = b.st[1];
        if (nloc == 0u) { xcd_barrier_complete(bar, b.x, nloc, nx); b.st[0] = nloc; b.st[1] = nx; }
        const unsigned old = xb_add(&bar[XB_XSUB(b.x)], 1u);
        const unsigned gen = old / nloc;
        if (old + 1u == (gen + 1u) * nloc) {
            __builtin_amdgcn_fence(__ATOMIC_RELEASE, "agent");
            asm volatile("s_waitcnt vmcnt(0)" ::: "memory");
            const unsigned og = xb_add(&bar[XB_TOP], 1u);
            const unsigned tg = og / nx;
            if (og + 1u == (tg + 1u) * nx) xb_add(&bar[XB_TOPGEN], 1u);
            else XB_SPIN(xb_ld(&bar[XB_TOPGEN]) == tg, bar);
            __builtin_amdgcn_fence(__ATOMIC_ACQUIRE, "agent");
            xb_add(&bar[XB_XGEN(b.x)], 1u);
            asm volatile("s_waitcnt vmcnt(0)" ::: "memory");
        } else {
            XB_SPIN(xb_ld(&bar[XB_XGEN(b.x)]) == gen, bar);
            __builtin_amdgcn_fence(__ATOMIC_ACQUIRE, "agent");
            asm volatile("s_waitcnt vmcnt(0)" ::: "memory");
        }
    }
    __syncthreads();
}

enum { K_PREP = 0, K_INPROJ = 1, K_DNPREP = 2, K_ATTN = 3, K_DNOUT = 4, K_OUTPROJ = 5 };
constexpr int N_PHASES = 13;
namespace cg = cooperative_groups;
__global__ void __launch_bounds__(512, 2) mega(Params p, int ph_lo, int ph_hi) {
    extern __shared__ __attribute__((aligned(16))) unsigned char lds_raw[];
    LAS unsigned char* lds = (LAS unsigned char*)lds_raw;
    cg::grid_group grid = cg::this_grid();
    const int G = gridDim.x;
    volatile LAS unsigned* MISC = (volatile LAS unsigned*)(lds + 131072 + 320);
    if (threadIdx.x < 32) MISC[threadIdx.x] = 0u;
    __syncthreads();
    XcdBarrier bar = xcd_barrier_post((unsigned*)(p.ws + WS_CTL) + 4096, MISC + 8);
    for (int ph = ph_lo; ph < ph_hi; ++ph) {
        const int l = ph / 6, kind = ph % 6;
#define PHASE_IDS int tid = threadIdx.x; asm volatile("" : "+v"(tid)); const int lane = tid & 63, wave = __builtin_amdgcn_readfirstlane(tid >> 6); \
        const int gw = blockIdx.x * 8 + wave, ngw = G * 8; unsigned char* ws = p.ws; (void)lane; (void)wave; (void)gw; (void)ngw; (void)ws;
        if (ph == 12) { PHASE_IDS
            for (int row = gw; row < NTOK; row += ngw) final_row(p, row, lane);
        } else if (kind == K_PREP) { PHASE_IDS
            if (l == 0) { phase_init(p, lds, gw, ngw, wave, lane); __syncthreads(); }
            LAS float* w8s = (LAS float*)lds;
            for (int e = tid; e < 8 * DM; e += 512) { const int c = e & 7, kk = e >> 3; w8s[c * DM + kk] = p.w_in[(size_t)l * DM * INW + (size_t)kk * INW + 1536 + c]; }
            __syncthreads();
            if (l == 0) { for (int row = gw; row < NTOK; row += ngw) prep_row<false>(p, 0, row, lane, w8s); }
            else { for (int row = gw; row < NTOK; row += ngw) prep_row<true>(p, l, row, lane, w8s); }
            __syncthreads();
        } else if (kind == K_INPROJ) { PHASE_IDS
            { pg8::Gemm g{(const bf16_t*)(ws + WS_H), (const bf16_t*)(ws + WS_WIN) + (size_t)l * NIN * DM, NTOK, NIN, DM};
              pg8::StaticOrder S; S.init(NTOK, NIN, G, (int)blockIdx.x);
              EpiProj E{(bf16_t*)(ws + WS_P), (bf16_t*)(ws + WS_SVT)};
              pg8::gemm_phase<EpiProj, pg8::StaticOrder, true, true>(lds, g, S, E); }
            if (l == 0) {
                for (int ll = 0; ll < DEPTH; ++ll) {
                    pg8::Gemm g{(const bf16_t*)(ws + WS_MEMN) + (size_t)ll * MEMROWS * DM, (const bf16_t*)(ws + WS_WMKV) + (size_t)ll * 512 * DM, MEMROWS, 512, DM};
                    pg8::StaticOrder S; S.init(MEMROWS, 512, G, (int)((blockIdx.x + G - 32 * ll) % G));
                    EpiMkv E{(bf16_t*)(ws + WS_MK) + (size_t)ll * MEMROWS * 256, (bf16_t*)(ws + WS_MVT) + (size_t)ll * MEMROWS * 256};
                    pg8::gemm_phase<EpiMkv, pg8::StaticOrder, true, true>(lds, g, S, E);
                }
            }
        } else if (kind == K_DNPREP) { PHASE_IDS
            dn_prep_phase(p, l, lds, tid, G);
        } else if (kind == K_ATTN) { PHASE_IDS
            if (wave == 0) for (int item = blockIdx.x; item < 256; item += G) dn_scan_item(p, item, lane);
            for (int u = gw; u < N_ATTN_UNITS; u += ngw) attn_unit(p, l, u, lane);
        } else if (kind == K_DNOUT) { PHASE_IDS
            dn_out_phase(p, l, lds, tid, G);
        } else { PHASE_IDS
            pg8::Gemm g{(const bf16_t*)(ws + WS_H), (const bf16_t*)(ws + WS_WOUT) + (size_t)l * DM * DM, NTOK, DM, DM};
            pg8::StaticOrder S; S.init(NTOK, DM, G, (int)blockIdx.x);
            EpiY E{(bf16_t*)(ws + WS_P), (float*)(ws + WS_STATS)};
            pg8::gemm_phase<EpiY, pg8::StaticOrder, true, true>(lds, g, S, E);
        }
        if (ph + 1 < ph_hi) { if (ph == ph_lo) grid.sync(); else xcd_barrier(bar); }
    }
}

#ifndef MK_MULTI
#define MK_MULTI 0
#endif
extern "C" void kernel_launch(void* const* d_in, const int* in_sizes, int n_in, void* d_out, int out_size, void* d_ws, size_t ws_size, hipStream_t stream) {
    static int grid = 0;
    constexpr int LDS_BYTES = 147456;
    if (grid == 0) {
        if (n_in != 13 || ws_size < WS_END || out_size != NTOK * DM) { fprintf(stderr, "kernel_launch: unexpected n_in %d / ws_size %zu / out_size %d\n", n_in, ws_size, out_size); grid = -1; return; }
        int dev = 0, cus = 0, per_cu = 0;
        if (hipGetDevice(&dev) != hipSuccess || hipDeviceGetAttribute(&cus, hipDeviceAttributeMultiprocessorCount, dev) != hipSuccess) { grid = -1; return; }
        if (hipFuncSetAttribute((const void*)mega, hipFuncAttributeMaxDynamicSharedMemorySize, LDS_BYTES) != hipSuccess) { fprintf(stderr, "kernel_launch: hipFuncSetAttribute failed\n"); grid = -1; return; }
        if (hipOccupancyMaxActiveBlocksPerMultiprocessor(&per_cu, (const void*)mega, 512, LDS_BYTES) != hipSuccess || per_cu < 1) { fprintf(stderr, "kernel_launch: occupancy query failed (%d)\n", per_cu); grid = -1; return; }
        grid = cus * 1;
    }
    if (grid < 0) return;
    Params p{};
    p.x = (const float*)d_in[0]; p.mem = (const float*)d_in[1]; p.pre_g = (const float*)d_in[2]; p.w_in = (const float*)d_in[3]; p.conv_w = (const float*)d_in[4];
    p.a_log = (const float*)d_in[5]; p.dt_bias = (const float*)d_in[6]; p.sinks = (const float*)d_in[7]; p.dn_g = (const float*)d_in[8]; p.mem_g = (const float*)d_in[9];
    p.w_mkv = (const float*)d_in[10]; p.w_out = (const float*)d_in[11]; p.post_g = (const float*)d_in[12];
    p.out = (float*)d_out; p.ws = (unsigned char*)d_ws;
    if (hipMemsetAsync((char*)d_ws + WS_CTL, 0, 1 * MiB, stream) != hipSuccess) { fprintf(stderr, "kernel_launch: hipMemsetAsync failed\n"); return; }
#if MK_MULTI
    for (int ph = 0; ph < N_PHASES; ++ph) hipLaunchKernelGGL(mega, dim3(grid), dim3(512), LDS_BYTES, stream, p, ph, ph + 1);
#else
    int lo = 0, hi = N_PHASES;
    void* args[] = {&p, &lo, &hi};
    const hipError_t e = hipLaunchCooperativeKernel((const void*)mega, dim3(grid), dim3(512), args, LDS_BYTES, stream);
    if (e != hipSuccess) fprintf(stderr, "kernel_launch: cooperative launch failed: %s (grid %d)\n", hipGetErrorString(e), grid);
#endif
}
```

```cpp
#include <hip/hip_runtime.h>
#include <hip/hip_cooperative_groups.h>
#include <cstdio>
#include <cstdint>

#define DI __device__ __forceinline__
#ifndef MK_REP
#define MK_REP 0
#endif
#define LAS __attribute__((address_space(3)))
typedef unsigned short bf16_t;
typedef float f32x4 __attribute__((ext_vector_type(4)));
typedef unsigned u32x4 __attribute__((ext_vector_type(4)));
typedef unsigned u32x2 __attribute__((ext_vector_type(2)));

constexpr int DM = 1024, NB = 16, SEQ = 4096, NTOK = NB * SEQ, DEPTH = 2;
constexpr int INW = 2824;
constexpr int NIN = 2816;
constexpr int NMEM = 256, MEMROWS = NB * NMEM;
constexpr float EPS = 1e-6f;
constexpr int C_SQ = 0, C_SK = 512, C_SV = 640, C_DQ = 768, C_DK = 1024, C_DV = 1280, C_MQ = 1536, C_GATE = 1792;

constexpr size_t MiB = 1u << 20;
constexpr size_t WS_CTL = 0;
constexpr size_t WS_WIN = 1 * MiB;
constexpr size_t WS_WOUT = 12 * MiB;
constexpr size_t WS_WMKV = 16 * MiB;
constexpr size_t WS_W8 = 18 * MiB;
constexpr size_t WS_MEMN = 19 * MiB;
constexpr size_t WS_MK = 35 * MiB;
constexpr size_t WS_MVT = 39 * MiB;
constexpr size_t WS_BA = 43 * MiB;
constexpr size_t WS_STATS = 45 * MiB;
constexpr size_t WS_SVT = 49 * MiB;
constexpr size_t WS_H = 65 * MiB;
constexpr size_t WS_P = 193 * MiB;
constexpr size_t WS_DN = 545 * MiB;
constexpr size_t WS_END = 801 * MiB;

struct Params {
    const float *x, *mem, *pre_g, *w_in, *conv_w, *a_log, *dt_bias, *sinks, *dn_g, *mem_g, *w_mkv, *w_out, *post_g;
    float* out;
    unsigned char* ws;
};

DI unsigned f2bf(float f) { unsigned u = __float_as_uint(f); return (u + 0x7fffu + ((u >> 16) & 1u)) >> 16; }
DI unsigned pk2(float lo, float hi) { return f2bf(lo) | (f2bf(hi) << 16); }
DI float bf2f(unsigned u) { return __uint_as_float(u << 16); }
DI float bflo(unsigned u) { return __uint_as_float(u << 16); }
DI float bfhi(unsigned u) { return __uint_as_float(u & 0xffff0000u); }
DI float wave_sum(float v) {
#pragma unroll
    for (int o = 1; o < 64; o <<= 1) v += __shfl_xor(v, o);
    return v;
}
DI float sigmoidf_(float x) { return 1.f / (1.f + __expf(-x)); }
DI float siluf_(float x) { return x / (1.f + __expf(-x)); }
DI float softplusf_(float x) { return x > 20.f ? x : log1pf(expf(x)); }

DI void transpose_item(const float* W, int Nsrc, int src_n0, int k0, bf16_t* WT, int K, int dst_n0, LAS float* scr, int lane) {
#pragma unroll 8
    for (int i = 0; i < 32; ++i) { const int kk = 2 * i + (lane >> 5); scr[kk * 33 + (lane & 31)] = W[(size_t)(k0 + kk) * Nsrc + src_n0 + (lane & 31)]; }
    asm volatile("s_waitcnt lgkmcnt(0)" ::: "memory");
    const int c = lane & 7;
#pragma unroll
    for (int j = 0; j < 4; ++j) {
        const int n = (lane >> 3) + 8 * j; const LAS float* s = scr + (8 * c) * 33 + n;
        u32x4 o; o.x = pk2(s[0 * 33], s[1 * 33]); o.y = pk2(s[2 * 33], s[3 * 33]); o.z = pk2(s[4 * 33], s[5 * 33]); o.w = pk2(s[6 * 33], s[7 * 33]);
        *(u32x4*)(WT + (size_t)(dst_n0 + n) * K + k0 + 8 * c) = o;
    }
    asm volatile("s_waitcnt lgkmcnt(0)" ::: "memory");
}

DI void phase_init(const Params& p, LAS unsigned char* lds, int gw, int ngw, int wave, int lane) {
    LAS float* scr = (LAS float*)(lds + wave * 16384);
    constexpr int I_IN = 16 * (NIN / 32), I_OUT = 16 * 32, I_MKV = 16 * 16, I_L = I_IN + I_OUT + I_MKV;
    for (int it = gw; it < DEPTH * I_L; it += ngw) {
        const int l = it / I_L; int r = it % I_L;
        if (r < I_IN) {
            const int kb = r / (NIN / 32), nb = r % (NIN / 32), n0 = nb * 32;
            transpose_item(p.w_in + (size_t)l * DM * INW, INW, n0 + (n0 >= 1536 ? 8 : 0), kb * 64, (bf16_t*)(p.ws + WS_WIN) + (size_t)l * NIN * DM, DM, n0, scr, lane);
        } else if (r < I_IN + I_OUT) {
            r -= I_IN; const int kb = r / 32, nb = r % 32;
            transpose_item(p.w_out + (size_t)l * DM * DM, DM, nb * 32, kb * 64, (bf16_t*)(p.ws + WS_WOUT) + (size_t)l * DM * DM, DM, nb * 32, scr, lane);
        } else {
            r -= I_IN + I_OUT; const int kb = r / 16, nb = r % 16;
            transpose_item(p.w_mkv + (size_t)l * DM * 512, 512, nb * 32, kb * 64, (bf16_t*)(p.ws + WS_WMKV) + (size_t)l * 512 * DM, DM, nb * 32, scr, lane);
        }
    }
    for (int it = gw; it < DEPTH * MEMROWS; it += ngw) {
        const int l = it / MEMROWS, row = it % MEMROWS;
        const f32x4* xr = (const f32x4*)(p.mem + (size_t)row * DM) + lane;
        f32x4 v[4]; float s = 0.f;
#pragma unroll
        for (int j = 0; j < 4; ++j) { v[j] = xr[64 * j]; s += (v[j].x * v[j].x + v[j].y * v[j].y) + (v[j].z * v[j].z + v[j].w * v[j].w); }
        const float r = rsqrtf(wave_sum(s) * (1.f / DM) + EPS);
        const f32x4* gr = (const f32x4*)(p.mem_g + (size_t)l * DM) + lane;
        u32x2* o = (u32x2*)((bf16_t*)(p.ws + WS_MEMN) + ((size_t)l * MEMROWS + row) * DM) + lane;
#pragma unroll
        for (int j = 0; j < 4; ++j) { const f32x4 g = gr[64 * j]; u32x2 w; w.x = pk2(v[j].x * r * g.x, v[j].y * r * g.y); w.y = pk2(v[j].z * r * g.z, v[j].w * r * g.w); o[64 * j] = w; }
    }
}

template <bool L1> DI void prep_row(const Params& p, int l, int row, int lane, const LAS float* W8) {
    const f32x4* xr = (const f32x4*)(p.x + (size_t)row * DM) + lane;
    f32x4 v[4];
#pragma unroll
    for (int j = 0; j < 4; ++j) v[j] = xr[64 * j];
    if (L1) {
        const f32x4* st = (const f32x4*)((const float*)(p.ws + WS_STATS) + (size_t)row * 16);
        const f32x4 s0 = st[0], s1 = st[1], s2 = st[2], s3 = st[3];
        const float ss = ((s0.x + s0.y) + (s0.z + s0.w)) + ((s1.x + s1.y) + (s1.z + s1.w)) + ((s2.x + s2.y) + (s2.z + s2.w)) + ((s3.x + s3.y) + (s3.z + s3.w));
        const float ry = rsqrtf(ss * (1.f / DM) + EPS);
        const u32x2* yr = (const u32x2*)((const bf16_t*)(p.ws + WS_P) + (size_t)row * DM) + lane;
        const f32x4* pg = (const f32x4*)(p.post_g + (size_t)(l - 1) * DM) + lane;
        f32x4* xo = (f32x4*)(p.out + (size_t)row * DM) + lane;
#pragma unroll
        for (int j = 0; j < 4; ++j) {
            const u32x2 y = yr[64 * j]; const f32x4 g = pg[64 * j];
            v[j].x += bflo(y.x) * ry * g.x; v[j].y += bfhi(y.x) * ry * g.y; v[j].z += bflo(y.y) * ry * g.z; v[j].w += bfhi(y.y) * ry * g.w;
            xo[64 * j] = v[j];
        }
    }
    float s = 0.f;
#pragma unroll
    for (int j = 0; j < 4; ++j) s += (v[j].x * v[j].x + v[j].y * v[j].y) + (v[j].z * v[j].z + v[j].w * v[j].w);
    const float r = rsqrtf(wave_sum(s) * (1.f / DM) + EPS);
    const f32x4* gr = (const f32x4*)(p.pre_g + (size_t)l * DM) + lane;
    u32x2* ho = (u32x2*)((bf16_t*)(p.ws + WS_H) + (size_t)row * DM) + lane;
#pragma unroll
    for (int j = 0; j < 4; ++j) {
        const f32x4 g = gr[64 * j];
        v[j].x *= r * g.x; v[j].y *= r * g.y; v[j].z *= r * g.z; v[j].w *= r * g.w;
        u32x2 w; w.x = pk2(v[j].x, v[j].y); w.y = pk2(v[j].z, v[j].w); ho[64 * j] = w;
    }
    float mine = 0.f;
#pragma unroll
    for (int c = 0; c < 8; ++c) {
        const LAS f32x4* wr = (const LAS f32x4*)(W8 + c * DM) + lane; float d = 0.f;
#pragma unroll
        for (int j = 0; j < 4; ++j) { const f32x4 w = wr[64 * j]; d += (v[j].x * w.x + v[j].y * w.y) + (v[j].z * w.z + v[j].w * w.w); }
        d = wave_sum(d);
        mine = (lane == c) ? d : mine;
    }
    if (lane < 8) {
        float o;
        if (lane < 4) o = sigmoidf_(mine);
        else { const int h = lane - 4; o = -__expf(p.a_log[l * 4 + h]) * softplusf_(mine + p.dt_bias[l * 4 + h]); }
        ((float*)(p.ws + WS_BA))[(size_t)row * 8 + lane] = o;
    }
}

DI void final_row(const Params& p, int row, int lane) {
    const f32x4* st = (const f32x4*)((const float*)(p.ws + WS_STATS) + (size_t)row * 16);
    const f32x4 s0 = st[0], s1 = st[1], s2 = st[2], s3 = st[3];
    const float ss = ((s0.x + s0.y) + (s0.z + s0.w)) + ((s1.x + s1.y) + (s1.z + s1.w)) + ((s2.x + s2.y) + (s2.z + s2.w)) + ((s3.x + s3.y) + (s3.z + s3.w));
    const float ry = rsqrtf(ss * (1.f / DM) + EPS);
    const u32x2* yr = (const u32x2*)((const bf16_t*)(p.ws + WS_P) + (size_t)row * DM) + lane;
    const f32x4* pg = (const f32x4*)(p.post_g + (size_t)(DEPTH - 1) * DM) + lane;
    f32x4* xo = (f32x4*)(p.out + (size_t)row * DM) + lane;
#pragma unroll
    for (int j = 0; j < 4; ++j) {
        const u32x2 y = yr[64 * j]; const f32x4 g = pg[64 * j]; f32x4 v = xo[64 * j];
        v.x += bflo(y.x) * ry * g.x; v.y += bfhi(y.x) * ry * g.y; v.z += bflo(y.y) * ry * g.z; v.w += bfhi(y.y) * ry * g.w;
        xo[64 * j] = v;
    }
}


namespace pg8 {
#define PG8_LAS __attribute__((address_space(3)))
typedef unsigned short bf16_t;
typedef short bf16x8 __attribute__((ext_vector_type(8)));
typedef float f32x4 __attribute__((ext_vector_type(4)));
typedef unsigned u32x4 __attribute__((ext_vector_type(4)));
constexpr int BM = 256, BK = 64, HALF = 128, HTB = HALF * BK * 2  , STAGE_BYTES = 8 * HTB, NXCD = 8, WGM = 8;

__host__ __device__ __forceinline__ int lds_byte(int r, int c) { const int st = (r >> 4) * 2 + (c >> 5), rr = r & 15, cc = c & 31, ob = rr * 64 + cc * 2; return st * 1024 + (ob ^ (((ob >> 9) & 1) << 5)); }
__host__ __device__ __forceinline__ void stage_rc(int b, int& R, int& C) { const int st = b / 1024, sb = b % 1024, swz = sb ^ (((sb >> 9) & 1) << 5); R = (st >> 1) * 16 + swz / 64; C = (st & 1) * 32 + (swz % 64) / 2; }
__host__ __device__ __forceinline__ int perm32(int rho) { const int n = rho >> 4, i = rho & 15; return 8 * (i >> 2) + 4 * n + (i & 3); }

struct Unit { int pm, pn; };
struct Gemm { const bf16_t* A; const bf16_t* Bt; int M, N, K; };

struct StaticOrder {
    int nM, nN, nwg, G, c;
    __host__ __device__ void init(int M, int N, int G_, int c_) { nM = M / BM; nN = N / BM; nwg = nM * nN; G = G_; c = c_; }
    __host__ __device__ bool next(int i, Unit& u) const {
        const long L = (long)i * G + c; if (L >= nwg) return false;
        int wgid = (int)L; { const int q = nwg / NXCD, r = nwg % NXCD, xcd = wgid % NXCD, off = wgid / NXCD; wgid = (xcd < r ? xcd * (q + 1) : r * (q + 1) + (xcd - r) * q) + off; }
        const int nig = WGM * nN, gid = wgid / nig, fm = gid * WGM, gsz = (nM - fm) < WGM ? (nM - fm) : WGM;
        u.pm = fm + ((wgid % nig) % gsz); u.pn = (wgid % nig) / gsz; return true;
    }
    __device__ __forceinline__ void a_ready(const Unit&) const {}
    __device__ __forceinline__ void done(const Unit&) const {}
};

__device__ __forceinline__ unsigned cvt_pk_bf16(float lo, float hi) { unsigned r; asm volatile("v_cvt_pk_bf16_f32 %0, %1, %2" : "=v"(r) : "v"(lo), "v"(hi)); return r; }
template <class Epi, class Sched, bool ALIGN_EPI = false, bool SP2 = false>
__device__ __forceinline__ void gemm_phase(PG8_LAS unsigned char* lds, const Gemm g, const Sched& S, const Epi& E) {
    int tid = threadIdx.x; asm volatile("" : "+v"(tid));
    const int wid = __builtin_amdgcn_readfirstlane(tid >> 6), lane = tid & 63, wr = wid >> 2, wc = wid & 3, fr = lane & 15, fq = lane >> 4;
    const int K = g.K, nt = K / BK;
    unsigned voffA[2], voffB[2];
#pragma unroll
    for (int i = 0; i < 2; ++i) { int R, C; stage_rc(tid * 16 + i * 8192, R, C); const int Rb = Epi::PERM ? ((R & ~31) + perm32(R & 31)) : R;
        voffA[i] = (unsigned)(R * K + C) * 2u; voffB[i] = (unsigned)(Rb * K + C) * 2u; }
    const size_t kstep = (size_t)(BK * 2);
    const size_t hstep = (size_t)HALF * K * 2;
    const size_t tstep = 2 * hstep;
    const unsigned ldsw = (unsigned)wid * 1024u;
    const int aoff = lds_byte(wr * 64 + fr, fq * 8), boff = lds_byte(wc * 32 + fr, fq * 8);
#define PG8_SA(b, h) (((b) * 2 + (h)) * HTB)
#define PG8_SB(b, h) ((4 + (b) * 2 + (h)) * HTB)
#define PG8_STAGE(bufoff, gbase, voff) do { _Pragma("unroll") for (int _i = 0; _i < 2; ++_i) \
        __builtin_amdgcn_global_load_lds((const unsigned*)((const char*)(gbase) + (voff)[_i]), (PG8_LAS unsigned*)(lds + (bufoff) + ldsw + _i * 8192), 16, 0, 0); } while (0)
#define PG8_LDA(dst, b, h) do { _Pragma("unroll") for (int m = 0; m < 4; ++m) _Pragma("unroll") for (int k = 0; k < 2; ++k) dst[m][k] = *(const PG8_LAS bf16x8*)(lds + PG8_SA(b, h) + aoff + m * 2048 + k * 1024); } while (0)
#define PG8_LDB(dst, b, h) do { _Pragma("unroll") for (int n = 0; n < 2; ++n) _Pragma("unroll") for (int k = 0; k < 2; ++k) dst[n][k] = *(const PG8_LAS bf16x8*)(lds + PG8_SB(b, h) + boff + n * 2048 + k * 1024); } while (0)
#define PG8_MMA(ai, bj, At, Bt) do { __builtin_amdgcn_s_setprio(1); _Pragma("unroll") for (int m = 0; m < 4; ++m) _Pragma("unroll") for (int n = 0; n < 2; ++n) _Pragma("unroll") for (int k = 0; k < 2; ++k) \
        acc[ai][bj][m][n] = __builtin_amdgcn_mfma_f32_16x16x32_bf16(Bt[n][k], At[m][k], acc[ai][bj][m][n], 0, 0, 0); __builtin_amdgcn_s_setprio(0); } while (0)
#define PG8_WAIT_V(n) asm volatile("s_waitcnt vmcnt(" #n ")" ::: "memory")
#define PG8_WAIT_L(n) asm volatile("s_waitcnt lgkmcnt(" #n ")" ::: "memory")
#define PG8_BAR __builtin_amdgcn_s_barrier()
#define PG8_SCHED __builtin_amdgcn_sched_barrier(0)
    Unit cur, nxt; int ui = 0;
    if (!S.next(0, cur)) return;
    f32x4 acc[2][2][4][2];
#pragma unroll
    for (int a = 0; a < 2; ++a)
#pragma unroll
        for (int b = 0; b < 2; ++b)
#pragma unroll
            for (int m = 0; m < 4; ++m)
#pragma unroll
                for (int n = 0; n < 2; ++n) acc[a][b][m][n] = (f32x4){0.f, 0.f, 0.f, 0.f};
    bf16x8 At[4][2], B0[2][2], B1[2][2];
    const char* cA = (const char*)g.A + (size_t)cur.pm * tstep; const char* cB = (const char*)g.Bt + (size_t)cur.pn * tstep;
    S.a_ready(cur);
    if constexpr (SP2) {
        PG8_STAGE(PG8_SB(0, 0), cB, voffB); PG8_STAGE(PG8_SB(0, 1), cB + hstep, voffB); PG8_STAGE(PG8_SA(0, 0), cA, voffA); PG8_STAGE(PG8_SA(0, 1), cA + hstep, voffA);
        if (wr == 1) PG8_BAR;
        PG8_WAIT_V(2); PG8_BAR;
        PG8_STAGE(PG8_SB(1, 0), cB + kstep, voffB); PG8_STAGE(PG8_SA(1, 0), cA + kstep, voffA); PG8_STAGE(PG8_SB(1, 1), cB + hstep + kstep, voffB);
        PG8_WAIT_V(6); PG8_BAR;
    } else {
        PG8_STAGE(PG8_SB(0, 0), cB, voffB); PG8_STAGE(PG8_SA(0, 0), cA, voffA); PG8_STAGE(PG8_SB(0, 1), cB + hstep, voffB); PG8_STAGE(PG8_SA(0, 1), cA + hstep, voffA);
        if (wr == 1) PG8_BAR;
        PG8_WAIT_V(4); PG8_BAR;
        PG8_STAGE(PG8_SB(1, 0), cB + kstep, voffB); PG8_STAGE(PG8_SA(1, 0), cA + kstep, voffA); PG8_STAGE(PG8_SB(1, 1), cB + hstep + kstep, voffB);
        PG8_WAIT_V(6); PG8_BAR;
    }
    for (;;) {
        const bool has_next = S.next(ui + 1, nxt);
        const char* nA = has_next ? (const char*)g.A + (size_t)nxt.pm * tstep : cA; const char* nB = has_next ? (const char*)g.Bt + (size_t)nxt.pn * tstep : cB;
        for (int t = 0; t < nt; t += 2) {
            const bool last = (t == nt - 2);
            const char* a1 = cA + (size_t)(t + 1) * kstep;
            const char* a2 = last ? nA : cA + (size_t)(t + 2) * kstep; const char* b2 = last ? nB : cB + (size_t)(t + 2) * kstep;
            const char* a3 = a2 + kstep; const char* b3 = b2 + kstep;
            if (last && has_next) S.a_ready(nxt);
            if constexpr (SP2) {
            PG8_LDB(B0, 0, 0); PG8_LDB(B1, 0, 1); PG8_SCHED; PG8_LDA(At, 0, 0); PG8_STAGE(PG8_SA(1, 1), a1 + hstep, voffA);
            PG8_WAIT_V(8); PG8_WAIT_L(0); PG8_BAR; PG8_MMA(0, 0, At, B0); PG8_MMA(0, 1, At, B1); PG8_BAR; PG8_SCHED;
            PG8_LDA(At, 0, 1); PG8_STAGE(PG8_SB(0, 0), b2, voffB); PG8_STAGE(PG8_SB(0, 1), b2 + hstep, voffB); PG8_STAGE(PG8_SA(0, 0), a2, voffA);
            PG8_WAIT_V(8); PG8_WAIT_L(0); PG8_BAR; PG8_MMA(1, 0, At, B0); PG8_MMA(1, 1, At, B1); PG8_BAR; PG8_SCHED;
            PG8_LDB(B0, 1, 0); PG8_LDB(B1, 1, 1); PG8_SCHED; PG8_LDA(At, 1, 0); PG8_STAGE(PG8_SA(0, 1), a2 + hstep, voffA);
            PG8_WAIT_V(8); PG8_WAIT_L(0); PG8_BAR; PG8_MMA(0, 0, At, B0); PG8_MMA(0, 1, At, B1); PG8_BAR; PG8_SCHED;
            PG8_LDA(At, 1, 1); PG8_STAGE(PG8_SB(1, 0), b3, voffB); PG8_STAGE(PG8_SB(1, 1), b3 + hstep, voffB); PG8_STAGE(PG8_SA(1, 0), a3, voffA);
            PG8_WAIT_V(8); PG8_WAIT_L(0); PG8_BAR; PG8_MMA(1, 0, At, B0); PG8_MMA(1, 1, At, B1); PG8_BAR; PG8_SCHED;
            } else {
            PG8_LDB(B0, 0, 0); PG8_SCHED; PG8_LDA(At, 0, 0); PG8_STAGE(PG8_SA(1, 1), a1 + hstep, voffA);
            PG8_WAIT_L(8); PG8_BAR; PG8_WAIT_L(0); PG8_MMA(0, 0, At, B0); PG8_BAR; PG8_SCHED;
            PG8_LDB(B1, 0, 1); PG8_STAGE(PG8_SB(0, 0), b2, voffB);
            PG8_BAR; PG8_WAIT_L(0); PG8_MMA(0, 1, At, B1); PG8_BAR;
            PG8_LDA(At, 0, 1); PG8_STAGE(PG8_SA(0, 0), a2, voffA);
            PG8_BAR; PG8_WAIT_L(0); PG8_MMA(1, 0, At, B0); PG8_BAR; PG8_SCHED;
            PG8_STAGE(PG8_SB(0, 1), b2 + hstep, voffB);
            PG8_WAIT_V(6); PG8_BAR; PG8_MMA(1, 1, At, B1); PG8_BAR;
            PG8_LDB(B0, 1, 0); PG8_SCHED; PG8_LDA(At, 1, 0); PG8_STAGE(PG8_SA(0, 1), a2 + hstep, voffA);
            PG8_WAIT_L(8); PG8_BAR; PG8_WAIT_L(0); PG8_MMA(0, 0, At, B0); PG8_BAR; PG8_SCHED;
            PG8_LDB(B1, 1, 1); PG8_STAGE(PG8_SB(1, 0), b3, voffB);
            PG8_BAR; PG8_WAIT_L(0); PG8_MMA(0, 1, At, B1); PG8_BAR;
            PG8_LDA(At, 1, 1); PG8_STAGE(PG8_SA(1, 0), a3, voffA);
            PG8_BAR; PG8_WAIT_L(0); PG8_MMA(1, 0, At, B0); PG8_BAR; PG8_SCHED;
            PG8_STAGE(PG8_SB(1, 1), b3 + hstep, voffB);
            PG8_WAIT_V(6); PG8_BAR; PG8_MMA(1, 1, At, B1); PG8_BAR;
            }
        }
        if constexpr (ALIGN_EPI) { if (wr == 0) PG8_BAR; }
        if constexpr (!Epi::AFTER_DRAIN) { E(acc, cur, wr, wc, fr, fq); S.done(cur); }
        if (!has_next) break;
#pragma unroll
        for (int a = 0; a < 2; ++a)
#pragma unroll
            for (int b = 0; b < 2; ++b)
#pragma unroll
                for (int m = 0; m < 4; ++m)
#pragma unroll
                    for (int n = 0; n < 2; ++n) acc[a][b][m][n] = (f32x4){0.f, 0.f, 0.f, 0.f};
        cur = nxt; cA = nA; cB = nB; ++ui;
        if constexpr (ALIGN_EPI) { if (wr == 1) PG8_BAR; }
    }
    PG8_WAIT_V(0);
    if constexpr (!ALIGN_EPI) { if (wr == 0) PG8_BAR; }
    PG8_BAR;
    if constexpr (Epi::AFTER_DRAIN) { E.fused(acc, cur, wr, wc, fr, fq, lds, wid, lane); S.done(cur); }
#undef PG8_SA
#undef PG8_SB
#undef PG8_STAGE
#undef PG8_LDA
#undef PG8_LDB
#undef PG8_MMA
#undef PG8_WAIT_V
#undef PG8_WAIT_L
#undef PG8_BAR
#undef PG8_SCHED
}
}
using pg8::cvt_pk_bf16;
struct EpiProj {
    static constexpr bool PERM = true, AFTER_DRAIN = false;
    bf16_t* O; bf16_t* svT;
    DI void operator()(const f32x4 (&acc)[2][2][4][2], const pg8::Unit& u, int wr, int wc, int fr, int fq) const {
        const int row0 = u.pm * 256 + wr * 64 + fr, col0 = u.pn * 256 + wc * 32 + 8 * fq;
#pragma unroll
        for (int ai = 0; ai < 2; ++ai)
#pragma unroll
            for (int m = 0; m < 4; ++m) { bf16_t* rowp = O + (size_t)(row0 + ai * 128 + m * 16) * NIN + col0;
#pragma unroll
                for (int bj = 0; bj < 2; ++bj) { const f32x4 v0 = acc[ai][bj][m][0], v1 = acc[ai][bj][m][1];
                    u32x4 w; w.x = cvt_pk_bf16(v0[0], v0[1]); w.y = cvt_pk_bf16(v0[2], v0[3]); w.z = cvt_pk_bf16(v1[0], v1[1]); w.w = cvt_pk_bf16(v1[2], v1[3]);
                    *(u32x4*)(rowp + bj * 128) = w; } }
        if (u.pn == 2) {
#pragma unroll
            for (int ai = 0; ai < 2; ++ai)
#pragma unroll
                for (int m = 0; m < 4; ++m) { const int row = row0 + ai * 128 + m * 16, b = row >> 12, s = row & (SEQ - 1);
#pragma unroll
                    for (int n = 0; n < 2; ++n)
#pragma unroll
                        for (int e = 0; e < 4; ++e) { const int c = wc * 32 + 8 * fq + 4 * n + e;
                            svT[((size_t)(b * 2 + (c >> 6)) * 64 + (c & 63)) * SEQ + s] = (bf16_t)f2bf(acc[ai][1][m][n][e]); } }
        }
    }
};
struct EpiMkv {
    static constexpr bool PERM = true, AFTER_DRAIN = false;
    bf16_t* mk; bf16_t* mvT;
    DI void operator()(const f32x4 (&acc)[2][2][4][2], const pg8::Unit& u, int wr, int wc, int fr, int fq) const {
        const int row0 = u.pm * 256 + wr * 64 + fr;
#pragma unroll
        for (int ai = 0; ai < 2; ++ai)
#pragma unroll
            for (int m = 0; m < 4; ++m) { const int row = row0 + ai * 128 + m * 16;
                if (u.pn == 0) {
#pragma unroll
                    for (int bj = 0; bj < 2; ++bj) { const f32x4 v0 = acc[ai][bj][m][0], v1 = acc[ai][bj][m][1];
                        u32x4 w; w.x = cvt_pk_bf16(v0[0], v0[1]); w.y = cvt_pk_bf16(v0[2], v0[3]); w.z = cvt_pk_bf16(v1[0], v1[1]); w.w = cvt_pk_bf16(v1[2], v1[3]);
                        *(u32x4*)(mk + (size_t)row * 256 + bj * 128 + wc * 32 + 8 * fq) = w; }
                } else { const int b = row >> 8, mm = row & 255;
#pragma unroll
                    for (int bj = 0; bj < 2; ++bj)
#pragma unroll
                        for (int n = 0; n < 2; ++n)
#pragma unroll
                            for (int e = 0; e < 4; ++e) { const int c = bj * 128 + wc * 32 + 8 * fq + 4 * n + e;
                                mvT[((size_t)(b * 4 + (c >> 6)) * 64 + (c & 63)) * NMEM + mm] = (bf16_t)f2bf(acc[ai][bj][m][n][e]); } }
            }
    }
};
struct EpiY {
    static constexpr bool PERM = true, AFTER_DRAIN = false;
    bf16_t* Y; float* stats;
    DI void operator()(const f32x4 (&acc)[2][2][4][2], const pg8::Unit& u, int wr, int wc, int fr, int fq) const {
        const int row0 = u.pm * 256 + wr * 64 + fr, col0 = u.pn * 256 + wc * 32 + 8 * fq;
#pragma unroll
        for (int ai = 0; ai < 2; ++ai)
#pragma unroll
            for (int m = 0; m < 4; ++m) { const int row = row0 + ai * 128 + m * 16; bf16_t* rowp = Y + (size_t)row * DM + col0; float ss = 0.f;
#pragma unroll
                for (int bj = 0; bj < 2; ++bj) { const f32x4 v0 = acc[ai][bj][m][0], v1 = acc[ai][bj][m][1];
                    ss += (v0[0] * v0[0] + v0[1] * v0[1]) + (v0[2] * v0[2] + v0[3] * v0[3]) + (v1[0] * v1[0] + v1[1] * v1[1]) + (v1[2] * v1[2] + v1[3] * v1[3]);
                    u32x4 w; w.x = cvt_pk_bf16(v0[0], v0[1]); w.y = cvt_pk_bf16(v0[2], v0[3]); w.z = cvt_pk_bf16(v1[0], v1[1]); w.w = cvt_pk_bf16(v1[2], v1[3]);
                    *(u32x4*)(rowp + bj * 128) = w; }
                ss += __shfl_xor(ss, 16); ss += __shfl_xor(ss, 32);
                if (fq == 0) stats[(size_t)row * 16 + u.pn * 4 + wc] = ss; }
    }
};

typedef short bf16x8 __attribute__((ext_vector_type(8)));
typedef short s16x4 __attribute__((ext_vector_type(4)));
typedef float f32x16 __attribute__((ext_vector_type(16)));
typedef float f32x2_t __attribute__((ext_vector_type(2)));
typedef __bf16 bf16x2_t __attribute__((ext_vector_type(2)));
DI unsigned cvtpk(float lo, float hi) { f32x2_t v = {lo, hi}; bf16x2_t b = __builtin_convertvector(v, bf16x2_t); return __builtin_bit_cast(unsigned, b); }
#define MFMA32(a, b, c) __builtin_amdgcn_mfma_f32_32x32x16_bf16((a), (b), (c), 0, 0, 0)
#define MFMA16(a, b, c) __builtin_amdgcn_mfma_f32_16x16x32_bf16((a), (b), (c), 0, 0, 0)
constexpr int KROW = 144;
constexpr int SWA_VS = 392, MEM_VS = 520;
constexpr int SWA_IMG = 192 * KROW + 64 * SWA_VS;
constexpr int MEM_IMG = 256 * KROW + 64 * MEM_VS;
constexpr int ATT_STAGE = 2 * SWA_IMG;
static_assert(ATT_STAGE + 8 * 4608 <= 147328 && MEM_IMG <= ATT_STAGE, "attention LDS map");

DI void attn_wave(f32x16& o0, f32x16& o1, float& lsum, float m, const bf16x8 (&qf)[4], const LAS unsigned char* Kimg, const LAS unsigned char* VTimg, int vs,
                  int st0, int st1, int st_lo, int st_hi, int r, int h) {
    constexpr float SC = 0.125f * 1.4426950408889634f;
#pragma unroll
    for (int i = 0; i < 16; ++i) { o0[i] = 0.f; o1[i] = 0.f; }
    for (int st = st0; st < st1; ++st) {
        const LAS unsigned char* kp = Kimg + (32 * st + r) * KROW + 16 * h;
        bf16x8 kf[4];
#pragma unroll
        for (int ks = 0; ks < 4; ++ks) kf[ks] = *(const LAS bf16x8*)(kp + 32 * ks);
        const LAS unsigned char* vp = VTimg + r * vs + (32 * st + 4 * h) * 2;
        s16x4 va[2][2][2];
#pragma unroll
        for (int dt = 0; dt < 2; ++dt)
#pragma unroll
            for (int ss = 0; ss < 2; ++ss)
#pragma unroll
                for (int hf = 0; hf < 2; ++hf) va[dt][ss][hf] = *(const LAS s16x4*)(vp + dt * 32 * vs + (16 * ss + 8 * hf) * 2);
        f32x16 s;
#pragma unroll
        for (int i = 0; i < 16; ++i) s[i] = 0.f;
#pragma unroll
        for (int ks = 0; ks < 4; ++ks) s = MFMA32(kf[ks], qf[ks], s);
        const bool mlo = st == st_lo, mhi = st == st_hi;
        float tm = -1e30f;
#pragma unroll
        for (int i = 0; i < 16; ++i) {
            const int c = (i & 3) + 8 * (i >> 2) + 4 * h;
            float v = s[i] * SC;
            if (mlo && !(c > r)) v = -1e30f;
            if (mhi && !(c <= r)) v = -1e30f;
            s[i] = v; tm = fmaxf(tm, v);
        }
        tm = fmaxf(tm, __shfl_xor(tm, 32));
        const float mn = fmaxf(m, tm), alpha = __builtin_amdgcn_exp2f(m - mn);
        m = mn;
        float ps = 0.f;
#pragma unroll
        for (int i = 0; i < 16; ++i) { s[i] = __builtin_amdgcn_exp2f(s[i] - mn); ps += s[i]; }
        lsum = lsum * alpha + ps;
#pragma unroll
        for (int i = 0; i < 16; ++i) { o0[i] *= alpha; o1[i] *= alpha; }
#pragma unroll
        for (int ss = 0; ss < 2; ++ss) {
            u32x4 pw; pw.x = cvtpk(s[8 * ss + 0], s[8 * ss + 1]); pw.y = cvtpk(s[8 * ss + 2], s[8 * ss + 3]); pw.z = cvtpk(s[8 * ss + 4], s[8 * ss + 5]); pw.w = cvtpk(s[8 * ss + 6], s[8 * ss + 7]);
            const bf16x8 pf = __builtin_bit_cast(bf16x8, pw);
            const bf16x8 v0 = __builtin_shufflevector(va[0][ss][0], va[0][ss][1], 0, 1, 2, 3, 4, 5, 6, 7);
            const bf16x8 v1 = __builtin_shufflevector(va[1][ss][0], va[1][ss][1], 0, 1, 2, 3, 4, 5, 6, 7);
            o0 = MFMA32(v0, pf, o0); o1 = MFMA32(v1, pf, o1);
        }
    }
    lsum += __shfl_xor(lsum, 32);
}
DI void attn_store(const Params& p, const f32x16& o0, const f32x16& o1, float lsum, LAS unsigned char* stg, size_t row0, int mcol, int lane) {
    const int r = lane & 31, h = lane >> 5;
    const float inv = 1.f / lsum;
#pragma unroll
    for (int g4 = 0; g4 < 4; ++g4) {
        u32x2 w0, w1;
        w0.x = cvtpk(o0[4 * g4 + 0] * inv, o0[4 * g4 + 1] * inv); w0.y = cvtpk(o0[4 * g4 + 2] * inv, o0[4 * g4 + 3] * inv);
        w1.x = cvtpk(o1[4 * g4 + 0] * inv, o1[4 * g4 + 1] * inv); w1.y = cvtpk(o1[4 * g4 + 2] * inv, o1[4 * g4 + 3] * inv);
        *(LAS u32x2*)(stg + r * 144 + (8 * g4 + 4 * h) * 2) = w0;
        *(LAS u32x2*)(stg + r * 144 + (32 + 8 * g4 + 4 * h) * 2) = w1;
    }
    asm volatile("s_waitcnt lgkmcnt(0)" ::: "memory");
    const bf16_t* P = (const bf16_t*)(p.ws + WS_P);
    bf16_t* MIX = (bf16_t*)(p.ws + WS_H);
#pragma unroll
    for (int i = 0; i < 4; ++i) {
        const int row = 8 * i + (lane >> 3), ch = lane & 7;
        const u32x4 ov = *(const LAS u32x4*)(stg + row * 144 + 16 * ch);
        const u32x4 gv = *(const u32x4*)(P + (row0 + row) * NIN + C_GATE + mcol + 8 * ch);
        u32x4 w;
        w.x = cvtpk(bflo(ov.x) * siluf_(bflo(gv.x)), bfhi(ov.x) * siluf_(bfhi(gv.x)));
        w.y = cvtpk(bflo(ov.y) * siluf_(bflo(gv.y)), bfhi(ov.y) * siluf_(bfhi(gv.y)));
        w.z = cvtpk(bflo(ov.z) * siluf_(bflo(gv.z)), bfhi(ov.z) * siluf_(bfhi(gv.z)));
        w.w = cvtpk(bflo(ov.w) * siluf_(bflo(gv.w)), bfhi(ov.w) * siluf_(bfhi(gv.w)));
        *(u32x4*)(MIX + (row0 + row) * DM + mcol + 8 * ch) = w;
    }
    asm volatile("s_waitcnt lgkmcnt(0)" ::: "memory");
}
DI void attn_phase(const Params& p, int l, LAS unsigned char* lds, int tid, int G) {
    const int lane = tid & 63, wave = __builtin_amdgcn_readfirstlane(tid >> 6), r = lane & 31, h = lane >> 5;
    const bf16_t* P = (const bf16_t*)(p.ws + WS_P);
    LAS unsigned char* stg = lds + ATT_STAGE + wave * 4608;
    const u32x4 zero4 = (u32x4){0u, 0u, 0u, 0u};
    for (int cc = blockIdx.x; cc < 256; cc += G) {
        {
            const int bk = cc >> 3, b = bk >> 1, kvh = bk & 1, qb0 = (cc & 7) * 8;
            const int g = wave >> 1, qh = wave & 1, head = kvh * 4 + g;
            const bf16_t* Kg = P + (size_t)b * SEQ * NIN + C_SK + kvh * 64;
            const bf16_t* Vg = (const bf16_t*)(p.ws + WS_SVT) + (size_t)(b * 2 + kvh) * 64 * SEQ;
            const float sink = p.sinks[l * 8 + head] * 1.4426950408889634f;
            u32x4 kreg[3], vreg[3]; bf16x8 qf[4], qn[4];
#define SWA_ISSUE(qb_) do { const int kb0_ = 64 * (qb_) - 128; \
                _Pragma("unroll") for (int i_ = 0; i_ < 3; ++i_) { const int idx_ = tid + 512 * i_; \
                    { const int row_ = idx_ >> 3, ch_ = idx_ & 7, kr_ = kb0_ + row_; kreg[i_] = kr_ >= 0 ? *(const u32x4*)(Kg + (size_t)kr_ * NIN + 8 * ch_) : zero4; } \
                    { const int d_ = idx_ / 24, ch_ = idx_ % 24, k0_ = kb0_ + 8 * ch_; vreg[i_] = k0_ >= 0 ? *(const u32x4*)(Vg + (size_t)d_ * SEQ + k0_) : zero4; } } \
                { const bf16_t* Qp_ = P + ((size_t)b * SEQ + 64 * (qb_) + 32 * qh + r) * NIN + C_SQ + head * 64 + 8 * h; \
                  _Pragma("unroll") for (int ks_ = 0; ks_ < 4; ++ks_) qn[ks_] = *(const bf16x8*)(Qp_ + 16 * ks_); } } while (0)
#define SWA_WRITE(buf_) do { LAS unsigned char* Ki_ = lds + (buf_) * SWA_IMG; LAS unsigned char* Vi_ = Ki_ + 192 * KROW; \
                _Pragma("unroll") for (int i_ = 0; i_ < 3; ++i_) { const int idx_ = tid + 512 * i_; \
                    *(LAS u32x4*)(Ki_ + (idx_ >> 3) * KROW + 16 * (idx_ & 7)) = kreg[i_]; \
                    { LAS unsigned char* d_ = Vi_ + (idx_ / 24) * SWA_VS + 16 * (idx_ % 24); u32x2 a_, b_; a_.x = vreg[i_].x; a_.y = vreg[i_].y; b_.x = vreg[i_].z; b_.y = vreg[i_].w; \
                      *(LAS u32x2*)d_ = a_; *(LAS u32x2*)(d_ + 8) = b_; } } } while (0)
            SWA_ISSUE(qb0);
            SWA_WRITE(0);
#pragma unroll
            for (int ks = 0; ks < 4; ++ks) qf[ks] = qn[ks];
            __syncthreads();
            for (int i = 0; i < 8; ++i) {
                const int qb = qb0 + i;
                if (i < 7) SWA_ISSUE(qb + 1);
                {
                    const LAS unsigned char* Kimg = lds + (i & 1) * SWA_IMG; const LAS unsigned char* VTimg = Kimg + 192 * KROW;
                    const int first = 4 - 2 * qb, st0 = qh > first ? qh : first;
                    f32x16 o0, o1; float lsum = h == 0 ? 1.f : 0.f;
                    attn_wave(o0, o1, lsum, sink, qf, Kimg, VTimg, SWA_VS, st0, qh + 5, qh, qh + 4, r, h);
                    attn_store(p, o0, o1, lsum, stg, (size_t)b * SEQ + 64 * qb + 32 * qh, head * 64, lane);
                }
                if (i < 7) { SWA_WRITE((i + 1) & 1);
#pragma unroll
                    for (int ks = 0; ks < 4; ++ks) qf[ks] = qn[ks]; }
                __syncthreads();
            }
#undef SWA_ISSUE
#undef SWA_WRITE
        }
        {
            const int bh = cc >> 2, b = bh >> 2, hm = bh & 3, qk0 = (cc & 3) * 4;
            const bf16_t* Kg = (const bf16_t*)(p.ws + WS_MK) + (size_t)l * MEMROWS * 256 + (size_t)b * NMEM * 256 + hm * 64;
            const bf16_t* Vg = (const bf16_t*)(p.ws + WS_MVT) + (size_t)l * MEMROWS * 256 + (size_t)(b * 4 + hm) * 64 * NMEM;
            LAS unsigned char* Ki = lds; LAS unsigned char* Vi = lds + 256 * KROW;
#pragma unroll
            for (int i = 0; i < 4; ++i) { const int idx = tid + 512 * i;
                *(LAS u32x4*)(Ki + (idx >> 3) * KROW + 16 * (idx & 7)) = *(const u32x4*)(Kg + (size_t)(idx >> 3) * 256 + 8 * (idx & 7));
                const u32x4 v = *(const u32x4*)(Vg + (size_t)(idx >> 5) * NMEM + 8 * (idx & 31));
                LAS unsigned char* d = Vi + (idx >> 5) * MEM_VS + 16 * (idx & 31); u32x2 a_, b_; a_.x = v.x; a_.y = v.y; b_.x = v.z; b_.y = v.w;
                *(LAS u32x2*)d = a_; *(LAS u32x2*)(d + 8) = b_; }
            bf16x8 qf[4], qn[4];
            { const bf16_t* Qp = P + ((size_t)b * SEQ + 256 * qk0 + 32 * wave + r) * NIN + C_MQ + hm * 64 + 8 * h;
#pragma unroll
              for (int ks = 0; ks < 4; ++ks) qf[ks] = *(const bf16x8*)(Qp + 16 * ks); }
            __syncthreads();
            for (int i = 0; i < 4; ++i) {
                const int qk = qk0 + i;
                if (i < 3) { const bf16_t* Qp = P + ((size_t)b * SEQ + 256 * (qk + 1) + 32 * wave + r) * NIN + C_MQ + hm * 64 + 8 * h;
#pragma unroll
                    for (int ks = 0; ks < 4; ++ks) qn[ks] = *(const bf16x8*)(Qp + 16 * ks); }
                f32x16 o0, o1; float lsum = 0.f;
                attn_wave(o0, o1, lsum, -1e30f, qf, Ki, Vi, MEM_VS, 0, 8, -1, -1, r, h);
                attn_store(p, o0, o1, lsum, stg, (size_t)b * SEQ + 256 * qk + 32 * wave, 768 + hm * 64, lane);
                if (i < 3) {
#pragma unroll
                    for (int ks = 0; ks < 4; ++ks) qf[ks] = qn[ks]; }
            }
            __syncthreads();
        }
    }
}

constexpr size_t DN_M = WS_DN;
constexpr size_t DN_NT = WS_DN + 32 * MiB;
constexpr size_t DN_UT = WS_DN + 96 * MiB;
constexpr size_t DN_W = WS_DN + 128 * MiB;
constexpr size_t DN_QG = WS_DN + 160 * MiB;
constexpr size_t DN_IN = WS_DN + 192 * MiB;
constexpr size_t DN_ST = WS_DN + 224 * MiB;
constexpr int LDK = 72;

DI void mm16x64(f32x4 (&acc)[4], const LAS bf16_t* A, int r0, const LAS bf16_t* Bt, int fr, int fq) {
    bf16x8 a[2];
#pragma unroll
    for (int ks = 0; ks < 2; ++ks) a[ks] = *(const LAS bf16x8*)(A + (r0 + fr) * LDK + 32 * ks + 8 * fq);
#pragma unroll
    for (int nt = 0; nt < 4; ++nt)
#pragma unroll
        for (int ks = 0; ks < 2; ++ks) { const bf16x8 b = *(const LAS bf16x8*)(Bt + (16 * nt + fr) * LDK + 32 * ks + 8 * fq); acc[nt] = MFMA16(a[ks], b, acc[nt]); }
}
DI void conv16(float (&out)[16], const bf16_t* Pcol, size_t rowb, int s0, const float* cw) {
#pragma unroll
    for (int e = 0; e < 16; ++e) out[e] = 0.f;
#pragma unroll
    for (int j = 0; j < 4; ++j) {
        const int s = s0 + j;
        if (s >= 0) {
            const u32x4 x0 = *(const u32x4*)(Pcol + (rowb + s) * NIN), x1 = *(const u32x4*)(Pcol + (rowb + s) * NIN + 8);
            const f32x4 w0 = *(const f32x4*)(cw + j * 768), w1 = *(const f32x4*)(cw + j * 768 + 4), w2 = *(const f32x4*)(cw + j * 768 + 8), w3 = *(const f32x4*)(cw + j * 768 + 12);
            out[0] += w0.x * bflo(x0.x); out[1] += w0.y * bfhi(x0.x); out[2] += w0.z * bflo(x0.y); out[3] += w0.w * bfhi(x0.y);
            out[4] += w1.x * bflo(x0.z); out[5] += w1.y * bfhi(x0.z); out[6] += w1.z * bflo(x0.w); out[7] += w1.w * bfhi(x0.w);
            out[8] += w2.x * bflo(x1.x); out[9] += w2.y * bfhi(x1.x); out[10] += w2.z * bflo(x1.y); out[11] += w2.w * bfhi(x1.y);
            out[12] += w3.x * bflo(x1.z); out[13] += w3.y * bfhi(x1.z); out[14] += w3.z * bflo(x1.w); out[15] += w3.w * bfhi(x1.w);
        }
    }
#pragma unroll
    for (int e = 0; e < 16; ++e) out[e] = siluf_(out[e]);
}
DI u32x4 pack8(const float* v) { u32x4 w; w.x = cvtpk(v[0], v[1]); w.y = cvtpk(v[2], v[3]); w.z = cvtpk(v[4], v[5]); w.w = cvtpk(v[6], v[7]); return w; }
DI u32x2 pack4(const f32x4 v) { u32x2 w; w.x = cvtpk(v[0], v[1]); w.y = cvtpk(v[2], v[3]); return w; }

DI void dn_prep_phase(const Params& p, int l, LAS unsigned char* lds, int tid, int G) {
    const int sg = tid >> 8, ts = tid & 255, lane = tid & 63, wsg = (tid >> 6) & 3, fr = lane & 15, fq = lane >> 4;
    LAS unsigned char* base = lds + sg * 65536;
    LAS bf16_t* qs = (LAS bf16_t*)(base); LAS bf16_t* Tm = qs;
    LAS bf16_t* ks = (LAS bf16_t*)(base + 9216); LAS bf16_t* uT = ks;
    LAS bf16_t* kdT = (LAS bf16_t*)(base + 18432);
    LAS bf16_t* kbgT = (LAS bf16_t*)(base + 27648);
    LAS bf16_t* vbT = (LAS bf16_t*)(base + 36864);
    LAS float* Lf = (LAS float*)(base + 46080); LAS bf16_t* wT = (LAS bf16_t*)(base + 46080);
    LAS float* gcs = (LAS float*)(base + 63488); LAS float* betas = gcs + 64;
    const bf16_t* P = (const bf16_t*)(p.ws + WS_P);
    const float* BA = (const float*)(p.ws + WS_BA);
    const float* cwl = p.conv_w + (size_t)l * 4 * 768;
    const int t = ts >> 2, seg = ts & 3;
    for (int it = blockIdx.x; it < 2048; it += G) {
        const int ch = 2 * it + sg, b = ch >> 8, h = (ch >> 6) & 3, n = ch & 63;
        const size_t rowb = (size_t)b * SEQ, row = rowb + n * 64 + t; const int s0 = n * 64 + t - 3;
        float cq[16], ck[16], cv[16];
        conv16(cq, P + C_DQ + h * 64 + 16 * seg, rowb, s0, cwl + h * 64 + 16 * seg);
        conv16(ck, P + C_DK + h * 64 + 16 * seg, rowb, s0, cwl + 256 + h * 64 + 16 * seg);
        conv16(cv, P + C_DV + h * 64 + 16 * seg, rowb, s0, cwl + 512 + h * 64 + 16 * seg);
        float sq = 0.f, sk = 0.f;
#pragma unroll
        for (int e = 0; e < 16; ++e) { sq += cq[e] * cq[e]; sk += ck[e] * ck[e]; }
        sq += __shfl_xor(sq, 1); sq += __shfl_xor(sq, 2); sk += __shfl_xor(sk, 1); sk += __shfl_xor(sk, 2);
        const float rq = rsqrtf(sq + EPS) * 0.125f, rk = rsqrtf(sk + EPS);
#pragma unroll
        for (int e = 0; e < 16; ++e) { cq[e] *= rq; ck[e] *= rk; }
        const float beta = BA[row * 8 + h], g = BA[row * 8 + 4 + h];
        *(LAS u32x4*)(qs + t * LDK + 16 * seg) = pack8(cq); *(LAS u32x4*)(qs + t * LDK + 16 * seg + 8) = pack8(cq + 8);
        *(LAS u32x4*)(ks + t * LDK + 16 * seg) = pack8(ck); *(LAS u32x4*)(ks + t * LDK + 16 * seg + 8) = pack8(ck + 8);
        if (seg == 0) { gcs[t] = g; betas[t] = beta; }
        __syncthreads();
        float x = gcs[lane];
#pragma unroll
        for (int o = 1; o < 64; o <<= 1) { const float y = __shfl_up(x, o); if (lane >= o) x += y; }
        const float gc_t = __shfl(x, t), gl = __shfl(x, 63);
        __syncthreads();
        if (wsg == 0) gcs[lane] = x;
        const float eg = __expf(gc_t), ed = __expf(gl - gc_t);
#pragma unroll
        for (int e = 0; e < 16; ++e) { const int i = 16 * seg + e;
            kdT[i * LDK + t] = (bf16_t)f2bf(ck[e] * ed); kbgT[i * LDK + t] = (bf16_t)f2bf(ck[e] * beta * eg); vbT[i * LDK + t] = (bf16_t)f2bf(cv[e] * beta); }
        { float qg[16];
#pragma unroll
          for (int e = 0; e < 16; ++e) qg[e] = cq[e] * eg;
          bf16_t* dst = (bf16_t*)(p.ws + DN_QG) + (size_t)ch * 4096 + t * 64 + 16 * seg;
          *(u32x4*)dst = pack8(qg); *(u32x4*)(dst + 8) = pack8(qg + 8); }
        __syncthreads();
        {
            f32x4 acc[4], acc2[4];
#pragma unroll
            for (int nt = 0; nt < 4; ++nt) { acc[nt] = (f32x4){0.f, 0.f, 0.f, 0.f}; acc2[nt] = (f32x4){0.f, 0.f, 0.f, 0.f}; }
            mm16x64(acc, ks, 16 * wsg, ks, fr, fq);
            mm16x64(acc2, ks, 16 * wsg, qs, fr, fq);
            const int r0 = 16 * wsg + 4 * fq;
            float gr[4], br[4];
#pragma unroll
            for (int r = 0; r < 4; ++r) { gr[r] = gcs[r0 + r]; br[r] = betas[r0 + r]; }
#pragma unroll
            for (int nt = 0; nt < 4; ++nt) { const int cc = 16 * nt + fr; const float gcol = gcs[cc];
#pragma unroll
                for (int r = 0; r < 4; ++r) { const int c = r0 + r;
                    Lf[c * 68 + cc] = (cc < c) ? br[r] * acc[nt][r] * __expf(gr[r] - gcol) : 0.f; }
                f32x4 iv;
#pragma unroll
                for (int r = 0; r < 4; ++r) { const int s = r0 + r;
                    iv[r] = (s <= cc) ? acc2[nt][r] * __expf(gcol - gr[r]) : 0.f; }
                *(u32x2*)((bf16_t*)(p.ws + DN_IN) + (size_t)ch * 4096 + cc * 64 + r0) = pack4(iv); }
        }
        __syncthreads();
        if (wsg == 0) {
            float T[64];
#pragma unroll
            for (int c = 0; c < 64; ++c) T[c] = 0.f;
            const float lanef = (float)lane;
#pragma unroll
            for (int c = 0; c < 64; ++c) {
                float d = lanef; if (c > 0) asm volatile("" : "+v"(d) : "v"(T[c - 1]));
                float a0 = fmaxf(0.f, 1.f - fabsf(d - (float)c)), a1 = 0.f, a2 = 0.f, a3 = 0.f;
#pragma unroll
                for (int s4 = 0; s4 < (c + 3) / 4; ++s4) { const f32x4 Lv = *(const LAS f32x4*)(Lf + c * 68 + 4 * s4);
                    a0 -= Lv.x * T[4 * s4]; a1 -= Lv.y * T[4 * s4 + 1]; a2 -= Lv.z * T[4 * s4 + 2]; a3 -= Lv.w * T[4 * s4 + 3]; }
                T[c] = (a0 + a1) + (a2 + a3);
            }
#pragma unroll
            for (int c = 0; c < 64; ++c) Tm[c * LDK + lane] = (bf16_t)f2bf(T[c]);
        }
        __syncthreads();
        {   f32x4 au[4], aw[4], awr[4];
#pragma unroll
            for (int nt = 0; nt < 4; ++nt) { au[nt] = (f32x4){0.f, 0.f, 0.f, 0.f}; aw[nt] = au[nt]; awr[nt] = au[nt]; }
            mm16x64(au, Tm, 16 * wsg, vbT, fr, fq);
            mm16x64(aw, Tm, 16 * wsg, kbgT, fr, fq);
            mm16x64(awr, kbgT, 16 * wsg, Tm, fr, fq);
            const int r0 = 16 * wsg + 4 * fq;
#pragma unroll
            for (int nt = 0; nt < 4; ++nt) { const int cc = 16 * nt + fr;
                const u32x2 pu = pack4(au[nt]);
                *(LAS u32x2*)(uT + cc * LDK + r0) = pu; *(u32x2*)((bf16_t*)(p.ws + DN_UT) + (size_t)ch * 4096 + cc * 64 + r0) = pu;
                *(LAS u32x2*)(wT + cc * LDK + r0) = pack4(aw[nt]);
                *(u32x2*)((bf16_t*)(p.ws + DN_W) + (size_t)ch * 4096 + cc * 64 + r0) = pack4(awr[nt]); }
        }
        __syncthreads();
        {   f32x4 am[4], an[4];
#pragma unroll
            for (int nt = 0; nt < 4; ++nt) { am[nt] = (f32x4){0.f, 0.f, 0.f, 0.f}; an[nt] = am[nt]; }
            mm16x64(am, wT, 16 * wsg, kdT, fr, fq);
            mm16x64(an, kdT, 16 * wsg, uT, fr, fq);
            const int r0 = 16 * wsg + 4 * fq; const float egl = __expf(gl);
#pragma unroll
            for (int nt = 0; nt < 4; ++nt) { const int cc = 16 * nt + fr; f32x4 mv;
#pragma unroll
                for (int r = 0; r < 4; ++r) mv[r] = ((r0 + r) == cc ? egl : 0.f) - am[nt][r];
                *(u32x2*)((bf16_t*)(p.ws + DN_M) + (size_t)ch * 4096 + cc * 64 + r0) = pack4(mv);
                *(f32x4*)((float*)(p.ws + DN_NT) + (size_t)ch * 4096 + cc * 64 + r0) = an[nt]; }
        }
        __syncthreads();
    }
}
DI void dn_scan_item(const Params& p, int item, int lane) {
    const int bh = item >> 2, js = item & 3, fr = lane & 15, fq = lane >> 4, j = 16 * js + fr;
    f32x4 S[4];
#pragma unroll
    for (int mt = 0; mt < 4; ++mt) S[mt] = (f32x4){0.f, 0.f, 0.f, 0.f};
    const bf16_t* Mb = (const bf16_t*)(p.ws + DN_M) + (size_t)bh * 64 * 4096;
    const float* Nb = (const float*)(p.ws + DN_NT) + (size_t)bh * 64 * 4096;
    bf16_t* Sb = (bf16_t*)(p.ws + DN_ST) + (size_t)bh * 64 * 4096;
    s16x4 an[4][2][2]; f32x4 cn[4];
#pragma unroll
    for (int mt = 0; mt < 4; ++mt) { cn[mt] = *(const f32x4*)(Nb + j * 64 + 16 * mt + 4 * fq);
#pragma unroll
        for (int ks = 0; ks < 2; ++ks) { an[mt][ks][0] = *(const s16x4*)(Mb + (16 * mt + fr) * 64 + 32 * ks + 4 * fq); an[mt][ks][1] = *(const s16x4*)(Mb + (16 * mt + fr) * 64 + 32 * ks + 16 + 4 * fq); } }
    for (int n = 0; n < 64; ++n) {
        s16x4 ac[4][2][2]; f32x4 cc[4];
#pragma unroll
        for (int mt = 0; mt < 4; ++mt) { cc[mt] = cn[mt];
#pragma unroll
            for (int ks = 0; ks < 2; ++ks) { ac[mt][ks][0] = an[mt][ks][0]; ac[mt][ks][1] = an[mt][ks][1]; } }
        if (n + 1 < 63) { const bf16_t* M = Mb + (size_t)(n + 1) * 4096; const float* N = Nb + (size_t)(n + 1) * 4096;
#pragma unroll
            for (int mt = 0; mt < 4; ++mt) { cn[mt] = *(const f32x4*)(N + j * 64 + 16 * mt + 4 * fq);
#pragma unroll
                for (int ks = 0; ks < 2; ++ks) { an[mt][ks][0] = *(const s16x4*)(M + (16 * mt + fr) * 64 + 32 * ks + 4 * fq); an[mt][ks][1] = *(const s16x4*)(M + (16 * mt + fr) * 64 + 32 * ks + 16 + 4 * fq); } } }
        bf16_t* ST = Sb + (size_t)n * 4096;
#pragma unroll
        for (int mt = 0; mt < 4; ++mt) *(u32x2*)(ST + j * 64 + 16 * mt + 4 * fq) = pack4(S[mt]);
        if (n == 63) break;
        bf16x8 bfr[2];
#pragma unroll
        for (int ks = 0; ks < 2; ++ks) { u32x4 w; const u32x2 lo = pack4(S[2 * ks]), hi = pack4(S[2 * ks + 1]); w.x = lo.x; w.y = lo.y; w.z = hi.x; w.w = hi.y; bfr[ks] = __builtin_bit_cast(bf16x8, w); }
#pragma unroll
        for (int mt = 0; mt < 4; ++mt) { f32x4 a = cc[mt];
#pragma unroll
            for (int ks = 0; ks < 2; ++ks) a = MFMA16(__builtin_shufflevector(ac[mt][ks][0], ac[mt][ks][1], 0, 1, 2, 3, 4, 5, 6, 7), bfr[ks], a);
            S[mt] = a; }
    }
}
DI void dn_out_phase(const Params& p, int l, LAS unsigned char* lds, int tid, int G) {
    const int sg = tid >> 8, lane = tid & 63, js = (tid >> 6) & 3, fr = lane & 15, fq = lane >> 4, j = 16 * js + fr;
    LAS float* ssb = (LAS float*)lds + sg * 256;
    const bf16_t* P = (const bf16_t*)(p.ws + WS_P);
    bf16_t* MIX = (bf16_t*)(p.ws + WS_H);
    const float gn = p.dn_g[l * 64 + j];
    for (int it = blockIdx.x; it < 2048; it += G) {
        const int ch = 2 * it + sg, b = ch >> 8, h = (ch >> 6) & 3, n = ch & 63;
        const bf16_t* W = (const bf16_t*)(p.ws + DN_W) + (size_t)ch * 4096; const bf16_t* QG = (const bf16_t*)(p.ws + DN_QG) + (size_t)ch * 4096;
        const bf16_t* IN = (const bf16_t*)(p.ws + DN_IN) + (size_t)ch * 4096; const bf16_t* ST = (const bf16_t*)(p.ws + DN_ST) + (size_t)ch * 4096;
        const bf16_t* UT = (const bf16_t*)(p.ws + DN_UT) + (size_t)ch * 4096;
        bf16x8 bS[2];
#pragma unroll
        for (int ks = 0; ks < 2; ++ks) bS[ks] = *(const bf16x8*)(ST + j * 64 + 32 * ks + 8 * fq);
        f32x4 vn[4], o[4];
#pragma unroll
        for (int mt = 0; mt < 4; ++mt) { f32x4 tt = (f32x4){0.f, 0.f, 0.f, 0.f};
#pragma unroll
            for (int ks = 0; ks < 2; ++ks) tt = MFMA16(*(const bf16x8*)(W + (16 * mt + fr) * 64 + 32 * ks + 8 * fq), bS[ks], tt);
            const u32x2 uu = *(const u32x2*)(UT + j * 64 + 16 * mt + 4 * fq);
            vn[mt] = (f32x4){bflo(uu.x) - tt[0], bfhi(uu.x) - tt[1], bflo(uu.y) - tt[2], bfhi(uu.y) - tt[3]}; }
        bf16x8 bV[2];
#pragma unroll
        for (int ks = 0; ks < 2; ++ks) { u32x4 w; const u32x2 lo = pack4(vn[2 * ks]), hi = pack4(vn[2 * ks + 1]); w.x = lo.x; w.y = lo.y; w.z = hi.x; w.w = hi.y; bV[ks] = __builtin_bit_cast(bf16x8, w); }
#pragma unroll
        for (int mt = 0; mt < 4; ++mt) { f32x4 a = (f32x4){0.f, 0.f, 0.f, 0.f};
#pragma unroll
            for (int ks = 0; ks < 2; ++ks) a = MFMA16(*(const bf16x8*)(QG + (16 * mt + fr) * 64 + 32 * ks + 8 * fq), bS[ks], a);
#pragma unroll
            for (int ks = 0; ks < 2; ++ks) { const s16x4 lo = *(const s16x4*)(IN + (16 * mt + fr) * 64 + 32 * ks + 4 * fq), hi = *(const s16x4*)(IN + (16 * mt + fr) * 64 + 32 * ks + 16 + 4 * fq);
                a = MFMA16(__builtin_shufflevector(lo, hi, 0, 1, 2, 3, 4, 5, 6, 7), bV[ks], a); }
            o[mt] = a; }
#pragma unroll
        for (int mt = 0; mt < 4; ++mt)
#pragma unroll
            for (int r = 0; r < 4; ++r) { float q = o[mt][r] * o[mt][r]; q += __shfl_xor(q, 1); q += __shfl_xor(q, 2); q += __shfl_xor(q, 4); q += __shfl_xor(q, 8);
                if (fr == 0) ssb[js * 64 + 16 * mt + 4 * fq + r] = q; }
        __syncthreads();
#pragma unroll
        for (int mt = 0; mt < 4; ++mt)
#pragma unroll
            for (int r = 0; r < 4; ++r) { const int c = 16 * mt + 4 * fq + r; const float tot = (ssb[c] + ssb[64 + c]) + (ssb[128 + c] + ssb[192 + c]);
                const float rinv = rsqrtf(tot * (1.f / 64.f) + EPS);
                const size_t row = (size_t)b * SEQ + n * 64 + c; const int mcol = 512 + h * 64 + j;
                const float gt = bf2f(P[row * NIN + C_GATE + mcol]);
                MIX[row * DM + mcol] = (bf16_t)f2bf(o[mt][r] * rinv * gn * siluf_(gt)); }
        __syncthreads();
    }
}

typedef __attribute__((address_space(1))) unsigned gu32;
#define XB_TMO      128
#define XB_XCNT(j)  (256  + 64 * (j))
#define XB_XSUB(j)  (1280 + 64 * (j))
#define XB_XGEN(j)  (2304 + 64 * (j))
#define XB_TOP      3328
#define XB_TOPGEN   3392
#define XCD_BAR_WORDS 3456
#define XB_SPIN_CAP (1u << 18)

__device__ __forceinline__ unsigned xb_ld(unsigned* p)              { return __hip_atomic_load(p, __ATOMIC_RELAXED, __HIP_MEMORY_SCOPE_AGENT); }
__device__ __forceinline__ unsigned xb_add(unsigned* p, unsigned v) { return __hip_atomic_fetch_add(p, v, __ATOMIC_RELAXED, __HIP_MEMORY_SCOPE_AGENT); }
__device__ __forceinline__ unsigned xb_xcc_id() { return (unsigned)__builtin_amdgcn_s_getreg((3 << 11) | 20) & 0xFu; }
#define XB_SPIN(cond, bar) do { unsigned _sp = 0; while (cond) { __builtin_amdgcn_s_sleep(1); \
    if ((++_sp & 255u) == 0u) { if (xb_ld(&(bar)[XB_TMO])) break; if (_sp > XB_SPIN_CAP) { atomicAdd(&(bar)[XB_TMO], 1u); break; } } } } while (0)

struct XcdBarrier {
    unsigned* bar; unsigned x;
    volatile LAS unsigned* st;
};

__device__ __forceinline__ XcdBarrier xcd_barrier_post(unsigned* bar, volatile LAS unsigned* st) {
    XcdBarrier b; b.bar = bar; b.x = xb_xcc_id(); b.st = st;
    if (threadIdx.x == 0) (void)xb_add(&bar[XB_XCNT(b.x)], 1u);
    return b;
}
__device__ __forceinline__ void xcd_barrier_complete(unsigned* bar, unsigned x, unsigned& nloc, unsigned& nx) {
    const unsigned G = gridDim.x * gridDim.y * gridDim.z;
    unsigned sum, cnt, mine, sp = 0u;
    for (;;) {
        sum = 0u; cnt = 0u; mine = 0u;
#pragma unroll
        for (unsigned j = 0; j < 16; ++j) { const unsigned c = xb_ld(&bar[XB_XCNT(j)]); sum += c; cnt += (c > 0u) ? 1u : 0u; mine = (j == x) ? c : mine; }
        if (sum == G) break;
        __builtin_amdgcn_s_sleep(1);
        if ((++sp & 255u) == 0u) { if (xb_ld(&bar[XB_TMO])) break; if (sp > XB_SPIN_CAP) { atomicAdd(&bar[XB_TMO], 1u); break; } }
    }
    nloc = mine > 0u ? mine : 1u; nx = cnt > 0u ? cnt : 1u;
}

__device__ __forceinline__ void xcd_barrier(const XcdBarrier& b) {
    asm volatile("s_waitcnt vmcnt(0)" ::: "memory");
    __syncthreads();
    if (threadIdx.x == 0) {
        unsigned* bar = b.bar;
        __builtin_amdgcn_s_waitcnt(0);
        unsigned nloc = b.st[0], nx = b.st[1];
        if (nloc == 0u) { xcd_barrier_complete(bar, b.x, nloc, nx); b.st[0] = nloc; b.st[1] = nx; }
        const unsigned old = xb_add(&bar[XB_XSUB(b.x)], 1u);
        const unsigned gen = old / nloc;
        if (old + 1u == (gen + 1u) * nloc) {
            __builtin_amdgcn_fence(__ATOMIC_RELEASE, "agent");
            asm volatile("s_waitcnt vmcnt(0)" ::: "memory");
            const unsigned og = xb_add(&bar[XB_TOP], 1u);
            const unsigned tg = og / nx;
            if (og + 1u == (tg + 1u) * nx) xb_add(&bar[XB_TOPGEN], 1u);
            else XB_SPIN(xb_ld(&bar[XB_TOPGEN]) == tg, bar);
            __builtin_amdgcn_fence(__ATOMIC_ACQUIRE, "agent");
            xb_add(&bar[XB_XGEN(b.x)], 1u);
            asm volatile("s_waitcnt vmcnt(0)" ::: "memory");
        } else {
            XB_SPIN(xb_ld(&bar[XB_XGEN(b.x)]) == gen, bar);
            __builtin_amdgcn_fence(__ATOMIC_ACQUIRE, "agent");
            asm volatile("s_waitcnt vmcnt(0)" ::: "memory");
        }
    }
    __syncthreads();
}

enum { K_PREP = 0, K_INPROJ = 1, K_DNPREP = 2, K_ATTN = 3, K_DNOUT = 4, K_OUTPROJ = 5 };
constexpr int N_PHASES = 13;
namespace cg = cooperative_groups;
__global__ void __launch_bounds__(512, 2) mega(Params p, int ph_lo, int ph_hi) {
    extern __shared__ __attribute__((aligned(16))) unsigned char lds_raw[];
    LAS unsigned char* lds = (LAS unsigned char*)lds_raw;
    cg::grid_group grid = cg::this_grid();
    const int G = gridDim.x;
    volatile LAS unsigned* MISC = (volatile LAS unsigned*)(lds + 147328);
    if (threadIdx.x < 32) MISC[threadIdx.x] = 0u;
    __syncthreads();
    XcdBarrier bar = xcd_barrier_post((unsigned*)(p.ws + WS_CTL) + 4096, MISC + 8);
    for (int ph = ph_lo; ph < ph_hi; ++ph) {
        const int l = ph / 6, kind = ph % 6;
        const int nrep = (ph != 12 && ((MK_REP >> kind) & 1)) ? 2 : 1;
        for (int rep = 0; rep < nrep; ++rep) {
#define PHASE_IDS int tid = threadIdx.x; asm volatile("" : "+v"(tid)); const int lane = tid & 63, wave = __builtin_amdgcn_readfirstlane(tid >> 6); \
        const int gw = blockIdx.x * 8 + wave, ngw = G * 8; unsigned char* ws = p.ws; (void)lane; (void)wave; (void)gw; (void)ngw; (void)ws;
        if (ph == 12) { PHASE_IDS
            for (int row = gw; row < NTOK; row += ngw) final_row(p, row, lane);
        } else if (kind == K_PREP) { PHASE_IDS
            if (l == 0) { phase_init(p, lds, gw, ngw, wave, lane); __syncthreads(); }
            LAS float* w8s = (LAS float*)lds;
            for (int e = tid; e < 8 * DM; e += 512) { const int c = e & 7, kk = e >> 3; w8s[c * DM + kk] = p.w_in[(size_t)l * DM * INW + (size_t)kk * INW + 1536 + c]; }
            __syncthreads();
            if (l == 0) { for (int row = gw; row < NTOK; row += ngw) prep_row<false>(p, 0, row, lane, w8s); }
            else { for (int row = gw; row < NTOK; row += ngw) prep_row<true>(p, l, row, lane, w8s); }
            __syncthreads();
        } else if (kind == K_INPROJ) { PHASE_IDS
            { pg8::Gemm g{(const bf16_t*)(ws + WS_H), (const bf16_t*)(ws + WS_WIN) + (size_t)l * NIN * DM, NTOK, NIN, DM};
              pg8::StaticOrder S; S.init(NTOK, NIN, G, (int)blockIdx.x);
              EpiProj E{(bf16_t*)(ws + WS_P), (bf16_t*)(ws + WS_SVT)};
              pg8::gemm_phase<EpiProj, pg8::StaticOrder, true, true>(lds, g, S, E); }
            if (l == 0) {
                for (int ll = 0; ll < DEPTH; ++ll) {
                    pg8::Gemm g{(const bf16_t*)(ws + WS_MEMN) + (size_t)ll * MEMROWS * DM, (const bf16_t*)(ws + WS_WMKV) + (size_t)ll * 512 * DM, MEMROWS, 512, DM};
                    pg8::StaticOrder S; S.init(MEMROWS, 512, G, (int)((blockIdx.x + G - 32 * ll) % G));
                    EpiMkv E{(bf16_t*)(ws + WS_MK) + (size_t)ll * MEMROWS * 256, (bf16_t*)(ws + WS_MVT) + (size_t)ll * MEMROWS * 256};
                    pg8::gemm_phase<EpiMkv, pg8::StaticOrder, true, true>(lds, g, S, E);
                }
            }
        } else if (kind == K_DNPREP) { PHASE_IDS
            dn_prep_phase(p, l, lds, tid, G);
        } else if (kind == K_ATTN) { PHASE_IDS
            if (wave == 0) for (int item = blockIdx.x; item < 256; item += G) dn_scan_item(p, item, lane);
            attn_phase(p, l, lds, tid, G);
        } else if (kind == K_DNOUT) { PHASE_IDS
            dn_out_phase(p, l, lds, tid, G);
        } else { PHASE_IDS
            pg8::Gemm g{(const bf16_t*)(ws + WS_H), (const bf16_t*)(ws + WS_WOUT) + (size_t)l * DM * DM, NTOK, DM, DM};
            pg8::StaticOrder S; S.init(NTOK, DM, G, (int)blockIdx.x);
            EpiY E{(bf16_t*)(ws + WS_P), (float*)(ws + WS_STATS)};
            pg8::gemm_phase<EpiY, pg8::StaticOrder, true, true>(lds, g, S, E);
        }
        if (rep + 1 < nrep) __syncthreads();
        }
        if (ph + 1 < ph_hi) { if (ph == ph_lo) grid.sync(); else xcd_barrier(bar); }
    }
}

#ifndef MK_MULTI
#define MK_MULTI 0
#endif
extern "C" void kernel_launch(void* const* d_in, const int* in_sizes, int n_in, void* d_out, int out_size, void* d_ws, size_t ws_size, hipStream_t stream) {
    static int grid = 0;
    constexpr int LDS_BYTES = 147456;
    if (grid == 0) {
        if (n_in != 13 || ws_size < WS_END || out_size != NTOK * DM) { fprintf(stderr, "kernel_launch: unexpected n_in %d / ws_size %zu / out_size %d\n", n_in, ws_size, out_size); grid = -1; return; }
        int dev = 0, cus = 0, per_cu = 0;
        if (hipGetDevice(&dev) != hipSuccess || hipDeviceGetAttribute(&cus, hipDeviceAttributeMultiprocessorCount, dev) != hipSuccess) { grid = -1; return; }
        if (hipFuncSetAttribute((const void*)mega, hipFuncAttributeMaxDynamicSharedMemorySize, LDS_BYTES) != hipSuccess) { fprintf(stderr, "kernel_launch: hipFuncSetAttribute failed\n"); grid = -1; return; }
        if (hipOccupancyMaxActiveBlocksPerMultiprocessor(&per_cu, (const void*)mega, 512, LDS_BYTES) != hipSuccess || per_cu < 1) { fprintf(stderr, "kernel_launch: occupancy query failed (%d)\n", per_cu); grid = -1; return; }
        grid = cus * 1;
    }
    if (grid < 0) return;
    Params p{};
    p.x = (const float*)d_in[0]; p.mem = (const float*)d_in[1]; p.pre_g = (const float*)d_in[2]; p.w_in = (const float*)d_in[3]; p.conv_w = (const float*)d_in[4];
    p.a_log = (const float*)d_in[5]; p.dt_bias = (const float*)d_in[6]; p.sinks = (const float*)d_in[7]; p.dn_g = (const float*)d_in[8]; p.mem_g = (const float*)d_in[9];
    p.w_mkv = (const float*)d_in[10]; p.w_out = (const float*)d_in[11]; p.post_g = (const float*)d_in[12];
    p.out = (float*)d_out; p.ws = (unsigned char*)d_ws;
    if (hipMemsetAsync((char*)d_ws + WS_CTL, 0, 1 * MiB, stream) != hipSuccess) { fprintf(stderr, "kernel_launch: hipMemsetAsync failed\n"); return; }
#if MK_MULTI
    for (int ph = 0; ph < N_PHASES; ++ph) hipLaunchKernelGGL(mega, dim3(grid), dim3(512), LDS_BYTES, stream, p, ph, ph + 1);
#else
    int lo = 0, hi = N_PHASES;
    void* args[] = {&p, &lo, &hi};
    const hipError_t e = hipLaunchCooperativeKernel((const void*)mega, dim3(grid), dim3(512), args, LDS_BYTES, stream);
    if (e != hipSuccess) fprintf(stderr, "kernel_launch: cooperative launch failed: %s (grid %d)\n", hipGetErrorString(e), grid);
#endif
}
```

```cpp
#include <hip/hip_runtime.h>
#include <hip/hip_cooperative_groups.h>
#include <cstdio>
#include <cstdint>

#define DI __device__ __forceinline__
#ifndef MK_REP
#define MK_REP 0
#endif
#define LAS __attribute__((address_space(3)))
typedef unsigned short bf16_t;
typedef float f32x4 __attribute__((ext_vector_type(4)));
typedef unsigned u32x4 __attribute__((ext_vector_type(4)));
typedef unsigned u32x2 __attribute__((ext_vector_type(2)));

constexpr int DM = 1024, NB = 16, SEQ = 4096, NTOK = NB * SEQ, DEPTH = 2;
constexpr int INW = 2824;
constexpr int NIN = 2816;
constexpr int NMEM = 256, MEMROWS = NB * NMEM;
constexpr float EPS = 1e-6f;
constexpr int C_SQ = 0, C_SK = 512, C_SV = 640, C_DQ = 768, C_DK = 1024, C_DV = 1280, C_MQ = 1536, C_GATE = 1792;

constexpr size_t MiB = 1u << 20;
constexpr size_t WS_CTL = 0;
constexpr size_t WS_WIN = 1 * MiB;
constexpr size_t WS_WOUT = 12 * MiB;
constexpr size_t WS_WMKV = 16 * MiB;
constexpr size_t WS_W8 = 18 * MiB;
constexpr size_t WS_MEMN = 19 * MiB;
constexpr size_t WS_MK = 35 * MiB;
constexpr size_t WS_MVT = 39 * MiB;
constexpr size_t WS_BA = 43 * MiB;
constexpr size_t WS_STATS = 45 * MiB;
constexpr size_t WS_SVT = 49 * MiB;
constexpr size_t WS_H = 65 * MiB;
constexpr size_t WS_P = 193 * MiB;
constexpr size_t WS_DN = 545 * MiB;
constexpr size_t WS_END = 801 * MiB;

struct Params {
    const float *x, *mem, *pre_g, *w_in, *conv_w, *a_log, *dt_bias, *sinks, *dn_g, *mem_g, *w_mkv, *w_out, *post_g;
    float* out;
    unsigned char* ws;
};

DI unsigned f2bf(float f) { unsigned u = __float_as_uint(f); return (u + 0x7fffu + ((u >> 16) & 1u)) >> 16; }
DI unsigned pk2(float lo, float hi) { return f2bf(lo) | (f2bf(hi) << 16); }
DI float bf2f(unsigned u) { return __uint_as_float(u << 16); }
DI float bflo(unsigned u) { return __uint_as_float(u << 16); }
DI float bfhi(unsigned u) { return __uint_as_float(u & 0xffff0000u); }
DI float wave_sum(float v) {
#pragma unroll
    for (int o = 1; o < 64; o <<= 1) v += __shfl_xor(v, o);
    return v;
}
DI float sigmoidf_(float x) { return __builtin_amdgcn_rcpf(1.f + __builtin_amdgcn_exp2f(-1.4426950408889634f * x)); }
DI float siluf_(float x) { return x * __builtin_amdgcn_rcpf(1.f + __builtin_amdgcn_exp2f(-1.4426950408889634f * x)); }
DI float softplusf_(float x) { return x > 20.f ? x : log1pf(expf(x)); }

DI void transpose_item(const float* W, int Nsrc, int src_n0, int k0, bf16_t* WT, int K, int dst_n0, LAS float* scr, int lane) {
#pragma unroll 8
    for (int i = 0; i < 32; ++i) { const int kk = 2 * i + (lane >> 5); scr[kk * 33 + (lane & 31)] = W[(size_t)(k0 + kk) * Nsrc + src_n0 + (lane & 31)]; }
    asm volatile("s_waitcnt lgkmcnt(0)" ::: "memory");
    const int c = lane & 7;
#pragma unroll
    for (int j = 0; j < 4; ++j) {
        const int n = (lane >> 3) + 8 * j; const LAS float* s = scr + (8 * c) * 33 + n;
        u32x4 o; o.x = pk2(s[0 * 33], s[1 * 33]); o.y = pk2(s[2 * 33], s[3 * 33]); o.z = pk2(s[4 * 33], s[5 * 33]); o.w = pk2(s[6 * 33], s[7 * 33]);
        *(u32x4*)(WT + (size_t)(dst_n0 + n) * K + k0 + 8 * c) = o;
    }
    asm volatile("s_waitcnt lgkmcnt(0)" ::: "memory");
}

DI void phase_init(const Params& p, LAS unsigned char* lds, int gw, int ngw, int wave, int lane) {
    LAS float* scr = (LAS float*)(lds + wave * 16384);
    constexpr int I_IN = 16 * (NIN / 32), I_OUT = 16 * 32, I_MKV = 16 * 16, I_L = I_IN + I_OUT + I_MKV;
    for (int it = gw; it < DEPTH * I_L; it += ngw) {
        const int l = it / I_L; int r = it % I_L;
        if (r < I_IN) {
            const int kb = r / (NIN / 32), nb = r % (NIN / 32), n0 = nb * 32;
            transpose_item(p.w_in + (size_t)l * DM * INW, INW, n0 + (n0 >= 1536 ? 8 : 0), kb * 64, (bf16_t*)(p.ws + WS_WIN) + (size_t)l * NIN * DM, DM, n0, scr, lane);
        } else if (r < I_IN + I_OUT) {
            r -= I_IN; const int kb = r / 32, nb = r % 32;
            transpose_item(p.w_out + (size_t)l * DM * DM, DM, nb * 32, kb * 64, (bf16_t*)(p.ws + WS_WOUT) + (size_t)l * DM * DM, DM, nb * 32, scr, lane);
        } else {
            r -= I_IN + I_OUT; const int kb = r / 16, nb = r % 16;
            transpose_item(p.w_mkv + (size_t)l * DM * 512, 512, nb * 32, kb * 64, (bf16_t*)(p.ws + WS_WMKV) + (size_t)l * 512 * DM, DM, nb * 32, scr, lane);
        }
    }
    for (int it = gw; it < DEPTH * MEMROWS; it += ngw) {
        const int l = it / MEMROWS, row = it % MEMROWS;
        const f32x4* xr = (const f32x4*)(p.mem + (size_t)row * DM) + lane;
        f32x4 v[4]; float s = 0.f;
#pragma unroll
        for (int j = 0; j < 4; ++j) { v[j] = xr[64 * j]; s += (v[j].x * v[j].x + v[j].y * v[j].y) + (v[j].z * v[j].z + v[j].w * v[j].w); }
        const float r = rsqrtf(wave_sum(s) * (1.f / DM) + EPS);
        const f32x4* gr = (const f32x4*)(p.mem_g + (size_t)l * DM) + lane;
        u32x2* o = (u32x2*)((bf16_t*)(p.ws + WS_MEMN) + ((size_t)l * MEMROWS + row) * DM) + lane;
#pragma unroll
        for (int j = 0; j < 4; ++j) { const f32x4 g = gr[64 * j]; u32x2 w; w.x = pk2(v[j].x * r * g.x, v[j].y * r * g.y); w.y = pk2(v[j].z * r * g.z, v[j].w * r * g.w); o[64 * j] = w; }
    }
}

template <bool L1> DI void prep_row(const Params& p, int l, int row, int lane, const LAS float* W8) {
    const f32x4* xr = (const f32x4*)(p.x + (size_t)row * DM) + lane;
    f32x4 v[4];
#pragma unroll
    for (int j = 0; j < 4; ++j) v[j] = xr[64 * j];
    if (L1) {
        const f32x4* st = (const f32x4*)((const float*)(p.ws + WS_STATS) + (size_t)row * 16);
        const f32x4 s0 = st[0], s1 = st[1], s2 = st[2], s3 = st[3];
        const float ss = ((s0.x + s0.y) + (s0.z + s0.w)) + ((s1.x + s1.y) + (s1.z + s1.w)) + ((s2.x + s2.y) + (s2.z + s2.w)) + ((s3.x + s3.y) + (s3.z + s3.w));
        const float ry = rsqrtf(ss * (1.f / DM) + EPS);
        const u32x2* yr = (const u32x2*)((const bf16_t*)(p.ws + WS_P) + (size_t)row * DM) + lane;
        const f32x4* pg = (const f32x4*)(p.post_g + (size_t)(l - 1) * DM) + lane;
        f32x4* xo = (f32x4*)(p.out + (size_t)row * DM) + lane;
#pragma unroll
        for (int j = 0; j < 4; ++j) {
            const u32x2 y = yr[64 * j]; const f32x4 g = pg[64 * j];
            v[j].x += bflo(y.x) * ry * g.x; v[j].y += bfhi(y.x) * ry * g.y; v[j].z += bflo(y.y) * ry * g.z; v[j].w += bfhi(y.y) * ry * g.w;
            xo[64 * j] = v[j];
        }
    }
    float s = 0.f;
#pragma unroll
    for (int j = 0; j < 4; ++j) s += (v[j].x * v[j].x + v[j].y * v[j].y) + (v[j].z * v[j].z + v[j].w * v[j].w);
    const float r = rsqrtf(wave_sum(s) * (1.f / DM) + EPS);
    const f32x4* gr = (const f32x4*)(p.pre_g + (size_t)l * DM) + lane;
    u32x2* ho = (u32x2*)((bf16_t*)(p.ws + WS_H) + (size_t)row * DM) + lane;
#pragma unroll
    for (int j = 0; j < 4; ++j) {
        const f32x4 g = gr[64 * j];
        v[j].x *= r * g.x; v[j].y *= r * g.y; v[j].z *= r * g.z; v[j].w *= r * g.w;
        u32x2 w; w.x = pk2(v[j].x, v[j].y); w.y = pk2(v[j].z, v[j].w); ho[64 * j] = w;
    }
    float mine = 0.f;
#pragma unroll
    for (int c = 0; c < 8; ++c) {
        const LAS f32x4* wr = (const LAS f32x4*)(W8 + c * DM) + lane; float d = 0.f;
#pragma unroll
        for (int j = 0; j < 4; ++j) { const f32x4 w = wr[64 * j]; d += (v[j].x * w.x + v[j].y * w.y) + (v[j].z * w.z + v[j].w * w.w); }
        d = wave_sum(d);
        mine = (lane == c) ? d : mine;
    }
    if (lane < 8) {
        float o;
        if (lane < 4) o = sigmoidf_(mine);
        else { const int h = lane - 4; o = -__expf(p.a_log[l * 4 + h]) * softplusf_(mine + p.dt_bias[l * 4 + h]); }
        ((float*)(p.ws + WS_BA))[(size_t)row * 8 + lane] = o;
    }
}

DI void final_row(const Params& p, int row, int lane) {
    const f32x4* st = (const f32x4*)((const float*)(p.ws + WS_STATS) + (size_t)row * 16);
    const f32x4 s0 = st[0], s1 = st[1], s2 = st[2], s3 = st[3];
    const float ss = ((s0.x + s0.y) + (s0.z + s0.w)) + ((s1.x + s1.y) + (s1.z + s1.w)) + ((s2.x + s2.y) + (s2.z + s2.w)) + ((s3.x + s3.y) + (s3.z + s3.w));
    const float ry = rsqrtf(ss * (1.f / DM) + EPS);
    const u32x2* yr = (const u32x2*)((const bf16_t*)(p.ws + WS_P) + (size_t)row * DM) + lane;
    const f32x4* pg = (const f32x4*)(p.post_g + (size_t)(DEPTH - 1) * DM) + lane;
    f32x4* xo = (f32x4*)(p.out + (size_t)row * DM) + lane;
#pragma unroll
    for (int j = 0; j < 4; ++j) {
        const u32x2 y = yr[64 * j]; const f32x4 g = pg[64 * j]; f32x4 v = xo[64 * j];
        v.x += bflo(y.x) * ry * g.x; v.y += bfhi(y.x) * ry * g.y; v.z += bflo(y.y) * ry * g.z; v.w += bfhi(y.y) * ry * g.w;
        xo[64 * j] = v;
    }
}


namespace pg8 {
#define PG8_LAS __attribute__((address_space(3)))
typedef unsigned short bf16_t;
typedef short bf16x8 __attribute__((ext_vector_type(8)));
typedef float f32x4 __attribute__((ext_vector_type(4)));
typedef unsigned u32x4 __attribute__((ext_vector_type(4)));
constexpr int BM = 256, BK = 64, HALF = 128, HTB = HALF * BK * 2  , STAGE_BYTES = 8 * HTB, NXCD = 8, WGM = 8;

__host__ __device__ __forceinline__ int lds_byte(int r, int c) { const int st = (r >> 4) * 2 + (c >> 5), rr = r & 15, cc = c & 31, ob = rr * 64 + cc * 2; return st * 1024 + (ob ^ (((ob >> 9) & 1) << 5)); }
__host__ __device__ __forceinline__ void stage_rc(int b, int& R, int& C) { const int st = b / 1024, sb = b % 1024, swz = sb ^ (((sb >> 9) & 1) << 5); R = (st >> 1) * 16 + swz / 64; C = (st & 1) * 32 + (swz % 64) / 2; }
__host__ __device__ __forceinline__ int perm32(int rho) { const int n = rho >> 4, i = rho & 15; return 8 * (i >> 2) + 4 * n + (i & 3); }

struct Unit { int pm, pn; };
struct Gemm { const bf16_t* A; const bf16_t* Bt; int M, N, K; };

struct StaticOrder {
    int nM, nN, nwg, G, c;
    __host__ __device__ void init(int M, int N, int G_, int c_) { nM = M / BM; nN = N / BM; nwg = nM * nN; G = G_; c = c_; }
    __host__ __device__ bool next(int i, Unit& u) const {
        const long L = (long)i * G + c; if (L >= nwg) return false;
        int wgid = (int)L; { const int q = nwg / NXCD, r = nwg % NXCD, xcd = wgid % NXCD, off = wgid / NXCD; wgid = (xcd < r ? xcd * (q + 1) : r * (q + 1) + (xcd - r) * q) + off; }
        const int nig = WGM * nN, gid = wgid / nig, fm = gid * WGM, gsz = (nM - fm) < WGM ? (nM - fm) : WGM;
        u.pm = fm + ((wgid % nig) % gsz); u.pn = (wgid % nig) / gsz; return true;
    }
    __device__ __forceinline__ void a_ready(const Unit&) const {}
    __device__ __forceinline__ void done(const Unit&) const {}
};

__device__ __forceinline__ unsigned cvt_pk_bf16(float lo, float hi) { unsigned r; asm volatile("v_cvt_pk_bf16_f32 %0, %1, %2" : "=v"(r) : "v"(lo), "v"(hi)); return r; }
template <class Epi, class Sched, bool ALIGN_EPI = false, bool SP2 = false>
__device__ __forceinline__ void gemm_phase(PG8_LAS unsigned char* lds, const Gemm g, const Sched& S, const Epi& E, int tid_in) {
    int tid = tid_in; asm volatile("" : "+v"(tid));
    const int wid = __builtin_amdgcn_readfirstlane(tid >> 6), lane = tid & 63, wr = wid >> 2, wc = wid & 3, fr = lane & 15, fq = lane >> 4;
    const int K = g.K, nt = K / BK;
    unsigned voffA[2], voffB[2];
#pragma unroll
    for (int i = 0; i < 2; ++i) { int R, C; stage_rc(tid * 16 + i * 8192, R, C); const int Rb = Epi::PERM ? ((R & ~31) + perm32(R & 31)) : R;
        voffA[i] = (unsigned)(R * K + C) * 2u; voffB[i] = (unsigned)(Rb * K + C) * 2u; }
    const size_t kstep = (size_t)(BK * 2);
    const size_t hstep = (size_t)HALF * K * 2;
    const size_t tstep = 2 * hstep;
    const unsigned ldsw = (unsigned)wid * 1024u;
    const int aoff = lds_byte(wr * 64 + fr, fq * 8), boff = lds_byte(wc * 32 + fr, fq * 8);
#define PG8_SA(b, h) (((b) * 2 + (h)) * HTB)
#define PG8_SB(b, h) ((4 + (b) * 2 + (h)) * HTB)
#define PG8_STAGE(bufoff, gbase, voff) do { _Pragma("unroll") for (int _i = 0; _i < 2; ++_i) \
        __builtin_amdgcn_global_load_lds((const unsigned*)((const char*)(gbase) + (voff)[_i]), (PG8_LAS unsigned*)(lds + (bufoff) + ldsw + _i * 8192), 16, 0, 0); } while (0)
#define PG8_LDA(dst, b, h) do { _Pragma("unroll") for (int m = 0; m < 4; ++m) _Pragma("unroll") for (int k = 0; k < 2; ++k) dst[m][k] = *(const PG8_LAS bf16x8*)(lds + PG8_SA(b, h) + aoff + m * 2048 + k * 1024); } while (0)
#define PG8_LDB(dst, b, h) do { _Pragma("unroll") for (int n = 0; n < 2; ++n) _Pragma("unroll") for (int k = 0; k < 2; ++k) dst[n][k] = *(const PG8_LAS bf16x8*)(lds + PG8_SB(b, h) + boff + n * 2048 + k * 1024); } while (0)
#define PG8_MMA(ai, bj, At, Bt) do { __builtin_amdgcn_s_setprio(1); _Pragma("unroll") for (int m = 0; m < 4; ++m) _Pragma("unroll") for (int n = 0; n < 2; ++n) _Pragma("unroll") for (int k = 0; k < 2; ++k) \
        acc[ai][bj][m][n] = __builtin_amdgcn_mfma_f32_16x16x32_bf16(Bt[n][k], At[m][k], acc[ai][bj][m][n], 0, 0, 0); __builtin_amdgcn_s_setprio(0); } while (0)
#define PG8_WAIT_V(n) asm volatile("s_waitcnt vmcnt(" #n ")" ::: "memory")
#define PG8_WAIT_L(n) asm volatile("s_waitcnt lgkmcnt(" #n ")" ::: "memory")
#define PG8_BAR __builtin_amdgcn_s_barrier()
#define PG8_SCHED __builtin_amdgcn_sched_barrier(0)
    Unit cur, nxt; int ui = 0;
    if (!S.next(0, cur)) return;
    f32x4 acc[2][2][4][2];
#pragma unroll
    for (int a = 0; a < 2; ++a)
#pragma unroll
        for (int b = 0; b < 2; ++b)
#pragma unroll
            for (int m = 0; m < 4; ++m)
#pragma unroll
                for (int n = 0; n < 2; ++n) acc[a][b][m][n] = (f32x4){0.f, 0.f, 0.f, 0.f};
    bf16x8 At[4][2], B0[2][2], B1[2][2];
    const char* cA = (const char*)g.A + (size_t)cur.pm * tstep; const char* cB = (const char*)g.Bt + (size_t)cur.pn * tstep;
    S.a_ready(cur);
    if constexpr (SP2) {
        PG8_STAGE(PG8_SB(0, 0), cB, voffB); PG8_STAGE(PG8_SB(0, 1), cB + hstep, voffB); PG8_STAGE(PG8_SA(0, 0), cA, voffA); PG8_STAGE(PG8_SA(0, 1), cA + hstep, voffA);
        if (wr == 1) PG8_BAR;
        PG8_WAIT_V(2); PG8_BAR;
        PG8_STAGE(PG8_SB(1, 0), cB + kstep, voffB); PG8_STAGE(PG8_SA(1, 0), cA + kstep, voffA); PG8_STAGE(PG8_SB(1, 1), cB + hstep + kstep, voffB);
        PG8_WAIT_V(6); PG8_BAR;
    } else {
        PG8_STAGE(PG8_SB(0, 0), cB, voffB); PG8_STAGE(PG8_SA(0, 0), cA, voffA); PG8_STAGE(PG8_SB(0, 1), cB + hstep, voffB); PG8_STAGE(PG8_SA(0, 1), cA + hstep, voffA);
        if (wr == 1) PG8_BAR;
        PG8_WAIT_V(4); PG8_BAR;
        PG8_STAGE(PG8_SB(1, 0), cB + kstep, voffB); PG8_STAGE(PG8_SA(1, 0), cA + kstep, voffA); PG8_STAGE(PG8_SB(1, 1), cB + hstep + kstep, voffB);
        PG8_WAIT_V(6); PG8_BAR;
    }
    for (;;) {
        const bool has_next = S.next(ui + 1, nxt);
        const char* nA = has_next ? (const char*)g.A + (size_t)nxt.pm * tstep : cA; const char* nB = has_next ? (const char*)g.Bt + (size_t)nxt.pn * tstep : cB;
        for (int t = 0; t < nt; t += 2) {
            const bool last = (t == nt - 2);
            const char* a1 = cA + (size_t)(t + 1) * kstep;
            const char* a2 = last ? nA : cA + (size_t)(t + 2) * kstep; const char* b2 = last ? nB : cB + (size_t)(t + 2) * kstep;
            const char* a3 = a2 + kstep; const char* b3 = b2 + kstep;
            if (last && has_next) S.a_ready(nxt);
            if constexpr (SP2) {
            PG8_LDB(B0, 0, 0); PG8_LDB(B1, 0, 1); PG8_SCHED; PG8_LDA(At, 0, 0); PG8_STAGE(PG8_SA(1, 1), a1 + hstep, voffA);
            PG8_WAIT_V(8); PG8_WAIT_L(0); PG8_BAR; PG8_MMA(0, 0, At, B0); PG8_MMA(0, 1, At, B1); PG8_BAR; PG8_SCHED;
            PG8_LDA(At, 0, 1); PG8_STAGE(PG8_SB(0, 0), b2, voffB); PG8_STAGE(PG8_SB(0, 1), b2 + hstep, voffB); PG8_STAGE(PG8_SA(0, 0), a2, voffA);
            PG8_WAIT_V(8); PG8_WAIT_L(0); PG8_BAR; PG8_MMA(1, 0, At, B0); PG8_MMA(1, 1, At, B1); PG8_BAR; PG8_SCHED;
            PG8_LDB(B0, 1, 0); PG8_LDB(B1, 1, 1); PG8_SCHED; PG8_LDA(At, 1, 0); PG8_STAGE(PG8_SA(0, 1), a2 + hstep, voffA);
            PG8_WAIT_V(8); PG8_WAIT_L(0); PG8_BAR; PG8_MMA(0, 0, At, B0); PG8_MMA(0, 1, At, B1); PG8_BAR; PG8_SCHED;
            PG8_LDA(At, 1, 1); PG8_STAGE(PG8_SB(1, 0), b3, voffB); PG8_STAGE(PG8_SB(1, 1), b3 + hstep, voffB); PG8_STAGE(PG8_SA(1, 0), a3, voffA);
            PG8_WAIT_V(8); PG8_WAIT_L(0); PG8_BAR; PG8_MMA(1, 0, At, B0); PG8_MMA(1, 1, At, B1); PG8_BAR; PG8_SCHED;
            } else {
            PG8_LDB(B0, 0, 0); PG8_SCHED; PG8_LDA(At, 0, 0); PG8_STAGE(PG8_SA(1, 1), a1 + hstep, voffA);
            PG8_WAIT_L(8); PG8_BAR; PG8_WAIT_L(0); PG8_MMA(0, 0, At, B0); PG8_BAR; PG8_SCHED;
            PG8_LDB(B1, 0, 1); PG8_STAGE(PG8_SB(0, 0), b2, voffB);
            PG8_BAR; PG8_WAIT_L(0); PG8_MMA(0, 1, At, B1); PG8_BAR;
            PG8_LDA(At, 0, 1); PG8_STAGE(PG8_SA(0, 0), a2, voffA);
            PG8_BAR; PG8_WAIT_L(0); PG8_MMA(1, 0, At, B0); PG8_BAR; PG8_SCHED;
            PG8_STAGE(PG8_SB(0, 1), b2 + hstep, voffB);
            PG8_WAIT_V(6); PG8_BAR; PG8_MMA(1, 1, At, B1); PG8_BAR;
            PG8_LDB(B0, 1, 0); PG8_SCHED; PG8_LDA(At, 1, 0); PG8_STAGE(PG8_SA(0, 1), a2 + hstep, voffA);
            PG8_WAIT_L(8); PG8_BAR; PG8_WAIT_L(0); PG8_MMA(0, 0, At, B0); PG8_BAR; PG8_SCHED;
            PG8_LDB(B1, 1, 1); PG8_STAGE(PG8_SB(1, 0), b3, voffB);
            PG8_BAR; PG8_WAIT_L(0); PG8_MMA(0, 1, At, B1); PG8_BAR;
            PG8_LDA(At, 1, 1); PG8_STAGE(PG8_SA(1, 0), a3, voffA);
            PG8_BAR; PG8_WAIT_L(0); PG8_MMA(1, 0, At, B0); PG8_BAR; PG8_SCHED;
            PG8_STAGE(PG8_SB(1, 1), b3 + hstep, voffB);
            PG8_WAIT_V(6); PG8_BAR; PG8_MMA(1, 1, At, B1); PG8_BAR;
            }
        }
        if constexpr (ALIGN_EPI) { if (wr == 0) PG8_BAR; }
        if constexpr (!Epi::AFTER_DRAIN) { E(acc, cur, wr, wc, fr, fq); S.done(cur); }
        if (!has_next) break;
#pragma unroll
        for (int a = 0; a < 2; ++a)
#pragma unroll
            for (int b = 0; b < 2; ++b)
#pragma unroll
                for (int m = 0; m < 4; ++m)
#pragma unroll
                    for (int n = 0; n < 2; ++n) acc[a][b][m][n] = (f32x4){0.f, 0.f, 0.f, 0.f};
        cur = nxt; cA = nA; cB = nB; ++ui;
        if constexpr (ALIGN_EPI) { if (wr == 1) PG8_BAR; }
    }
    PG8_WAIT_V(0);
    if constexpr (!ALIGN_EPI) { if (wr == 0) PG8_BAR; }
    PG8_BAR;
    if constexpr (Epi::AFTER_DRAIN) { E.fused(acc, cur, wr, wc, fr, fq, lds, wid, lane); S.done(cur); }
#undef PG8_SA
#undef PG8_SB
#undef PG8_STAGE
#undef PG8_LDA
#undef PG8_LDB
#undef PG8_MMA
#undef PG8_WAIT_V
#undef PG8_WAIT_L
#undef PG8_BAR
#undef PG8_SCHED
}
}
using pg8::cvt_pk_bf16;
struct EpiProj {
    static constexpr bool PERM = true, AFTER_DRAIN = false;
    bf16_t* O; bf16_t* svT;
    DI void operator()(const f32x4 (&acc)[2][2][4][2], const pg8::Unit& u, int wr, int wc, int fr, int fq) const {
        const int row0 = u.pm * 256 + wr * 64 + fr, col0 = u.pn * 256 + wc * 32 + 8 * fq;
#pragma unroll
        for (int ai = 0; ai < 2; ++ai)
#pragma unroll
            for (int m = 0; m < 4; ++m) { bf16_t* rowp = O + (size_t)(row0 + ai * 128 + m * 16) * NIN + col0;
#pragma unroll
                for (int bj = 0; bj < 2; ++bj) { const f32x4 v0 = acc[ai][bj][m][0], v1 = acc[ai][bj][m][1];
                    u32x4 w; w.x = cvt_pk_bf16(v0[0], v0[1]); w.y = cvt_pk_bf16(v0[2], v0[3]); w.z = cvt_pk_bf16(v1[0], v1[1]); w.w = cvt_pk_bf16(v1[2], v1[3]);
                    *(u32x4*)(rowp + bj * 128) = w; } }
        if (u.pn == 2) {
#pragma unroll
            for (int ai = 0; ai < 2; ++ai)
#pragma unroll
                for (int m = 0; m < 4; ++m) { const int row = row0 + ai * 128 + m * 16, b = row >> 12, s = row & (SEQ - 1);
#pragma unroll
                    for (int n = 0; n < 2; ++n)
#pragma unroll
                        for (int e = 0; e < 4; ++e) { const int c = wc * 32 + 8 * fq + 4 * n + e;
                            svT[((size_t)(b * 2 + (c >> 6)) * 64 + (c & 63)) * SEQ + s] = (bf16_t)f2bf(acc[ai][1][m][n][e]); } }
        }
    }
};
struct EpiMkv {
    static constexpr bool PERM = true, AFTER_DRAIN = false;
    bf16_t* mk; bf16_t* mvT;
    DI void operator()(const f32x4 (&acc)[2][2][4][2], const pg8::Unit& u, int wr, int wc, int fr, int fq) const {
        const int row0 = u.pm * 256 + wr * 64 + fr;
#pragma unroll
        for (int ai = 0; ai < 2; ++ai)
#pragma unroll
            for (int m = 0; m < 4; ++m) { const int row = row0 + ai * 128 + m * 16;
                if (u.pn == 0) {
#pragma unroll
                    for (int bj = 0; bj < 2; ++bj) { const f32x4 v0 = acc[ai][bj][m][0], v1 = acc[ai][bj][m][1];
                        u32x4 w; w.x = cvt_pk_bf16(v0[0], v0[1]); w.y = cvt_pk_bf16(v0[2], v0[3]); w.z = cvt_pk_bf16(v1[0], v1[1]); w.w = cvt_pk_bf16(v1[2], v1[3]);
                        *(u32x4*)(mk + (size_t)row * 256 + bj * 128 + wc * 32 + 8 * fq) = w; }
                } else { const int b = row >> 8, mm = row & 255;
#pragma unroll
                    for (int bj = 0; bj < 2; ++bj)
#pragma unroll
                        for (int n = 0; n < 2; ++n)
#pragma unroll
                            for (int e = 0; e < 4; ++e) { const int c = bj * 128 + wc * 32 + 8 * fq + 4 * n + e;
                                mvT[((size_t)(b * 4 + (c >> 6)) * 64 + (c & 63)) * NMEM + mm] = (bf16_t)f2bf(acc[ai][bj][m][n][e]); } }
            }
    }
};
struct EpiY {
    static constexpr bool PERM = true, AFTER_DRAIN = false;
    bf16_t* Y; float* stats;
    DI void operator()(const f32x4 (&acc)[2][2][4][2], const pg8::Unit& u, int wr, int wc, int fr, int fq) const {
        const int row0 = u.pm * 256 + wr * 64 + fr, col0 = u.pn * 256 + wc * 32 + 8 * fq;
#pragma unroll
        for (int ai = 0; ai < 2; ++ai)
#pragma unroll
            for (int m = 0; m < 4; ++m) { const int row = row0 + ai * 128 + m * 16; bf16_t* rowp = Y + (size_t)row * DM + col0; float ss = 0.f;
#pragma unroll
                for (int bj = 0; bj < 2; ++bj) { const f32x4 v0 = acc[ai][bj][m][0], v1 = acc[ai][bj][m][1];
                    ss += (v0[0] * v0[0] + v0[1] * v0[1]) + (v0[2] * v0[2] + v0[3] * v0[3]) + (v1[0] * v1[0] + v1[1] * v1[1]) + (v1[2] * v1[2] + v1[3] * v1[3]);
                    u32x4 w; w.x = cvt_pk_bf16(v0[0], v0[1]); w.y = cvt_pk_bf16(v0[2], v0[3]); w.z = cvt_pk_bf16(v1[0], v1[1]); w.w = cvt_pk_bf16(v1[2], v1[3]);
                    *(u32x4*)(rowp + bj * 128) = w; }
                ss += __shfl_xor(ss, 16); ss += __shfl_xor(ss, 32);
                if (fq == 0) stats[(size_t)row * 16 + u.pn * 4 + wc] = ss; }
    }
};

typedef short bf16x8 __attribute__((ext_vector_type(8)));
typedef short s16x4 __attribute__((ext_vector_type(4)));
typedef float f32x16 __attribute__((ext_vector_type(16)));
typedef float f32x2_t __attribute__((ext_vector_type(2)));
typedef __bf16 bf16x2_t __attribute__((ext_vector_type(2)));
DI unsigned cvtpk(float lo, float hi) { f32x2_t v = {lo, hi}; bf16x2_t b = __builtin_convertvector(v, bf16x2_t); return __builtin_bit_cast(unsigned, b); }
#define MFMA32(a, b, c) __builtin_amdgcn_mfma_f32_32x32x16_bf16((a), (b), (c), 0, 0, 0)
#define MFMA16(a, b, c) __builtin_amdgcn_mfma_f32_16x16x32_bf16((a), (b), (c), 0, 0, 0)
constexpr int KROW = 144;
constexpr int SWA_VS = 392, MEM_VS = 520;
constexpr int SWA_IMG = 192 * KROW + 64 * SWA_VS;
constexpr int MEM_IMG = 256 * KROW + 64 * MEM_VS;
constexpr int ATT_STAGE = 2 * SWA_IMG;
static_assert(ATT_STAGE + 8 * 4608 <= 147328 && MEM_IMG <= ATT_STAGE, "attention LDS map");

DI void attn_wave(f32x16& o0, f32x16& o1, float& lsum, float m, const bf16x8 (&qf)[4], const LAS unsigned char* Kimg, const LAS unsigned char* VTimg, int vs,
                  int st0, int st1, int st_lo, int st_hi, int r, int h) {
    constexpr float SC = 0.125f * 1.4426950408889634f;
#pragma unroll
    for (int i = 0; i < 16; ++i) { o0[i] = 0.f; o1[i] = 0.f; }
    for (int st = st0; st < st1; ++st) {
        const LAS unsigned char* kp = Kimg + (32 * st + r) * KROW + 16 * h;
        bf16x8 kf[4];
#pragma unroll
        for (int ks = 0; ks < 4; ++ks) kf[ks] = *(const LAS bf16x8*)(kp + 32 * ks);
        const LAS unsigned char* vp = VTimg + r * vs + (32 * st + 4 * h) * 2;
        s16x4 va[2][2][2];
#pragma unroll
        for (int dt = 0; dt < 2; ++dt)
#pragma unroll
            for (int ss = 0; ss < 2; ++ss)
#pragma unroll
                for (int hf = 0; hf < 2; ++hf) va[dt][ss][hf] = *(const LAS s16x4*)(vp + dt * 32 * vs + (16 * ss + 8 * hf) * 2);
        f32x16 s;
#pragma unroll
        for (int i = 0; i < 16; ++i) s[i] = 0.f;
#pragma unroll
        for (int ks = 0; ks < 4; ++ks) s = MFMA32(kf[ks], qf[ks], s);
        if (st == st_lo || st == st_hi) {
            const bool lo = st == st_lo;
#pragma unroll
            for (int i = 0; i < 16; ++i) { const int c = (i & 3) + 8 * (i >> 2) + 4 * h; const bool ok = lo ? (c > r) : (c <= r); s[i] = ok ? s[i] : -1e30f; }
        }
        float tm = fmaxf(fmaxf(s[0], s[1]), fmaxf(s[2], s[3]));
#pragma unroll
        for (int i = 4; i < 16; i += 4) tm = fmaxf(fmaxf(tm, fmaxf(s[i], s[i + 1])), fmaxf(s[i + 2], s[i + 3]));
        tm = fmaxf(tm, __shfl_xor(tm, 32)) * SC;
        if (__any(tm > m)) {
            const float mn = fmaxf(m, tm), alpha = __builtin_amdgcn_exp2f(m - mn);
            m = mn; lsum *= alpha;
#pragma unroll
            for (int i = 0; i < 16; ++i) { o0[i] *= alpha; o1[i] *= alpha; }
        }
        float ps = 0.f;
#pragma unroll
        for (int i = 0; i < 16; ++i) { s[i] = __builtin_amdgcn_exp2f(__builtin_fmaf(s[i], SC, -m)); ps += s[i]; }
        lsum += ps;
#pragma unroll
        for (int ss = 0; ss < 2; ++ss) {
            u32x4 pw; pw.x = cvtpk(s[8 * ss + 0], s[8 * ss + 1]); pw.y = cvtpk(s[8 * ss + 2], s[8 * ss + 3]); pw.z = cvtpk(s[8 * ss + 4], s[8 * ss + 5]); pw.w = cvtpk(s[8 * ss + 6], s[8 * ss + 7]);
            const bf16x8 pf = __builtin_bit_cast(bf16x8, pw);
            const bf16x8 v0 = __builtin_shufflevector(va[0][ss][0], va[0][ss][1], 0, 1, 2, 3, 4, 5, 6, 7);
            const bf16x8 v1 = __builtin_shufflevector(va[1][ss][0], va[1][ss][1], 0, 1, 2, 3, 4, 5, 6, 7);
            o0 = MFMA32(v0, pf, o0); o1 = MFMA32(v1, pf, o1);
        }
    }
    lsum += __shfl_xor(lsum, 32);
}
DI u32x4 ldg16(const void* base, unsigned off) { return *(const u32x4*)((const char*)base + off); }
DI void attn_gate_load(u32x4 (&gv)[4], const bf16_t* gbase  , int lane) {
    const unsigned off = (unsigned)((lane >> 3) * NIN + 8 * (lane & 7)) * 2u;
#pragma unroll
    for (int i = 0; i < 4; ++i) gv[i] = ldg16(gbase + (size_t)i * 8 * NIN, off);
}
DI void attn_store(const f32x16& o0, const f32x16& o1, float lsum, const u32x4 (&gvv)[4], LAS unsigned char* stg, bf16_t* obase  , int lane) {
    const int r = lane & 31, h = lane >> 5;
    const float inv = 1.f / lsum;
#pragma unroll
    for (int g4 = 0; g4 < 4; ++g4) {
        u32x2 w0, w1;
        w0.x = cvtpk(o0[4 * g4 + 0] * inv, o0[4 * g4 + 1] * inv); w0.y = cvtpk(o0[4 * g4 + 2] * inv, o0[4 * g4 + 3] * inv);
        w1.x = cvtpk(o1[4 * g4 + 0] * inv, o1[4 * g4 + 1] * inv); w1.y = cvtpk(o1[4 * g4 + 2] * inv, o1[4 * g4 + 3] * inv);
        *(LAS u32x2*)(stg + r * 144 + (8 * g4 + 4 * h) * 2) = w0;
        *(LAS u32x2*)(stg + r * 144 + (32 + 8 * g4 + 4 * h) * 2) = w1;
    }
    asm volatile("s_waitcnt lgkmcnt(0)" ::: "memory");
    const unsigned ooff = (unsigned)((lane >> 3) * DM + 8 * (lane & 7)) * 2u;
    const LAS unsigned char* sp = stg + (lane >> 3) * 144 + 16 * (lane & 7);
#pragma unroll
    for (int i = 0; i < 4; ++i) {
        const u32x4 ov = *(const LAS u32x4*)(sp + i * 8 * 144);
        const u32x4 gv = gvv[i];
        u32x4 w;
        w.x = cvtpk(bflo(ov.x) * siluf_(bflo(gv.x)), bfhi(ov.x) * siluf_(bfhi(gv.x)));
        w.y = cvtpk(bflo(ov.y) * siluf_(bflo(gv.y)), bfhi(ov.y) * siluf_(bfhi(gv.y)));
        w.z = cvtpk(bflo(ov.z) * siluf_(bflo(gv.z)), bfhi(ov.z) * siluf_(bfhi(gv.z)));
        w.w = cvtpk(bflo(ov.w) * siluf_(bflo(gv.w)), bfhi(ov.w) * siluf_(bfhi(gv.w)));
        *(u32x4*)((char*)(obase + (size_t)i * 8 * DM) + ooff) = w;
    }
    asm volatile("s_waitcnt lgkmcnt(0)" ::: "memory");
}
DI void attn_phase(const Params& p, int l, LAS unsigned char* lds, int tid, int G) {
    const int lane = tid & 63, wave = __builtin_amdgcn_readfirstlane(tid >> 6), r = lane & 31, h = lane >> 5;
    const bf16_t* P = (const bf16_t*)(p.ws + WS_P);
    bf16_t* MIX = (bf16_t*)(p.ws + WS_H);
    LAS unsigned char* stg = lds + ATT_STAGE + wave * 4608;
    const unsigned qoff = (unsigned)(r * NIN + 8 * h) * 2u;
    for (int cc = blockIdx.x; cc < 256; cc += G) {
        {
            const int bk = cc >> 3, b = bk >> 1, kvh = bk & 1, qb0 = (cc & 7) * 8;
            const int g = wave >> 1, qh = wave & 1, head = kvh * 4 + g;
            const bf16_t* Kg = P + (size_t)b * SEQ * NIN + C_SK + kvh * 64;
            const bf16_t* Vg = (const bf16_t*)(p.ws + WS_SVT) + (size_t)(b * 2 + kvh) * 64 * SEQ;
            const bf16_t* Qg = P + ((size_t)b * SEQ + 32 * qh) * NIN + C_SQ + head * 64;
            const bf16_t* Gg = P + ((size_t)b * SEQ + 32 * qh) * NIN + C_GATE + head * 64;
            bf16_t* Og = MIX + ((size_t)b * SEQ + 32 * qh) * DM + head * 64;
            const float sink = p.sinks[l * 8 + head] * 1.4426950408889634f;
            const int krow = tid >> 3, kch = tid & 7, vd = tid / 24, vch = tid % 24;
            u32x4 kreg[3], vreg[3]; bf16x8 qf[4], qn[4];
#define SWA_ISSUE(qb_) do { const int kb0_ = 64 * (qb_) - 128; \
                _Pragma("unroll") for (int i_ = 0; i_ < 3; ++i_) { \
                    { int kr_ = kb0_ + krow + 64 * i_; kr_ = kr_ < 0 ? 0 : kr_; kreg[i_] = ldg16(Kg, (unsigned)(kr_ * NIN + 8 * kch) * 2u); }     \
                    { const int idx_ = tid + 512 * i_, d_ = idx_ / 24, ch_ = idx_ % 24; int k0_ = kb0_ + 8 * ch_; k0_ = k0_ < 0 ? 0 : k0_; vreg[i_] = ldg16(Vg, (unsigned)(d_ * SEQ + k0_) * 2u); } } \
                { const bf16_t* Qp_ = Qg + (size_t)(64 * (qb_)) * NIN; \
                  _Pragma("unroll") for (int ks_ = 0; ks_ < 4; ++ks_) qn[ks_] = __builtin_bit_cast(bf16x8, ldg16(Qp_ + 16 * ks_, qoff)); } } while (0)
#define SWA_WRITE(buf_) do { LAS unsigned char* Ki_ = lds + (buf_) * SWA_IMG; LAS unsigned char* Vi_ = Ki_ + 192 * KROW; \
                _Pragma("unroll") for (int i_ = 0; i_ < 3; ++i_) { const int idx_ = tid + 512 * i_; \
                    *(LAS u32x4*)(Ki_ + (krow + 64 * i_) * KROW + 16 * kch) = kreg[i_]; \
                    { LAS unsigned char* d_ = Vi_ + (idx_ / 24) * SWA_VS + 16 * (idx_ % 24); u32x2 a_, b_; a_.x = vreg[i_].x; a_.y = vreg[i_].y; b_.x = vreg[i_].z; b_.y = vreg[i_].w; \
                      *(LAS u32x2*)d_ = a_; *(LAS u32x2*)(d_ + 8) = b_; } } } while (0)
            (void)vd; (void)vch;
            SWA_ISSUE(qb0);
            SWA_WRITE(0);
#pragma unroll
            for (int ks = 0; ks < 4; ++ks) qf[ks] = qn[ks];
            __syncthreads();
            for (int i = 0; i < 8; ++i) {
                const int qb = qb0 + i;
                if (i < 7) SWA_ISSUE(qb + 1);
                {
                    const LAS unsigned char* Kimg = lds + (i & 1) * SWA_IMG; const LAS unsigned char* VTimg = Kimg + 192 * KROW;
                    const int first = 4 - 2 * qb, st0 = qh > first ? qh : first;
                    f32x16 o0, o1; float lsum = h == 0 ? 1.f : 0.f; u32x4 gv[4];
                    attn_gate_load(gv, Gg + (size_t)(64 * qb) * NIN, lane);
                    attn_wave(o0, o1, lsum, sink, qf, Kimg, VTimg, SWA_VS, st0, qh + 5, qh, qh + 4, r, h);
                    attn_store(o0, o1, lsum, gv, stg, Og + (size_t)(64 * qb) * DM, lane);
                }
                if (i < 7) { SWA_WRITE((i + 1) & 1);
#pragma unroll
                    for (int ks = 0; ks < 4; ++ks) qf[ks] = qn[ks]; }
                __syncthreads();
            }
#undef SWA_ISSUE
#undef SWA_WRITE
        }
        {
            const int bh = cc >> 2, b = bh >> 2, hm = bh & 3, qk0 = (cc & 3) * 4;
            const bf16_t* Kg = (const bf16_t*)(p.ws + WS_MK) + (size_t)l * MEMROWS * 256 + (size_t)b * NMEM * 256 + hm * 64;
            const bf16_t* Vg = (const bf16_t*)(p.ws + WS_MVT) + (size_t)l * MEMROWS * 256 + (size_t)(b * 4 + hm) * 64 * NMEM;
            const bf16_t* Qg = P + ((size_t)b * SEQ + 32 * wave) * NIN + C_MQ + hm * 64;
            const bf16_t* Gg = P + ((size_t)b * SEQ + 32 * wave) * NIN + C_GATE + 768 + hm * 64;
            bf16_t* Og = MIX + ((size_t)b * SEQ + 32 * wave) * DM + 768 + hm * 64;
            LAS unsigned char* Ki = lds; LAS unsigned char* Vi = lds + 256 * KROW;
#pragma unroll
            for (int i = 0; i < 4; ++i) { const int idx = tid + 512 * i;
                *(LAS u32x4*)(Ki + (idx >> 3) * KROW + 16 * (idx & 7)) = ldg16(Kg, (unsigned)((idx >> 3) * 256 + 8 * (idx & 7)) * 2u);
                const u32x4 v = ldg16(Vg, (unsigned)((idx >> 5) * NMEM + 8 * (idx & 31)) * 2u);
                LAS unsigned char* d = Vi + (idx >> 5) * MEM_VS + 16 * (idx & 31); u32x2 a_, b_; a_.x = v.x; a_.y = v.y; b_.x = v.z; b_.y = v.w;
                *(LAS u32x2*)d = a_; *(LAS u32x2*)(d + 8) = b_; }
            bf16x8 qf[4], qn[4];
#pragma unroll
            for (int ks = 0; ks < 4; ++ks) qf[ks] = __builtin_bit_cast(bf16x8, ldg16(Qg + (size_t)(256 * qk0) * NIN + 16 * ks, qoff));
            __syncthreads();
            for (int i = 0; i < 4; ++i) {
                const int qk = qk0 + i;
                if (i < 3) {
#pragma unroll
                    for (int ks = 0; ks < 4; ++ks) qn[ks] = __builtin_bit_cast(bf16x8, ldg16(Qg + (size_t)(256 * (qk + 1)) * NIN + 16 * ks, qoff)); }
                f32x16 o0, o1; float lsum = 0.f; u32x4 gv[4];
                attn_gate_load(gv, Gg + (size_t)(256 * qk) * NIN, lane);
                attn_wave(o0, o1, lsum, -1e30f, qf, Ki, Vi, MEM_VS, 0, 8, -1, -1, r, h);
                attn_store(o0, o1, lsum, gv, stg, Og + (size_t)(256 * qk) * DM, lane);
                if (i < 3) {
#pragma unroll
                    for (int ks = 0; ks < 4; ++ks) qf[ks] = qn[ks]; }
            }
            __syncthreads();
        }
    }
}

constexpr size_t DN_M = WS_DN;
constexpr size_t DN_NT = WS_DN + 32 * MiB;
constexpr size_t DN_UT = WS_DN + 96 * MiB;
constexpr size_t DN_W = WS_DN + 128 * MiB;
constexpr size_t DN_QG = WS_DN + 160 * MiB;
constexpr size_t DN_IN = WS_DN + 192 * MiB;
constexpr size_t DN_ST = WS_DN + 224 * MiB;
constexpr int LDK = 72;

DI void mm16x64(f32x4 (&acc)[4], const LAS bf16_t* A, int r0, const LAS bf16_t* Bt, int fr, int fq) {
    bf16x8 a[2];
#pragma unroll
    for (int ks = 0; ks < 2; ++ks) a[ks] = *(const LAS bf16x8*)(A + (r0 + fr) * LDK + 32 * ks + 8 * fq);
#pragma unroll
    for (int nt = 0; nt < 4; ++nt)
#pragma unroll
        for (int ks = 0; ks < 2; ++ks) { const bf16x8 b = *(const LAS bf16x8*)(Bt + (16 * nt + fr) * LDK + 32 * ks + 8 * fq); acc[nt] = MFMA16(a[ks], b, acc[nt]); }
}
DI void conv16(float (&out)[16], const bf16_t* Pcol, size_t rowb, int s0, const float* cw) {
#pragma unroll
    for (int e = 0; e < 16; ++e) out[e] = 0.f;
#pragma unroll
    for (int j = 0; j < 4; ++j) {
        const int s = s0 + j;
        if (s >= 0) {
            const u32x4 x0 = *(const u32x4*)(Pcol + (rowb + s) * NIN), x1 = *(const u32x4*)(Pcol + (rowb + s) * NIN + 8);
            const f32x4 w0 = *(const f32x4*)(cw + j * 768), w1 = *(const f32x4*)(cw + j * 768 + 4), w2 = *(const f32x4*)(cw + j * 768 + 8), w3 = *(const f32x4*)(cw + j * 768 + 12);
            out[0] += w0.x * bflo(x0.x); out[1] += w0.y * bfhi(x0.x); out[2] += w0.z * bflo(x0.y); out[3] += w0.w * bfhi(x0.y);
            out[4] += w1.x * bflo(x0.z); out[5] += w1.y * bfhi(x0.z); out[6] += w1.z * bflo(x0.w); out[7] += w1.w * bfhi(x0.w);
            out[8] += w2.x * bflo(x1.x); out[9] += w2.y * bfhi(x1.x); out[10] += w2.z * bflo(x1.y); out[11] += w2.w * bfhi(x1.y);
            out[12] += w3.x * bflo(x1.z); out[13] += w3.y * bfhi(x1.z); out[14] += w3.z * bflo(x1.w); out[15] += w3.w * bfhi(x1.w);
        }
    }
#pragma unroll
    for (int e = 0; e < 16; ++e) out[e] = siluf_(out[e]);
}
DI u32x4 pack8(const float* v) { u32x4 w; w.x = cvtpk(v[0], v[1]); w.y = cvtpk(v[2], v[3]); w.z = cvtpk(v[4], v[5]); w.w = cvtpk(v[6], v[7]); return w; }
DI u32x2 pack4(const f32x4 v) { u32x2 w; w.x = cvtpk(v[0], v[1]); w.y = cvtpk(v[2], v[3]); return w; }

DI void dn_prep_phase(const Params& p, int l, LAS unsigned char* lds, int tid, int G) {
    const int sg = tid >> 8, ts = tid & 255, lane = tid & 63, wsg = (tid >> 6) & 3, fr = lane & 15, fq = lane >> 4;
    LAS unsigned char* base = lds + sg * 65536;
    LAS bf16_t* qs = (LAS bf16_t*)(base); LAS bf16_t* Tm = qs;
    LAS bf16_t* ks = (LAS bf16_t*)(base + 9216); LAS bf16_t* uT = ks;
    LAS bf16_t* kdT = (LAS bf16_t*)(base + 18432);
    LAS bf16_t* kbgT = (LAS bf16_t*)(base + 27648);
    LAS bf16_t* vbT = (LAS bf16_t*)(base + 36864);
    LAS float* Lf = (LAS float*)(base + 46080); LAS bf16_t* wT = (LAS bf16_t*)(base + 46080);
    LAS float* gcs = (LAS float*)(base + 63488); LAS float* betas = gcs + 64;
    const bf16_t* P = (const bf16_t*)(p.ws + WS_P);
    const float* BA = (const float*)(p.ws + WS_BA);
    const float* cwl = p.conv_w + (size_t)l * 4 * 768;
    const int t = ts >> 2, seg = ts & 3;
    for (int it = blockIdx.x; it < 2048; it += G) {
        const int ch = 2 * it + sg, b = ch >> 8, h = (ch >> 6) & 3, n = ch & 63;
        const size_t rowb = (size_t)b * SEQ, row = rowb + n * 64 + t; const int s0 = n * 64 + t - 3;
        float cq[16], ck[16], cv[16];
        conv16(cq, P + C_DQ + h * 64 + 16 * seg, rowb, s0, cwl + h * 64 + 16 * seg);
        conv16(ck, P + C_DK + h * 64 + 16 * seg, rowb, s0, cwl + 256 + h * 64 + 16 * seg);
        conv16(cv, P + C_DV + h * 64 + 16 * seg, rowb, s0, cwl + 512 + h * 64 + 16 * seg);
        float sq = 0.f, sk = 0.f;
#pragma unroll
        for (int e = 0; e < 16; ++e) { sq += cq[e] * cq[e]; sk += ck[e] * ck[e]; }
        sq += __shfl_xor(sq, 1); sq += __shfl_xor(sq, 2); sk += __shfl_xor(sk, 1); sk += __shfl_xor(sk, 2);
        const float rq = rsqrtf(sq + EPS) * 0.125f, rk = rsqrtf(sk + EPS);
#pragma unroll
        for (int e = 0; e < 16; ++e) { cq[e] *= rq; ck[e] *= rk; }
        const float beta = BA[row * 8 + h], g = BA[row * 8 + 4 + h];
        *(LAS u32x4*)(qs + t * LDK + 16 * seg) = pack8(cq); *(LAS u32x4*)(qs + t * LDK + 16 * seg + 8) = pack8(cq + 8);
        *(LAS u32x4*)(ks + t * LDK + 16 * seg) = pack8(ck); *(LAS u32x4*)(ks + t * LDK + 16 * seg + 8) = pack8(ck + 8);
        if (seg == 0) { gcs[t] = g; betas[t] = beta; }
        __syncthreads();
        float x = gcs[lane];
#pragma unroll
        for (int o = 1; o < 64; o <<= 1) { const float y = __shfl_up(x, o); if (lane >= o) x += y; }
        const float gc_t = __shfl(x, t), gl = __shfl(x, 63);
        __syncthreads();
        if (wsg == 0) gcs[lane] = x;
        const float eg = __expf(gc_t), ed = __expf(gl - gc_t);
#pragma unroll
        for (int e = 0; e < 16; ++e) { const int i = 16 * seg + e;
            kdT[i * LDK + t] = (bf16_t)f2bf(ck[e] * ed); kbgT[i * LDK + t] = (bf16_t)f2bf(ck[e] * beta * eg); vbT[i * LDK + t] = (bf16_t)f2bf(cv[e] * beta); }
        { float qg[16];
#pragma unroll
          for (int e = 0; e < 16; ++e) qg[e] = cq[e] * eg;
          bf16_t* dst = (bf16_t*)(p.ws + DN_QG) + (size_t)ch * 4096 + t * 64 + 16 * seg;
          *(u32x4*)dst = pack8(qg); *(u32x4*)(dst + 8) = pack8(qg + 8); }
        __syncthreads();
        {
            f32x4 acc[4], acc2[4];
#pragma unroll
            for (int nt = 0; nt < 4; ++nt) { acc[nt] = (f32x4){0.f, 0.f, 0.f, 0.f}; acc2[nt] = (f32x4){0.f, 0.f, 0.f, 0.f}; }
            mm16x64(acc, ks, 16 * wsg, ks, fr, fq);
            mm16x64(acc2, ks, 16 * wsg, qs, fr, fq);
            const int r0 = 16 * wsg + 4 * fq;
            float gr[4], br[4];
#pragma unroll
            for (int r = 0; r < 4; ++r) { gr[r] = gcs[r0 + r]; br[r] = betas[r0 + r]; }
#pragma unroll
            for (int nt = 0; nt < 4; ++nt) { const int cc = 16 * nt + fr; const float gcol = gcs[cc];
#pragma unroll
                for (int r = 0; r < 4; ++r) { const int c = r0 + r;
                    Lf[c * 68 + cc] = (cc < c) ? br[r] * acc[nt][r] * __expf(gr[r] - gcol) : 0.f; }
                f32x4 iv;
#pragma unroll
                for (int r = 0; r < 4; ++r) { const int s = r0 + r;
                    iv[r] = (s <= cc) ? acc2[nt][r] * __expf(gcol - gr[r]) : 0.f; }
                *(u32x2*)((bf16_t*)(p.ws + DN_IN) + (size_t)ch * 4096 + cc * 64 + r0) = pack4(iv); }
        }
        __syncthreads();
        if (wsg == 0) {
            float T[64];
#pragma unroll
            for (int c = 0; c < 64; ++c) T[c] = 0.f;
            const float lanef = (float)lane;
#pragma unroll
            for (int c = 0; c < 64; ++c) {
                float d = lanef; if (c > 0) asm volatile("" : "+v"(d) : "v"(T[c - 1]));
                float a0 = fmaxf(0.f, 1.f - fabsf(d - (float)c)), a1 = 0.f, a2 = 0.f, a3 = 0.f;
#pragma unroll
                for (int s4 = 0; s4 < (c + 3) / 4; ++s4) { const f32x4 Lv = *(const LAS f32x4*)(Lf + c * 68 + 4 * s4);
                    a0 -= Lv.x * T[4 * s4]; a1 -= Lv.y * T[4 * s4 + 1]; a2 -= Lv.z * T[4 * s4 + 2]; a3 -= Lv.w * T[4 * s4 + 3]; }
                T[c] = (a0 + a1) + (a2 + a3);
            }
#pragma unroll
            for (int c = 0; c < 64; ++c) Tm[c * LDK + lane] = (bf16_t)f2bf(T[c]);
        }
        __syncthreads();
        {   f32x4 au[4], aw[4], awr[4];
#pragma unroll
            for (int nt = 0; nt < 4; ++nt) { au[nt] = (f32x4){0.f, 0.f, 0.f, 0.f}; aw[nt] = au[nt]; awr[nt] = au[nt]; }
            mm16x64(au, Tm, 16 * wsg, vbT, fr, fq);
            mm16x64(aw, Tm, 16 * wsg, kbgT, fr, fq);
            mm16x64(awr, kbgT, 16 * wsg, Tm, fr, fq);
            const int r0 = 16 * wsg + 4 * fq;
#pragma unroll
            for (int nt = 0; nt < 4; ++nt) { const int cc = 16 * nt + fr;
                const u32x2 pu = pack4(au[nt]);
                *(LAS u32x2*)(uT + cc * LDK + r0) = pu; *(u32x2*)((bf16_t*)(p.ws + DN_UT) + (size_t)ch * 4096 + cc * 64 + r0) = pu;
                *(LAS u32x2*)(wT + cc * LDK + r0) = pack4(aw[nt]);
                *(u32x2*)((bf16_t*)(p.ws + DN_W) + (size_t)ch * 4096 + cc * 64 + r0) = pack4(awr[nt]); }
        }
        __syncthreads();
        {   f32x4 am[4], an[4];
#pragma unroll
            for (int nt = 0; nt < 4; ++nt) { am[nt] = (f32x4){0.f, 0.f, 0.f, 0.f}; an[nt] = am[nt]; }
            mm16x64(am, wT, 16 * wsg, kdT, fr, fq);
            mm16x64(an, kdT, 16 * wsg, uT, fr, fq);
            const int r0 = 16 * wsg + 4 * fq; const float egl = __expf(gl);
#pragma unroll
            for (int nt = 0; nt < 4; ++nt) { const int cc = 16 * nt + fr; f32x4 mv;
#pragma unroll
                for (int r = 0; r < 4; ++r) mv[r] = ((r0 + r) == cc ? egl : 0.f) - am[nt][r];
                *(u32x2*)((bf16_t*)(p.ws + DN_M) + (size_t)ch * 4096 + cc * 64 + r0) = pack4(mv);
                *(f32x4*)((float*)(p.ws + DN_NT) + (size_t)ch * 4096 + cc * 64 + r0) = an[nt]; }
        }
        __syncthreads();
    }
}
#define SCAN_LOAD(A_, C_, n_) do { const bf16_t* M_ = Mb + (size_t)(n_) * 4096; const float* N_ = Nb + (size_t)(n_) * 4096; \
        _Pragma("unroll") for (int mt = 0; mt < 4; ++mt) { C_[mt] = *(const f32x4*)(N_ + j * 64 + 16 * mt + 4 * fq); \
            _Pragma("unroll") for (int ks = 0; ks < 2; ++ks) { A_[mt][ks][0] = *(const s16x4*)(M_ + (16 * mt + fr) * 64 + 32 * ks + 4 * fq); A_[mt][ks][1] = *(const s16x4*)(M_ + (16 * mt + fr) * 64 + 32 * ks + 16 + 4 * fq); } } } while (0)
#define SCAN_STORE(n_) do { bf16_t* ST_ = Sb + (size_t)(n_) * 4096; _Pragma("unroll") for (int mt = 0; mt < 4; ++mt) *(u32x2*)(ST_ + j * 64 + 16 * mt + 4 * fq) = pack4(S[mt]); } while (0)
#define SCAN_STEP(A_, C_) do { bf16x8 bfr_[2]; \
        _Pragma("unroll") for (int ks = 0; ks < 2; ++ks) { u32x4 w_; const u32x2 lo_ = pack4(S[2 * ks]), hi_ = pack4(S[2 * ks + 1]); w_.x = lo_.x; w_.y = lo_.y; w_.z = hi_.x; w_.w = hi_.y; bfr_[ks] = __builtin_bit_cast(bf16x8, w_); } \
        _Pragma("unroll") for (int mt = 0; mt < 4; ++mt) { f32x4 a_ = C_[mt]; \
            _Pragma("unroll") for (int ks = 0; ks < 2; ++ks) a_ = MFMA16(__builtin_shufflevector(A_[mt][ks][0], A_[mt][ks][1], 0, 1, 2, 3, 4, 5, 6, 7), bfr_[ks], a_); \
            S[mt] = a_; } } while (0)
DI void dn_scan_item(const Params& p, int item, int lane) {
    const int bh = item >> 2, js = item & 3, fr = lane & 15, fq = lane >> 4, j = 16 * js + fr;
    f32x4 S[4];
#pragma unroll
    for (int mt = 0; mt < 4; ++mt) S[mt] = (f32x4){0.f, 0.f, 0.f, 0.f};
    const bf16_t* Mb = (const bf16_t*)(p.ws + DN_M) + (size_t)bh * 64 * 4096;
    const float* Nb = (const float*)(p.ws + DN_NT) + (size_t)bh * 64 * 4096;
    bf16_t* Sb = (bf16_t*)(p.ws + DN_ST) + (size_t)bh * 64 * 4096;
    s16x4 aA[4][2][2], aB[4][2][2]; f32x4 cA[4], cB[4];
    SCAN_LOAD(aA, cA, 0); SCAN_LOAD(aB, cB, 1);
    for (int n = 0; n < 62; n += 2) {
        SCAN_STORE(n);     SCAN_STEP(aA, cA); SCAN_LOAD(aA, cA, n + 2);
        SCAN_STORE(n + 1); SCAN_STEP(aB, cB); if (n + 3 < 63) SCAN_LOAD(aB, cB, n + 3);
    }
    SCAN_STORE(62); SCAN_STEP(aA, cA);
    SCAN_STORE(63);
}
#undef SCAN_LOAD
#undef SCAN_STORE
#undef SCAN_STEP
DI void dn_out_phase(const Params& p, int l, LAS unsigned char* lds, int tid, int G) {
    const int sg = tid >> 8, lane = tid & 63, js = (tid >> 6) & 3, fr = lane & 15, fq = lane >> 4, j = 16 * js + fr;
    LAS float* ssb = (LAS float*)lds + sg * 256;
    const bf16_t* P = (const bf16_t*)(p.ws + WS_P);
    bf16_t* MIX = (bf16_t*)(p.ws + WS_H);
    const float gn = p.dn_g[l * 64 + j];
    for (int it = blockIdx.x; it < 2048; it += G) {
        const int ch = 2 * it + sg, b = ch >> 8, h = (ch >> 6) & 3, n = ch & 63;
        const bf16_t* W = (const bf16_t*)(p.ws + DN_W) + (size_t)ch * 4096; const bf16_t* QG = (const bf16_t*)(p.ws + DN_QG) + (size_t)ch * 4096;
        const bf16_t* IN = (const bf16_t*)(p.ws + DN_IN) + (size_t)ch * 4096; const bf16_t* ST = (const bf16_t*)(p.ws + DN_ST) + (size_t)ch * 4096;
        const bf16_t* UT = (const bf16_t*)(p.ws + DN_UT) + (size_t)ch * 4096;
        bf16x8 bS[2];
#pragma unroll
        for (int ks = 0; ks < 2; ++ks) bS[ks] = *(const bf16x8*)(ST + j * 64 + 32 * ks + 8 * fq);
        f32x4 vn[4], o[4];
#pragma unroll
        for (int mt = 0; mt < 4; ++mt) { f32x4 tt = (f32x4){0.f, 0.f, 0.f, 0.f};
#pragma unroll
            for (int ks = 0; ks < 2; ++ks) tt = MFMA16(*(const bf16x8*)(W + (16 * mt + fr) * 64 + 32 * ks + 8 * fq), bS[ks], tt);
            const u32x2 uu = *(const u32x2*)(UT + j * 64 + 16 * mt + 4 * fq);
            vn[mt] = (f32x4){bflo(uu.x) - tt[0], bfhi(uu.x) - tt[1], bflo(uu.y) - tt[2], bfhi(uu.y) - tt[3]}; }
        bf16x8 bV[2];
#pragma unroll
        for (int ks = 0; ks < 2; ++ks) { u32x4 w; const u32x2 lo = pack4(vn[2 * ks]), hi = pack4(vn[2 * ks + 1]); w.x = lo.x; w.y = lo.y; w.z = hi.x; w.w = hi.y; bV[ks] = __builtin_bit_cast(bf16x8, w); }
#pragma unroll
        for (int mt = 0; mt < 4; ++mt) { f32x4 a = (f32x4){0.f, 0.f, 0.f, 0.f};
#pragma unroll
            for (int ks = 0; ks < 2; ++ks) a = MFMA16(*(const bf16x8*)(QG + (16 * mt + fr) * 64 + 32 * ks + 8 * fq), bS[ks], a);
#pragma unroll
            for (int ks = 0; ks < 2; ++ks) { const s16x4 lo = *(const s16x4*)(IN + (16 * mt + fr) * 64 + 32 * ks + 4 * fq), hi = *(const s16x4*)(IN + (16 * mt + fr) * 64 + 32 * ks + 16 + 4 * fq);
                a = MFMA16(__builtin_shufflevector(lo, hi, 0, 1, 2, 3, 4, 5, 6, 7), bV[ks], a); }
            o[mt] = a; }
#pragma unroll
        for (int mt = 0; mt < 4; ++mt)
#pragma unroll
            for (int r = 0; r < 4; ++r) { float q = o[mt][r] * o[mt][r]; q += __shfl_xor(q, 1); q += __shfl_xor(q, 2); q += __shfl_xor(q, 4); q += __shfl_xor(q, 8);
                if (fr == 0) ssb[js * 64 + 16 * mt + 4 * fq + r] = q; }
        __syncthreads();
#pragma unroll
        for (int mt = 0; mt < 4; ++mt)
#pragma unroll
            for (int r = 0; r < 4; ++r) { const int c = 16 * mt + 4 * fq + r; const float tot = (ssb[c] + ssb[64 + c]) + (ssb[128 + c] + ssb[192 + c]);
                const float rinv = rsqrtf(tot * (1.f / 64.f) + EPS);
                const size_t row = (size_t)b * SEQ + n * 64 + c; const int mcol = 512 + h * 64 + j;
                const float gt = bf2f(P[row * NIN + C_GATE + mcol]);
                MIX[row * DM + mcol] = (bf16_t)f2bf(o[mt][r] * rinv * gn * siluf_(gt)); }
        __syncthreads();
    }
}

typedef __attribute__((address_space(1))) unsigned gu32;
#define XB_TMO      128
#define XB_XCNT(j)  (256  + 64 * (j))
#define XB_XSUB(j)  (1280 + 64 * (j))
#define XB_XGEN(j)  (2304 + 64 * (j))
#define XB_TOP      3328
#define XB_TOPGEN   3392
#define XCD_BAR_WORDS 3456
#define XB_SPIN_CAP (1u << 18)

__device__ __forceinline__ unsigned xb_ld(unsigned* p)              { return __hip_atomic_load(p, __ATOMIC_RELAXED, __HIP_MEMORY_SCOPE_AGENT); }
__device__ __forceinline__ unsigned xb_add(unsigned* p, unsigned v) { return __hip_atomic_fetch_add(p, v, __ATOMIC_RELAXED, __HIP_MEMORY_SCOPE_AGENT); }
__device__ __forceinline__ unsigned xb_xcc_id() { return (unsigned)__builtin_amdgcn_s_getreg((3 << 11) | 20) & 0xFu; }
#define XB_SPIN(cond, bar) do { unsigned _sp = 0; while (cond) { __builtin_amdgcn_s_sleep(1); \
    if ((++_sp & 255u) == 0u) { if (xb_ld(&(bar)[XB_TMO])) break; if (_sp > XB_SPIN_CAP) { atomicAdd(&(bar)[XB_TMO], 1u); break; } } } } while (0)

struct XcdBarrier {
    unsigned* bar; unsigned x;
    volatile LAS unsigned* st;
};

__device__ __forceinline__ XcdBarrier xcd_barrier_post(unsigned* bar, volatile LAS unsigned* st) {
    XcdBarrier b; b.bar = bar; b.x = xb_xcc_id(); b.st = st;
    if (threadIdx.x == 0) (void)xb_add(&bar[XB_XCNT(b.x)], 1u);
    return b;
}
__device__ __forceinline__ void xcd_barrier_complete(unsigned* bar, unsigned x, unsigned& nloc, unsigned& nx) {
    const unsigned G = gridDim.x * gridDim.y * gridDim.z;
    unsigned sum, cnt, mine, sp = 0u;
    for (;;) {
        sum = 0u; cnt = 0u; mine = 0u;
#pragma unroll
        for (unsigned j = 0; j < 16; ++j) { const unsigned c = xb_ld(&bar[XB_XCNT(j)]); sum += c; cnt += (c > 0u) ? 1u : 0u; mine = (j == x) ? c : mine; }
        if (sum == G) break;
        __builtin_amdgcn_s_sleep(1);
        if ((++sp & 255u) == 0u) { if (xb_ld(&bar[XB_TMO])) break; if (sp > XB_SPIN_CAP) { atomicAdd(&bar[XB_TMO], 1u); break; } }
    }
    nloc = mine > 0u ? mine : 1u; nx = cnt > 0u ? cnt : 1u;
}

__device__ __forceinline__ void xcd_barrier(const XcdBarrier& b, bool leader_thread) {
    asm volatile("s_waitcnt vmcnt(0)" ::: "memory");
    __syncthreads();
    if (leader_thread) {
        unsigned* bar = b.bar;
        __builtin_amdgcn_s_waitcnt(0);
        unsigned nloc = b.st[0], nx = b.st[1];
        if (nloc == 0u) { xcd_barrier_complete(bar, b.x, nloc, nx); b.st[0] = nloc; b.st[1] = nx; }
        const unsigned old = xb_add(&bar[XB_XSUB(b.x)], 1u);
        const unsigned gen = old / nloc;
        if (old + 1u == (gen + 1u) * nloc) {
            __builtin_amdgcn_fence(__ATOMIC_RELEASE, "agent");
            asm volatile("s_waitcnt vmcnt(0)" ::: "memory");
            const unsigned og = xb_add(&bar[XB_TOP], 1u);
            const unsigned tg = og / nx;
            if (og + 1u == (tg + 1u) * nx) xb_add(&bar[XB_TOPGEN], 1u);
            else XB_SPIN(xb_ld(&bar[XB_TOPGEN]) == tg, bar);
            __builtin_amdgcn_fence(__ATOMIC_ACQUIRE, "agent");
            xb_add(&bar[XB_XGEN(b.x)], 1u);
            asm volatile("s_waitcnt vmcnt(0)" ::: "memory");
        } else {
            XB_SPIN(xb_ld(&bar[XB_XGEN(b.x)]) == gen, bar);
            __builtin_amdgcn_fence(__ATOMIC_ACQUIRE, "agent");
            asm volatile("s_waitcnt vmcnt(0)" ::: "memory");
        }
    }
    __syncthreads();
}

enum { K_PREP = 0, K_INPROJ = 1, K_DNPREP = 2, K_ATTN = 3, K_DNOUT = 4, K_OUTPROJ = 5 };
constexpr int N_PHASES = 13;
namespace cg = cooperative_groups;
__global__ void __launch_bounds__(512, 2) mega(Params p, int ph_lo, int ph_hi) {
    extern __shared__ __attribute__((aligned(16))) unsigned char lds_raw[];
    LAS unsigned char* lds = (LAS unsigned char*)lds_raw;
    cg::grid_group grid = cg::this_grid();
    const int G = gridDim.x;
    const int wave_s = __builtin_amdgcn_readfirstlane(threadIdx.x >> 6);
    volatile LAS unsigned* MISC = (volatile LAS unsigned*)(lds + 147328);
    if (threadIdx.x < 32) MISC[threadIdx.x] = 0u;
    __syncthreads();
    XcdBarrier bar = xcd_barrier_post((unsigned*)(p.ws + WS_CTL) + 4096, MISC + 8);
    for (int ph = ph_lo; ph < ph_hi; ++ph) {
        const int l = ph / 6, kind = ph % 6;
        const int nrep = (ph != 12 && ((MK_REP >> kind) & 1)) ? 2 : 1;
        for (int rep = 0; rep < nrep; ++rep) {
#define PHASE_IDS int tid = wave_s * 64 + (int)__builtin_amdgcn_mbcnt_hi(~0u, __builtin_amdgcn_mbcnt_lo(~0u, 0u)); asm volatile("" : "+v"(tid)); const int lane = tid & 63, wave = wave_s; \
        const int gw = blockIdx.x * 8 + wave, ngw = G * 8; unsigned char* ws = p.ws; (void)lane; (void)wave; (void)gw; (void)ngw; (void)ws;
        if (ph == 12) { PHASE_IDS
            for (int row = gw; row < NTOK; row += ngw) final_row(p, row, lane);
        } else if (kind == K_PREP) { PHASE_IDS
            if (l == 0) { phase_init(p, lds, gw, ngw, wave, lane); __syncthreads(); }
            LAS float* w8s = (LAS float*)lds;
            for (int e = tid; e < 8 * DM; e += 512) { const int c = e & 7, kk = e >> 3; w8s[c * DM + kk] = p.w_in[(size_t)l * DM * INW + (size_t)kk * INW + 1536 + c]; }
            __syncthreads();
            if (l == 0) { for (int row = gw; row < NTOK; row += ngw) prep_row<false>(p, 0, row, lane, w8s); }
            else { for (int row = gw; row < NTOK; row += ngw) prep_row<true>(p, l, row, lane, w8s); }
            __syncthreads();
        } else if (kind == K_INPROJ) { PHASE_IDS
            { pg8::Gemm g{(const bf16_t*)(ws + WS_H), (const bf16_t*)(ws + WS_WIN) + (size_t)l * NIN * DM, NTOK, NIN, DM};
              pg8::StaticOrder S; S.init(NTOK, NIN, G, (int)blockIdx.x);
              EpiProj E{(bf16_t*)(ws + WS_P), (bf16_t*)(ws + WS_SVT)};
              pg8::gemm_phase<EpiProj, pg8::StaticOrder, true, true>(lds, g, S, E, tid); }
            if (l == 0) {
                for (int ll = 0; ll < DEPTH; ++ll) {
                    pg8::Gemm g{(const bf16_t*)(ws + WS_MEMN) + (size_t)ll * MEMROWS * DM, (const bf16_t*)(ws + WS_WMKV) + (size_t)ll * 512 * DM, MEMROWS, 512, DM};
                    pg8::StaticOrder S; S.init(MEMROWS, 512, G, (int)((blockIdx.x + G - 32 * ll) % G));
                    EpiMkv E{(bf16_t*)(ws + WS_MK) + (size_t)ll * MEMROWS * 256, (bf16_t*)(ws + WS_MVT) + (size_t)ll * MEMROWS * 256};
                    pg8::gemm_phase<EpiMkv, pg8::StaticOrder, true, true>(lds, g, S, E, tid);
                }
            }
        } else if (kind == K_DNPREP) { PHASE_IDS
            dn_prep_phase(p, l, lds, tid, G);
        } else if (kind == K_ATTN) { PHASE_IDS
            for (int srep = 0; srep < (((MK_REP >> 6) & 1) ? 2 : 1); ++srep)
            if (wave == 0) for (int item = blockIdx.x; item < 256; item += G) dn_scan_item(p, item, lane);
            attn_phase(p, l, lds, tid, G);
        } else if (kind == K_DNOUT) { PHASE_IDS
            dn_out_phase(p, l, lds, tid, G);
        } else { PHASE_IDS
            pg8::Gemm g{(const bf16_t*)(ws + WS_H), (const bf16_t*)(ws + WS_WOUT) + (size_t)l * DM * DM, NTOK, DM, DM};
            pg8::StaticOrder S; S.init(NTOK, DM, G, (int)blockIdx.x);
            EpiY E{(bf16_t*)(ws + WS_P), (float*)(ws + WS_STATS)};
            pg8::gemm_phase<EpiY, pg8::StaticOrder, true, true>(lds, g, S, E, tid);
        }
        if (rep + 1 < nrep) __syncthreads();
        }
        if (ph + 1 < ph_hi) { if (ph == ph_lo) grid.sync(); else xcd_barrier(bar, wave_s == 0 && __builtin_amdgcn_mbcnt_hi(~0u, __builtin_amdgcn_mbcnt_lo(~0u, 0u)) == 0u); }
    }
}

#ifndef MK_MULTI
#define MK_MULTI 0
#endif
extern "C" void kernel_launch(void* const* d_in, const int* in_sizes, int n_in, void* d_out, int out_size, void* d_ws, size_t ws_size, hipStream_t stream) {
    static int grid = 0;
    constexpr int LDS_BYTES = 147456;
    if (grid == 0) {
        if (n_in != 13 || ws_size < WS_END || out_size != NTOK * DM) { fprintf(stderr, "kernel_launch: unexpected n_in %d / ws_size %zu / out_size %d\n", n_in, ws_size, out_size); grid = -1; return; }
        int dev = 0, cus = 0, per_cu = 0;
        if (hipGetDevice(&dev) != hipSuccess || hipDeviceGetAttribute(&cus, hipDeviceAttributeMultiprocessorCount, dev) != hipSuccess) { grid = -1; return; }
        if (hipFuncSetAttribute((const void*)mega, hipFuncAttributeMaxDynamicSharedMemorySize, LDS_BYTES) != hipSuccess) { fprintf(stderr, "kernel_launch: hipFuncSetAttribute failed\n"); grid = -1; return; }
        if (hipOccupancyMaxActiveBlocksPerMultiprocessor(&per_cu, (const void*)mega, 512, LDS_BYTES) != hipSuccess || per_cu < 1) { fprintf(stderr, "kernel_launch: occupancy query failed (%d)\n", per_cu); grid = -1; return; }
        grid = cus * 1;
    }
    if (grid < 0) return;
    Params p{};
    p.x = (const float*)d_in[0]; p.mem = (const float*)d_in[1]; p.pre_g = (const float*)d_in[2]; p.w_in = (const float*)d_in[3]; p.conv_w = (const float*)d_in[4];
    p.a_log = (const float*)d_in[5]; p.dt_bias = (const float*)d_in[6]; p.sinks = (const float*)d_in[7]; p.dn_g = (const float*)d_in[8]; p.mem_g = (const float*)d_in[9];
    p.w_mkv = (const float*)d_in[10]; p.w_out = (const float*)d_in[11]; p.post_g = (const float*)d_in[12];
    p.out = (float*)d_out; p.ws = (unsigned char*)d_ws;
    if (hipMemsetAsync((char*)d_ws + WS_CTL, 0, 1 * MiB, stream) != hipSuccess) { fprintf(stderr, "kernel_launch: hipMemsetAsync failed\n"); return; }
#if MK_MULTI
    for (int ph = 0; ph < N_PHASES; ++ph) hipLaunchKernelGGL(mega, dim3(grid), dim3(512), LDS_BYTES, stream, p, ph, ph + 1);
#else
    int lo = 0, hi = N_PHASES;
    void* args[] = {&p, &lo, &hi};
    const hipError_t e = hipLaunchCooperativeKernel((const void*)mega, dim3(grid), dim3(512), args, LDS_BYTES, stream);
    if (e != hipSuccess) fprintf(stderr, "kernel_launch: cooperative launch failed: %s (grid %d)\n", hipGetErrorString(e), grid);
#endif
}
```

```cpp
#include <hip/hip_runtime.h>
#include <hip/hip_cooperative_groups.h>
#include <cstdio>
#include <cstdint>

#define DI __device__ __forceinline__
#ifndef MK_SEC
#define MK_SEC 0
#endif
#define SEC_BEGIN(id) long long t0_sec##id = 0; if (MK_SEC == id) t0_sec##id = clock64();
#define SEC_END(id) if (MK_SEC == id) { const long long dt_ = clock64() - t0_sec##id; const long long t1_ = clock64(); while (clock64() - t1_ < dt_) {} }
#ifndef MK_REP
#define MK_REP 0
#endif
#define LAS __attribute__((address_space(3)))
typedef unsigned short bf16_t;
typedef float f32x4 __attribute__((ext_vector_type(4)));
typedef unsigned u32x4 __attribute__((ext_vector_type(4)));
typedef unsigned u32x2 __attribute__((ext_vector_type(2)));

constexpr int DM = 1024, NB = 16, SEQ = 4096, NTOK = NB * SEQ, DEPTH = 2;
constexpr int INW = 2824;
constexpr int NIN = 2816;
constexpr int NMEM = 256, MEMROWS = NB * NMEM;
constexpr float EPS = 1e-6f;
constexpr int C_SQ = 0, C_SK = 512, C_SV = 640, C_DQ = 768, C_DK = 1024, C_DV = 1280, C_MQ = 1536, C_GATE = 1792;

constexpr size_t MiB = 1u << 20;
constexpr size_t WS_CTL = 0;
constexpr size_t WS_WIN = 1 * MiB;
constexpr size_t WS_WOUT = 12 * MiB;
constexpr size_t WS_WMKV = 16 * MiB;
constexpr size_t WS_W8 = 18 * MiB;
constexpr size_t WS_MEMN = 19 * MiB;
constexpr size_t WS_MK = 35 * MiB;
constexpr size_t WS_MVT = 39 * MiB;
constexpr size_t WS_BA = 43 * MiB;
constexpr size_t WS_STATS = 45 * MiB;
constexpr size_t WS_SVT = 49 * MiB;
constexpr size_t WS_H = 65 * MiB;
constexpr size_t WS_P = 193 * MiB;
constexpr size_t WS_DN = 545 * MiB;
constexpr size_t WS_END = 801 * MiB;

struct Params {
    const float *x, *mem, *pre_g, *w_in, *conv_w, *a_log, *dt_bias, *sinks, *dn_g, *mem_g, *w_mkv, *w_out, *post_g;
    float* out;
    unsigned char* ws;
};

DI unsigned f2bf(float f) { unsigned u = __float_as_uint(f); return (u + 0x7fffu + ((u >> 16) & 1u)) >> 16; }
DI unsigned pk2(float lo, float hi) { return f2bf(lo) | (f2bf(hi) << 16); }
DI float bf2f(unsigned u) { return __uint_as_float(u << 16); }
DI float bflo(unsigned u) { return __uint_as_float(u << 16); }
DI float bfhi(unsigned u) { return __uint_as_float(u & 0xffff0000u); }
DI float wave_sum(float v) {
#pragma unroll
    for (int o = 1; o < 64; o <<= 1) v += __shfl_xor(v, o);
    return v;
}
DI float sigmoidf_(float x) { return __builtin_amdgcn_rcpf(1.f + __builtin_amdgcn_exp2f(-1.4426950408889634f * x)); }
DI float siluf_(float x) { return x * __builtin_amdgcn_rcpf(1.f + __builtin_amdgcn_exp2f(-1.4426950408889634f * x)); }
DI float softplusf_(float x) { return x > 20.f ? x : log1pf(expf(x)); }

DI void transpose_item(const float* W, int Nsrc, int src_n0, int k0, bf16_t* WT, int K, int dst_n0, LAS float* scr, int lane) {
#pragma unroll 8
    for (int i = 0; i < 32; ++i) { const int kk = 2 * i + (lane >> 5); scr[kk * 33 + (lane & 31)] = W[(size_t)(k0 + kk) * Nsrc + src_n0 + (lane & 31)]; }
    asm volatile("s_waitcnt lgkmcnt(0)" ::: "memory");
    const int c = lane & 7;
#pragma unroll
    for (int j = 0; j < 4; ++j) {
        const int n = (lane >> 3) + 8 * j; const LAS float* s = scr + (8 * c) * 33 + n;
        u32x4 o; o.x = pk2(s[0 * 33], s[1 * 33]); o.y = pk2(s[2 * 33], s[3 * 33]); o.z = pk2(s[4 * 33], s[5 * 33]); o.w = pk2(s[6 * 33], s[7 * 33]);
        *(u32x4*)(WT + (size_t)(dst_n0 + n) * K + k0 + 8 * c) = o;
    }
    asm volatile("s_waitcnt lgkmcnt(0)" ::: "memory");
}

DI void phase_init(const Params& p, LAS unsigned char* lds, int gw, int ngw, int wave, int lane) {
    LAS float* scr = (LAS float*)(lds + wave * 16384);
    constexpr int I_IN = 16 * (NIN / 32), I_OUT = 16 * 32, I_MKV = 16 * 16, I_L = I_IN + I_OUT + I_MKV;
    for (int it = gw; it < DEPTH * I_L; it += ngw) {
        const int l = it / I_L; int r = it % I_L;
        if (r < I_IN) {
            const int kb = r / (NIN / 32), nb = r % (NIN / 32), n0 = nb * 32;
            transpose_item(p.w_in + (size_t)l * DM * INW, INW, n0 + (n0 >= 1536 ? 8 : 0), kb * 64, (bf16_t*)(p.ws + WS_WIN) + (size_t)l * NIN * DM, DM, n0, scr, lane);
        } else if (r < I_IN + I_OUT) {
            r -= I_IN; const int kb = r / 32, nb = r % 32;
            transpose_item(p.w_out + (size_t)l * DM * DM, DM, nb * 32, kb * 64, (bf16_t*)(p.ws + WS_WOUT) + (size_t)l * DM * DM, DM, nb * 32, scr, lane);
        } else {
            r -= I_IN + I_OUT; const int kb = r / 16, nb = r % 16;
            transpose_item(p.w_mkv + (size_t)l * DM * 512, 512, nb * 32, kb * 64, (bf16_t*)(p.ws + WS_WMKV) + (size_t)l * 512 * DM, DM, nb * 32, scr, lane);
        }
    }
    for (int it = gw; it < DEPTH * MEMROWS; it += ngw) {
        const int l = it / MEMROWS, row = it % MEMROWS;
        const f32x4* xr = (const f32x4*)(p.mem + (size_t)row * DM) + lane;
        f32x4 v[4]; float s = 0.f;
#pragma unroll
        for (int j = 0; j < 4; ++j) { v[j] = xr[64 * j]; s += (v[j].x * v[j].x + v[j].y * v[j].y) + (v[j].z * v[j].z + v[j].w * v[j].w); }
        const float r = rsqrtf(wave_sum(s) * (1.f / DM) + EPS);
        const f32x4* gr = (const f32x4*)(p.mem_g + (size_t)l * DM) + lane;
        u32x2* o = (u32x2*)((bf16_t*)(p.ws + WS_MEMN) + ((size_t)l * MEMROWS + row) * DM) + lane;
#pragma unroll
        for (int j = 0; j < 4; ++j) { const f32x4 g = gr[64 * j]; u32x2 w; w.x = pk2(v[j].x * r * g.x, v[j].y * r * g.y); w.y = pk2(v[j].z * r * g.z, v[j].w * r * g.w); o[64 * j] = w; }
    }
}

template <bool L1> DI void prep_row(const Params& p, int l, int row, int lane, const LAS float* W8) {
    const f32x4* xr = (const f32x4*)(p.x + (size_t)row * DM) + lane;
    f32x4 v[4];
#pragma unroll
    for (int j = 0; j < 4; ++j) v[j] = xr[64 * j];
    if (L1) {
        const f32x4* st = (const f32x4*)((const float*)(p.ws + WS_STATS) + (size_t)row * 16);
        const f32x4 s0 = st[0], s1 = st[1], s2 = st[2], s3 = st[3];
        const float ss = ((s0.x + s0.y) + (s0.z + s0.w)) + ((s1.x + s1.y) + (s1.z + s1.w)) + ((s2.x + s2.y) + (s2.z + s2.w)) + ((s3.x + s3.y) + (s3.z + s3.w));
        const float ry = rsqrtf(ss * (1.f / DM) + EPS);
        const u32x2* yr = (const u32x2*)((const bf16_t*)(p.ws + WS_P) + (size_t)row * DM) + lane;
        const f32x4* pg = (const f32x4*)(p.post_g + (size_t)(l - 1) * DM) + lane;
        f32x4* xo = (f32x4*)(p.out + (size_t)row * DM) + lane;
#pragma unroll
        for (int j = 0; j < 4; ++j) {
            const u32x2 y = yr[64 * j]; const f32x4 g = pg[64 * j];
            v[j].x += bflo(y.x) * ry * g.x; v[j].y += bfhi(y.x) * ry * g.y; v[j].z += bflo(y.y) * ry * g.z; v[j].w += bfhi(y.y) * ry * g.w;
            xo[64 * j] = v[j];
        }
    }
    float s = 0.f;
#pragma unroll
    for (int j = 0; j < 4; ++j) s += (v[j].x * v[j].x + v[j].y * v[j].y) + (v[j].z * v[j].z + v[j].w * v[j].w);
    const float r = rsqrtf(wave_sum(s) * (1.f / DM) + EPS);
    const f32x4* gr = (const f32x4*)(p.pre_g + (size_t)l * DM) + lane;
    u32x2* ho = (u32x2*)((bf16_t*)(p.ws + WS_H) + (size_t)row * DM) + lane;
#pragma unroll
    for (int j = 0; j < 4; ++j) {
        const f32x4 g = gr[64 * j];
        v[j].x *= r * g.x; v[j].y *= r * g.y; v[j].z *= r * g.z; v[j].w *= r * g.w;
        u32x2 w; w.x = pk2(v[j].x, v[j].y); w.y = pk2(v[j].z, v[j].w); ho[64 * j] = w;
    }
    float mine = 0.f;
#pragma unroll
    for (int c = 0; c < 8; ++c) {
        const LAS f32x4* wr = (const LAS f32x4*)(W8 + c * DM) + lane; float d = 0.f;
#pragma unroll
        for (int j = 0; j < 4; ++j) { const f32x4 w = wr[64 * j]; d += (v[j].x * w.x + v[j].y * w.y) + (v[j].z * w.z + v[j].w * w.w); }
        d = wave_sum(d);
        mine = (lane == c) ? d : mine;
    }
    if (lane < 8) {
        float o;
        if (lane < 4) o = sigmoidf_(mine);
        else { const int h = lane - 4; o = -__expf(p.a_log[l * 4 + h]) * softplusf_(mine + p.dt_bias[l * 4 + h]); }
        ((float*)(p.ws + WS_BA))[(size_t)row * 8 + lane] = o;
    }
}

DI void final_row(const Params& p, int row, int lane) {
    const f32x4* st = (const f32x4*)((const float*)(p.ws + WS_STATS) + (size_t)row * 16);
    const f32x4 s0 = st[0], s1 = st[1], s2 = st[2], s3 = st[3];
    const float ss = ((s0.x + s0.y) + (s0.z + s0.w)) + ((s1.x + s1.y) + (s1.z + s1.w)) + ((s2.x + s2.y) + (s2.z + s2.w)) + ((s3.x + s3.y) + (s3.z + s3.w));
    const float ry = rsqrtf(ss * (1.f / DM) + EPS);
    const u32x2* yr = (const u32x2*)((const bf16_t*)(p.ws + WS_P) + (size_t)row * DM) + lane;
    const f32x4* pg = (const f32x4*)(p.post_g + (size_t)(DEPTH - 1) * DM) + lane;
    f32x4* xo = (f32x4*)(p.out + (size_t)row * DM) + lane;
#pragma unroll
    for (int j = 0; j < 4; ++j) {
        const u32x2 y = yr[64 * j]; const f32x4 g = pg[64 * j]; f32x4 v = xo[64 * j];
        v.x += bflo(y.x) * ry * g.x; v.y += bfhi(y.x) * ry * g.y; v.z += bflo(y.y) * ry * g.z; v.w += bfhi(y.y) * ry * g.w;
        xo[64 * j] = v;
    }
}


namespace pg8 {
#define PG8_LAS __attribute__((address_space(3)))
typedef unsigned short bf16_t;
typedef short bf16x8 __attribute__((ext_vector_type(8)));
typedef float f32x4 __attribute__((ext_vector_type(4)));
typedef unsigned u32x4 __attribute__((ext_vector_type(4)));
constexpr int BM = 256, BK = 64, HALF = 128, HTB = HALF * BK * 2  , STAGE_BYTES = 8 * HTB, NXCD = 8, WGM = 8;

__host__ __device__ __forceinline__ int lds_byte(int r, int c) { const int st = (r >> 4) * 2 + (c >> 5), rr = r & 15, cc = c & 31, ob = rr * 64 + cc * 2; return st * 1024 + (ob ^ (((ob >> 9) & 1) << 5)); }
__host__ __device__ __forceinline__ void stage_rc(int b, int& R, int& C) { const int st = b / 1024, sb = b % 1024, swz = sb ^ (((sb >> 9) & 1) << 5); R = (st >> 1) * 16 + swz / 64; C = (st & 1) * 32 + (swz % 64) / 2; }
__host__ __device__ __forceinline__ int perm32(int rho) { const int n = rho >> 4, i = rho & 15; return 8 * (i >> 2) + 4 * n + (i & 3); }

struct Unit { int pm, pn; };
struct Gemm { const bf16_t* A; const bf16_t* Bt; int M, N, K; };

struct StaticOrder {
    int nM, nN, nwg, G, c;
    __host__ __device__ void init(int M, int N, int G_, int c_) { nM = M / BM; nN = N / BM; nwg = nM * nN; G = G_; c = c_; }
    __host__ __device__ bool next(int i, Unit& u) const {
        const long L = (long)i * G + c; if (L >= nwg) return false;
        int wgid = (int)L; { const int q = nwg / NXCD, r = nwg % NXCD, xcd = wgid % NXCD, off = wgid / NXCD; wgid = (xcd < r ? xcd * (q + 1) : r * (q + 1) + (xcd - r) * q) + off; }
        const int nig = WGM * nN, gid = wgid / nig, fm = gid * WGM, gsz = (nM - fm) < WGM ? (nM - fm) : WGM;
        u.pm = fm + ((wgid % nig) % gsz); u.pn = (wgid % nig) / gsz; return true;
    }
    __device__ __forceinline__ void a_ready(const Unit&) const {}
    __device__ __forceinline__ void done(const Unit&) const {}
};

__device__ __forceinline__ unsigned cvt_pk_bf16(float lo, float hi) { unsigned r; asm volatile("v_cvt_pk_bf16_f32 %0, %1, %2" : "=v"(r) : "v"(lo), "v"(hi)); return r; }
template <class Epi, class Sched, bool ALIGN_EPI = false, bool SP2 = false>
__device__ __forceinline__ void gemm_phase(PG8_LAS unsigned char* lds, const Gemm g, const Sched& S, const Epi& E, int tid_in) {
    int tid = tid_in; asm volatile("" : "+v"(tid));
    const int wid = __builtin_amdgcn_readfirstlane(tid >> 6), lane = tid & 63, wr = wid >> 2, wc = wid & 3, fr = lane & 15, fq = lane >> 4;
    const int K = g.K, nt = K / BK;
    unsigned voffA[2], voffB[2];
#pragma unroll
    for (int i = 0; i < 2; ++i) { int R, C; stage_rc(tid * 16 + i * 8192, R, C); const int Rb = Epi::PERM ? ((R & ~31) + perm32(R & 31)) : R;
        voffA[i] = (unsigned)(R * K + C) * 2u; voffB[i] = (unsigned)(Rb * K + C) * 2u; }
    const size_t kstep = (size_t)(BK * 2);
    const size_t hstep = (size_t)HALF * K * 2;
    const size_t tstep = 2 * hstep;
    const unsigned ldsw = (unsigned)wid * 1024u;
    const int aoff = lds_byte(wr * 64 + fr, fq * 8), boff = lds_byte(wc * 32 + fr, fq * 8);
#define PG8_SA(b, h) (((b) * 2 + (h)) * HTB)
#define PG8_SB(b, h) ((4 + (b) * 2 + (h)) * HTB)
#define PG8_STAGE(bufoff, gbase, voff) do { _Pragma("unroll") for (int _i = 0; _i < 2; ++_i) \
        __builtin_amdgcn_global_load_lds((const unsigned*)((const char*)(gbase) + (voff)[_i]), (PG8_LAS unsigned*)(lds + (bufoff) + ldsw + _i * 8192), 16, 0, 0); } while (0)
#define PG8_LDA(dst, b, h) do { _Pragma("unroll") for (int m = 0; m < 4; ++m) _Pragma("unroll") for (int k = 0; k < 2; ++k) dst[m][k] = *(const PG8_LAS bf16x8*)(lds + PG8_SA(b, h) + aoff + m * 2048 + k * 1024); } while (0)
#define PG8_LDB(dst, b, h) do { _Pragma("unroll") for (int n = 0; n < 2; ++n) _Pragma("unroll") for (int k = 0; k < 2; ++k) dst[n][k] = *(const PG8_LAS bf16x8*)(lds + PG8_SB(b, h) + boff + n * 2048 + k * 1024); } while (0)
#define PG8_MMA(ai, bj, At, Bt) do { __builtin_amdgcn_s_setprio(1); _Pragma("unroll") for (int m = 0; m < 4; ++m) _Pragma("unroll") for (int n = 0; n < 2; ++n) _Pragma("unroll") for (int k = 0; k < 2; ++k) \
        acc[ai][bj][m][n] = __builtin_amdgcn_mfma_f32_16x16x32_bf16(Bt[n][k], At[m][k], acc[ai][bj][m][n], 0, 0, 0); __builtin_amdgcn_s_setprio(0); } while (0)
#define PG8_WAIT_V(n) asm volatile("s_waitcnt vmcnt(" #n ")" ::: "memory")
#define PG8_WAIT_L(n) asm volatile("s_waitcnt lgkmcnt(" #n ")" ::: "memory")
#define PG8_BAR __builtin_amdgcn_s_barrier()
#define PG8_SCHED __builtin_amdgcn_sched_barrier(0)
    Unit cur, nxt; int ui = 0;
    if (!S.next(0, cur)) return;
    f32x4 acc[2][2][4][2];
#pragma unroll
    for (int a = 0; a < 2; ++a)
#pragma unroll
        for (int b = 0; b < 2; ++b)
#pragma unroll
            for (int m = 0; m < 4; ++m)
#pragma unroll
                for (int n = 0; n < 2; ++n) acc[a][b][m][n] = (f32x4){0.f, 0.f, 0.f, 0.f};
    bf16x8 At[4][2], B0[2][2], B1[2][2];
    const char* cA = (const char*)g.A + (size_t)cur.pm * tstep; const char* cB = (const char*)g.Bt + (size_t)cur.pn * tstep;
    S.a_ready(cur);
    if constexpr (SP2) {
        PG8_STAGE(PG8_SB(0, 0), cB, voffB); PG8_STAGE(PG8_SB(0, 1), cB + hstep, voffB); PG8_STAGE(PG8_SA(0, 0), cA, voffA); PG8_STAGE(PG8_SA(0, 1), cA + hstep, voffA);
        if (wr == 1) PG8_BAR;
        PG8_WAIT_V(2); PG8_BAR;
        PG8_STAGE(PG8_SB(1, 0), cB + kstep, voffB); PG8_STAGE(PG8_SA(1, 0), cA + kstep, voffA); PG8_STAGE(PG8_SB(1, 1), cB + hstep + kstep, voffB);
        PG8_WAIT_V(6); PG8_BAR;
    } else {
        PG8_STAGE(PG8_SB(0, 0), cB, voffB); PG8_STAGE(PG8_SA(0, 0), cA, voffA); PG8_STAGE(PG8_SB(0, 1), cB + hstep, voffB); PG8_STAGE(PG8_SA(0, 1), cA + hstep, voffA);
        if (wr == 1) PG8_BAR;
        PG8_WAIT_V(4); PG8_BAR;
        PG8_STAGE(PG8_SB(1, 0), cB + kstep, voffB); PG8_STAGE(PG8_SA(1, 0), cA + kstep, voffA); PG8_STAGE(PG8_SB(1, 1), cB + hstep + kstep, voffB);
        PG8_WAIT_V(6); PG8_BAR;
    }
    for (;;) {
        const bool has_next = S.next(ui + 1, nxt);
        const char* nA = has_next ? (const char*)g.A + (size_t)nxt.pm * tstep : cA; const char* nB = has_next ? (const char*)g.Bt + (size_t)nxt.pn * tstep : cB;
        for (int t = 0; t < nt; t += 2) {
            const bool last = (t == nt - 2);
            const char* a1 = cA + (size_t)(t + 1) * kstep;
            const char* a2 = last ? nA : cA + (size_t)(t + 2) * kstep; const char* b2 = last ? nB : cB + (size_t)(t + 2) * kstep;
            const char* a3 = a2 + kstep; const char* b3 = b2 + kstep;
            if (last && has_next) S.a_ready(nxt);
            if constexpr (SP2) {
            PG8_LDB(B0, 0, 0); PG8_LDB(B1, 0, 1); PG8_SCHED; PG8_LDA(At, 0, 0); PG8_STAGE(PG8_SA(1, 1), a1 + hstep, voffA);
            PG8_WAIT_V(8); PG8_WAIT_L(0); PG8_BAR; PG8_MMA(0, 0, At, B0); PG8_MMA(0, 1, At, B1); PG8_BAR; PG8_SCHED;
            PG8_LDA(At, 0, 1); PG8_STAGE(PG8_SB(0, 0), b2, voffB); PG8_STAGE(PG8_SB(0, 1), b2 + hstep, voffB); PG8_STAGE(PG8_SA(0, 0), a2, voffA);
            PG8_WAIT_V(8); PG8_WAIT_L(0); PG8_BAR; PG8_MMA(1, 0, At, B0); PG8_MMA(1, 1, At, B1); PG8_BAR; PG8_SCHED;
            PG8_LDB(B0, 1, 0); PG8_LDB(B1, 1, 1); PG8_SCHED; PG8_LDA(At, 1, 0); PG8_STAGE(PG8_SA(0, 1), a2 + hstep, voffA);
            PG8_WAIT_V(8); PG8_WAIT_L(0); PG8_BAR; PG8_MMA(0, 0, At, B0); PG8_MMA(0, 1, At, B1); PG8_BAR; PG8_SCHED;
            PG8_LDA(At, 1, 1); PG8_STAGE(PG8_SB(1, 0), b3, voffB); PG8_STAGE(PG8_SB(1, 1), b3 + hstep, voffB); PG8_STAGE(PG8_SA(1, 0), a3, voffA);
            PG8_WAIT_V(8); PG8_WAIT_L(0); PG8_BAR; PG8_MMA(1, 0, At, B0); PG8_MMA(1, 1, At, B1); PG8_BAR; PG8_SCHED;
            } else {
            PG8_LDB(B0, 0, 0); PG8_SCHED; PG8_LDA(At, 0, 0); PG8_STAGE(PG8_SA(1, 1), a1 + hstep, voffA);
            PG8_WAIT_L(8); PG8_BAR; PG8_WAIT_L(0); PG8_MMA(0, 0, At, B0); PG8_BAR; PG8_SCHED;
            PG8_LDB(B1, 0, 1); PG8_STAGE(PG8_SB(0, 0), b2, voffB);
            PG8_BAR; PG8_WAIT_L(0); PG8_MMA(0, 1, At, B1); PG8_BAR;
            PG8_LDA(At, 0, 1); PG8_STAGE(PG8_SA(0, 0), a2, voffA);
            PG8_BAR; PG8_WAIT_L(0); PG8_MMA(1, 0, At, B0); PG8_BAR; PG8_SCHED;
            PG8_STAGE(PG8_SB(0, 1), b2 + hstep, voffB);
            PG8_WAIT_V(6); PG8_BAR; PG8_MMA(1, 1, At, B1); PG8_BAR;
            PG8_LDB(B0, 1, 0); PG8_SCHED; PG8_LDA(At, 1, 0); PG8_STAGE(PG8_SA(0, 1), a2 + hstep, voffA);
            PG8_WAIT_L(8); PG8_BAR; PG8_WAIT_L(0); PG8_MMA(0, 0, At, B0); PG8_BAR; PG8_SCHED;
            PG8_LDB(B1, 1, 1); PG8_STAGE(PG8_SB(1, 0), b3, voffB);
            PG8_BAR; PG8_WAIT_L(0); PG8_MMA(0, 1, At, B1); PG8_BAR;
            PG8_LDA(At, 1, 1); PG8_STAGE(PG8_SA(1, 0), a3, voffA);
            PG8_BAR; PG8_WAIT_L(0); PG8_MMA(1, 0, At, B0); PG8_BAR; PG8_SCHED;
            PG8_STAGE(PG8_SB(1, 1), b3 + hstep, voffB);
            PG8_WAIT_V(6); PG8_BAR; PG8_MMA(1, 1, At, B1); PG8_BAR;
            }
        }
        if constexpr (ALIGN_EPI) { if (wr == 0) PG8_BAR; }
        if constexpr (!Epi::AFTER_DRAIN) { E(acc, cur, wr, wc, fr, fq); S.done(cur); }
        if (!has_next) break;
#pragma unroll
        for (int a = 0; a < 2; ++a)
#pragma unroll
            for (int b = 0; b < 2; ++b)
#pragma unroll
                for (int m = 0; m < 4; ++m)
#pragma unroll
                    for (int n = 0; n < 2; ++n) acc[a][b][m][n] = (f32x4){0.f, 0.f, 0.f, 0.f};
        cur = nxt; cA = nA; cB = nB; ++ui;
        if constexpr (ALIGN_EPI) { if (wr == 1) PG8_BAR; }
    }
    PG8_WAIT_V(0);
    if constexpr (!ALIGN_EPI) { if (wr == 0) PG8_BAR; }
    PG8_BAR;
    if constexpr (Epi::AFTER_DRAIN) { E.fused(acc, cur, wr, wc, fr, fq, lds, wid, lane); S.done(cur); }
#undef PG8_SA
#undef PG8_SB
#undef PG8_STAGE
#undef PG8_LDA
#undef PG8_LDB
#undef PG8_MMA
#undef PG8_WAIT_V
#undef PG8_WAIT_L
#undef PG8_BAR
#undef PG8_SCHED
}
}
using pg8::cvt_pk_bf16;
struct EpiProj {
    static constexpr bool PERM = true, AFTER_DRAIN = false;
    bf16_t* O; bf16_t* svT;
    DI void operator()(const f32x4 (&acc)[2][2][4][2], const pg8::Unit& u, int wr, int wc, int fr, int fq) const {
        const int row0 = u.pm * 256 + wr * 64 + fr, col0 = u.pn * 256 + wc * 32 + 8 * fq;
#pragma unroll
        for (int ai = 0; ai < 2; ++ai)
#pragma unroll
            for (int m = 0; m < 4; ++m) { bf16_t* rowp = O + (size_t)(row0 + ai * 128 + m * 16) * NIN + col0;
#pragma unroll
                for (int bj = 0; bj < 2; ++bj) { const f32x4 v0 = acc[ai][bj][m][0], v1 = acc[ai][bj][m][1];
                    u32x4 w; w.x = cvt_pk_bf16(v0[0], v0[1]); w.y = cvt_pk_bf16(v0[2], v0[3]); w.z = cvt_pk_bf16(v1[0], v1[1]); w.w = cvt_pk_bf16(v1[2], v1[3]);
                    *(u32x4*)(rowp + bj * 128) = w; } }
        if (u.pn == 2) {
#pragma unroll
            for (int ai = 0; ai < 2; ++ai)
#pragma unroll
                for (int m = 0; m < 4; ++m) { const int row = row0 + ai * 128 + m * 16, b = row >> 12, s = row & (SEQ - 1);
#pragma unroll
                    for (int n = 0; n < 2; ++n)
#pragma unroll
                        for (int e = 0; e < 4; ++e) { const int c = wc * 32 + 8 * fq + 4 * n + e;
                            svT[((size_t)(b * 2 + (c >> 6)) * 64 + (c & 63)) * SEQ + s] = (bf16_t)f2bf(acc[ai][1][m][n][e]); } }
        }
    }
};
struct EpiMkv {
    static constexpr bool PERM = true, AFTER_DRAIN = false;
    bf16_t* mk; bf16_t* mvT;
    DI void operator()(const f32x4 (&acc)[2][2][4][2], const pg8::Unit& u, int wr, int wc, int fr, int fq) const {
        const int row0 = u.pm * 256 + wr * 64 + fr;
#pragma unroll
        for (int ai = 0; ai < 2; ++ai)
#pragma unroll
            for (int m = 0; m < 4; ++m) { const int row = row0 + ai * 128 + m * 16;
                if (u.pn == 0) {
#pragma unroll
                    for (int bj = 0; bj < 2; ++bj) { const f32x4 v0 = acc[ai][bj][m][0], v1 = acc[ai][bj][m][1];
                        u32x4 w; w.x = cvt_pk_bf16(v0[0], v0[1]); w.y = cvt_pk_bf16(v0[2], v0[3]); w.z = cvt_pk_bf16(v1[0], v1[1]); w.w = cvt_pk_bf16(v1[2], v1[3]);
                        *(u32x4*)(mk + (size_t)row * 256 + bj * 128 + wc * 32 + 8 * fq) = w; }
                } else { const int b = row >> 8, mm = row & 255;
#pragma unroll
                    for (int bj = 0; bj < 2; ++bj)
#pragma unroll
                        for (int n = 0; n < 2; ++n)
#pragma unroll
                            for (int e = 0; e < 4; ++e) { const int c = bj * 128 + wc * 32 + 8 * fq + 4 * n + e;
                                mvT[((size_t)(b * 4 + (c >> 6)) * 64 + (c & 63)) * NMEM + mm] = (bf16_t)f2bf(acc[ai][bj][m][n][e]); } }
            }
    }
};
struct EpiY {
    static constexpr bool PERM = true, AFTER_DRAIN = false;
    bf16_t* Y; float* stats;
    DI void operator()(const f32x4 (&acc)[2][2][4][2], const pg8::Unit& u, int wr, int wc, int fr, int fq) const {
        const int row0 = u.pm * 256 + wr * 64 + fr, col0 = u.pn * 256 + wc * 32 + 8 * fq;
#pragma unroll
        for (int ai = 0; ai < 2; ++ai)
#pragma unroll
            for (int m = 0; m < 4; ++m) { const int row = row0 + ai * 128 + m * 16; bf16_t* rowp = Y + (size_t)row * DM + col0; float ss = 0.f;
#pragma unroll
                for (int bj = 0; bj < 2; ++bj) { const f32x4 v0 = acc[ai][bj][m][0], v1 = acc[ai][bj][m][1];
                    ss += (v0[0] * v0[0] + v0[1] * v0[1]) + (v0[2] * v0[2] + v0[3] * v0[3]) + (v1[0] * v1[0] + v1[1] * v1[1]) + (v1[2] * v1[2] + v1[3] * v1[3]);
                    u32x4 w; w.x = cvt_pk_bf16(v0[0], v0[1]); w.y = cvt_pk_bf16(v0[2], v0[3]); w.z = cvt_pk_bf16(v1[0], v1[1]); w.w = cvt_pk_bf16(v1[2], v1[3]);
                    *(u32x4*)(rowp + bj * 128) = w; }
                ss += __shfl_xor(ss, 16); ss += __shfl_xor(ss, 32);
                if (fq == 0) stats[(size_t)row * 16 + u.pn * 4 + wc] = ss; }
    }
};

typedef short bf16x8 __attribute__((ext_vector_type(8)));
typedef short s16x4 __attribute__((ext_vector_type(4)));
typedef float f32x16 __attribute__((ext_vector_type(16)));
typedef float f32x2_t __attribute__((ext_vector_type(2)));
typedef __bf16 bf16x2_t __attribute__((ext_vector_type(2)));
DI unsigned cvtpk(float lo, float hi) { f32x2_t v = {lo, hi}; bf16x2_t b = __builtin_convertvector(v, bf16x2_t); return __builtin_bit_cast(unsigned, b); }
#define MFMA32(a, b, c) __builtin_amdgcn_mfma_f32_32x32x16_bf16((a), (b), (c), 0, 0, 0)
#define MFMA16(a, b, c) __builtin_amdgcn_mfma_f32_16x16x32_bf16((a), (b), (c), 0, 0, 0)
constexpr int KROW = 144;
constexpr int SWA_VS = 392, MEM_VS = 520;
constexpr int SWA_IMG = 192 * KROW + 64 * SWA_VS;
constexpr int MEM_IMG = 256 * KROW + 64 * MEM_VS;
constexpr int ATT_STAGE = 2 * SWA_IMG;
static_assert(ATT_STAGE + 8 * 4608 <= 147328 && MEM_IMG <= ATT_STAGE, "attention LDS map");

DI void attn_wave(f32x16& o0, f32x16& o1, float& lsum, float m, const bf16x8 (&qf)[4], const LAS unsigned char* Kimg, const LAS unsigned char* VTimg, int vs,
                  int st0, int st1, int st_lo, int st_hi, int r, int h) {
    constexpr float SC = 0.125f * 1.4426950408889634f;
#pragma unroll
    for (int i = 0; i < 16; ++i) { o0[i] = 0.f; o1[i] = 0.f; }
    for (int st = st0; st < st1; ++st) {
        const LAS unsigned char* kp = Kimg + (32 * st + r) * KROW + 16 * h;
        bf16x8 kf[4];
#pragma unroll
        for (int ks = 0; ks < 4; ++ks) kf[ks] = *(const LAS bf16x8*)(kp + 32 * ks);
        const LAS unsigned char* vp = VTimg + r * vs + (32 * st + 4 * h) * 2;
        s16x4 va[2][2][2];
#pragma unroll
        for (int dt = 0; dt < 2; ++dt)
#pragma unroll
            for (int ss = 0; ss < 2; ++ss)
#pragma unroll
                for (int hf = 0; hf < 2; ++hf) va[dt][ss][hf] = *(const LAS s16x4*)(vp + dt * 32 * vs + (16 * ss + 8 * hf) * 2);
        f32x16 s;
#pragma unroll
        for (int i = 0; i < 16; ++i) s[i] = 0.f;
#pragma unroll
        for (int ks = 0; ks < 4; ++ks) s = MFMA32(kf[ks], qf[ks], s);
        if (st == st_lo || st == st_hi) {
            const bool lo = st == st_lo;
#pragma unroll
            for (int i = 0; i < 16; ++i) { const int c = (i & 3) + 8 * (i >> 2) + 4 * h; const bool ok = lo ? (c > r) : (c <= r); s[i] = ok ? s[i] : -1e30f; }
        }
        float tm = fmaxf(fmaxf(s[0], s[1]), fmaxf(s[2], s[3]));
#pragma unroll
        for (int i = 4; i < 16; i += 4) tm = fmaxf(fmaxf(tm, fmaxf(s[i], s[i + 1])), fmaxf(s[i + 2], s[i + 3]));
        tm = fmaxf(tm, __shfl_xor(tm, 32)) * SC;
        if (__any(tm > m)) {
            const float mn = fmaxf(m, tm), alpha = __builtin_amdgcn_exp2f(m - mn);
            m = mn; lsum *= alpha;
#pragma unroll
            for (int i = 0; i < 16; ++i) { o0[i] *= alpha; o1[i] *= alpha; }
        }
        float ps = 0.f;
#pragma unroll
        for (int i = 0; i < 16; ++i) { s[i] = __builtin_amdgcn_exp2f(__builtin_fmaf(s[i], SC, -m)); ps += s[i]; }
        lsum += ps;
#pragma unroll
        for (int ss = 0; ss < 2; ++ss) {
            u32x4 pw; pw.x = cvtpk(s[8 * ss + 0], s[8 * ss + 1]); pw.y = cvtpk(s[8 * ss + 2], s[8 * ss + 3]); pw.z = cvtpk(s[8 * ss + 4], s[8 * ss + 5]); pw.w = cvtpk(s[8 * ss + 6], s[8 * ss + 7]);
            const bf16x8 pf = __builtin_bit_cast(bf16x8, pw);
            const bf16x8 v0 = __builtin_shufflevector(va[0][ss][0], va[0][ss][1], 0, 1, 2, 3, 4, 5, 6, 7);
            const bf16x8 v1 = __builtin_shufflevector(va[1][ss][0], va[1][ss][1], 0, 1, 2, 3, 4, 5, 6, 7);
            o0 = MFMA32(v0, pf, o0); o1 = MFMA32(v1, pf, o1);
        }
    }
    lsum += __shfl_xor(lsum, 32);
}
DI u32x4 ldg16(const void* base, unsigned off) { return *(const u32x4*)((const char*)base + off); }
DI void attn_gate_load(u32x4 (&gv)[4], const bf16_t* gbase  , int lane) {
    const unsigned off = (unsigned)((lane >> 3) * NIN + 8 * (lane & 7)) * 2u;
#pragma unroll
    for (int i = 0; i < 4; ++i) gv[i] = ldg16(gbase + (size_t)i * 8 * NIN, off);
}
DI void attn_store(const f32x16& o0, const f32x16& o1, float lsum, const u32x4 (&gvv)[4], LAS unsigned char* stg, bf16_t* obase  , int lane) {
    const int r = lane & 31, h = lane >> 5;
    const float inv = 1.f / lsum;
#pragma unroll
    for (int g4 = 0; g4 < 4; ++g4) {
        u32x2 w0, w1;
        w0.x = cvtpk(o0[4 * g4 + 0] * inv, o0[4 * g4 + 1] * inv); w0.y = cvtpk(o0[4 * g4 + 2] * inv, o0[4 * g4 + 3] * inv);
        w1.x = cvtpk(o1[4 * g4 + 0] * inv, o1[4 * g4 + 1] * inv); w1.y = cvtpk(o1[4 * g4 + 2] * inv, o1[4 * g4 + 3] * inv);
        *(LAS u32x2*)(stg + r * 144 + (8 * g4 + 4 * h) * 2) = w0;
        *(LAS u32x2*)(stg + r * 144 + (32 + 8 * g4 + 4 * h) * 2) = w1;
    }
    asm volatile("s_waitcnt lgkmcnt(0)" ::: "memory");
    const unsigned ooff = (unsigned)((lane >> 3) * DM + 8 * (lane & 7)) * 2u;
    const LAS unsigned char* sp = stg + (lane >> 3) * 144 + 16 * (lane & 7);
#pragma unroll
    for (int i = 0; i < 4; ++i) {
        const u32x4 ov = *(const LAS u32x4*)(sp + i * 8 * 144);
        const u32x4 gv = gvv[i];
        u32x4 w;
        w.x = cvtpk(bflo(ov.x) * siluf_(bflo(gv.x)), bfhi(ov.x) * siluf_(bfhi(gv.x)));
        w.y = cvtpk(bflo(ov.y) * siluf_(bflo(gv.y)), bfhi(ov.y) * siluf_(bfhi(gv.y)));
        w.z = cvtpk(bflo(ov.z) * siluf_(bflo(gv.z)), bfhi(ov.z) * siluf_(bfhi(gv.z)));
        w.w = cvtpk(bflo(ov.w) * siluf_(bflo(gv.w)), bfhi(ov.w) * siluf_(bfhi(gv.w)));
        *(u32x4*)((char*)(obase + (size_t)i * 8 * DM) + ooff) = w;
    }
    asm volatile("s_waitcnt lgkmcnt(0)" ::: "memory");
}
DI void attn_phase(const Params& p, int l, LAS unsigned char* lds, int tid, int G) {
    const int lane = tid & 63, wave = __builtin_amdgcn_readfirstlane(tid >> 6), r = lane & 31, h = lane >> 5;
    const bf16_t* P = (const bf16_t*)(p.ws + WS_P);
    bf16_t* MIX = (bf16_t*)(p.ws + WS_H);
    LAS unsigned char* stg = lds + ATT_STAGE + wave * 4608;
    const unsigned qoff = (unsigned)(r * NIN + 8 * h) * 2u;
    for (int cc = blockIdx.x; cc < 256; cc += G) {
        {
            const int bk = cc >> 3, b = bk >> 1, kvh = bk & 1, qb0 = (cc & 7) * 8;
            const int g = wave >> 1, qh = wave & 1, head = kvh * 4 + g;
            const bf16_t* Kg = P + (size_t)b * SEQ * NIN + C_SK + kvh * 64;
            const bf16_t* Vg = (const bf16_t*)(p.ws + WS_SVT) + (size_t)(b * 2 + kvh) * 64 * SEQ;
            const bf16_t* Qg = P + ((size_t)b * SEQ + 32 * qh) * NIN + C_SQ + head * 64;
            const bf16_t* Gg = P + ((size_t)b * SEQ + 32 * qh) * NIN + C_GATE + head * 64;
            bf16_t* Og = MIX + ((size_t)b * SEQ + 32 * qh) * DM + head * 64;
            const float sink = p.sinks[l * 8 + head] * 1.4426950408889634f;
            const int krow = tid >> 3, kch = tid & 7, vd = tid / 24, vch = tid % 24;
            u32x4 kreg[3], vreg[3]; bf16x8 qf[4], qn[4];
#define SWA_ISSUE(qb_) do { const int kb0_ = 64 * (qb_) - 128; \
                _Pragma("unroll") for (int i_ = 0; i_ < 3; ++i_) { \
                    { int kr_ = kb0_ + krow + 64 * i_; kr_ = kr_ < 0 ? 0 : kr_; kreg[i_] = ldg16(Kg, (unsigned)(kr_ * NIN + 8 * kch) * 2u); }     \
                    { const int idx_ = tid + 512 * i_, d_ = idx_ / 24, ch_ = idx_ % 24; int k0_ = kb0_ + 8 * ch_; k0_ = k0_ < 0 ? 0 : k0_; vreg[i_] = ldg16(Vg, (unsigned)(d_ * SEQ + k0_) * 2u); } } \
                { const bf16_t* Qp_ = Qg + (size_t)(64 * (qb_)) * NIN; \
                  _Pragma("unroll") for (int ks_ = 0; ks_ < 4; ++ks_) qn[ks_] = __builtin_bit_cast(bf16x8, ldg16(Qp_ + 16 * ks_, qoff)); } } while (0)
#define SWA_WRITE(buf_) do { LAS unsigned char* Ki_ = lds + (buf_) * SWA_IMG; LAS unsigned char* Vi_ = Ki_ + 192 * KROW; \
                _Pragma("unroll") for (int i_ = 0; i_ < 3; ++i_) { const int idx_ = tid + 512 * i_; \
                    *(LAS u32x4*)(Ki_ + (krow + 64 * i_) * KROW + 16 * kch) = kreg[i_]; \
                    { LAS unsigned char* d_ = Vi_ + (idx_ / 24) * SWA_VS + 16 * (idx_ % 24); u32x2 a_, b_; a_.x = vreg[i_].x; a_.y = vreg[i_].y; b_.x = vreg[i_].z; b_.y = vreg[i_].w; \
                      *(LAS u32x2*)d_ = a_; *(LAS u32x2*)(d_ + 8) = b_; } } } while (0)
            (void)vd; (void)vch;
            SWA_ISSUE(qb0);
            SWA_WRITE(0);
#pragma unroll
            for (int ks = 0; ks < 4; ++ks) qf[ks] = qn[ks];
            __syncthreads();
            for (int i = 0; i < 8; ++i) {
                const int qb = qb0 + i;
                if (i < 7) SWA_ISSUE(qb + 1);
                {
                    const LAS unsigned char* Kimg = lds + (i & 1) * SWA_IMG; const LAS unsigned char* VTimg = Kimg + 192 * KROW;
                    const int first = 4 - 2 * qb, st0 = qh > first ? qh : first;
                    f32x16 o0, o1; float lsum = h == 0 ? 1.f : 0.f; u32x4 gv[4];
                    attn_gate_load(gv, Gg + (size_t)(64 * qb) * NIN, lane);
                    attn_wave(o0, o1, lsum, sink, qf, Kimg, VTimg, SWA_VS, st0, qh + 5, qh, qh + 4, r, h);
                    attn_store(o0, o1, lsum, gv, stg, Og + (size_t)(64 * qb) * DM, lane);
                }
                if (i < 7) { SWA_WRITE((i + 1) & 1);
#pragma unroll
                    for (int ks = 0; ks < 4; ++ks) qf[ks] = qn[ks]; }
                __syncthreads();
            }
#undef SWA_ISSUE
#undef SWA_WRITE
        }
        {
            const int bh = cc >> 2, b = bh >> 2, hm = bh & 3, qk0 = (cc & 3) * 4;
            const bf16_t* Kg = (const bf16_t*)(p.ws + WS_MK) + (size_t)l * MEMROWS * 256 + (size_t)b * NMEM * 256 + hm * 64;
            const bf16_t* Vg = (const bf16_t*)(p.ws + WS_MVT) + (size_t)l * MEMROWS * 256 + (size_t)(b * 4 + hm) * 64 * NMEM;
            const bf16_t* Qg = P + ((size_t)b * SEQ + 32 * wave) * NIN + C_MQ + hm * 64;
            const bf16_t* Gg = P + ((size_t)b * SEQ + 32 * wave) * NIN + C_GATE + 768 + hm * 64;
            bf16_t* Og = MIX + ((size_t)b * SEQ + 32 * wave) * DM + 768 + hm * 64;
            LAS unsigned char* Ki = lds; LAS unsigned char* Vi = lds + 256 * KROW;
#pragma unroll
            for (int i = 0; i < 4; ++i) { const int idx = tid + 512 * i;
                *(LAS u32x4*)(Ki + (idx >> 3) * KROW + 16 * (idx & 7)) = ldg16(Kg, (unsigned)((idx >> 3) * 256 + 8 * (idx & 7)) * 2u);
                const u32x4 v = ldg16(Vg, (unsigned)((idx >> 5) * NMEM + 8 * (idx & 31)) * 2u);
                LAS unsigned char* d = Vi + (idx >> 5) * MEM_VS + 16 * (idx & 31); u32x2 a_, b_; a_.x = v.x; a_.y = v.y; b_.x = v.z; b_.y = v.w;
                *(LAS u32x2*)d = a_; *(LAS u32x2*)(d + 8) = b_; }
            bf16x8 qf[4], qn[4];
#pragma unroll
            for (int ks = 0; ks < 4; ++ks) qf[ks] = __builtin_bit_cast(bf16x8, ldg16(Qg + (size_t)(256 * qk0) * NIN + 16 * ks, qoff));
            __syncthreads();
            for (int i = 0; i < 4; ++i) {
                const int qk = qk0 + i;
                if (i < 3) {
#pragma unroll
                    for (int ks = 0; ks < 4; ++ks) qn[ks] = __builtin_bit_cast(bf16x8, ldg16(Qg + (size_t)(256 * (qk + 1)) * NIN + 16 * ks, qoff)); }
                f32x16 o0, o1; float lsum = 0.f; u32x4 gv[4];
                attn_gate_load(gv, Gg + (size_t)(256 * qk) * NIN, lane);
                attn_wave(o0, o1, lsum, -1e30f, qf, Ki, Vi, MEM_VS, 0, 8, -1, -1, r, h);
                attn_store(o0, o1, lsum, gv, stg, Og + (size_t)(256 * qk) * DM, lane);
                if (i < 3) {
#pragma unroll
                    for (int ks = 0; ks < 4; ++ks) qf[ks] = qn[ks]; }
            }
            __syncthreads();
        }
    }
}

constexpr size_t DN_M = WS_DN;
constexpr size_t DN_NT = WS_DN + 32 * MiB;
constexpr size_t DN_UT = WS_DN + 96 * MiB;
constexpr size_t DN_W = WS_DN + 128 * MiB;
constexpr size_t DN_QG = WS_DN + 160 * MiB;
constexpr size_t DN_IN = WS_DN + 192 * MiB;
constexpr size_t DN_ST = WS_DN + 224 * MiB;
constexpr int LDK = 72;

DI void mm16x64(f32x4 (&acc)[4], const LAS bf16_t* A, int r0, const LAS bf16_t* Bt, int fr, int fq) {
    bf16x8 a[2];
#pragma unroll
    for (int ks = 0; ks < 2; ++ks) a[ks] = *(const LAS bf16x8*)(A + (r0 + fr) * LDK + 32 * ks + 8 * fq);
#pragma unroll
    for (int nt = 0; nt < 4; ++nt)
#pragma unroll
        for (int ks = 0; ks < 2; ++ks) { const bf16x8 b = *(const LAS bf16x8*)(Bt + (16 * nt + fr) * LDK + 32 * ks + 8 * fq); acc[nt] = MFMA16(a[ks], b, acc[nt]); }
}
DI void conv16(float (&out)[16], const bf16_t* Pcol, size_t rowb, int s0, const float* cw) {
#pragma unroll
    for (int e = 0; e < 16; ++e) out[e] = 0.f;
#pragma unroll
    for (int j = 0; j < 4; ++j) {
        const int s = s0 + j;
        if (s >= 0) {
            const u32x4 x0 = *(const u32x4*)(Pcol + (rowb + s) * NIN), x1 = *(const u32x4*)(Pcol + (rowb + s) * NIN + 8);
            const f32x4 w0 = *(const f32x4*)(cw + j * 768), w1 = *(const f32x4*)(cw + j * 768 + 4), w2 = *(const f32x4*)(cw + j * 768 + 8), w3 = *(const f32x4*)(cw + j * 768 + 12);
            out[0] += w0.x * bflo(x0.x); out[1] += w0.y * bfhi(x0.x); out[2] += w0.z * bflo(x0.y); out[3] += w0.w * bfhi(x0.y);
            out[4] += w1.x * bflo(x0.z); out[5] += w1.y * bfhi(x0.z); out[6] += w1.z * bflo(x0.w); out[7] += w1.w * bfhi(x0.w);
            out[8] += w2.x * bflo(x1.x); out[9] += w2.y * bfhi(x1.x); out[10] += w2.z * bflo(x1.y); out[11] += w2.w * bfhi(x1.y);
            out[12] += w3.x * bflo(x1.z); out[13] += w3.y * bfhi(x1.z); out[14] += w3.z * bflo(x1.w); out[15] += w3.w * bfhi(x1.w);
        }
    }
#pragma unroll
    for (int e = 0; e < 16; ++e) out[e] = siluf_(out[e]);
}
DI u32x4 pack8(const float* v) { u32x4 w; w.x = cvtpk(v[0], v[1]); w.y = cvtpk(v[2], v[3]); w.z = cvtpk(v[4], v[5]); w.w = cvtpk(v[6], v[7]); return w; }
DI u32x2 pack4(const f32x4 v) { u32x2 w; w.x = cvtpk(v[0], v[1]); w.y = cvtpk(v[2], v[3]); return w; }

DI void dn_prep_phase(const Params& p, int l, LAS unsigned char* lds, int tid, int G) {
    const int sg = tid >> 8, ts = tid & 255, lane = tid & 63, wsg = (tid >> 6) & 3, fr = lane & 15, fq = lane >> 4;
    LAS unsigned char* base = lds + sg * 65536;
    LAS bf16_t* qs = (LAS bf16_t*)(base); LAS bf16_t* Tm = qs;
    LAS bf16_t* ks = (LAS bf16_t*)(base + 9216); LAS bf16_t* uT = ks;
    LAS bf16_t* kdT = (LAS bf16_t*)(base + 18432);
    LAS bf16_t* kbgT = (LAS bf16_t*)(base + 27648);
    LAS bf16_t* vbT = (LAS bf16_t*)(base + 36864);
    LAS float* Lf = (LAS float*)(base + 46080); LAS bf16_t* wT = (LAS bf16_t*)(base + 46080);
    LAS float* gcs = (LAS float*)(base + 63488); LAS float* betas = gcs + 64;
    const bf16_t* P = (const bf16_t*)(p.ws + WS_P);
    const float* BA = (const float*)(p.ws + WS_BA);
    const float* cwl = p.conv_w + (size_t)l * 4 * 768;
    const int t = ts >> 2, seg = ts & 3;
    for (int it = blockIdx.x; it < 2048; it += G) {
        const int ch = 2 * it + sg, b = ch >> 8, h = (ch >> 6) & 3, n = ch & 63;
        const size_t rowb = (size_t)b * SEQ, row = rowb + n * 64 + t; const int s0 = n * 64 + t - 3;
        SEC_BEGIN(1)
        float cq[16], ck[16], cv[16];
        conv16(cq, P + C_DQ + h * 64 + 16 * seg, rowb, s0, cwl + h * 64 + 16 * seg);
        conv16(ck, P + C_DK + h * 64 + 16 * seg, rowb, s0, cwl + 256 + h * 64 + 16 * seg);
        conv16(cv, P + C_DV + h * 64 + 16 * seg, rowb, s0, cwl + 512 + h * 64 + 16 * seg);
        float sq = 0.f, sk = 0.f;
#pragma unroll
        for (int e = 0; e < 16; ++e) { sq += cq[e] * cq[e]; sk += ck[e] * ck[e]; }
        sq += __shfl_xor(sq, 1); sq += __shfl_xor(sq, 2); sk += __shfl_xor(sk, 1); sk += __shfl_xor(sk, 2);
        const float rq = rsqrtf(sq + EPS) * 0.125f, rk = rsqrtf(sk + EPS);
#pragma unroll
        for (int e = 0; e < 16; ++e) { cq[e] *= rq; ck[e] *= rk; }
        const float beta = BA[row * 8 + h], g = BA[row * 8 + 4 + h];
        *(LAS u32x4*)(qs + t * LDK + 16 * seg) = pack8(cq); *(LAS u32x4*)(qs + t * LDK + 16 * seg + 8) = pack8(cq + 8);
        *(LAS u32x4*)(ks + t * LDK + 16 * seg) = pack8(ck); *(LAS u32x4*)(ks + t * LDK + 16 * seg + 8) = pack8(ck + 8);
        if (seg == 0) { gcs[t] = g; betas[t] = beta; }
        __syncthreads();
        SEC_END(1)
        SEC_BEGIN(2)
        float x = gcs[lane];
#pragma unroll
        for (int o = 1; o < 64; o <<= 1) { const float y = __shfl_up(x, o); if (lane >= o) x += y; }
        const float gc_t = __shfl(x, t), gl = __shfl(x, 63);
        __syncthreads();
        if (wsg == 0) gcs[lane] = x;
        const float eg = __expf(gc_t), ed = __expf(gl - gc_t);
#pragma unroll
        for (int e = 0; e < 16; ++e) { const int i = 16 * seg + e;
            kdT[i * LDK + t] = (bf16_t)f2bf(ck[e] * ed); kbgT[i * LDK + t] = (bf16_t)f2bf(ck[e] * beta * eg); vbT[i * LDK + t] = (bf16_t)f2bf(cv[e] * beta); }
        { float qg[16];
#pragma unroll
          for (int e = 0; e < 16; ++e) qg[e] = cq[e] * eg;
          bf16_t* dst = (bf16_t*)(p.ws + DN_QG) + (size_t)ch * 4096 + t * 64 + 16 * seg;
          *(u32x4*)dst = pack8(qg); *(u32x4*)(dst + 8) = pack8(qg + 8); }
        __syncthreads();
        SEC_END(2)
        SEC_BEGIN(3)
        {
            f32x4 acc[4], acc2[4];
#pragma unroll
            for (int nt = 0; nt < 4; ++nt) { acc[nt] = (f32x4){0.f, 0.f, 0.f, 0.f}; acc2[nt] = (f32x4){0.f, 0.f, 0.f, 0.f}; }
            mm16x64(acc, ks, 16 * wsg, ks, fr, fq);
            mm16x64(acc2, ks, 16 * wsg, qs, fr, fq);
            const int r0 = 16 * wsg + 4 * fq;
            float gr[4], br[4];
#pragma unroll
            for (int r = 0; r < 4; ++r) { gr[r] = gcs[r0 + r]; br[r] = betas[r0 + r]; }
#pragma unroll
            for (int nt = 0; nt < 4; ++nt) { const int cc = 16 * nt + fr; const float gcol = gcs[cc];
#pragma unroll
                for (int r = 0; r < 4; ++r) { const int c = r0 + r;
                    Lf[c * 68 + cc] = (cc < c) ? br[r] * acc[nt][r] * __expf(gr[r] - gcol) : 0.f; }
                f32x4 iv;
#pragma unroll
                for (int r = 0; r < 4; ++r) { const int s = r0 + r;
                    iv[r] = (s <= cc) ? acc2[nt][r] * __expf(gcol - gr[r]) : 0.f; }
                *(u32x2*)((bf16_t*)(p.ws + DN_IN) + (size_t)ch * 4096 + cc * 64 + r0) = pack4(iv); }
        }
        __syncthreads();
        SEC_END(3)
        SEC_BEGIN(4)
        if (wsg == 0) {
            float T[64];
#pragma unroll
            for (int c = 0; c < 64; ++c) T[c] = 0.f;
            const float lanef = (float)lane;
#pragma unroll
            for (int c = 0; c < 64; ++c) {
                float d = lanef; if (c > 0) asm volatile("" : "+v"(d) : "v"(T[c - 1]));
                float a0 = fmaxf(0.f, 1.f - fabsf(d - (float)c)), a1 = 0.f, a2 = 0.f, a3 = 0.f;
#pragma unroll
                for (int s4 = 0; s4 < (c + 3) / 4; ++s4) { const f32x4 Lv = *(const LAS f32x4*)(Lf + c * 68 + 4 * s4);
                    a0 -= Lv.x * T[4 * s4]; a1 -= Lv.y * T[4 * s4 + 1]; a2 -= Lv.z * T[4 * s4 + 2]; a3 -= Lv.w * T[4 * s4 + 3]; }
                T[c] = (a0 + a1) + (a2 + a3);
            }
#pragma unroll
            for (int c = 0; c < 64; ++c) Tm[c * LDK + lane] = (bf16_t)f2bf(T[c]);
        }
        __syncthreads();
        SEC_END(4)
        SEC_BEGIN(5)
        {   f32x4 au[4], aw[4], awr[4];
#pragma unroll
            for (int nt = 0; nt < 4; ++nt) { au[nt] = (f32x4){0.f, 0.f, 0.f, 0.f}; aw[nt] = au[nt]; awr[nt] = au[nt]; }
            mm16x64(au, Tm, 16 * wsg, vbT, fr, fq);
            mm16x64(aw, Tm, 16 * wsg, kbgT, fr, fq);
            mm16x64(awr, kbgT, 16 * wsg, Tm, fr, fq);
            const int r0 = 16 * wsg + 4 * fq;
#pragma unroll
            for (int nt = 0; nt < 4; ++nt) { const int cc = 16 * nt + fr;
                const u32x2 pu = pack4(au[nt]);
                *(LAS u32x2*)(uT + cc * LDK + r0) = pu; *(u32x2*)((bf16_t*)(p.ws + DN_UT) + (size_t)ch * 4096 + cc * 64 + r0) = pu;
                *(LAS u32x2*)(wT + cc * LDK + r0) = pack4(aw[nt]);
                *(u32x2*)((bf16_t*)(p.ws + DN_W) + (size_t)ch * 4096 + cc * 64 + r0) = pack4(awr[nt]); }
        }
        __syncthreads();
        SEC_END(5)
        SEC_BEGIN(6)
        {   f32x4 am[4], an[4];
#pragma unroll
            for (int nt = 0; nt < 4; ++nt) { am[nt] = (f32x4){0.f, 0.f, 0.f, 0.f}; an[nt] = am[nt]; }
            mm16x64(am, wT, 16 * wsg, kdT, fr, fq);
            mm16x64(an, kdT, 16 * wsg, uT, fr, fq);
            const int r0 = 16 * wsg + 4 * fq; const float egl = __expf(gl);
#pragma unroll
            for (int nt = 0; nt < 4; ++nt) { const int cc = 16 * nt + fr; f32x4 mv;
#pragma unroll
                for (int r = 0; r < 4; ++r) mv[r] = ((r0 + r) == cc ? egl : 0.f) - am[nt][r];
                *(u32x2*)((bf16_t*)(p.ws + DN_M) + (size_t)ch * 4096 + cc * 64 + r0) = pack4(mv);
                *(f32x4*)((float*)(p.ws + DN_NT) + (size_t)ch * 4096 + cc * 64 + r0) = an[nt]; }
        }
        __syncthreads();
        SEC_END(6)
    }
}
#define SCAN_LOAD(A_, C_, n_) do { const bf16_t* M_ = Mb + (size_t)(n_) * 4096; const float* N_ = Nb + (size_t)(n_) * 4096; \
        _Pragma("unroll") for (int mt = 0; mt < 4; ++mt) { C_[mt] = *(const f32x4*)(N_ + j * 64 + 16 * mt + 4 * fq); \
            _Pragma("unroll") for (int ks = 0; ks < 2; ++ks) { A_[mt][ks][0] = *(const s16x4*)(M_ + (16 * mt + fr) * 64 + 32 * ks + 4 * fq); A_[mt][ks][1] = *(const s16x4*)(M_ + (16 * mt + fr) * 64 + 32 * ks + 16 + 4 * fq); } } } while (0)
#define SCAN_STORE(n_) do { bf16_t* ST_ = Sb + (size_t)(n_) * 4096; _Pragma("unroll") for (int mt = 0; mt < 4; ++mt) *(u32x2*)(ST_ + j * 64 + 16 * mt + 4 * fq) = pack4(S[mt]); } while (0)
#define SCAN_STEP(A_, C_) do { bf16x8 bfr_[2]; \
        _Pragma("unroll") for (int ks = 0; ks < 2; ++ks) { u32x4 w_; const u32x2 lo_ = pack4(S[2 * ks]), hi_ = pack4(S[2 * ks + 1]); w_.x = lo_.x; w_.y = lo_.y; w_.z = hi_.x; w_.w = hi_.y; bfr_[ks] = __builtin_bit_cast(bf16x8, w_); } \
        _Pragma("unroll") for (int mt = 0; mt < 4; ++mt) { f32x4 a_ = C_[mt]; \
            _Pragma("unroll") for (int ks = 0; ks < 2; ++ks) a_ = MFMA16(__builtin_shufflevector(A_[mt][ks][0], A_[mt][ks][1], 0, 1, 2, 3, 4, 5, 6, 7), bfr_[ks], a_); \
            S[mt] = a_; } } while (0)
DI void dn_scan_item(const Params& p, int item, int lane) {
    const int bh = item >> 2, js = item & 3, fr = lane & 15, fq = lane >> 4, j = 16 * js + fr;
    f32x4 S[4];
#pragma unroll
    for (int mt = 0; mt < 4; ++mt) S[mt] = (f32x4){0.f, 0.f, 0.f, 0.f};
    const bf16_t* Mb = (const bf16_t*)(p.ws + DN_M) + (size_t)bh * 64 * 4096;
    const float* Nb = (const float*)(p.ws + DN_NT) + (size_t)bh * 64 * 4096;
    bf16_t* Sb = (bf16_t*)(p.ws + DN_ST) + (size_t)bh * 64 * 4096;
    s16x4 aA[4][2][2], aB[4][2][2]; f32x4 cA[4], cB[4];
    SCAN_LOAD(aA, cA, 0); SCAN_LOAD(aB, cB, 1);
    for (int n = 0; n < 62; n += 2) {
        SCAN_STORE(n);     SCAN_STEP(aA, cA); SCAN_LOAD(aA, cA, n + 2);
        SCAN_STORE(n + 1); SCAN_STEP(aB, cB); if (n + 3 < 63) SCAN_LOAD(aB, cB, n + 3);
    }
    SCAN_STORE(62); SCAN_STEP(aA, cA);
    SCAN_STORE(63);
}
#undef SCAN_LOAD
#undef SCAN_STORE
#undef SCAN_STEP
DI void dn_out_phase(const Params& p, int l, LAS unsigned char* lds, int tid, int G) {
    const int sg = tid >> 8, ts = tid & 255, lane = tid & 63, w = __builtin_amdgcn_readfirstlane((tid >> 6) & 3), fr = lane & 15, fq = lane >> 4, r0 = 16 * w;
    LAS unsigned char* base = lds + sg * 40960;
    LAS bf16_t* vT = (LAS bf16_t*)(base + 18432);
    LAS unsigned char* stg = base + 27648 + w * 2304;
    const bf16_t* P = (const bf16_t*)(p.ws + WS_P);
    bf16_t* MIX = (bf16_t*)(p.ws + WS_H);
    float gn[4];
#pragma unroll
    for (int nt = 0; nt < 4; ++nt) gn[nt] = p.dn_g[l * 64 + 16 * nt + fr];
    const unsigned offA = (unsigned)((r0 + fr) * 64 + 8 * fq) * 2u;
    const unsigned offU = (unsigned)(fr * 64 + r0 + 4 * fq) * 2u;
    const unsigned offS0 = (unsigned)((ts >> 3) * 64 + 8 * (ts & 7)) * 2u;
    const unsigned offG = (unsigned)((lane >> 3) * NIN + 8 * (lane & 7)) * 2u, offO = (unsigned)((lane >> 3) * DM + 8 * (lane & 7)) * 2u;
    u32x4 stn[2], wn[2], qn[2], inn[2], gvn[2]; u32x2 un[4];
#define DNO_LOAD(ch_) do { const size_t cb_ = (size_t)(ch_) * 4096; const int b_ = (ch_) >> 8, h_ = ((ch_) >> 6) & 3, n_ = (ch_) & 63; \
        const bf16_t* ST_ = (const bf16_t*)(p.ws + DN_ST) + cb_; stn[0] = ldg16(ST_, offS0); stn[1] = ldg16(ST_ + 32 * 64, offS0); \
        const bf16_t* W_ = (const bf16_t*)(p.ws + DN_W) + cb_; wn[0] = ldg16(W_, offA); wn[1] = ldg16(W_ + 32, offA); \
        const bf16_t* Q_ = (const bf16_t*)(p.ws + DN_QG) + cb_; qn[0] = ldg16(Q_, offA); qn[1] = ldg16(Q_ + 32, offA); \
        const bf16_t* I_ = (const bf16_t*)(p.ws + DN_IN) + cb_; inn[0] = ldg16(I_, offA); inn[1] = ldg16(I_ + 32, offA); \
        const bf16_t* U_ = (const bf16_t*)(p.ws + DN_UT) + cb_; _Pragma("unroll") for (int nt_ = 0; nt_ < 4; ++nt_) un[nt_] = *(const u32x2*)((const char*)(U_ + 16 * nt_ * 64) + offU); \
        const bf16_t* G_ = P + ((size_t)b_ * SEQ + n_ * 64 + r0) * NIN + C_GATE + 512 + h_ * 64; gvn[0] = ldg16(G_, offG); gvn[1] = ldg16(G_ + (size_t)8 * NIN, offG); } while (0)
#define DNO_WRITE_ST(buf_) do { LAS unsigned char* d_ = base + (buf_) * 9216 + (ts >> 3) * 144 + 16 * (ts & 7); *(LAS u32x4*)d_ = stn[0]; *(LAS u32x4*)(d_ + 32 * 144) = stn[1]; } while (0)
    int it = blockIdx.x, buf = 0;
    if (it < 2048) { DNO_LOAD(2 * it + sg); DNO_WRITE_ST(0); }
    __syncthreads();
    for (; it < 2048; it += G) {
        const int ch = 2 * it + sg, b = ch >> 8, h = (ch >> 6) & 3, n = ch & 63;
        const bf16x8 wA[2] = {__builtin_bit_cast(bf16x8, wn[0]), __builtin_bit_cast(bf16x8, wn[1])}, qA[2] = {__builtin_bit_cast(bf16x8, qn[0]), __builtin_bit_cast(bf16x8, qn[1])};
        const bf16x8 iA[2] = {__builtin_bit_cast(bf16x8, inn[0]), __builtin_bit_cast(bf16x8, inn[1])};
        const u32x4 gv[2] = {gvn[0], gvn[1]}; u32x2 uc[4];
#pragma unroll
        for (int nt = 0; nt < 4; ++nt) uc[nt] = un[nt];
        const bool has_next = it + G < 2048;
        if (has_next) DNO_LOAD(2 * (it + G) + sg);
        const LAS unsigned char* Si = base + buf * 9216;
        bf16x8 bS[4][2];
#pragma unroll
        for (int nt = 0; nt < 4; ++nt)
#pragma unroll
            for (int ks = 0; ks < 2; ++ks) bS[nt][ks] = *(const LAS bf16x8*)(Si + (16 * nt + fr) * 144 + 64 * ks + 16 * fq);
#pragma unroll
        for (int nt = 0; nt < 4; ++nt) { f32x4 a = (f32x4){0.f, 0.f, 0.f, 0.f};
#pragma unroll
            for (int ks = 0; ks < 2; ++ks) a = MFMA16(wA[ks], bS[nt][ks], a);
            const f32x4 vn = (f32x4){bflo(uc[nt].x) - a[0], bfhi(uc[nt].x) - a[1], bflo(uc[nt].y) - a[2], bfhi(uc[nt].y) - a[3]};
            *(LAS u32x2*)(vT + (16 * nt + fr) * LDK + r0 + 4 * fq) = pack4(vn); }
        __syncthreads();
        f32x4 o[4];
#pragma unroll
        for (int nt = 0; nt < 4; ++nt) { f32x4 a = (f32x4){0.f, 0.f, 0.f, 0.f};
#pragma unroll
            for (int ks = 0; ks < 2; ++ks) a = MFMA16(qA[ks], bS[nt][ks], a);
#pragma unroll
            for (int ks = 0; ks < 2; ++ks) a = MFMA16(iA[ks], *(const LAS bf16x8*)(vT + (16 * nt + fr) * LDK + 32 * ks + 8 * fq), a);
            o[nt] = a; }
        float rinv[4];
#pragma unroll
        for (int r = 0; r < 4; ++r) { float q = (o[0][r] * o[0][r] + o[1][r] * o[1][r]) + (o[2][r] * o[2][r] + o[3][r] * o[3][r]);
            q += __shfl_xor(q, 1); q += __shfl_xor(q, 2); q += __shfl_xor(q, 4); q += __shfl_xor(q, 8);
            rinv[r] = rsqrtf(q * (1.f / 64.f) + EPS); }
#pragma unroll
        for (int nt = 0; nt < 4; ++nt)
#pragma unroll
            for (int r = 0; r < 4; ++r) *(LAS bf16_t*)(stg + (4 * fq + r) * 144 + (16 * nt + fr) * 2) = (bf16_t)f2bf(o[nt][r] * rinv[r] * gn[nt]);
        asm volatile("s_waitcnt lgkmcnt(0)" ::: "memory");
        { bf16_t* Ob = MIX + ((size_t)b * SEQ + n * 64 + r0) * DM + 512 + h * 64;
#pragma unroll
          for (int i = 0; i < 2; ++i) {
              const u32x4 ov = *(const LAS u32x4*)(stg + ((lane >> 3) + 8 * i) * 144 + 16 * (lane & 7)); const u32x4 g4 = gv[i];
              u32x4 wv;
              wv.x = cvtpk(bflo(ov.x) * siluf_(bflo(g4.x)), bfhi(ov.x) * siluf_(bfhi(g4.x)));
              wv.y = cvtpk(bflo(ov.y) * siluf_(bflo(g4.y)), bfhi(ov.y) * siluf_(bfhi(g4.y)));
              wv.z = cvtpk(bflo(ov.z) * siluf_(bflo(g4.z)), bfhi(ov.z) * siluf_(bfhi(g4.z)));
              wv.w = cvtpk(bflo(ov.w) * siluf_(bflo(g4.w)), bfhi(ov.w) * siluf_(bfhi(g4.w)));
              *(u32x4*)((char*)(Ob + (size_t)i * 8 * DM) + offO) = wv; } }
        if (has_next) DNO_WRITE_ST(buf ^ 1);
        buf ^= 1;
        __syncthreads();
    }
#undef DNO_LOAD
#undef DNO_WRITE_ST
}

typedef __attribute__((address_space(1))) unsigned gu32;
#define XB_TMO      128
#define XB_XCNT(j)  (256  + 64 * (j))
#define XB_XSUB(j)  (1280 + 64 * (j))
#define XB_XGEN(j)  (2304 + 64 * (j))
#define XB_TOP      3328
#define XB_TOPGEN   3392
#define XCD_BAR_WORDS 3456
#define XB_SPIN_CAP (1u << 18)

__device__ __forceinline__ unsigned xb_ld(unsigned* p)              { return __hip_atomic_load(p, __ATOMIC_RELAXED, __HIP_MEMORY_SCOPE_AGENT); }
__device__ __forceinline__ unsigned xb_add(unsigned* p, unsigned v) { return __hip_atomic_fetch_add(p, v, __ATOMIC_RELAXED, __HIP_MEMORY_SCOPE_AGENT); }
__device__ __forceinline__ unsigned xb_xcc_id() { return (unsigned)__builtin_amdgcn_s_getreg((3 << 11) | 20) & 0xFu; }
#define XB_SPIN(cond, bar) do { unsigned _sp = 0; while (cond) { __builtin_amdgcn_s_sleep(1); \
    if ((++_sp & 255u) == 0u) { if (xb_ld(&(bar)[XB_TMO])) break; if (_sp > XB_SPIN_CAP) { atomicAdd(&(bar)[XB_TMO], 1u); break; } } } } while (0)

struct XcdBarrier {
    unsigned* bar; unsigned x;
    volatile LAS unsigned* st;
};

__device__ __forceinline__ XcdBarrier xcd_barrier_post(unsigned* bar, volatile LAS unsigned* st) {
    XcdBarrier b; b.bar = bar; b.x = xb_xcc_id(); b.st = st;
    if (threadIdx.x == 0) (void)xb_add(&bar[XB_XCNT(b.x)], 1u);
    return b;
}
__device__ __forceinline__ void xcd_barrier_complete(unsigned* bar, unsigned x, unsigned& nloc, unsigned& nx) {
    const unsigned G = gridDim.x * gridDim.y * gridDim.z;
    unsigned sum, cnt, mine, sp = 0u;
    for (;;) {
        sum = 0u; cnt = 0u; mine = 0u;
#pragma unroll
        for (unsigned j = 0; j < 16; ++j) { const unsigned c = xb_ld(&bar[XB_XCNT(j)]); sum += c; cnt += (c > 0u) ? 1u : 0u; mine = (j == x) ? c : mine; }
        if (sum == G) break;
        __builtin_amdgcn_s_sleep(1);
        if ((++sp & 255u) == 0u) { if (xb_ld(&bar[XB_TMO])) break; if (sp > XB_SPIN_CAP) { atomicAdd(&bar[XB_TMO], 1u); break; } }
    }
    nloc = mine > 0u ? mine : 1u; nx = cnt > 0u ? cnt : 1u;
}

__device__ __forceinline__ void xcd_barrier(const XcdBarrier& b, bool leader_thread) {
    asm volatile("s_waitcnt vmcnt(0)" ::: "memory");
    __syncthreads();
    if (leader_thread) {
        unsigned* bar = b.bar;
        __builtin_amdgcn_s_waitcnt(0);
        unsigned nloc = b.st[0], nx = b.st[1];
        if (nloc == 0u) { xcd_barrier_complete(bar, b.x, nloc, nx); b.st[0] = nloc; b.st[1] = nx; }
        const unsigned old = xb_add(&bar[XB_XSUB(b.x)], 1u);
        const unsigned gen = old / nloc;
        if (old + 1u == (gen + 1u) * nloc) {
            __builtin_amdgcn_fence(__ATOMIC_RELEASE, "agent");
            asm volatile("s_waitcnt vmcnt(0)" ::: "memory");
            const unsigned og = xb_add(&bar[XB_TOP], 1u);
            const unsigned tg = og / nx;
            if (og + 1u == (tg + 1u) * nx) xb_add(&bar[XB_TOPGEN], 1u);
            else XB_SPIN(xb_ld(&bar[XB_TOPGEN]) == tg, bar);
            __builtin_amdgcn_fence(__ATOMIC_ACQUIRE, "agent");
            xb_add(&bar[XB_XGEN(b.x)], 1u);
            asm volatile("s_waitcnt vmcnt(0)" ::: "memory");
        } else {
            XB_SPIN(xb_ld(&bar[XB_XGEN(b.x)]) == gen, bar);
            __builtin_amdgcn_fence(__ATOMIC_ACQUIRE, "agent");
            asm volatile("s_waitcnt vmcnt(0)" ::: "memory");
        }
    }
    __syncthreads();
}

enum { K_PREP = 0, K_INPROJ = 1, K_DNPREP = 2, K_ATTN = 3, K_DNOUT = 4, K_OUTPROJ = 5 };
constexpr int N_PHASES = 13;
namespace cg = cooperative_groups;
__global__ void __launch_bounds__(512, 2) mega(Params p, int ph_lo, int ph_hi) {
    extern __shared__ __attribute__((aligned(16))) unsigned char lds_raw[];
    LAS unsigned char* lds = (LAS unsigned char*)lds_raw;
    cg::grid_group grid = cg::this_grid();
    const int G = gridDim.x;
    const int wave_s = __builtin_amdgcn_readfirstlane(threadIdx.x >> 6);
    volatile LAS unsigned* MISC = (volatile LAS unsigned*)(lds + 147328);
    if (threadIdx.x < 32) MISC[threadIdx.x] = 0u;
    __syncthreads();
    XcdBarrier bar = xcd_barrier_post((unsigned*)(p.ws + WS_CTL) + 4096, MISC + 8);
    for (int ph = ph_lo; ph < ph_hi; ++ph) {
        const int l = ph / 6, kind = ph % 6;
        const int nrep = (ph != 12 && ((MK_REP >> kind) & 1)) ? 2 : 1;
        for (int rep = 0; rep < nrep; ++rep) {
#define PHASE_IDS int tid = wave_s * 64 + (int)__builtin_amdgcn_mbcnt_hi(~0u, __builtin_amdgcn_mbcnt_lo(~0u, 0u)); asm volatile("" : "+v"(tid)); const int lane = tid & 63, wave = wave_s; \
        const int gw = blockIdx.x * 8 + wave, ngw = G * 8; unsigned char* ws = p.ws; (void)lane; (void)wave; (void)gw; (void)ngw; (void)ws;
        if (ph == 12) { PHASE_IDS
            for (int row = gw; row < NTOK; row += ngw) final_row(p, row, lane);
        } else if (kind == K_PREP) { PHASE_IDS
            if (l == 0) { phase_init(p, lds, gw, ngw, wave, lane); __syncthreads(); }
            LAS float* w8s = (LAS float*)lds;
            for (int e = tid; e < 8 * DM; e += 512) { const int c = e & 7, kk = e >> 3; w8s[c * DM + kk] = p.w_in[(size_t)l * DM * INW + (size_t)kk * INW + 1536 + c]; }
            __syncthreads();
            if (l == 0) { for (int row = gw; row < NTOK; row += ngw) prep_row<false>(p, 0, row, lane, w8s); }
            else { for (int row = gw; row < NTOK; row += ngw) prep_row<true>(p, l, row, lane, w8s); }
            __syncthreads();
        } else if (kind == K_INPROJ) { PHASE_IDS
            { pg8::Gemm g{(const bf16_t*)(ws + WS_H), (const bf16_t*)(ws + WS_WIN) + (size_t)l * NIN * DM, NTOK, NIN, DM};
              pg8::StaticOrder S; S.init(NTOK, NIN, G, (int)blockIdx.x);
              EpiProj E{(bf16_t*)(ws + WS_P), (bf16_t*)(ws + WS_SVT)};
              pg8::gemm_phase<EpiProj, pg8::StaticOrder, true, true>(lds, g, S, E, tid); }
            if (l == 0) {
                for (int ll = 0; ll < DEPTH; ++ll) {
                    pg8::Gemm g{(const bf16_t*)(ws + WS_MEMN) + (size_t)ll * MEMROWS * DM, (const bf16_t*)(ws + WS_WMKV) + (size_t)ll * 512 * DM, MEMROWS, 512, DM};
                    pg8::StaticOrder S; S.init(MEMROWS, 512, G, (int)((blockIdx.x + G - 32 * ll) % G));
                    EpiMkv E{(bf16_t*)(ws + WS_MK) + (size_t)ll * MEMROWS * 256, (bf16_t*)(ws + WS_MVT) + (size_t)ll * MEMROWS * 256};
                    pg8::gemm_phase<EpiMkv, pg8::StaticOrder, true, true>(lds, g, S, E, tid);
                }
            }
        } else if (kind == K_DNPREP) { PHASE_IDS
            dn_prep_phase(p, l, lds, tid, G);
        } else if (kind == K_ATTN) { PHASE_IDS
            for (int srep = 0; srep < (((MK_REP >> 6) & 1) ? 2 : 1); ++srep)
            if (wave == 0) for (int item = blockIdx.x; item < 256; item += G) dn_scan_item(p, item, lane);
            attn_phase(p, l, lds, tid, G);
        } else if (kind == K_DNOUT) { PHASE_IDS
            dn_out_phase(p, l, lds, tid, G);
        } else { PHASE_IDS
            pg8::Gemm g{(const bf16_t*)(ws + WS_H), (const bf16_t*)(ws + WS_WOUT) + (size_t)l * DM * DM, NTOK, DM, DM};
            pg8::StaticOrder S; S.init(NTOK, DM, G, (int)blockIdx.x);
            EpiY E{(bf16_t*)(ws + WS_P), (float*)(ws + WS_STATS)};
            pg8::gemm_phase<EpiY, pg8::StaticOrder, true, true>(lds, g, S, E, tid);
        }
        if (rep + 1 < nrep) __syncthreads();
        }
        if (ph + 1 < ph_hi) { if (ph == ph_lo) grid.sync(); else xcd_barrier(bar, wave_s == 0 && __builtin_amdgcn_mbcnt_hi(~0u, __builtin_amdgcn_mbcnt_lo(~0u, 0u)) == 0u); }
    }
}

#ifndef MK_MULTI
#define MK_MULTI 0
#endif
extern "C" void kernel_launch(void* const* d_in, const int* in_sizes, int n_in, void* d_out, int out_size, void* d_ws, size_t ws_size, hipStream_t stream) {
    static int grid = 0;
    constexpr int LDS_BYTES = 147456;
    if (grid == 0) {
        if (n_in != 13 || ws_size < WS_END || out_size != NTOK * DM) { fprintf(stderr, "kernel_launch: unexpected n_in %d / ws_size %zu / out_size %d\n", n_in, ws_size, out_size); grid = -1; return; }
        int dev = 0, cus = 0, per_cu = 0;
        if (hipGetDevice(&dev) != hipSuccess || hipDeviceGetAttribute(&cus, hipDeviceAttributeMultiprocessorCount, dev) != hipSuccess) { grid = -1; return; }
        if (hipFuncSetAttribute((const void*)mega, hipFuncAttributeMaxDynamicSharedMemorySize, LDS_BYTES) != hipSuccess) { fprintf(stderr, "kernel_launch: hipFuncSetAttribute failed\n"); grid = -1; return; }
        if (hipOccupancyMaxActiveBlocksPerMultiprocessor(&per_cu, (const void*)mega, 512, LDS_BYTES) != hipSuccess || per_cu < 1) { fprintf(stderr, "kernel_launch: occupancy query failed (%d)\n", per_cu); grid = -1; return; }
        grid = cus * 1;
    }
    if (grid < 0) return;
    Params p{};
    p.x = (const float*)d_in[0]; p.mem = (const float*)d_in[1]; p.pre_g = (const float*)d_in[2]; p.w_in = (const float*)d_in[3]; p.conv_w = (const float*)d_in[4];
    p.a_log = (const float*)d_in[5]; p.dt_bias = (const float*)d_in[6]; p.sinks = (const float*)d_in[7]; p.dn_g = (const float*)d_in[8]; p.mem_g = (const float*)d_in[9];
    p.w_mkv = (const float*)d_in[10]; p.w_out = (const float*)d_in[11]; p.post_g = (const float*)d_in[12];
    p.out = (float*)d_out; p.ws = (unsigned char*)d_ws;
    if (hipMemsetAsync((char*)d_ws + WS_CTL, 0, 1 * MiB, stream) != hipSuccess) { fprintf(stderr, "kernel_launch: hipMemsetAsync failed\n"); return; }
#if MK_MULTI
    for (int ph = 0; ph < N_PHASES; ++ph) hipLaunchKernelGGL(mega, dim3(grid), dim3(512), LDS_BYTES, stream, p, ph, ph + 1);
#else
    int lo = 0, hi = N_PHASES;
    void* args[] = {&p, &lo, &hi};
    const hipError_t e = hipLaunchCooperativeKernel((const void*)mega, dim3(grid), dim3(512), args, LDS_BYTES, stream);
    if (e != hipSuccess) fprintf(stderr, "kernel_launch: cooperative launch failed: %s (grid %d)\n", hipGetErrorString(e), grid);
#endif
}
```

```cpp
#include <hip/hip_runtime.h>
#include <hip/hip_cooperative_groups.h>
#include <cstdio>
#include <cstdint>

#define DI __device__ __forceinline__
#ifndef MK_SEC
#define MK_SEC 0
#endif
#define SEC_BEGIN(id) long long t0_sec##id = 0; if (MK_SEC == id) t0_sec##id = clock64();
#define SEC_END(id) if (MK_SEC == id) { const long long dt_ = clock64() - t0_sec##id; const long long t1_ = clock64(); while (clock64() - t1_ < dt_) {} }
#ifndef MK_REP
#define MK_REP 0
#endif
#define LAS __attribute__((address_space(3)))
typedef unsigned short bf16_t;
typedef float f32x4 __attribute__((ext_vector_type(4)));
typedef unsigned u32x4 __attribute__((ext_vector_type(4)));
typedef unsigned u32x2 __attribute__((ext_vector_type(2)));

constexpr int DM = 1024, NB = 16, SEQ = 4096, NTOK = NB * SEQ, DEPTH = 2;
constexpr int INW = 2824;
constexpr int NIN = 2816;
constexpr int NMEM = 256, MEMROWS = NB * NMEM;
constexpr float EPS = 1e-6f;
constexpr int C_SQ = 0, C_SK = 512, C_SV = 640, C_DQ = 768, C_DK = 1024, C_DV = 1280, C_MQ = 1536, C_GATE = 1792;

constexpr size_t MiB = 1u << 20;
constexpr size_t WS_CTL = 0;
constexpr size_t WS_WIN = 1 * MiB;
constexpr size_t WS_WOUT = 12 * MiB;
constexpr size_t WS_WMKV = 16 * MiB;
constexpr size_t WS_W8 = 18 * MiB;
constexpr size_t WS_MEMN = 19 * MiB;
constexpr size_t WS_MK = 35 * MiB;
constexpr size_t WS_MVT = 39 * MiB;
constexpr size_t WS_BA = 43 * MiB;
constexpr size_t WS_STATS = 45 * MiB;
constexpr size_t WS_SVT = 49 * MiB;
constexpr size_t WS_H = 65 * MiB;
constexpr size_t WS_P = 193 * MiB;
constexpr size_t WS_DN = 545 * MiB;
constexpr size_t WS_END = 801 * MiB;

struct Params {
    const float *x, *mem, *pre_g, *w_in, *conv_w, *a_log, *dt_bias, *sinks, *dn_g, *mem_g, *w_mkv, *w_out, *post_g;
    float* out;
    unsigned char* ws;
};

DI unsigned f2bf(float f) { unsigned u = __float_as_uint(f); return (u + 0x7fffu + ((u >> 16) & 1u)) >> 16; }
DI unsigned pk2(float lo, float hi) { return f2bf(lo) | (f2bf(hi) << 16); }
DI float bf2f(unsigned u) { return __uint_as_float(u << 16); }
DI float bflo(unsigned u) { return __uint_as_float(u << 16); }
DI float bfhi(unsigned u) { return __uint_as_float(u & 0xffff0000u); }
DI float wave_sum(float v) {
#pragma unroll
    for (int o = 1; o < 64; o <<= 1) v += __shfl_xor(v, o);
    return v;
}
DI float sigmoidf_(float x) { return __builtin_amdgcn_rcpf(1.f + __builtin_amdgcn_exp2f(-1.4426950408889634f * x)); }
DI float siluf_(float x) { return x * __builtin_amdgcn_rcpf(1.f + __builtin_amdgcn_exp2f(-1.4426950408889634f * x)); }
DI float softplusf_(float x) { return x > 20.f ? x : log1pf(expf(x)); }

DI void transpose_item(const float* W, int Nsrc, int src_n0, int k0, bf16_t* WT, int K, int dst_n0, LAS float* scr, int lane) {
#pragma unroll 8
    for (int i = 0; i < 32; ++i) { const int kk = 2 * i + (lane >> 5); scr[kk * 33 + (lane & 31)] = W[(size_t)(k0 + kk) * Nsrc + src_n0 + (lane & 31)]; }
    asm volatile("s_waitcnt lgkmcnt(0)" ::: "memory");
    const int c = lane & 7;
#pragma unroll
    for (int j = 0; j < 4; ++j) {
        const int n = (lane >> 3) + 8 * j; const LAS float* s = scr + (8 * c) * 33 + n;
        u32x4 o; o.x = pk2(s[0 * 33], s[1 * 33]); o.y = pk2(s[2 * 33], s[3 * 33]); o.z = pk2(s[4 * 33], s[5 * 33]); o.w = pk2(s[6 * 33], s[7 * 33]);
        *(u32x4*)(WT + (size_t)(dst_n0 + n) * K + k0 + 8 * c) = o;
    }
    asm volatile("s_waitcnt lgkmcnt(0)" ::: "memory");
}

DI void phase_init(const Params& p, LAS unsigned char* lds, int gw, int ngw, int wave, int lane) {
    LAS float* scr = (LAS float*)(lds + wave * 16384);
    constexpr int I_IN = 16 * (NIN / 32), I_OUT = 16 * 32, I_MKV = 16 * 16, I_L = I_IN + I_OUT + I_MKV;
    for (int it = gw; it < DEPTH * I_L; it += ngw) {
        const int l = it / I_L; int r = it % I_L;
        if (r < I_IN) {
            const int kb = r / (NIN / 32), nb = r % (NIN / 32), n0 = nb * 32;
            transpose_item(p.w_in + (size_t)l * DM * INW, INW, n0 + (n0 >= 1536 ? 8 : 0), kb * 64, (bf16_t*)(p.ws + WS_WIN) + (size_t)l * NIN * DM, DM, n0, scr, lane);
        } else if (r < I_IN + I_OUT) {
            r -= I_IN; const int kb = r / 32, nb = r % 32;
            transpose_item(p.w_out + (size_t)l * DM * DM, DM, nb * 32, kb * 64, (bf16_t*)(p.ws + WS_WOUT) + (size_t)l * DM * DM, DM, nb * 32, scr, lane);
        } else {
            r -= I_IN + I_OUT; const int kb = r / 16, nb = r % 16;
            transpose_item(p.w_mkv + (size_t)l * DM * 512, 512, nb * 32, kb * 64, (bf16_t*)(p.ws + WS_WMKV) + (size_t)l * 512 * DM, DM, nb * 32, scr, lane);
        }
    }
    for (int it = gw; it < DEPTH * MEMROWS; it += ngw) {
        const int l = it / MEMROWS, row = it % MEMROWS;
        const f32x4* xr = (const f32x4*)(p.mem + (size_t)row * DM) + lane;
        f32x4 v[4]; float s = 0.f;
#pragma unroll
        for (int j = 0; j < 4; ++j) { v[j] = xr[64 * j]; s += (v[j].x * v[j].x + v[j].y * v[j].y) + (v[j].z * v[j].z + v[j].w * v[j].w); }
        const float r = rsqrtf(wave_sum(s) * (1.f / DM) + EPS);
        const f32x4* gr = (const f32x4*)(p.mem_g + (size_t)l * DM) + lane;
        u32x2* o = (u32x2*)((bf16_t*)(p.ws + WS_MEMN) + ((size_t)l * MEMROWS + row) * DM) + lane;
#pragma unroll
        for (int j = 0; j < 4; ++j) { const f32x4 g = gr[64 * j]; u32x2 w; w.x = pk2(v[j].x * r * g.x, v[j].y * r * g.y); w.y = pk2(v[j].z * r * g.z, v[j].w * r * g.w); o[64 * j] = w; }
    }
}

struct RowRegs { f32x4 x[4]; u32x2 y[4]; float st; };
template <bool L1> DI void prep_load(const Params& p, RowRegs& R, int row, int lane) {
    const f32x4* xr = (const f32x4*)(p.x + (size_t)row * DM) + lane;
#pragma unroll
    for (int j = 0; j < 4; ++j) R.x[j] = xr[64 * j];
    if (L1) {
        const u32x2* yr = (const u32x2*)((const bf16_t*)(p.ws + WS_P) + (size_t)row * DM) + lane;
#pragma unroll
        for (int j = 0; j < 4; ++j) R.y[j] = yr[64 * j];
        R.st = ((const float*)(p.ws + WS_STATS))[(size_t)row * 16 + (lane & 15)];
    }
}
template <bool L1> DI void prep_compute(const Params& p, int l, const RowRegs& R, int row, int lane, const LAS float* W8) {
    f32x4 v[4];
#pragma unroll
    for (int j = 0; j < 4; ++j) v[j] = R.x[j];
    if (L1) {
        float ss = R.st; ss += __shfl_xor(ss, 1); ss += __shfl_xor(ss, 2); ss += __shfl_xor(ss, 4); ss += __shfl_xor(ss, 8);
        const float ry = rsqrtf(ss * (1.f / DM) + EPS);
        const f32x4* pg = (const f32x4*)(p.post_g + (size_t)(l - 1) * DM) + lane;
        f32x4* xo = (f32x4*)(p.out + (size_t)row * DM) + lane;
#pragma unroll
        for (int j = 0; j < 4; ++j) {
            const u32x2 y = R.y[j]; const f32x4 g = pg[64 * j];
            v[j].x += bflo(y.x) * ry * g.x; v[j].y += bfhi(y.x) * ry * g.y; v[j].z += bflo(y.y) * ry * g.z; v[j].w += bfhi(y.y) * ry * g.w;
            xo[64 * j] = v[j];
        }
    }
    float s = 0.f;
#pragma unroll
    for (int j = 0; j < 4; ++j) s += (v[j].x * v[j].x + v[j].y * v[j].y) + (v[j].z * v[j].z + v[j].w * v[j].w);
    const float r = rsqrtf(wave_sum(s) * (1.f / DM) + EPS);
    const f32x4* gr = (const f32x4*)(p.pre_g + (size_t)l * DM) + lane;
    u32x2* ho = (u32x2*)((bf16_t*)(p.ws + WS_H) + (size_t)row * DM) + lane;
#pragma unroll
    for (int j = 0; j < 4; ++j) {
        const f32x4 g = gr[64 * j];
        v[j].x *= r * g.x; v[j].y *= r * g.y; v[j].z *= r * g.z; v[j].w *= r * g.w;
        u32x2 w; w.x = pk2(v[j].x, v[j].y); w.y = pk2(v[j].z, v[j].w); ho[64 * j] = w;
    }
    float d[8];
#pragma unroll
    for (int c = 0; c < 8; ++c) {
        const LAS f32x4* wr = (const LAS f32x4*)(W8 + c * DM) + lane; float a = 0.f;
#pragma unroll
        for (int j = 0; j < 4; ++j) { const f32x4 w = wr[64 * j]; a += (v[j].x * w.x + v[j].y * w.y) + (v[j].z * w.z + v[j].w * w.w); }
        d[c] = a;
    }
    const bool b0 = lane & 1, b1 = lane & 2, b2 = lane & 4;
    float e4[4], e2[2], e1;
#pragma unroll
    for (int i = 0; i < 4; ++i) { const float send = b0 ? d[i] : d[4 + i]; const float keep = b0 ? d[4 + i] : d[i]; e4[i] = keep + __shfl_xor(send, 1); }
#pragma unroll
    for (int i = 0; i < 2; ++i) { const float send = b1 ? e4[i] : e4[2 + i]; const float keep = b1 ? e4[2 + i] : e4[i]; e2[i] = keep + __shfl_xor(send, 2); }
    { const float send = b2 ? e2[0] : e2[1]; const float keep = b2 ? e2[1] : e2[0]; e1 = keep + __shfl_xor(send, 4); }
    e1 += __shfl_xor(e1, 8); e1 += __shfl_xor(e1, 16); e1 += __shfl_xor(e1, 32);
    if (lane < 8) {
        const int c = (lane & 1) * 4 + (lane & 2) + ((lane >> 2) & 1);
        float o;
        if (c < 4) o = sigmoidf_(e1);
        else { const int h = c - 4; o = -__expf(p.a_log[l * 4 + h]) * softplusf_(e1 + p.dt_bias[l * 4 + h]); }
        ((float*)(p.ws + WS_BA))[(size_t)row * 8 + c] = o;
    }
}
template <bool L1> DI void prep_rows(const Params& p, int l, int gw, int ngw, int lane, const LAS float* W8) {
    RowRegs A, B;
    int row = gw;
    if (row < NTOK) prep_load<L1>(p, A, row, lane);
    for (; row < NTOK; row += 2 * ngw) {
        if (row + ngw < NTOK) prep_load<L1>(p, B, row + ngw, lane);
        prep_compute<L1>(p, l, A, row, lane, W8);
        if (row + ngw < NTOK) { if (row + 2 * ngw < NTOK) prep_load<L1>(p, A, row + 2 * ngw, lane); prep_compute<L1>(p, l, B, row + ngw, lane, W8); }
    }
}

struct FinRegs { f32x4 x[4]; u32x2 y[4]; float st; };
DI void final_load(const Params& p, FinRegs& R, int row, int lane) {
    const f32x4* xo = (const f32x4*)(p.out + (size_t)row * DM) + lane; const u32x2* yr = (const u32x2*)((const bf16_t*)(p.ws + WS_P) + (size_t)row * DM) + lane;
#pragma unroll
    for (int j = 0; j < 4; ++j) { R.x[j] = xo[64 * j]; R.y[j] = yr[64 * j]; }
    R.st = ((const float*)(p.ws + WS_STATS))[(size_t)row * 16 + (lane & 15)];
}
DI void final_compute(const Params& p, const FinRegs& R, int row, int lane) {
    float ss = R.st; ss += __shfl_xor(ss, 1); ss += __shfl_xor(ss, 2); ss += __shfl_xor(ss, 4); ss += __shfl_xor(ss, 8);
    const float ry = rsqrtf(ss * (1.f / DM) + EPS);
    const f32x4* pg = (const f32x4*)(p.post_g + (size_t)(DEPTH - 1) * DM) + lane;
    f32x4* xo = (f32x4*)(p.out + (size_t)row * DM) + lane;
#pragma unroll
    for (int j = 0; j < 4; ++j) {
        const u32x2 y = R.y[j]; const f32x4 g = pg[64 * j]; f32x4 v = R.x[j];
        v.x += bflo(y.x) * ry * g.x; v.y += bfhi(y.x) * ry * g.y; v.z += bflo(y.y) * ry * g.z; v.w += bfhi(y.y) * ry * g.w;
        xo[64 * j] = v;
    }
}
DI void final_rows(const Params& p, int gw, int ngw, int lane) {
    FinRegs A, B;
    int row = gw;
    if (row < NTOK) final_load(p, A, row, lane);
    for (; row < NTOK; row += 2 * ngw) {
        if (row + ngw < NTOK) final_load(p, B, row + ngw, lane);
        final_compute(p, A, row, lane);
        if (row + ngw < NTOK) { if (row + 2 * ngw < NTOK) final_load(p, A, row + 2 * ngw, lane); final_compute(p, B, row + ngw, lane); }
    }
}

namespace pg8 {
#define PG8_LAS __attribute__((address_space(3)))
typedef unsigned short bf16_t;
typedef short bf16x8 __attribute__((ext_vector_type(8)));
typedef float f32x4 __attribute__((ext_vector_type(4)));
typedef unsigned u32x4 __attribute__((ext_vector_type(4)));
constexpr int BM = 256, BK = 64, HALF = 128, HTB = HALF * BK * 2  , STAGE_BYTES = 8 * HTB, NXCD = 8, WGM = 8;

__host__ __device__ __forceinline__ int lds_byte(int r, int c) { const int st = (r >> 4) * 2 + (c >> 5), rr = r & 15, cc = c & 31, ob = rr * 64 + cc * 2; return st * 1024 + (ob ^ (((ob >> 9) & 1) << 5)); }
__host__ __device__ __forceinline__ void stage_rc(int b, int& R, int& C) { const int st = b / 1024, sb = b % 1024, swz = sb ^ (((sb >> 9) & 1) << 5); R = (st >> 1) * 16 + swz / 64; C = (st & 1) * 32 + (swz % 64) / 2; }
__host__ __device__ __forceinline__ int perm32(int rho) { const int n = rho >> 4, i = rho & 15; return 8 * (i >> 2) + 4 * n + (i & 3); }

struct Unit { int pm, pn; };
struct Gemm { const bf16_t* A; const bf16_t* Bt; int M, N, K; };

struct StaticOrder {
    int nM, nN, nwg, G, c;
    __host__ __device__ void init(int M, int N, int G_, int c_) { nM = M / BM; nN = N / BM; nwg = nM * nN; G = G_; c = c_; }
    __host__ __device__ bool next(int i, Unit& u) const {
        const long L = (long)i * G + c; if (L >= nwg) return false;
        int wgid = (int)L; { const int q = nwg / NXCD, r = nwg % NXCD, xcd = wgid % NXCD, off = wgid / NXCD; wgid = (xcd < r ? xcd * (q + 1) : r * (q + 1) + (xcd - r) * q) + off; }
        const int nig = WGM * nN, gid = wgid / nig, fm = gid * WGM, gsz = (nM - fm) < WGM ? (nM - fm) : WGM;
        u.pm = fm + ((wgid % nig) % gsz); u.pn = (wgid % nig) / gsz; return true;
    }
    __device__ __forceinline__ void a_ready(const Unit&) const {}
    __device__ __forceinline__ void done(const Unit&) const {}
};

__device__ __forceinline__ unsigned cvt_pk_bf16(float lo, float hi) { unsigned r; asm volatile("v_cvt_pk_bf16_f32 %0, %1, %2" : "=v"(r) : "v"(lo), "v"(hi)); return r; }
template <class Epi, class Sched, bool ALIGN_EPI = false, bool SP2 = false>
__device__ __forceinline__ void gemm_phase(PG8_LAS unsigned char* lds, const Gemm g, const Sched& S, const Epi& E, int tid_in) {
    int tid = tid_in; asm volatile("" : "+v"(tid));
    const int wid = __builtin_amdgcn_readfirstlane(tid >> 6), lane = tid & 63, wr = wid >> 2, wc = wid & 3, fr = lane & 15, fq = lane >> 4;
    const int K = g.K, nt = K / BK;
    unsigned voffA[2], voffB[2];
#pragma unroll
    for (int i = 0; i < 2; ++i) { int R, C; stage_rc(tid * 16 + i * 8192, R, C); const int Rb = Epi::PERM ? ((R & ~31) + perm32(R & 31)) : R;
        voffA[i] = (unsigned)(R * K + C) * 2u; voffB[i] = (unsigned)(Rb * K + C) * 2u; }
    const size_t kstep = (size_t)(BK * 2);
    const size_t hstep = (size_t)HALF * K * 2;
    const size_t tstep = 2 * hstep;
    const unsigned ldsw = (unsigned)wid * 1024u;
    const int aoff = lds_byte(wr * 64 + fr, fq * 8), boff = lds_byte(wc * 32 + fr, fq * 8);
#define PG8_SA(b, h) (((b) * 2 + (h)) * HTB)
#define PG8_SB(b, h) ((4 + (b) * 2 + (h)) * HTB)
#define PG8_STAGE(bufoff, gbase, voff) do { _Pragma("unroll") for (int _i = 0; _i < 2; ++_i) \
        __builtin_amdgcn_global_load_lds((const unsigned*)((const char*)(gbase) + (voff)[_i]), (PG8_LAS unsigned*)(lds + (bufoff) + ldsw + _i * 8192), 16, 0, 0); } while (0)
#define PG8_LDA(dst, b, h) do { _Pragma("unroll") for (int m = 0; m < 4; ++m) _Pragma("unroll") for (int k = 0; k < 2; ++k) dst[m][k] = *(const PG8_LAS bf16x8*)(lds + PG8_SA(b, h) + aoff + m * 2048 + k * 1024); } while (0)
#define PG8_LDB(dst, b, h) do { _Pragma("unroll") for (int n = 0; n < 2; ++n) _Pragma("unroll") for (int k = 0; k < 2; ++k) dst[n][k] = *(const PG8_LAS bf16x8*)(lds + PG8_SB(b, h) + boff + n * 2048 + k * 1024); } while (0)
#define PG8_MMA(ai, bj, At, Bt) do { __builtin_amdgcn_s_setprio(1); _Pragma("unroll") for (int m = 0; m < 4; ++m) _Pragma("unroll") for (int n = 0; n < 2; ++n) _Pragma("unroll") for (int k = 0; k < 2; ++k) \
        acc[ai][bj][m][n] = __builtin_amdgcn_mfma_f32_16x16x32_bf16(Bt[n][k], At[m][k], acc[ai][bj][m][n], 0, 0, 0); __builtin_amdgcn_s_setprio(0); } while (0)
#define PG8_WAIT_V(n) asm volatile("s_waitcnt vmcnt(" #n ")" ::: "memory")
#define PG8_WAIT_L(n) asm volatile("s_waitcnt lgkmcnt(" #n ")" ::: "memory")
#define PG8_BAR __builtin_amdgcn_s_barrier()
#define PG8_SCHED __builtin_amdgcn_sched_barrier(0)
    Unit cur, nxt; int ui = 0;
    if (!S.next(0, cur)) return;
    f32x4 acc[2][2][4][2];
#pragma unroll
    for (int a = 0; a < 2; ++a)
#pragma unroll
        for (int b = 0; b < 2; ++b)
#pragma unroll
            for (int m = 0; m < 4; ++m)
#pragma unroll
                for (int n = 0; n < 2; ++n) acc[a][b][m][n] = (f32x4){0.f, 0.f, 0.f, 0.f};
    bf16x8 At[4][2], B0[2][2], B1[2][2];
    const char* cA = (const char*)g.A + (size_t)cur.pm * tstep; const char* cB = (const char*)g.Bt + (size_t)cur.pn * tstep;
    S.a_ready(cur);
    if constexpr (SP2) {
        PG8_STAGE(PG8_SB(0, 0), cB, voffB); PG8_STAGE(PG8_SB(0, 1), cB + hstep, voffB); PG8_STAGE(PG8_SA(0, 0), cA, voffA); PG8_STAGE(PG8_SA(0, 1), cA + hstep, voffA);
        if (wr == 1) PG8_BAR;
        PG8_WAIT_V(2); PG8_BAR;
        PG8_STAGE(PG8_SB(1, 0), cB + kstep, voffB); PG8_STAGE(PG8_SA(1, 0), cA + kstep, voffA); PG8_STAGE(PG8_SB(1, 1), cB + hstep + kstep, voffB);
        PG8_WAIT_V(6); PG8_BAR;
    } else {
        PG8_STAGE(PG8_SB(0, 0), cB, voffB); PG8_STAGE(PG8_SA(0, 0), cA, voffA); PG8_STAGE(PG8_SB(0, 1), cB + hstep, voffB); PG8_STAGE(PG8_SA(0, 1), cA + hstep, voffA);
        if (wr == 1) PG8_BAR;
        PG8_WAIT_V(4); PG8_BAR;
        PG8_STAGE(PG8_SB(1, 0), cB + kstep, voffB); PG8_STAGE(PG8_SA(1, 0), cA + kstep, voffA); PG8_STAGE(PG8_SB(1, 1), cB + hstep + kstep, voffB);
        PG8_WAIT_V(6); PG8_BAR;
    }
    for (;;) {
        const bool has_next = S.next(ui + 1, nxt);
        const char* nA = has_next ? (const char*)g.A + (size_t)nxt.pm * tstep : cA; const char* nB = has_next ? (const char*)g.Bt + (size_t)nxt.pn * tstep : cB;
        for (int t = 0; t < nt; t += 2) {
            const bool last = (t == nt - 2);
            const char* a1 = cA + (size_t)(t + 1) * kstep;
            const char* a2 = last ? nA : cA + (size_t)(t + 2) * kstep; const char* b2 = last ? nB : cB + (size_t)(t + 2) * kstep;
            const char* a3 = a2 + kstep; const char* b3 = b2 + kstep;
            if (last && has_next) S.a_ready(nxt);
            if constexpr (SP2) {
            PG8_LDB(B0, 0, 0); PG8_LDB(B1, 0, 1); PG8_SCHED; PG8_LDA(At, 0, 0); PG8_STAGE(PG8_SA(1, 1), a1 + hstep, voffA);
            PG8_WAIT_V(8); PG8_WAIT_L(0); PG8_BAR; PG8_MMA(0, 0, At, B0); PG8_MMA(0, 1, At, B1); PG8_BAR; PG8_SCHED;
            PG8_LDA(At, 0, 1); PG8_STAGE(PG8_SB(0, 0), b2, voffB); PG8_STAGE(PG8_SB(0, 1), b2 + hstep, voffB); PG8_STAGE(PG8_SA(0, 0), a2, voffA);
            PG8_WAIT_V(8); PG8_WAIT_L(0); PG8_BAR; PG8_MMA(1, 0, At, B0); PG8_MMA(1, 1, At, B1); PG8_BAR; PG8_SCHED;
            PG8_LDB(B0, 1, 0); PG8_LDB(B1, 1, 1); PG8_SCHED; PG8_LDA(At, 1, 0); PG8_STAGE(PG8_SA(0, 1), a2 + hstep, voffA);
            PG8_WAIT_V(8); PG8_WAIT_L(0); PG8_BAR; PG8_MMA(0, 0, At, B0); PG8_MMA(0, 1, At, B1); PG8_BAR; PG8_SCHED;
            PG8_LDA(At, 1, 1); PG8_STAGE(PG8_SB(1, 0), b3, voffB); PG8_STAGE(PG8_SB(1, 1), b3 + hstep, voffB); PG8_STAGE(PG8_SA(1, 0), a3, voffA);
            PG8_WAIT_V(8); PG8_WAIT_L(0); PG8_BAR; PG8_MMA(1, 0, At, B0); PG8_MMA(1, 1, At, B1); PG8_BAR; PG8_SCHED;
            } else {
            PG8_LDB(B0, 0, 0); PG8_SCHED; PG8_LDA(At, 0, 0); PG8_STAGE(PG8_SA(1, 1), a1 + hstep, voffA);
            PG8_WAIT_L(8); PG8_BAR; PG8_WAIT_L(0); PG8_MMA(0, 0, At, B0); PG8_BAR; PG8_SCHED;
            PG8_LDB(B1, 0, 1); PG8_STAGE(PG8_SB(0, 0), b2, voffB);
            PG8_BAR; PG8_WAIT_L(0); PG8_MMA(0, 1, At, B1); PG8_BAR;
            PG8_LDA(At, 0, 1); PG8_STAGE(PG8_SA(0, 0), a2, voffA);
            PG8_BAR; PG8_WAIT_L(0); PG8_MMA(1, 0, At, B0); PG8_BAR; PG8_SCHED;
            PG8_STAGE(PG8_SB(0, 1), b2 + hstep, voffB);
            PG8_WAIT_V(6); PG8_BAR; PG8_MMA(1, 1, At, B1); PG8_BAR;
            PG8_LDB(B0, 1, 0); PG8_SCHED; PG8_LDA(At, 1, 0); PG8_STAGE(PG8_SA(0, 1), a2 + hstep, voffA);
            PG8_WAIT_L(8); PG8_BAR; PG8_WAIT_L(0); PG8_MMA(0, 0, At, B0); PG8_BAR; PG8_SCHED;
            PG8_LDB(B1, 1, 1); PG8_STAGE(PG8_SB(1, 0), b3, voffB);
            PG8_BAR; PG8_WAIT_L(0); PG8_MMA(0, 1, At, B1); PG8_BAR;
            PG8_LDA(At, 1, 1); PG8_STAGE(PG8_SA(1, 0), a3, voffA);
            PG8_BAR; PG8_WAIT_L(0); PG8_MMA(1, 0, At, B0); PG8_BAR; PG8_SCHED;
            PG8_STAGE(PG8_SB(1, 1), b3 + hstep, voffB);
            PG8_WAIT_V(6); PG8_BAR; PG8_MMA(1, 1, At, B1); PG8_BAR;
            }
        }
        if constexpr (ALIGN_EPI) { if (wr == 0) PG8_BAR; }
        if constexpr (!Epi::AFTER_DRAIN) { E(acc, cur, wr, wc, fr, fq); S.done(cur); }
        if (!has_next) break;
#pragma unroll
        for (int a = 0; a < 2; ++a)
#pragma unroll
            for (int b = 0; b < 2; ++b)
#pragma unroll
                for (int m = 0; m < 4; ++m)
#pragma unroll
                    for (int n = 0; n < 2; ++n) acc[a][b][m][n] = (f32x4){0.f, 0.f, 0.f, 0.f};
        cur = nxt; cA = nA; cB = nB; ++ui;
        if constexpr (ALIGN_EPI) { if (wr == 1) PG8_BAR; }
    }
    PG8_WAIT_V(0);
    if constexpr (!ALIGN_EPI) { if (wr == 0) PG8_BAR; }
    PG8_BAR;
    if constexpr (Epi::AFTER_DRAIN) { E.fused(acc, cur, wr, wc, fr, fq, lds, wid, lane); S.done(cur); }
#undef PG8_SA
#undef PG8_SB
#undef PG8_STAGE
#undef PG8_LDA
#undef PG8_LDB
#undef PG8_MMA
#undef PG8_WAIT_V
#undef PG8_WAIT_L
#undef PG8_BAR
#undef PG8_SCHED
}
}
using pg8::cvt_pk_bf16;
struct EpiProj {
    static constexpr bool PERM = true, AFTER_DRAIN = false;
    bf16_t* O; bf16_t* svT;
    DI void operator()(const f32x4 (&acc)[2][2][4][2], const pg8::Unit& u, int wr, int wc, int fr, int fq) const {
        const int row0 = u.pm * 256 + wr * 64 + fr, col0 = u.pn * 256 + wc * 32 + 8 * fq;
#pragma unroll
        for (int ai = 0; ai < 2; ++ai)
#pragma unroll
            for (int m = 0; m < 4; ++m) { bf16_t* rowp = O + (size_t)(row0 + ai * 128 + m * 16) * NIN + col0;
#pragma unroll
                for (int bj = 0; bj < 2; ++bj) { const f32x4 v0 = acc[ai][bj][m][0], v1 = acc[ai][bj][m][1];
                    u32x4 w; w.x = cvt_pk_bf16(v0[0], v0[1]); w.y = cvt_pk_bf16(v0[2], v0[3]); w.z = cvt_pk_bf16(v1[0], v1[1]); w.w = cvt_pk_bf16(v1[2], v1[3]);
                    *(u32x4*)(rowp + bj * 128) = w; } }
        if (u.pn == 2) {
#pragma unroll
            for (int ai = 0; ai < 2; ++ai)
#pragma unroll
                for (int m = 0; m < 4; ++m) { const int row = row0 + ai * 128 + m * 16, b = row >> 12, s = row & (SEQ - 1);
#pragma unroll
                    for (int n = 0; n < 2; ++n)
#pragma unroll
                        for (int e = 0; e < 4; ++e) { const int c = wc * 32 + 8 * fq + 4 * n + e;
                            svT[((size_t)(b * 2 + (c >> 6)) * 64 + (c & 63)) * SEQ + s] = (bf16_t)f2bf(acc[ai][1][m][n][e]); } }
        }
    }
};
struct EpiMkv {
    static constexpr bool PERM = true, AFTER_DRAIN = false;
    bf16_t* mk; bf16_t* mvT;
    DI void operator()(const f32x4 (&acc)[2][2][4][2], const pg8::Unit& u, int wr, int wc, int fr, int fq) const {
        const int row0 = u.pm * 256 + wr * 64 + fr;
#pragma unroll
        for (int ai = 0; ai < 2; ++ai)
#pragma unroll
            for (int m = 0; m < 4; ++m) { const int row = row0 + ai * 128 + m * 16;
                if (u.pn == 0) {
#pragma unroll
                    for (int bj = 0; bj < 2; ++bj) { const f32x4 v0 = acc[ai][bj][m][0], v1 = acc[ai][bj][m][1];
                        u32x4 w; w.x = cvt_pk_bf16(v0[0], v0[1]); w.y = cvt_pk_bf16(v0[2], v0[3]); w.z = cvt_pk_bf16(v1[0], v1[1]); w.w = cvt_pk_bf16(v1[2], v1[3]);
                        *(u32x4*)(mk + (size_t)row * 256 + bj * 128 + wc * 32 + 8 * fq) = w; }
                } else { const int b = row >> 8, mm = row & 255;
#pragma unroll
                    for (int bj = 0; bj < 2; ++bj)
#pragma unroll
                        for (int n = 0; n < 2; ++n)
#pragma unroll
                            for (int e = 0; e < 4; ++e) { const int c = bj * 128 + wc * 32 + 8 * fq + 4 * n + e;
                                mvT[((size_t)(b * 4 + (c >> 6)) * 64 + (c & 63)) * NMEM + mm] = (bf16_t)f2bf(acc[ai][bj][m][n][e]); } }
            }
    }
};
struct EpiY {
    static constexpr bool PERM = true, AFTER_DRAIN = false;
    bf16_t* Y; float* stats;
    DI void operator()(const f32x4 (&acc)[2][2][4][2], const pg8::Unit& u, int wr, int wc, int fr, int fq) const {
        const int row0 = u.pm * 256 + wr * 64 + fr, col0 = u.pn * 256 + wc * 32 + 8 * fq;
#pragma unroll
        for (int ai = 0; ai < 2; ++ai)
#pragma unroll
            for (int m = 0; m < 4; ++m) { const int row = row0 + ai * 128 + m * 16; bf16_t* rowp = Y + (size_t)row * DM + col0; float ss = 0.f;
#pragma unroll
                for (int bj = 0; bj < 2; ++bj) { const f32x4 v0 = acc[ai][bj][m][0], v1 = acc[ai][bj][m][1];
                    ss += (v0[0] * v0[0] + v0[1] * v0[1]) + (v0[2] * v0[2] + v0[3] * v0[3]) + (v1[0] * v1[0] + v1[1] * v1[1]) + (v1[2] * v1[2] + v1[3] * v1[3]);
                    u32x4 w; w.x = cvt_pk_bf16(v0[0], v0[1]); w.y = cvt_pk_bf16(v0[2], v0[3]); w.z = cvt_pk_bf16(v1[0], v1[1]); w.w = cvt_pk_bf16(v1[2], v1[3]);
                    *(u32x4*)(rowp + bj * 128) = w; }
                ss += __shfl_xor(ss, 16); ss += __shfl_xor(ss, 32);
                if (fq == 0) stats[(size_t)row * 16 + u.pn * 4 + wc] = ss; }
    }
};

typedef short bf16x8 __attribute__((ext_vector_type(8)));
typedef short s16x4 __attribute__((ext_vector_type(4)));
typedef float f32x16 __attribute__((ext_vector_type(16)));
typedef float f32x2_t __attribute__((ext_vector_type(2)));
typedef __bf16 bf16x2_t __attribute__((ext_vector_type(2)));
DI unsigned cvtpk(float lo, float hi) { f32x2_t v = {lo, hi}; bf16x2_t b = __builtin_convertvector(v, bf16x2_t); return __builtin_bit_cast(unsigned, b); }
#define MFMA32(a, b, c) __builtin_amdgcn_mfma_f32_32x32x16_bf16((a), (b), (c), 0, 0, 0)
#define MFMA16(a, b, c) __builtin_amdgcn_mfma_f32_16x16x32_bf16((a), (b), (c), 0, 0, 0)
constexpr int KROW = 144;
constexpr int SWA_VS = 392, MEM_VS = 520;
constexpr int SWA_IMG = 192 * KROW + 64 * SWA_VS;
constexpr int MEM_IMG = 256 * KROW + 64 * MEM_VS;
constexpr int ATT_STAGE = 2 * SWA_IMG;
static_assert(ATT_STAGE + 8 * 4608 <= 147328 && MEM_IMG <= ATT_STAGE, "attention LDS map");

DI void attn_wave(f32x16& o0, f32x16& o1, float& lsum, float m, const bf16x8 (&qf)[4], const LAS unsigned char* Kimg, const LAS unsigned char* VTimg, int vs,
                  int st0, int st1, int st_lo, int st_hi, int r, int h) {
    constexpr float SC = 0.125f * 1.4426950408889634f;
#pragma unroll
    for (int i = 0; i < 16; ++i) { o0[i] = 0.f; o1[i] = 0.f; }
    for (int st = st0; st < st1; ++st) {
        const LAS unsigned char* kp = Kimg + (32 * st + r) * KROW + 16 * h;
        bf16x8 kf[4];
#pragma unroll
        for (int ks = 0; ks < 4; ++ks) kf[ks] = *(const LAS bf16x8*)(kp + 32 * ks);
        const LAS unsigned char* vp = VTimg + r * vs + (32 * st + 4 * h) * 2;
        s16x4 va[2][2][2];
#pragma unroll
        for (int dt = 0; dt < 2; ++dt)
#pragma unroll
            for (int ss = 0; ss < 2; ++ss)
#pragma unroll
                for (int hf = 0; hf < 2; ++hf) va[dt][ss][hf] = *(const LAS s16x4*)(vp + dt * 32 * vs + (16 * ss + 8 * hf) * 2);
        f32x16 s;
#pragma unroll
        for (int i = 0; i < 16; ++i) s[i] = 0.f;
#pragma unroll
        for (int ks = 0; ks < 4; ++ks) s = MFMA32(kf[ks], qf[ks], s);
        if (st == st_lo || st == st_hi) {
            const bool lo = st == st_lo;
#pragma unroll
            for (int i = 0; i < 16; ++i) { const int c = (i & 3) + 8 * (i >> 2) + 4 * h; const bool ok = lo ? (c > r) : (c <= r); s[i] = ok ? s[i] : -1e30f; }
        }
        float tm = fmaxf(fmaxf(s[0], s[1]), fmaxf(s[2], s[3]));
#pragma unroll
        for (int i = 4; i < 16; i += 4) tm = fmaxf(fmaxf(tm, fmaxf(s[i], s[i + 1])), fmaxf(s[i + 2], s[i + 3]));
        tm = fmaxf(tm, __shfl_xor(tm, 32)) * SC;
        if (__any(tm > m)) {
            const float mn = fmaxf(m, tm), alpha = __builtin_amdgcn_exp2f(m - mn);
            m = mn; lsum *= alpha;
#pragma unroll
            for (int i = 0; i < 16; ++i) { o0[i] *= alpha; o1[i] *= alpha; }
        }
        float ps = 0.f;
#pragma unroll
        for (int i = 0; i < 16; ++i) { s[i] = __builtin_amdgcn_exp2f(__builtin_fmaf(s[i], SC, -m)); ps += s[i]; }
        lsum += ps;
#pragma unroll
        for (int ss = 0; ss < 2; ++ss) {
            u32x4 pw; pw.x = cvtpk(s[8 * ss + 0], s[8 * ss + 1]); pw.y = cvtpk(s[8 * ss + 2], s[8 * ss + 3]); pw.z = cvtpk(s[8 * ss + 4], s[8 * ss + 5]); pw.w = cvtpk(s[8 * ss + 6], s[8 * ss + 7]);
            const bf16x8 pf = __builtin_bit_cast(bf16x8, pw);
            const bf16x8 v0 = __builtin_shufflevector(va[0][ss][0], va[0][ss][1], 0, 1, 2, 3, 4, 5, 6, 7);
            const bf16x8 v1 = __builtin_shufflevector(va[1][ss][0], va[1][ss][1], 0, 1, 2, 3, 4, 5, 6, 7);
            o0 = MFMA32(v0, pf, o0); o1 = MFMA32(v1, pf, o1);
        }
    }
    lsum += __shfl_xor(lsum, 32);
}
DI u32x4 ldg16(const void* base, unsigned off) { return *(const u32x4*)((const char*)base + off); }
DI void stg8(void* base, unsigned off, u32x2 v) { *(u32x2*)((char*)base + off) = v; }
DI void stg16f(void* base, unsigned off, f32x4 v) { *(f32x4*)((char*)base + off) = v; }
DI void attn_gate_load(u32x4 (&gv)[4], const bf16_t* gbase  , int lane) {
    const unsigned off = (unsigned)((lane >> 3) * NIN + 8 * (lane & 7)) * 2u;
#pragma unroll
    for (int i = 0; i < 4; ++i) gv[i] = ldg16(gbase + (size_t)i * 8 * NIN, off);
}
DI void attn_store(const f32x16& o0, const f32x16& o1, float lsum, const u32x4 (&gvv)[4], LAS unsigned char* stg, bf16_t* obase  , int lane) {
    const int r = lane & 31, h = lane >> 5;
    const float inv = 1.f / lsum;
#pragma unroll
    for (int g4 = 0; g4 < 4; ++g4) {
        u32x2 w0, w1;
        w0.x = cvtpk(o0[4 * g4 + 0] * inv, o0[4 * g4 + 1] * inv); w0.y = cvtpk(o0[4 * g4 + 2] * inv, o0[4 * g4 + 3] * inv);
        w1.x = cvtpk(o1[4 * g4 + 0] * inv, o1[4 * g4 + 1] * inv); w1.y = cvtpk(o1[4 * g4 + 2] * inv, o1[4 * g4 + 3] * inv);
        *(LAS u32x2*)(stg + r * 144 + (8 * g4 + 4 * h) * 2) = w0;
        *(LAS u32x2*)(stg + r * 144 + (32 + 8 * g4 + 4 * h) * 2) = w1;
    }
    asm volatile("s_waitcnt lgkmcnt(0)" ::: "memory");
    const unsigned ooff = (unsigned)((lane >> 3) * DM + 8 * (lane & 7)) * 2u;
    const LAS unsigned char* sp = stg + (lane >> 3) * 144 + 16 * (lane & 7);
#pragma unroll
    for (int i = 0; i < 4; ++i) {
        const u32x4 ov = *(const LAS u32x4*)(sp + i * 8 * 144);
        const u32x4 gv = gvv[i];
        u32x4 w;
        w.x = cvtpk(bflo(ov.x) * siluf_(bflo(gv.x)), bfhi(ov.x) * siluf_(bfhi(gv.x)));
        w.y = cvtpk(bflo(ov.y) * siluf_(bflo(gv.y)), bfhi(ov.y) * siluf_(bfhi(gv.y)));
        w.z = cvtpk(bflo(ov.z) * siluf_(bflo(gv.z)), bfhi(ov.z) * siluf_(bfhi(gv.z)));
        w.w = cvtpk(bflo(ov.w) * siluf_(bflo(gv.w)), bfhi(ov.w) * siluf_(bfhi(gv.w)));
        *(u32x4*)((char*)(obase + (size_t)i * 8 * DM) + ooff) = w;
    }
    asm volatile("s_waitcnt lgkmcnt(0)" ::: "memory");
}
DI void attn_phase(const Params& p, int l, LAS unsigned char* lds, int tid, int G, int bx) {
    const int lane = tid & 63, wave = __builtin_amdgcn_readfirstlane(tid >> 6), r = lane & 31, h = lane >> 5;
    const bf16_t* P = (const bf16_t*)(p.ws + WS_P);
    bf16_t* MIX = (bf16_t*)(p.ws + WS_H);
    LAS unsigned char* stg = lds + ATT_STAGE + wave * 4608;
    const unsigned qoff = (unsigned)(r * NIN + 8 * h) * 2u;
    for (int cc = bx; cc < 256; cc += G) {
        {
            const int bk = cc >> 3, b = bk >> 1, kvh = bk & 1, qb0 = (cc & 7) * 8;
            const int g = wave >> 1, qh = wave & 1, head = kvh * 4 + g;
            const bf16_t* Kg = P + (size_t)b * SEQ * NIN + C_SK + kvh * 64;
            const bf16_t* Vg = (const bf16_t*)(p.ws + WS_SVT) + (size_t)(b * 2 + kvh) * 64 * SEQ;
            const bf16_t* Qg = P + ((size_t)b * SEQ + 32 * qh) * NIN + C_SQ + head * 64;
            const bf16_t* Gg = P + ((size_t)b * SEQ + 32 * qh) * NIN + C_GATE + head * 64;
            bf16_t* Og = MIX + ((size_t)b * SEQ + 32 * qh) * DM + head * 64;
            const float sink = p.sinks[l * 8 + head] * 1.4426950408889634f;
            const int krow = tid >> 3, kch = tid & 7, vd = tid / 24, vch = tid % 24;
            u32x4 kreg[3], vreg[3]; bf16x8 qf[4], qn[4];
#define SWA_ISSUE(qb_) do { const int kb0_ = 64 * (qb_) - 128; \
                _Pragma("unroll") for (int i_ = 0; i_ < 3; ++i_) { \
                    { int kr_ = kb0_ + krow + 64 * i_; kr_ = kr_ < 0 ? 0 : kr_; kreg[i_] = ldg16(Kg, (unsigned)(kr_ * NIN + 8 * kch) * 2u); }     \
                    { const int idx_ = tid + 512 * i_, d_ = idx_ / 24, ch_ = idx_ % 24; int k0_ = kb0_ + 8 * ch_; k0_ = k0_ < 0 ? 0 : k0_; vreg[i_] = ldg16(Vg, (unsigned)(d_ * SEQ + k0_) * 2u); } } \
                { const bf16_t* Qp_ = Qg + (size_t)(64 * (qb_)) * NIN; \
                  _Pragma("unroll") for (int ks_ = 0; ks_ < 4; ++ks_) qn[ks_] = __builtin_bit_cast(bf16x8, ldg16(Qp_ + 16 * ks_, qoff)); } } while (0)
#define SWA_WRITE(buf_) do { LAS unsigned char* Ki_ = lds + (buf_) * SWA_IMG; LAS unsigned char* Vi_ = Ki_ + 192 * KROW; \
                _Pragma("unroll") for (int i_ = 0; i_ < 3; ++i_) { const int idx_ = tid + 512 * i_; \
                    *(LAS u32x4*)(Ki_ + (krow + 64 * i_) * KROW + 16 * kch) = kreg[i_]; \
                    { LAS unsigned char* d_ = Vi_ + (idx_ / 24) * SWA_VS + 16 * (idx_ % 24); u32x2 a_, b_; a_.x = vreg[i_].x; a_.y = vreg[i_].y; b_.x = vreg[i_].z; b_.y = vreg[i_].w; \
                      *(LAS u32x2*)d_ = a_; *(LAS u32x2*)(d_ + 8) = b_; } } } while (0)
            (void)vd; (void)vch;
            SWA_ISSUE(qb0);
            SWA_WRITE(0);
#pragma unroll
            for (int ks = 0; ks < 4; ++ks) qf[ks] = qn[ks];
            __syncthreads();
            for (int i = 0; i < 8; ++i) {
                const int qb = qb0 + i;
                if (i < 7) SWA_ISSUE(qb + 1);
                {
                    const LAS unsigned char* Kimg = lds + (i & 1) * SWA_IMG; const LAS unsigned char* VTimg = Kimg + 192 * KROW;
                    const int first = 4 - 2 * qb, st0 = qh > first ? qh : first;
                    f32x16 o0, o1; float lsum = h == 0 ? 1.f : 0.f; u32x4 gv[4];
                    attn_gate_load(gv, Gg + (size_t)(64 * qb) * NIN, lane);
                    attn_wave(o0, o1, lsum, sink, qf, Kimg, VTimg, SWA_VS, st0, qh + 5, qh, qh + 4, r, h);
                    attn_store(o0, o1, lsum, gv, stg, Og + (size_t)(64 * qb) * DM, lane);
                }
                if (i < 7) { SWA_WRITE((i + 1) & 1);
#pragma unroll
                    for (int ks = 0; ks < 4; ++ks) qf[ks] = qn[ks]; }
                __syncthreads();
            }
#undef SWA_ISSUE
#undef SWA_WRITE
        }
        {
            const int bh = cc >> 2, b = bh >> 2, hm = bh & 3, qk0 = (cc & 3) * 4;
            const bf16_t* Kg = (const bf16_t*)(p.ws + WS_MK) + (size_t)l * MEMROWS * 256 + (size_t)b * NMEM * 256 + hm * 64;
            const bf16_t* Vg = (const bf16_t*)(p.ws + WS_MVT) + (size_t)l * MEMROWS * 256 + (size_t)(b * 4 + hm) * 64 * NMEM;
            const bf16_t* Qg = P + ((size_t)b * SEQ + 32 * wave) * NIN + C_MQ + hm * 64;
            const bf16_t* Gg = P + ((size_t)b * SEQ + 32 * wave) * NIN + C_GATE + 768 + hm * 64;
            bf16_t* Og = MIX + ((size_t)b * SEQ + 32 * wave) * DM + 768 + hm * 64;
            LAS unsigned char* Ki = lds; LAS unsigned char* Vi = lds + 256 * KROW;
#pragma unroll
            for (int i = 0; i < 4; ++i) { const int idx = tid + 512 * i;
                *(LAS u32x4*)(Ki + (idx >> 3) * KROW + 16 * (idx & 7)) = ldg16(Kg, (unsigned)((idx >> 3) * 256 + 8 * (idx & 7)) * 2u);
                const u32x4 v = ldg16(Vg, (unsigned)((idx >> 5) * NMEM + 8 * (idx & 31)) * 2u);
                LAS unsigned char* d = Vi + (idx >> 5) * MEM_VS + 16 * (idx & 31); u32x2 a_, b_; a_.x = v.x; a_.y = v.y; b_.x = v.z; b_.y = v.w;
                *(LAS u32x2*)d = a_; *(LAS u32x2*)(d + 8) = b_; }
            bf16x8 qf[4], qn[4];
#pragma unroll
            for (int ks = 0; ks < 4; ++ks) qf[ks] = __builtin_bit_cast(bf16x8, ldg16(Qg + (size_t)(256 * qk0) * NIN + 16 * ks, qoff));
            __syncthreads();
            for (int i = 0; i < 4; ++i) {
                const int qk = qk0 + i;
                if (i < 3) {
#pragma unroll
                    for (int ks = 0; ks < 4; ++ks) qn[ks] = __builtin_bit_cast(bf16x8, ldg16(Qg + (size_t)(256 * (qk + 1)) * NIN + 16 * ks, qoff)); }
                f32x16 o0, o1; float lsum = 0.f; u32x4 gv[4];
                attn_gate_load(gv, Gg + (size_t)(256 * qk) * NIN, lane);
                attn_wave(o0, o1, lsum, -1e30f, qf, Ki, Vi, MEM_VS, 0, 8, -1, -1, r, h);
                attn_store(o0, o1, lsum, gv, stg, Og + (size_t)(256 * qk) * DM, lane);
                if (i < 3) {
#pragma unroll
                    for (int ks = 0; ks < 4; ++ks) qf[ks] = qn[ks]; }
            }
            __syncthreads();
        }
    }
}

constexpr size_t DN_M = WS_DN;
constexpr size_t DN_NT = WS_DN + 32 * MiB;
constexpr size_t DN_UT = WS_DN + 96 * MiB;
constexpr size_t DN_W = WS_DN + 128 * MiB;
constexpr size_t DN_QG = WS_DN + 160 * MiB;
constexpr size_t DN_IN = WS_DN + 192 * MiB;
constexpr size_t DN_ST = WS_DN + 224 * MiB;
constexpr int LDK = 72;

DI void mm16x64(f32x4 (&acc)[4], const LAS bf16_t* A, int r0, const LAS bf16_t* Bt, int fr, int fq) {
    bf16x8 a[2];
#pragma unroll
    for (int ks = 0; ks < 2; ++ks) a[ks] = *(const LAS bf16x8*)(A + (r0 + fr) * LDK + 32 * ks + 8 * fq);
#pragma unroll
    for (int nt = 0; nt < 4; ++nt)
#pragma unroll
        for (int ks = 0; ks < 2; ++ks) { const bf16x8 b = *(const LAS bf16x8*)(Bt + (16 * nt + fr) * LDK + 32 * ks + 8 * fq); acc[nt] = MFMA16(a[ks], b, acc[nt]); }
}
DI void conv16(float (&out)[16], const bf16_t* Pcol, size_t rowb, int s0, const float* cw) {
#pragma unroll
    for (int e = 0; e < 16; ++e) out[e] = 0.f;
#pragma unroll
    for (int j = 0; j < 4; ++j) {
        const int s = s0 + j;
        if (s >= 0) {
            const u32x4 x0 = *(const u32x4*)(Pcol + (rowb + s) * NIN), x1 = *(const u32x4*)(Pcol + (rowb + s) * NIN + 8);
            const f32x4 w0 = *(const f32x4*)(cw + j * 768), w1 = *(const f32x4*)(cw + j * 768 + 4), w2 = *(const f32x4*)(cw + j * 768 + 8), w3 = *(const f32x4*)(cw + j * 768 + 12);
            out[0] += w0.x * bflo(x0.x); out[1] += w0.y * bfhi(x0.x); out[2] += w0.z * bflo(x0.y); out[3] += w0.w * bfhi(x0.y);
            out[4] += w1.x * bflo(x0.z); out[5] += w1.y * bfhi(x0.z); out[6] += w1.z * bflo(x0.w); out[7] += w1.w * bfhi(x0.w);
            out[8] += w2.x * bflo(x1.x); out[9] += w2.y * bfhi(x1.x); out[10] += w2.z * bflo(x1.y); out[11] += w2.w * bfhi(x1.y);
            out[12] += w3.x * bflo(x1.z); out[13] += w3.y * bfhi(x1.z); out[14] += w3.z * bflo(x1.w); out[15] += w3.w * bfhi(x1.w);
        }
    }
#pragma unroll
    for (int e = 0; e < 16; ++e) out[e] = siluf_(out[e]);
}
DI u32x4 pack8(const float* v) { u32x4 w; w.x = cvtpk(v[0], v[1]); w.y = cvtpk(v[2], v[3]); w.z = cvtpk(v[4], v[5]); w.w = cvtpk(v[6], v[7]); return w; }
DI u32x2 pack4(const f32x4 v) { u32x2 w; w.x = cvtpk(v[0], v[1]); w.y = cvtpk(v[2], v[3]); return w; }

constexpr int DNP_SG = 67584;
#define MFMAF32(a, b, c) __builtin_amdgcn_mfma_f32_16x16x4f32((a), (b), (c), 0, 0, 0)
DI void dn_prep_phase(const Params& p, int l, LAS unsigned char* lds, int tid, int G, int bx) {
    const int sg = tid >> 8, ts = tid & 255, lane = tid & 63, wsg = __builtin_amdgcn_readfirstlane((tid >> 6) & 3), fr = lane & 15, fq = lane >> 4;
    LAS unsigned char* base = lds + sg * DNP_SG;
    LAS bf16_t* qs = (LAS bf16_t*)(base); LAS float* Tf = (LAS float*)(base); LAS bf16_t* wT = (LAS bf16_t*)(base);
    LAS bf16_t* ks = (LAS bf16_t*)(base + 9216); LAS bf16_t* uT = ks;
    LAS bf16_t* kdT = (LAS bf16_t*)(base + 18432);
    LAS bf16_t* kbgT = (LAS bf16_t*)(base + 27648);
    LAS bf16_t* vbT = (LAS bf16_t*)(base + 36864);
    LAS float* Lf = (LAS float*)(base + 46080); LAS bf16_t* Tm = (LAS bf16_t*)(base + 46080);
    LAS float* gcs = (LAS float*)(base + 63488); LAS float* betas = gcs + 64;
    LAS float* cws = (LAS float*)(base + 64000);
    const bf16_t* P = (const bf16_t*)(p.ws + WS_P);
    const float* BA = (const float*)(p.ws + WS_BA);
    const int dg = ts & 15, tg = ts >> 4;
    const int xoff = ((4 * tg - 3) * NIN + 4 * dg) * 2;
    u32x2 xr[3][7]; float gL = 0.f, bL = 0.f;
#define DNP_LOAD(ch_) do { const int b_ = (ch_) >> 8, h_ = ((ch_) >> 6) & 3, n_ = (ch_) & 63; const size_t row0_ = (size_t)b_ * SEQ + n_ * 64; \
        const char* xb_ = (const char*)(P + row0_ * NIN + C_DQ + h_ * 64); \
        _Pragma("unroll") for (int t_ = 0; t_ < 3; ++t_) _Pragma("unroll") for (int jj_ = 0; jj_ < 7; ++jj_) xr[t_][jj_] = *(const u32x2*)(xb_ + t_ * 512 + jj_ * (NIN * 2) + xoff); \
        { const float* ba_ = BA + row0_ * 8 + h_; gL = ba_[lane * 8 + 4]; bL = ba_[lane * 8]; } } while (0)
    int it = bx, hcur = -1;
    if (it < 2048) DNP_LOAD(2 * it + sg);
    for (; it < 2048; it += G) {
        const int ch = 2 * it + sg, b = ch >> 8, h = (ch >> 6) & 3, n = ch & 63;
        if (h != hcur) {
            __syncthreads();
            for (int e2 = ts; e2 < 768; e2 += 256) cws[e2] = p.conv_w[(size_t)l * 4 * 768 + ((e2 >> 6) & 3) * 768 + (e2 >> 8) * 256 + h * 64 + (e2 & 63)];
            hcur = h;
            __syncthreads();
        }
        SEC_BEGIN(1)
        float c3[3][4][4];
#pragma unroll
        for (int t3 = 0; t3 < 3; ++t3) {
            f32x4 wv[4];
#pragma unroll
            for (int j = 0; j < 4; ++j) wv[j] = *(const LAS f32x4*)(cws + (t3 * 4 + j) * 64 + 4 * dg);
            float xf[7][4];
#pragma unroll
            for (int jj = 0; jj < 7; ++jj) { u32x2 x = xr[t3][jj]; if (n == 0 && 4 * tg - 3 + jj < 0) { x.x = 0u; x.y = 0u; }
                xf[jj][0] = bflo(x.x); xf[jj][1] = bfhi(x.x); xf[jj][2] = bflo(x.y); xf[jj][3] = bfhi(x.y); }
#pragma unroll
            for (int e = 0; e < 4; ++e)
#pragma unroll
                for (int d = 0; d < 4; ++d) c3[t3][e][d] = siluf_((wv[0][d] * xf[e][d] + wv[1][d] * xf[e + 1][d]) + (wv[2][d] * xf[e + 2][d] + wv[3][d] * xf[e + 3][d]));
        }
        float x = gL; const float betaL = bL;
#pragma unroll
        for (int o = 1; o < 64; o <<= 1) { const float y = __shfl_up(x, o); if (lane >= o) x += y; }
        const float gl = __shfl(x, 63);
        if (wsg == 0) { gcs[lane] = x; betas[lane] = betaL; }
        float eg[4], ed[4], be[4], rq[4], rk[4];
#pragma unroll
        for (int e = 0; e < 4; ++e) { const float gc = __shfl(x, 4 * tg + e); be[e] = __shfl(betaL, 4 * tg + e); eg[e] = __expf(gc); ed[e] = __expf(gl - gc);
            float sq = (c3[0][e][0] * c3[0][e][0] + c3[0][e][1] * c3[0][e][1]) + (c3[0][e][2] * c3[0][e][2] + c3[0][e][3] * c3[0][e][3]);
            float sk = (c3[1][e][0] * c3[1][e][0] + c3[1][e][1] * c3[1][e][1]) + (c3[1][e][2] * c3[1][e][2] + c3[1][e][3] * c3[1][e][3]);
            sq += __shfl_xor(sq, 1); sq += __shfl_xor(sq, 2); sq += __shfl_xor(sq, 4); sq += __shfl_xor(sq, 8);
            sk += __shfl_xor(sk, 1); sk += __shfl_xor(sk, 2); sk += __shfl_xor(sk, 4); sk += __shfl_xor(sk, 8);
            rq[e] = rsqrtf(sq + EPS) * 0.125f; rk[e] = rsqrtf(sk + EPS); }
        { bf16_t* qgd = (bf16_t*)(p.ws + DN_QG) + (size_t)ch * 4096;
#pragma unroll
          for (int e = 0; e < 4; ++e) {
              f32x4 q4, k4, g4;
#pragma unroll
              for (int d = 0; d < 4; ++d) { q4[d] = c3[0][e][d] * rq[e]; k4[d] = c3[1][e][d] * rk[e]; g4[d] = q4[d] * eg[e]; c3[0][e][d] = q4[d]; c3[1][e][d] = k4[d]; }
              *(LAS u32x2*)(qs + (4 * tg + e) * LDK + 4 * dg) = pack4(q4); *(LAS u32x2*)(ks + (4 * tg + e) * LDK + 4 * dg) = pack4(k4);
              stg8(qgd, (unsigned)((4 * tg + e) * 64 + 4 * dg) * 2u, pack4(g4)); }
#pragma unroll
          for (int d = 0; d < 4; ++d) {
              f32x4 a, bb, cvv;
#pragma unroll
              for (int e = 0; e < 4; ++e) { a[e] = c3[1][e][d] * ed[e]; bb[e] = c3[1][e][d] * be[e] * eg[e]; cvv[e] = c3[2][e][d] * be[e]; }
              *(LAS u32x2*)(kdT + (4 * dg + d) * LDK + 4 * tg) = pack4(a); *(LAS u32x2*)(kbgT + (4 * dg + d) * LDK + 4 * tg) = pack4(bb); *(LAS u32x2*)(vbT + (4 * dg + d) * LDK + 4 * tg) = pack4(cvv); } }
        __syncthreads();
        SEC_END(1)
        SEC_BEGIN(3)
        {
            f32x4 acc[4], acc2[4];
#pragma unroll
            for (int nt = 0; nt < 4; ++nt) { acc[nt] = (f32x4){0.f, 0.f, 0.f, 0.f}; acc2[nt] = (f32x4){0.f, 0.f, 0.f, 0.f}; }
            mm16x64(acc, ks, 16 * wsg, ks, fr, fq);
            mm16x64(acc2, ks, 16 * wsg, qs, fr, fq);
            const int r0 = 16 * wsg + 4 * fq;
            float gr[4], br[4];
#pragma unroll
            for (int r = 0; r < 4; ++r) { gr[r] = gcs[r0 + r]; br[r] = betas[r0 + r]; }
#pragma unroll
            for (int nt = 0; nt < 4; ++nt) { const int cc = 16 * nt + fr; const float gcol = gcs[cc];
#pragma unroll
                for (int r = 0; r < 4; ++r) { const int c = r0 + r;
                    Lf[c * 68 + cc] = (cc < c) ? br[r] * acc[nt][r] * __expf(gr[r] - gcol) : 0.f; }
                f32x4 iv;
#pragma unroll
                for (int r = 0; r < 4; ++r) { const int s2 = r0 + r;
                    iv[r] = (s2 <= cc) ? acc2[nt][r] * __expf(gcol - gr[r]) : 0.f; }
                stg8((bf16_t*)(p.ws + DN_IN) + (size_t)ch * 4096, (unsigned)(cc * 64 + r0) * 2u, pack4(iv)); }
        }
        __syncthreads();
        SEC_END(3)
        SEC_BEGIN(4)
        {
            {
                const int a = fq, j = fr; const LAS float* La = Lf + (16 * a) * 68 + 16 * a;
                float T[16];
#pragma unroll
                for (int c = 0; c < 16; ++c) T[c] = 0.f;
                const float jf = (float)j;
#pragma unroll
                for (int c = 0; c < 16; ++c) {
                    float a0 = fmaxf(0.f, 1.f - fabsf(jf - (float)c)), a1 = 0.f, a2 = 0.f, a3 = 0.f;
#pragma unroll
                    for (int s4 = 0; s4 < (c + 3) / 4; ++s4) { const f32x4 Lv = *(const LAS f32x4*)(La + c * 68 + 4 * s4);
                        a0 -= Lv.x * T[4 * s4]; a1 -= Lv.y * T[4 * s4 + 1]; a2 -= Lv.z * T[4 * s4 + 2]; a3 -= Lv.w * T[4 * s4 + 3]; }
                    T[c] = (a0 + a1) + (a2 + a3);
                }
#pragma unroll
                for (int c = 0; c < 16; ++c) Tf[(16 * a + c) * 68 + 16 * a + j] = T[c];
            }
            asm volatile("s_waitcnt lgkmcnt(0)" ::: "memory");
            const int bcol = wsg;
            LAS float* Xs = Tf + 16 * (bcol + 1);
            for (int a = bcol + 1; a < 4; ++a) {
                f32x4 xacc = (f32x4){0.f, 0.f, 0.f, 0.f};
                for (int c = bcol; c < a; ++c) {
#pragma unroll
                    for (int st = 0; st < 4; ++st) xacc = MFMAF32(Lf[(16 * a + fr) * 68 + 16 * c + 4 * st + fq], Tf[(16 * c + 4 * st + fq) * 68 + 16 * bcol + fr], xacc);
                }
#pragma unroll
                for (int r = 0; r < 4; ++r) Xs[(4 * fq + r) * 68 + fr] = xacc[r];
                asm volatile("s_waitcnt lgkmcnt(0)" ::: "memory");
                f32x4 tacc = (f32x4){0.f, 0.f, 0.f, 0.f};
#pragma unroll
                for (int st = 0; st < 4; ++st) tacc = MFMAF32(Tf[(16 * a + fr) * 68 + 16 * a + 4 * st + fq], Xs[(4 * st + fq) * 68 + fr], tacc);
#pragma unroll
                for (int r = 0; r < 4; ++r) Tf[(16 * a + 4 * fq + r) * 68 + 16 * bcol + fr] = -tacc[r];
                asm volatile("s_waitcnt lgkmcnt(0)" ::: "memory");
            }
        }
        __syncthreads();
        {
            const int c = ts >> 2, sgm = ts & 3; float v[16];
#pragma unroll
            for (int q4 = 0; q4 < 4; ++q4) { const f32x4 t4 = *(const LAS f32x4*)(Tf + c * 68 + 16 * sgm + 4 * q4);
#pragma unroll
                for (int e = 0; e < 4; ++e) v[4 * q4 + e] = (16 * sgm + 4 * q4 + e <= c) ? t4[e] : 0.f; }
            *(LAS u32x4*)(Tm + c * LDK + 16 * sgm) = pack8(v); *(LAS u32x4*)(Tm + c * LDK + 16 * sgm + 8) = pack8(v + 8);
        }
        __syncthreads();
        SEC_END(4)
        SEC_BEGIN(5)
        {   f32x4 au[4], aw[4], awr[4];
#pragma unroll
            for (int nt = 0; nt < 4; ++nt) { au[nt] = (f32x4){0.f, 0.f, 0.f, 0.f}; aw[nt] = au[nt]; awr[nt] = au[nt]; }
            mm16x64(au, Tm, 16 * wsg, vbT, fr, fq);
            mm16x64(aw, Tm, 16 * wsg, kbgT, fr, fq);
            mm16x64(awr, kbgT, 16 * wsg, Tm, fr, fq);
            const int r0 = 16 * wsg + 4 * fq;
#pragma unroll
            for (int nt = 0; nt < 4; ++nt) { const int cc = 16 * nt + fr;
                const u32x2 pu = pack4(au[nt]);
                *(LAS u32x2*)(uT + cc * LDK + r0) = pu; stg8((bf16_t*)(p.ws + DN_UT) + (size_t)ch * 4096, (unsigned)(cc * 64 + r0) * 2u, pu);
                *(LAS u32x2*)(wT + cc * LDK + r0) = pack4(aw[nt]);
                stg8((bf16_t*)(p.ws + DN_W) + (size_t)ch * 4096, (unsigned)(cc * 64 + r0) * 2u, pack4(awr[nt])); }
        }
        __syncthreads();
        SEC_END(5)
        if (it + G < 2048) DNP_LOAD(2 * (it + G) + sg);
        {   f32x4 am[4], an[4];
#pragma unroll
            for (int nt = 0; nt < 4; ++nt) { am[nt] = (f32x4){0.f, 0.f, 0.f, 0.f}; an[nt] = am[nt]; }
            mm16x64(am, wT, 16 * wsg, kdT, fr, fq);
            mm16x64(an, kdT, 16 * wsg, uT, fr, fq);
            const int r0 = 16 * wsg + 4 * fq; const float egl = __expf(gl);
#pragma unroll
            for (int nt = 0; nt < 4; ++nt) { const int cc = 16 * nt + fr; f32x4 mv;
#pragma unroll
                for (int r = 0; r < 4; ++r) mv[r] = ((r0 + r) == cc ? egl : 0.f) - am[nt][r];
                stg8((bf16_t*)(p.ws + DN_M) + (size_t)ch * 4096, (unsigned)(cc * 64 + r0) * 2u, pack4(mv));
                stg16f((float*)(p.ws + DN_NT) + (size_t)ch * 4096, (unsigned)(cc * 64 + r0) * 4u, an[nt]); }
        }
        __syncthreads();
    }
#undef DNP_LOAD
}
#define SCAN_LOAD(A_, C_, n_) do { const bf16_t* M_ = Mb + (size_t)(n_) * 4096; const float* N_ = Nb + (size_t)(n_) * 4096; \
        _Pragma("unroll") for (int mt = 0; mt < 4; ++mt) { C_[mt] = *(const f32x4*)(N_ + j * 64 + 16 * mt + 4 * fq); \
            _Pragma("unroll") for (int ks = 0; ks < 2; ++ks) { A_[mt][ks][0] = *(const s16x4*)(M_ + (16 * mt + fr) * 64 + 32 * ks + 4 * fq); A_[mt][ks][1] = *(const s16x4*)(M_ + (16 * mt + fr) * 64 + 32 * ks + 16 + 4 * fq); } } } while (0)
#define SCAN_STORE(n_) do { bf16_t* ST_ = Sb + (size_t)(n_) * 4096; _Pragma("unroll") for (int mt = 0; mt < 4; ++mt) *(u32x2*)(ST_ + j * 64 + 16 * mt + 4 * fq) = pack4(S[mt]); } while (0)
#define SCAN_STEP(A_, C_) do { bf16x8 bfr_[2]; \
        _Pragma("unroll") for (int ks = 0; ks < 2; ++ks) { u32x4 w_; const u32x2 lo_ = pack4(S[2 * ks]), hi_ = pack4(S[2 * ks + 1]); w_.x = lo_.x; w_.y = lo_.y; w_.z = hi_.x; w_.w = hi_.y; bfr_[ks] = __builtin_bit_cast(bf16x8, w_); } \
        _Pragma("unroll") for (int mt = 0; mt < 4; ++mt) { f32x4 a_ = C_[mt]; \
            _Pragma("unroll") for (int ks = 0; ks < 2; ++ks) a_ = MFMA16(__builtin_shufflevector(A_[mt][ks][0], A_[mt][ks][1], 0, 1, 2, 3, 4, 5, 6, 7), bfr_[ks], a_); \
            S[mt] = a_; } } while (0)
DI void dn_scan_item(const Params& p, int item, int lane) {
    const int bh = item >> 2, js = item & 3, fr = lane & 15, fq = lane >> 4, j = 16 * js + fr;
    f32x4 S[4];
#pragma unroll
    for (int mt = 0; mt < 4; ++mt) S[mt] = (f32x4){0.f, 0.f, 0.f, 0.f};
    const bf16_t* Mb = (const bf16_t*)(p.ws + DN_M) + (size_t)bh * 64 * 4096;
    const float* Nb = (const float*)(p.ws + DN_NT) + (size_t)bh * 64 * 4096;
    bf16_t* Sb = (bf16_t*)(p.ws + DN_ST) + (size_t)bh * 64 * 4096;
    s16x4 aA[4][2][2], aB[4][2][2]; f32x4 cA[4], cB[4];
    SCAN_LOAD(aA, cA, 0); SCAN_LOAD(aB, cB, 1);
    for (int n = 0; n < 62; n += 2) {
        SCAN_STORE(n);     SCAN_STEP(aA, cA); SCAN_LOAD(aA, cA, n + 2);
        SCAN_STORE(n + 1); SCAN_STEP(aB, cB); if (n + 3 < 63) SCAN_LOAD(aB, cB, n + 3);
    }
    SCAN_STORE(62); SCAN_STEP(aA, cA);
    SCAN_STORE(63);
}
#undef SCAN_LOAD
#undef SCAN_STORE
#undef SCAN_STEP
DI void dn_out_phase(const Params& p, int l, LAS unsigned char* lds, int tid, int G, int bx) {
    const int sg = tid >> 8, ts = tid & 255, lane = tid & 63, w = __builtin_amdgcn_readfirstlane((tid >> 6) & 3), fr = lane & 15, fq = lane >> 4, r0 = 16 * w;
    LAS unsigned char* base = lds + sg * 40960;
    LAS bf16_t* vT = (LAS bf16_t*)(base + 18432);
    LAS unsigned char* stg = base + 27648 + w * 2304;
    const bf16_t* P = (const bf16_t*)(p.ws + WS_P);
    bf16_t* MIX = (bf16_t*)(p.ws + WS_H);
    float gn[4];
#pragma unroll
    for (int nt = 0; nt < 4; ++nt) gn[nt] = p.dn_g[l * 64 + 16 * nt + fr];
    const unsigned offA = (unsigned)((r0 + fr) * 64 + 8 * fq) * 2u;
    const unsigned offU = (unsigned)(fr * 64 + r0 + 4 * fq) * 2u;
    const unsigned offS0 = (unsigned)((ts >> 3) * 64 + 8 * (ts & 7)) * 2u;
    const unsigned offG = (unsigned)((lane >> 3) * NIN + 8 * (lane & 7)) * 2u, offO = (unsigned)((lane >> 3) * DM + 8 * (lane & 7)) * 2u;
    u32x4 stn[2], wn[2], qn[2], inn[2], gvn[2]; u32x2 un[4];
#define DNO_LOAD(ch_) do { const size_t cb_ = (size_t)(ch_) * 4096; const int b_ = (ch_) >> 8, h_ = ((ch_) >> 6) & 3, n_ = (ch_) & 63; \
        const bf16_t* ST_ = (const bf16_t*)(p.ws + DN_ST) + cb_; stn[0] = ldg16(ST_, offS0); stn[1] = ldg16(ST_ + 32 * 64, offS0); \
        const bf16_t* W_ = (const bf16_t*)(p.ws + DN_W) + cb_; wn[0] = ldg16(W_, offA); wn[1] = ldg16(W_ + 32, offA); \
        const bf16_t* Q_ = (const bf16_t*)(p.ws + DN_QG) + cb_; qn[0] = ldg16(Q_, offA); qn[1] = ldg16(Q_ + 32, offA); \
        const bf16_t* I_ = (const bf16_t*)(p.ws + DN_IN) + cb_; inn[0] = ldg16(I_, offA); inn[1] = ldg16(I_ + 32, offA); \
        const bf16_t* U_ = (const bf16_t*)(p.ws + DN_UT) + cb_; _Pragma("unroll") for (int nt_ = 0; nt_ < 4; ++nt_) un[nt_] = *(const u32x2*)((const char*)(U_ + 16 * nt_ * 64) + offU); \
        const bf16_t* G_ = P + ((size_t)b_ * SEQ + n_ * 64 + r0) * NIN + C_GATE + 512 + h_ * 64; gvn[0] = ldg16(G_, offG); gvn[1] = ldg16(G_ + (size_t)8 * NIN, offG); } while (0)
#define DNO_WRITE_ST(buf_) do { LAS unsigned char* d_ = base + (buf_) * 9216 + (ts >> 3) * 144 + 16 * (ts & 7); *(LAS u32x4*)d_ = stn[0]; *(LAS u32x4*)(d_ + 32 * 144) = stn[1]; } while (0)
    int it = bx, buf = 0;
    if (it < 2048) { DNO_LOAD(2 * it + sg); DNO_WRITE_ST(0); }
    __syncthreads();
    for (; it < 2048; it += G) {
        const int ch = 2 * it + sg, b = ch >> 8, h = (ch >> 6) & 3, n = ch & 63;
        const bf16x8 wA[2] = {__builtin_bit_cast(bf16x8, wn[0]), __builtin_bit_cast(bf16x8, wn[1])}, qA[2] = {__builtin_bit_cast(bf16x8, qn[0]), __builtin_bit_cast(bf16x8, qn[1])};
        const bf16x8 iA[2] = {__builtin_bit_cast(bf16x8, inn[0]), __builtin_bit_cast(bf16x8, inn[1])};
        const u32x4 gv[2] = {gvn[0], gvn[1]}; u32x2 uc[4];
#pragma unroll
        for (int nt = 0; nt < 4; ++nt) uc[nt] = un[nt];
        const bool has_next = it + G < 2048;
        if (has_next) DNO_LOAD(2 * (it + G) + sg);
        const LAS unsigned char* Si = base + buf * 9216;
        bf16x8 bS[4][2];
#pragma unroll
        for (int nt = 0; nt < 4; ++nt)
#pragma unroll
            for (int ks = 0; ks < 2; ++ks) bS[nt][ks] = *(const LAS bf16x8*)(Si + (16 * nt + fr) * 144 + 64 * ks + 16 * fq);
#pragma unroll
        for (int nt = 0; nt < 4; ++nt) { f32x4 a = (f32x4){0.f, 0.f, 0.f, 0.f};
#pragma unroll
            for (int ks = 0; ks < 2; ++ks) a = MFMA16(wA[ks], bS[nt][ks], a);
            const f32x4 vn = (f32x4){bflo(uc[nt].x) - a[0], bfhi(uc[nt].x) - a[1], bflo(uc[nt].y) - a[2], bfhi(uc[nt].y) - a[3]};
            *(LAS u32x2*)(vT + (16 * nt + fr) * LDK + r0 + 4 * fq) = pack4(vn); }
        __syncthreads();
        f32x4 o[4];
#pragma unroll
        for (int nt = 0; nt < 4; ++nt) { f32x4 a = (f32x4){0.f, 0.f, 0.f, 0.f};
#pragma unroll
            for (int ks = 0; ks < 2; ++ks) a = MFMA16(qA[ks], bS[nt][ks], a);
#pragma unroll
            for (int ks = 0; ks < 2; ++ks) a = MFMA16(iA[ks], *(const LAS bf16x8*)(vT + (16 * nt + fr) * LDK + 32 * ks + 8 * fq), a);
            o[nt] = a; }
        float rinv[4];
#pragma unroll
        for (int r = 0; r < 4; ++r) { float q = (o[0][r] * o[0][r] + o[1][r] * o[1][r]) + (o[2][r] * o[2][r] + o[3][r] * o[3][r]);
            q += __shfl_xor(q, 1); q += __shfl_xor(q, 2); q += __shfl_xor(q, 4); q += __shfl_xor(q, 8);
            rinv[r] = rsqrtf(q * (1.f / 64.f) + EPS); }
#pragma unroll
        for (int nt = 0; nt < 4; ++nt)
#pragma unroll
            for (int r = 0; r < 4; ++r) *(LAS bf16_t*)(stg + (4 * fq + r) * 144 + (16 * nt + fr) * 2) = (bf16_t)f2bf(o[nt][r] * rinv[r] * gn[nt]);
        asm volatile("s_waitcnt lgkmcnt(0)" ::: "memory");
        { bf16_t* Ob = MIX + ((size_t)b * SEQ + n * 64 + r0) * DM + 512 + h * 64;
#pragma unroll
          for (int i = 0; i < 2; ++i) {
              const u32x4 ov = *(const LAS u32x4*)(stg + ((lane >> 3) + 8 * i) * 144 + 16 * (lane & 7)); const u32x4 g4 = gv[i];
              u32x4 wv;
              wv.x = cvtpk(bflo(ov.x) * siluf_(bflo(g4.x)), bfhi(ov.x) * siluf_(bfhi(g4.x)));
              wv.y = cvtpk(bflo(ov.y) * siluf_(bflo(g4.y)), bfhi(ov.y) * siluf_(bfhi(g4.y)));
              wv.z = cvtpk(bflo(ov.z) * siluf_(bflo(g4.z)), bfhi(ov.z) * siluf_(bfhi(g4.z)));
              wv.w = cvtpk(bflo(ov.w) * siluf_(bflo(g4.w)), bfhi(ov.w) * siluf_(bfhi(g4.w)));
              *(u32x4*)((char*)(Ob + (size_t)i * 8 * DM) + offO) = wv; } }
        if (has_next) DNO_WRITE_ST(buf ^ 1);
        buf ^= 1;
        __syncthreads();
    }
#undef DNO_LOAD
#undef DNO_WRITE_ST
}

typedef __attribute__((address_space(1))) unsigned gu32;
#define XB_TMO      128
#define XB_XCNT(j)  (256  + 64 * (j))
#define XB_XSUB(j)  (1280 + 64 * (j))
#define XB_XGEN(j)  (2304 + 64 * (j))
#define XB_TOP      3328
#define XB_TOPGEN   3392
#define XCD_BAR_WORDS 3456
#define XB_SPIN_CAP (1u << 18)

__device__ __forceinline__ unsigned xb_ld(unsigned* p)              { return __hip_atomic_load(p, __ATOMIC_RELAXED, __HIP_MEMORY_SCOPE_AGENT); }
__device__ __forceinline__ unsigned xb_add(unsigned* p, unsigned v) { return __hip_atomic_fetch_add(p, v, __ATOMIC_RELAXED, __HIP_MEMORY_SCOPE_AGENT); }
__device__ __forceinline__ unsigned xb_xcc_id() { return (unsigned)__builtin_amdgcn_s_getreg((3 << 11) | 20) & 0xFu; }
#define XB_SPIN(cond, bar) do { unsigned _sp = 0; while (cond) { __builtin_amdgcn_s_sleep(1); \
    if ((++_sp & 255u) == 0u) { if (xb_ld(&(bar)[XB_TMO])) break; if (_sp > XB_SPIN_CAP) { atomicAdd(&(bar)[XB_TMO], 1u); break; } } } } while (0)

struct XcdBarrier {
    unsigned* bar; unsigned x;
    volatile LAS unsigned* st;
};

__device__ __forceinline__ XcdBarrier xcd_barrier_post(unsigned* bar, volatile LAS unsigned* st) {
    XcdBarrier b; b.bar = bar; b.x = xb_xcc_id(); b.st = st;
    if (threadIdx.x == 0) (void)xb_add(&bar[XB_XCNT(b.x)], 1u);
    return b;
}
__device__ __forceinline__ void xcd_barrier_complete(unsigned* bar, unsigned x, unsigned& nloc, unsigned& nx) {
    const unsigned G = gridDim.x * gridDim.y * gridDim.z;
    unsigned sum, cnt, mine, sp = 0u;
    for (;;) {
        sum = 0u; cnt = 0u; mine = 0u;
#pragma unroll
        for (unsigned j = 0; j < 16; ++j) { const unsigned c = xb_ld(&bar[XB_XCNT(j)]); sum += c; cnt += (c > 0u) ? 1u : 0u; mine = (j == x) ? c : mine; }
        if (sum == G) break;
        __builtin_amdgcn_s_sleep(1);
        if ((++sp & 255u) == 0u) { if (xb_ld(&bar[XB_TMO])) break; if (sp > XB_SPIN_CAP) { atomicAdd(&bar[XB_TMO], 1u); break; } }
    }
    nloc = mine > 0u ? mine : 1u; nx = cnt > 0u ? cnt : 1u;
}

__device__ __forceinline__ void xcd_barrier(const XcdBarrier& b, bool leader_thread) {
    asm volatile("s_waitcnt vmcnt(0)" ::: "memory");
    __syncthreads();
    if (leader_thread) {
        unsigned* bar = b.bar;
        __builtin_amdgcn_s_waitcnt(0);
        unsigned nloc = b.st[0], nx = b.st[1];
        if (nloc == 0u) { xcd_barrier_complete(bar, b.x, nloc, nx); b.st[0] = nloc; b.st[1] = nx; }
        const unsigned old = xb_add(&bar[XB_XSUB(b.x)], 1u);
        const unsigned gen = old / nloc;
        if (old + 1u == (gen + 1u) * nloc) {
            __builtin_amdgcn_fence(__ATOMIC_RELEASE, "agent");
            asm volatile("s_waitcnt vmcnt(0)" ::: "memory");
            const unsigned og = xb_add(&bar[XB_TOP], 1u);
            const unsigned tg = og / nx;
            if (og + 1u == (tg + 1u) * nx) xb_add(&bar[XB_TOPGEN], 1u);
            else XB_SPIN(xb_ld(&bar[XB_TOPGEN]) == tg, bar);
            __builtin_amdgcn_fence(__ATOMIC_ACQUIRE, "agent");
            xb_add(&bar[XB_XGEN(b.x)], 1u);
            asm volatile("s_waitcnt vmcnt(0)" ::: "memory");
        } else {
            XB_SPIN(xb_ld(&bar[XB_XGEN(b.x)]) == gen, bar);
            __builtin_amdgcn_fence(__ATOMIC_ACQUIRE, "agent");
            asm volatile("s_waitcnt vmcnt(0)" ::: "memory");
        }
    }
    __syncthreads();
}

enum { K_PREP = 0, K_INPROJ = 1, K_DNPREP = 2, K_ATTN = 3, K_DNOUT = 4, K_OUTPROJ = 5 };
constexpr int N_PHASES = 13;
namespace cg = cooperative_groups;
__global__ void __launch_bounds__(512, 2) mega(Params p0, int ph_lo, int ph_hi) {
    extern __shared__ __attribute__((aligned(16))) unsigned char lds_raw[];
    LAS unsigned char* lds = (LAS unsigned char*)lds_raw;
    cg::grid_group grid = cg::this_grid();
    const int G = gridDim.x;
    const int wave_s = __builtin_amdgcn_readfirstlane(threadIdx.x >> 6);
    volatile LAS unsigned* MISC = (volatile LAS unsigned*)(lds + 147328);
    if (threadIdx.x < 32) MISC[threadIdx.x] = 0u;
    __syncthreads();
    XcdBarrier bar = xcd_barrier_post((unsigned*)(p0.ws + WS_CTL) + 4096, MISC + 8);
    for (int ph = ph_lo; ph < ph_hi; ++ph) {
        const int l = ph / 6, kind = ph % 6;
        const int nrep = (ph != 12 && ((MK_REP >> kind) & 1)) ? 2 : 1;
        for (int rep = 0; rep < nrep; ++rep) {
#define PHASE_IDS unsigned z_ = 0u; asm volatile("" : "+v"(z_)); int tid = wave_s * 64 + (int)__builtin_amdgcn_mbcnt_hi(~0u, __builtin_amdgcn_mbcnt_lo(~0u, z_)); const int lane = tid & 63, wave = wave_s; \
        int bx = blockIdx.x; asm volatile("" : "+s"(bx)); const int gw = bx * 8 + wave, ngw = G * 8; Params q = p0; asm volatile("" : "+s"(q.ws)); unsigned char* ws = q.ws; const Params& p = q; (void)lane; (void)wave; (void)gw; (void)ngw; (void)ws; (void)p;
        if (ph == 12) { PHASE_IDS
            final_rows(p, gw, ngw, lane);
        } else if (kind == K_PREP) { PHASE_IDS
            if (l == 0) { phase_init(p, lds, gw, ngw, wave, lane); __syncthreads(); }
            LAS float* w8s = (LAS float*)lds;
            for (int e = tid; e < 8 * DM; e += 512) { const int c = e & 7, kk = e >> 3; w8s[c * DM + kk] = p.w_in[(size_t)l * DM * INW + (size_t)kk * INW + 1536 + c]; }
            __syncthreads();
            if (l == 0) prep_rows<false>(p, 0, gw, ngw, lane, w8s); else prep_rows<true>(p, l, gw, ngw, lane, w8s);
            __syncthreads();
        } else if (kind == K_INPROJ) { PHASE_IDS
            { pg8::Gemm g{(const bf16_t*)(ws + WS_H), (const bf16_t*)(ws + WS_WIN) + (size_t)l * NIN * DM, NTOK, NIN, DM};
              pg8::StaticOrder S; S.init(NTOK, NIN, G, bx);
              EpiProj E{(bf16_t*)(ws + WS_P), (bf16_t*)(ws + WS_SVT)};
              pg8::gemm_phase<EpiProj, pg8::StaticOrder, true, true>(lds, g, S, E, tid); }
            if (l == 0) {
                for (int ll = 0; ll < DEPTH; ++ll) {
                    pg8::Gemm g{(const bf16_t*)(ws + WS_MEMN) + (size_t)ll * MEMROWS * DM, (const bf16_t*)(ws + WS_WMKV) + (size_t)ll * 512 * DM, MEMROWS, 512, DM};
                    pg8::StaticOrder S; S.init(MEMROWS, 512, G, (int)((bx + G - 32 * ll) % G));
                    EpiMkv E{(bf16_t*)(ws + WS_MK) + (size_t)ll * MEMROWS * 256, (bf16_t*)(ws + WS_MVT) + (size_t)ll * MEMROWS * 256};
                    pg8::gemm_phase<EpiMkv, pg8::StaticOrder, true, true>(lds, g, S, E, tid);
                }
            }
        } else if (kind == K_DNPREP) { PHASE_IDS
            dn_prep_phase(p, l, lds, tid, G, bx);
        } else if (kind == K_ATTN) { PHASE_IDS
            for (int srep = 0; srep < (((MK_REP >> 6) & 1) ? 2 : 1); ++srep)
            if (wave == 0) for (int item = bx; item < 256; item += G) dn_scan_item(p, item, lane);
            attn_phase(p, l, lds, tid, G, bx);
        } else if (kind == K_DNOUT) { PHASE_IDS
            dn_out_phase(p, l, lds, tid, G, bx);
        } else { PHASE_IDS
            pg8::Gemm g{(const bf16_t*)(ws + WS_H), (const bf16_t*)(ws + WS_WOUT) + (size_t)l * DM * DM, NTOK, DM, DM};
            pg8::StaticOrder S; S.init(NTOK, DM, G, bx);
            EpiY E{(bf16_t*)(ws + WS_P), (float*)(ws + WS_STATS)};
            pg8::gemm_phase<EpiY, pg8::StaticOrder, true, true>(lds, g, S, E, tid);
        }
        if (rep + 1 < nrep) __syncthreads();
        }
        if (ph + 1 < ph_hi) { if (ph == ph_lo) grid.sync(); else xcd_barrier(bar, wave_s == 0 && __builtin_amdgcn_mbcnt_hi(~0u, __builtin_amdgcn_mbcnt_lo(~0u, 0u)) == 0u); }
    }
}

#ifndef MK_MULTI
#define MK_MULTI 0
#endif
extern "C" void kernel_launch(void* const* d_in, const int* in_sizes, int n_in, void* d_out, int out_size, void* d_ws, size_t ws_size, hipStream_t stream) {
    static int grid = 0;
    constexpr int LDS_BYTES = 147456;
    if (grid == 0) {
        if (n_in != 13 || ws_size < WS_END || out_size != NTOK * DM) { fprintf(stderr, "kernel_launch: unexpected n_in %d / ws_size %zu / out_size %d\n", n_in, ws_size, out_size); grid = -1; return; }
        int dev = 0, cus = 0, per_cu = 0;
        if (hipGetDevice(&dev) != hipSuccess || hipDeviceGetAttribute(&cus, hipDeviceAttributeMultiprocessorCount, dev) != hipSuccess) { grid = -1; return; }
        if (hipFuncSetAttribute((const void*)mega, hipFuncAttributeMaxDynamicSharedMemorySize, LDS_BYTES) != hipSuccess) { fprintf(stderr, "kernel_launch: hipFuncSetAttribute failed\n"); grid = -1; return; }
        if (hipOccupancyMaxActiveBlocksPerMultiprocessor(&per_cu, (const void*)mega, 512, LDS_BYTES) != hipSuccess || per_cu < 1) { fprintf(stderr, "kernel_launch: occupancy query failed (%d)\n", per_cu); grid = -1; return; }
        grid = cus * 1;
    }
    if (grid < 0) return;
    Params p{};
    p.x = (const float*)d_in[0]; p.mem = (const float*)d_in[1]; p.pre_g = (const float*)d_in[2]; p.w_in = (const float*)d_in[3]; p.conv_w = (const float*)d_in[4];
    p.a_log = (const float*)d_in[5]; p.dt_bias = (const float*)d_in[6]; p.sinks = (const float*)d_in[7]; p.dn_g = (const float*)d_in[8]; p.mem_g = (const float*)d_in[9];
    p.w_mkv = (const float*)d_in[10]; p.w_out = (const float*)d_in[11]; p.post_g = (const float*)d_in[12];
    p.out = (float*)d_out; p.ws = (unsigned char*)d_ws;
    if (hipMemsetAsync((char*)d_ws + WS_CTL, 0, 1 * MiB, stream) != hipSuccess) { fprintf(stderr, "kernel_launch: hipMemsetAsync failed\n"); return; }
#if MK_MULTI
    for (int ph = 0; ph < N_PHASES; ++ph) hipLaunchKernelGGL(mega, dim3(grid), dim3(512), LDS_BYTES, stream, p, ph, ph + 1);
#else
    int lo = 0, hi = N_PHASES;
    void* args[] = {&p, &lo, &hi};
    const hipError_t e = hipLaunchCooperativeKernel((const void*)mega, dim3(grid), dim3(512), args, LDS_BYTES, stream);
    if (e != hipSuccess) fprintf(stderr, "kernel_launch: cooperative launch failed: %s (grid %d)\n", hipGetErrorString(e), grid);
#endif
}
```

```cpp
#include <hip/hip_runtime.h>
#include <hip/hip_cooperative_groups.h>
#include <cstdio>
#include <cstdint>

#define DI __device__ __forceinline__
#ifndef MK_SEC
#define MK_SEC 0
#endif
#define SEC_BEGIN(id) long long t0_sec##id = 0; if (MK_SEC == id) t0_sec##id = clock64();
#define SEC_END(id) if (MK_SEC == id) { const long long dt_ = clock64() - t0_sec##id; const long long t1_ = clock64(); while (clock64() - t1_ < dt_) {} }
#ifndef MK_REP
#define MK_REP 0
#endif
#define LAS __attribute__((address_space(3)))
typedef unsigned short bf16_t;
typedef float f32x4 __attribute__((ext_vector_type(4)));
typedef unsigned u32x4 __attribute__((ext_vector_type(4)));
typedef unsigned u32x2 __attribute__((ext_vector_type(2)));

constexpr int DM = 1024, NB = 16, SEQ = 4096, NTOK = NB * SEQ, DEPTH = 2;
constexpr int INW = 2824;
constexpr int NIN = 2816;
constexpr int NMEM = 256, MEMROWS = NB * NMEM;
constexpr float EPS = 1e-6f;
constexpr int C_SQ = 0, C_SK = 512, C_SV = 640, C_DQ = 768, C_DK = 1024, C_DV = 1280, C_MQ = 1536, C_GATE = 1792;

constexpr size_t MiB = 1u << 20;
constexpr size_t WS_CTL = 0;
constexpr size_t WS_WIN = 1 * MiB;
constexpr size_t WS_WOUT = 12 * MiB;
constexpr size_t WS_WMKV = 16 * MiB;
constexpr size_t WS_W8 = 18 * MiB;
constexpr size_t WS_MEMN = 19 * MiB;
constexpr size_t WS_MK = 35 * MiB;
constexpr size_t WS_MVT = 39 * MiB;
constexpr size_t WS_BA = 43 * MiB;
constexpr size_t WS_STATS = 45 * MiB;
constexpr size_t WS_SVT = 49 * MiB;
constexpr size_t WS_H = 65 * MiB;
constexpr size_t WS_P = 193 * MiB;
constexpr size_t WS_DN = 545 * MiB;
constexpr size_t WS_END = 801 * MiB;

struct Params {
    const float *x, *mem, *pre_g, *w_in, *conv_w, *a_log, *dt_bias, *sinks, *dn_g, *mem_g, *w_mkv, *w_out, *post_g;
    float* out;
    unsigned char* ws;
};

DI unsigned f2bf(float f) { unsigned u = __float_as_uint(f); return (u + 0x7fffu + ((u >> 16) & 1u)) >> 16; }
DI unsigned pk2(float lo, float hi) { return f2bf(lo) | (f2bf(hi) << 16); }
DI float bf2f(unsigned u) { return __uint_as_float(u << 16); }
DI float bflo(unsigned u) { return __uint_as_float(u << 16); }
DI float bfhi(unsigned u) { return __uint_as_float(u & 0xffff0000u); }
DI float wave_sum(float v) {
#pragma unroll
    for (int o = 1; o < 64; o <<= 1) v += __shfl_xor(v, o);
    return v;
}
DI float sigmoidf_(float x) { return __builtin_amdgcn_rcpf(1.f + __builtin_amdgcn_exp2f(-1.4426950408889634f * x)); }
DI float siluf_(float x) { return x * __builtin_amdgcn_rcpf(1.f + __builtin_amdgcn_exp2f(-1.4426950408889634f * x)); }
DI float softplusf_(float x) { return x > 20.f ? x : log1pf(expf(x)); }

DI void transpose_item(const float* W, int Nsrc, int src_n0, int k0, bf16_t* WT, int K, int dst_n0, LAS float* scr, int lane) {
#pragma unroll 8
    for (int i = 0; i < 32; ++i) { const int kk = 2 * i + (lane >> 5); scr[kk * 33 + (lane & 31)] = W[(size_t)(k0 + kk) * Nsrc + src_n0 + (lane & 31)]; }
    asm volatile("s_waitcnt lgkmcnt(0)" ::: "memory");
    const int c = lane & 7;
#pragma unroll
    for (int j = 0; j < 4; ++j) {
        const int n = (lane >> 3) + 8 * j; const LAS float* s = scr + (8 * c) * 33 + n;
        u32x4 o; o.x = pk2(s[0 * 33], s[1 * 33]); o.y = pk2(s[2 * 33], s[3 * 33]); o.z = pk2(s[4 * 33], s[5 * 33]); o.w = pk2(s[6 * 33], s[7 * 33]);
        *(u32x4*)(WT + (size_t)(dst_n0 + n) * K + k0 + 8 * c) = o;
    }
    asm volatile("s_waitcnt lgkmcnt(0)" ::: "memory");
}

DI void phase_init(const Params& p, LAS unsigned char* lds, int gw, int ngw, int wave, int lane) {
    LAS float* scr = (LAS float*)(lds + wave * 16384);
    constexpr int I_IN = 16 * (NIN / 32), I_OUT = 16 * 32, I_MKV = 16 * 16, I_L = I_IN + I_OUT + I_MKV;
    for (int it = gw; it < DEPTH * I_L; it += ngw) {
        const int l = it / I_L; int r = it % I_L;
        if (r < I_IN) {
            const int kb = r / (NIN / 32), nb = r % (NIN / 32), n0 = nb * 32;
            transpose_item(p.w_in + (size_t)l * DM * INW, INW, n0 + (n0 >= 1536 ? 8 : 0), kb * 64, (bf16_t*)(p.ws + WS_WIN) + (size_t)l * NIN * DM, DM, n0, scr, lane);
        } else if (r < I_IN + I_OUT) {
            r -= I_IN; const int kb = r / 32, nb = r % 32;
            transpose_item(p.w_out + (size_t)l * DM * DM, DM, nb * 32, kb * 64, (bf16_t*)(p.ws + WS_WOUT) + (size_t)l * DM * DM, DM, nb * 32, scr, lane);
        } else {
            r -= I_IN + I_OUT; const int kb = r / 16, nb = r % 16;
            transpose_item(p.w_mkv + (size_t)l * DM * 512, 512, nb * 32, kb * 64, (bf16_t*)(p.ws + WS_WMKV) + (size_t)l * 512 * DM, DM, nb * 32, scr, lane);
        }
    }
    for (int it = gw; it < DEPTH * MEMROWS; it += ngw) {
        const int l = it / MEMROWS, row = it % MEMROWS;
        const f32x4* xr = (const f32x4*)(p.mem + (size_t)row * DM) + lane;
        f32x4 v[4]; float s = 0.f;
#pragma unroll
        for (int j = 0; j < 4; ++j) { v[j] = xr[64 * j]; s += (v[j].x * v[j].x + v[j].y * v[j].y) + (v[j].z * v[j].z + v[j].w * v[j].w); }
        const float r = rsqrtf(wave_sum(s) * (1.f / DM) + EPS);
        const f32x4* gr = (const f32x4*)(p.mem_g + (size_t)l * DM) + lane;
        u32x2* o = (u32x2*)((bf16_t*)(p.ws + WS_MEMN) + ((size_t)l * MEMROWS + row) * DM) + lane;
#pragma unroll
        for (int j = 0; j < 4; ++j) { const f32x4 g = gr[64 * j]; u32x2 w; w.x = pk2(v[j].x * r * g.x, v[j].y * r * g.y); w.y = pk2(v[j].z * r * g.z, v[j].w * r * g.w); o[64 * j] = w; }
    }
}

struct RowRegs { f32x4 x[4]; u32x2 y[4]; float st; };
template <bool L1> DI void prep_load(const Params& p, RowRegs& R, int row, int lane) {
    const f32x4* xr = (const f32x4*)(p.x + (size_t)row * DM) + lane;
#pragma unroll
    for (int j = 0; j < 4; ++j) R.x[j] = xr[64 * j];
    if (L1) {
        const u32x2* yr = (const u32x2*)((const bf16_t*)(p.ws + WS_P) + (size_t)row * DM) + lane;
#pragma unroll
        for (int j = 0; j < 4; ++j) R.y[j] = yr[64 * j];
        R.st = ((const float*)(p.ws + WS_STATS))[(size_t)row * 16 + (lane & 15)];
    }
}
template <bool L1> DI void prep_compute(const Params& p, int l, const RowRegs& R, int row, int lane, const LAS float* W8) {
    f32x4 v[4];
#pragma unroll
    for (int j = 0; j < 4; ++j) v[j] = R.x[j];
    if (L1) {
        float ss = R.st; ss += __shfl_xor(ss, 1); ss += __shfl_xor(ss, 2); ss += __shfl_xor(ss, 4); ss += __shfl_xor(ss, 8);
        const float ry = rsqrtf(ss * (1.f / DM) + EPS);
        const f32x4* pg = (const f32x4*)(p.post_g + (size_t)(l - 1) * DM) + lane;
        f32x4* xo = (f32x4*)(p.out + (size_t)row * DM) + lane;
#pragma unroll
        for (int j = 0; j < 4; ++j) {
            const u32x2 y = R.y[j]; const f32x4 g = pg[64 * j];
            v[j].x += bflo(y.x) * ry * g.x; v[j].y += bfhi(y.x) * ry * g.y; v[j].z += bflo(y.y) * ry * g.z; v[j].w += bfhi(y.y) * ry * g.w;
            xo[64 * j] = v[j];
        }
    }
    float s = 0.f;
#pragma unroll
    for (int j = 0; j < 4; ++j) s += (v[j].x * v[j].x + v[j].y * v[j].y) + (v[j].z * v[j].z + v[j].w * v[j].w);
    const float r = rsqrtf(wave_sum(s) * (1.f / DM) + EPS);
    const f32x4* gr = (const f32x4*)(p.pre_g + (size_t)l * DM) + lane;
    u32x2* ho = (u32x2*)((bf16_t*)(p.ws + WS_H) + (size_t)row * DM) + lane;
#pragma unroll
    for (int j = 0; j < 4; ++j) {
        const f32x4 g = gr[64 * j];
        v[j].x *= r * g.x; v[j].y *= r * g.y; v[j].z *= r * g.z; v[j].w *= r * g.w;
        u32x2 w; w.x = pk2(v[j].x, v[j].y); w.y = pk2(v[j].z, v[j].w); ho[64 * j] = w;
    }
    float d[8];
#pragma unroll
    for (int c = 0; c < 8; ++c) {
        const LAS f32x4* wr = (const LAS f32x4*)(W8 + c * DM) + lane; float a = 0.f;
#pragma unroll
        for (int j = 0; j < 4; ++j) { const f32x4 w = wr[64 * j]; a += (v[j].x * w.x + v[j].y * w.y) + (v[j].z * w.z + v[j].w * w.w); }
        d[c] = a;
    }
    const bool b0 = lane & 1, b1 = lane & 2, b2 = lane & 4;
    float e4[4], e2[2], e1;
#pragma unroll
    for (int i = 0; i < 4; ++i) { const float send = b0 ? d[i] : d[4 + i]; const float keep = b0 ? d[4 + i] : d[i]; e4[i] = keep + __shfl_xor(send, 1); }
#pragma unroll
    for (int i = 0; i < 2; ++i) { const float send = b1 ? e4[i] : e4[2 + i]; const float keep = b1 ? e4[2 + i] : e4[i]; e2[i] = keep + __shfl_xor(send, 2); }
    { const float send = b2 ? e2[0] : e2[1]; const float keep = b2 ? e2[1] : e2[0]; e1 = keep + __shfl_xor(send, 4); }
    e1 += __shfl_xor(e1, 8); e1 += __shfl_xor(e1, 16); e1 += __shfl_xor(e1, 32);
    if (lane < 8) {
        const int c = (lane & 1) * 4 + (lane & 2) + ((lane >> 2) & 1);
        float o;
        if (c < 4) o = sigmoidf_(e1);
        else { const int h = c - 4; o = -__expf(p.a_log[l * 4 + h]) * softplusf_(e1 + p.dt_bias[l * 4 + h]); }
        ((float*)(p.ws + WS_BA))[(size_t)row * 8 + c] = o;
    }
}
template <bool L1> DI void prep_rows(const Params& p, int l, int gw, int ngw, int lane, const LAS float* W8) {
    RowRegs A, B;
    int row = gw;
    if (row < NTOK) prep_load<L1>(p, A, row, lane);
    for (; row < NTOK; row += 2 * ngw) {
        if (row + ngw < NTOK) prep_load<L1>(p, B, row + ngw, lane);
        prep_compute<L1>(p, l, A, row, lane, W8);
        if (row + ngw < NTOK) { if (row + 2 * ngw < NTOK) prep_load<L1>(p, A, row + 2 * ngw, lane); prep_compute<L1>(p, l, B, row + ngw, lane, W8); }
    }
}

struct FinRegs { f32x4 x[4]; u32x2 y[4]; float st; };
DI void final_load(const Params& p, FinRegs& R, int row, int lane) {
    const f32x4* xo = (const f32x4*)(p.out + (size_t)row * DM) + lane; const u32x2* yr = (const u32x2*)((const bf16_t*)(p.ws + WS_P) + (size_t)row * DM) + lane;
#pragma unroll
    for (int j = 0; j < 4; ++j) { R.x[j] = xo[64 * j]; R.y[j] = yr[64 * j]; }
    R.st = ((const float*)(p.ws + WS_STATS))[(size_t)row * 16 + (lane & 15)];
}
DI void final_compute(const Params& p, const FinRegs& R, int row, int lane) {
    float ss = R.st; ss += __shfl_xor(ss, 1); ss += __shfl_xor(ss, 2); ss += __shfl_xor(ss, 4); ss += __shfl_xor(ss, 8);
    const float ry = rsqrtf(ss * (1.f / DM) + EPS);
    const f32x4* pg = (const f32x4*)(p.post_g + (size_t)(DEPTH - 1) * DM) + lane;
    f32x4* xo = (f32x4*)(p.out + (size_t)row * DM) + lane;
#pragma unroll
    for (int j = 0; j < 4; ++j) {
        const u32x2 y = R.y[j]; const f32x4 g = pg[64 * j]; f32x4 v = R.x[j];
        v.x += bflo(y.x) * ry * g.x; v.y += bfhi(y.x) * ry * g.y; v.z += bflo(y.y) * ry * g.z; v.w += bfhi(y.y) * ry * g.w;
        xo[64 * j] = v;
    }
}
DI void final_rows(const Params& p, int gw, int ngw, int lane) {
    FinRegs A, B;
    int row = gw;
    if (row < NTOK) final_load(p, A, row, lane);
    for (; row < NTOK; row += 2 * ngw) {
        if (row + ngw < NTOK) final_load(p, B, row + ngw, lane);
        final_compute(p, A, row, lane);
        if (row + ngw < NTOK) { if (row + 2 * ngw < NTOK) final_load(p, A, row + 2 * ngw, lane); final_compute(p, B, row + ngw, lane); }
    }
}

namespace pg8 {
#define PG8_LAS __attribute__((address_space(3)))
typedef unsigned short bf16_t;
typedef short bf16x8 __attribute__((ext_vector_type(8)));
typedef float f32x4 __attribute__((ext_vector_type(4)));
typedef unsigned u32x4 __attribute__((ext_vector_type(4)));
constexpr int BM = 256, BK = 64, HALF = 128, HTB = HALF * BK * 2  , STAGE_BYTES = 8 * HTB, NXCD = 8, WGM = 8;

__host__ __device__ __forceinline__ int lds_byte(int r, int c) { const int st = (r >> 4) * 2 + (c >> 5), rr = r & 15, cc = c & 31, ob = rr * 64 + cc * 2; return st * 1024 + (ob ^ (((ob >> 9) & 1) << 5)); }
__host__ __device__ __forceinline__ void stage_rc(int b, int& R, int& C) { const int st = b / 1024, sb = b % 1024, swz = sb ^ (((sb >> 9) & 1) << 5); R = (st >> 1) * 16 + swz / 64; C = (st & 1) * 32 + (swz % 64) / 2; }
__host__ __device__ __forceinline__ int perm32(int rho) { const int n = rho >> 4, i = rho & 15; return 8 * (i >> 2) + 4 * n + (i & 3); }

struct Unit { int pm, pn; };
struct Gemm { const bf16_t* A; const bf16_t* Bt; int M, N, K; };

struct StaticOrder {
    int nM, nN, nwg, G, c;
    __host__ __device__ void init(int M, int N, int G_, int c_) { nM = M / BM; nN = N / BM; nwg = nM * nN; G = G_; c = c_; }
    __host__ __device__ bool next(int i, Unit& u) const {
        const long L = (long)i * G + c; if (L >= nwg) return false;
        int wgid = (int)L; { const int q = nwg / NXCD, r = nwg % NXCD, xcd = wgid % NXCD, off = wgid / NXCD; wgid = (xcd < r ? xcd * (q + 1) : r * (q + 1) + (xcd - r) * q) + off; }
        const int nig = WGM * nN, gid = wgid / nig, fm = gid * WGM, gsz = (nM - fm) < WGM ? (nM - fm) : WGM;
        u.pm = fm + ((wgid % nig) % gsz); u.pn = (wgid % nig) / gsz; return true;
    }
    __device__ __forceinline__ void a_ready(const Unit&) const {}
    __device__ __forceinline__ void done(const Unit&) const {}
};

__device__ __forceinline__ unsigned cvt_pk_bf16(float lo, float hi) { unsigned r; asm volatile("v_cvt_pk_bf16_f32 %0, %1, %2" : "=v"(r) : "v"(lo), "v"(hi)); return r; }
template <class Epi, class Sched, bool ALIGN_EPI = false, bool SP2 = false>
__device__ __forceinline__ void gemm_phase(PG8_LAS unsigned char* lds, const Gemm g, const Sched& S, const Epi& E, int tid_in) {
    int tid = tid_in; asm volatile("" : "+v"(tid));
    const int wid = __builtin_amdgcn_readfirstlane(tid >> 6), lane = tid & 63, wr = wid >> 2, wc = wid & 3, fr = lane & 15, fq = lane >> 4;
    const int K = g.K, nt = K / BK;
    unsigned voffA[2], voffB[2];
#pragma unroll
    for (int i = 0; i < 2; ++i) { int R, C; stage_rc(tid * 16 + i * 8192, R, C); const int Rb = Epi::PERM ? ((R & ~31) + perm32(R & 31)) : R;
        voffA[i] = (unsigned)(R * K + C) * 2u; voffB[i] = (unsigned)(Rb * K + C) * 2u; }
    const size_t kstep = (size_t)(BK * 2);
    const size_t hstep = (size_t)HALF * K * 2;
    const size_t tstep = 2 * hstep;
    const unsigned ldsw = (unsigned)wid * 1024u;
    const int aoff = lds_byte(wr * 64 + fr, fq * 8), boff = lds_byte(wc * 32 + fr, fq * 8);
#define PG8_SA(b, h) (((b) * 2 + (h)) * HTB)
#define PG8_SB(b, h) ((4 + (b) * 2 + (h)) * HTB)
#define PG8_STAGE(bufoff, gbase, voff) do { _Pragma("unroll") for (int _i = 0; _i < 2; ++_i) \
        __builtin_amdgcn_global_load_lds((const unsigned*)((const char*)(gbase) + (voff)[_i]), (PG8_LAS unsigned*)(lds + (bufoff) + ldsw + _i * 8192), 16, 0, 0); } while (0)
#define PG8_LDA(dst, b, h) do { _Pragma("unroll") for (int m = 0; m < 4; ++m) _Pragma("unroll") for (int k = 0; k < 2; ++k) dst[m][k] = *(const PG8_LAS bf16x8*)(lds + PG8_SA(b, h) + aoff + m * 2048 + k * 1024); } while (0)
#define PG8_LDB(dst, b, h) do { _Pragma("unroll") for (int n = 0; n < 2; ++n) _Pragma("unroll") for (int k = 0; k < 2; ++k) dst[n][k] = *(const PG8_LAS bf16x8*)(lds + PG8_SB(b, h) + boff + n * 2048 + k * 1024); } while (0)
#define PG8_MMA(ai, bj, At, Bt) do { __builtin_amdgcn_s_setprio(1); _Pragma("unroll") for (int m = 0; m < 4; ++m) _Pragma("unroll") for (int n = 0; n < 2; ++n) _Pragma("unroll") for (int k = 0; k < 2; ++k) \
        acc[ai][bj][m][n] = __builtin_amdgcn_mfma_f32_16x16x32_bf16(Bt[n][k], At[m][k], acc[ai][bj][m][n], 0, 0, 0); __builtin_amdgcn_s_setprio(0); } while (0)
#define PG8_WAIT_V(n) asm volatile("s_waitcnt vmcnt(" #n ")" ::: "memory")
#define PG8_WAIT_L(n) asm volatile("s_waitcnt lgkmcnt(" #n ")" ::: "memory")
#define PG8_BAR __builtin_amdgcn_s_barrier()
#define PG8_SCHED __builtin_amdgcn_sched_barrier(0)
    Unit cur, nxt; int ui = 0;
    if (!S.next(0, cur)) return;
    f32x4 acc[2][2][4][2];
#pragma unroll
    for (int a = 0; a < 2; ++a)
#pragma unroll
        for (int b = 0; b < 2; ++b)
#pragma unroll
            for (int m = 0; m < 4; ++m)
#pragma unroll
                for (int n = 0; n < 2; ++n) acc[a][b][m][n] = (f32x4){0.f, 0.f, 0.f, 0.f};
    bf16x8 At[4][2], B0[2][2], B1[2][2];
    const char* cA = (const char*)g.A + (size_t)cur.pm * tstep; const char* cB = (const char*)g.Bt + (size_t)cur.pn * tstep;
    S.a_ready(cur);
    if constexpr (SP2) {
        PG8_STAGE(PG8_SB(0, 0), cB, voffB); PG8_STAGE(PG8_SB(0, 1), cB + hstep, voffB); PG8_STAGE(PG8_SA(0, 0), cA, voffA); PG8_STAGE(PG8_SA(0, 1), cA + hstep, voffA);
        if (wr == 1) PG8_BAR;
        PG8_WAIT_V(2); PG8_BAR;
        PG8_STAGE(PG8_SB(1, 0), cB + kstep, voffB); PG8_STAGE(PG8_SA(1, 0), cA + kstep, voffA); PG8_STAGE(PG8_SB(1, 1), cB + hstep + kstep, voffB);
        PG8_WAIT_V(6); PG8_BAR;
    } else {
        PG8_STAGE(PG8_SB(0, 0), cB, voffB); PG8_STAGE(PG8_SA(0, 0), cA, voffA); PG8_STAGE(PG8_SB(0, 1), cB + hstep, voffB); PG8_STAGE(PG8_SA(0, 1), cA + hstep, voffA);
        if (wr == 1) PG8_BAR;
        PG8_WAIT_V(4); PG8_BAR;
        PG8_STAGE(PG8_SB(1, 0), cB + kstep, voffB); PG8_STAGE(PG8_SA(1, 0), cA + kstep, voffA); PG8_STAGE(PG8_SB(1, 1), cB + hstep + kstep, voffB);
        PG8_WAIT_V(6); PG8_BAR;
    }
    for (;;) {
        const bool has_next = S.next(ui + 1, nxt);
        const char* nA = has_next ? (const char*)g.A + (size_t)nxt.pm * tstep : cA; const char* nB = has_next ? (const char*)g.Bt + (size_t)nxt.pn * tstep : cB;
        for (int t = 0; t < nt; t += 2) {
            const bool last = (t == nt - 2);
            const char* a1 = cA + (size_t)(t + 1) * kstep;
            const char* a2 = last ? nA : cA + (size_t)(t + 2) * kstep; const char* b2 = last ? nB : cB + (size_t)(t + 2) * kstep;
            const char* a3 = a2 + kstep; const char* b3 = b2 + kstep;
            if (last && has_next) S.a_ready(nxt);
            if constexpr (SP2) {
            PG8_LDB(B0, 0, 0); PG8_LDB(B1, 0, 1); PG8_SCHED; PG8_LDA(At, 0, 0); PG8_STAGE(PG8_SA(1, 1), a1 + hstep, voffA);
            PG8_WAIT_V(8); PG8_WAIT_L(0); PG8_BAR; PG8_MMA(0, 0, At, B0); PG8_MMA(0, 1, At, B1); PG8_BAR; PG8_SCHED;
            PG8_LDA(At, 0, 1); PG8_STAGE(PG8_SB(0, 0), b2, voffB); PG8_STAGE(PG8_SB(0, 1), b2 + hstep, voffB); PG8_STAGE(PG8_SA(0, 0), a2, voffA);
            PG8_WAIT_V(8); PG8_WAIT_L(0); PG8_BAR; PG8_MMA(1, 0, At, B0); PG8_MMA(1, 1, At, B1); PG8_BAR; PG8_SCHED;
            PG8_LDB(B0, 1, 0); PG8_LDB(B1, 1, 1); PG8_SCHED; PG8_LDA(At, 1, 0); PG8_STAGE(PG8_SA(0, 1), a2 + hstep, voffA);
            PG8_WAIT_V(8); PG8_WAIT_L(0); PG8_BAR; PG8_MMA(0, 0, At, B0); PG8_MMA(0, 1, At, B1); PG8_BAR; PG8_SCHED;
            PG8_LDA(At, 1, 1); PG8_STAGE(PG8_SB(1, 0), b3, voffB); PG8_STAGE(PG8_SB(1, 1), b3 + hstep, voffB); PG8_STAGE(PG8_SA(1, 0), a3, voffA);
            PG8_WAIT_V(8); PG8_WAIT_L(0); PG8_BAR; PG8_MMA(1, 0, At, B0); PG8_MMA(1, 1, At, B1); PG8_BAR; PG8_SCHED;
            } else {
            PG8_LDB(B0, 0, 0); PG8_SCHED; PG8_LDA(At, 0, 0); PG8_STAGE(PG8_SA(1, 1), a1 + hstep, voffA);
            PG8_WAIT_L(8); PG8_BAR; PG8_WAIT_L(0); PG8_MMA(0, 0, At, B0); PG8_BAR; PG8_SCHED;
            PG8_LDB(B1, 0, 1); PG8_STAGE(PG8_SB(0, 0), b2, voffB);
            PG8_BAR; PG8_WAIT_L(0); PG8_MMA(0, 1, At, B1); PG8_BAR;
            PG8_LDA(At, 0, 1); PG8_STAGE(PG8_SA(0, 0), a2, voffA);
            PG8_BAR; PG8_WAIT_L(0); PG8_MMA(1, 0, At, B0); PG8_BAR; PG8_SCHED;
            PG8_STAGE(PG8_SB(0, 1), b2 + hstep, voffB);
            PG8_WAIT_V(6); PG8_BAR; PG8_MMA(1, 1, At, B1); PG8_BAR;
            PG8_LDB(B0, 1, 0); PG8_SCHED; PG8_LDA(At, 1, 0); PG8_STAGE(PG8_SA(0, 1), a2 + hstep, voffA);
            PG8_WAIT_L(8); PG8_BAR; PG8_WAIT_L(0); PG8_MMA(0, 0, At, B0); PG8_BAR; PG8_SCHED;
            PG8_LDB(B1, 1, 1); PG8_STAGE(PG8_SB(1, 0), b3, voffB);
            PG8_BAR; PG8_WAIT_L(0); PG8_MMA(0, 1, At, B1); PG8_BAR;
            PG8_LDA(At, 1, 1); PG8_STAGE(PG8_SA(1, 0), a3, voffA);
            PG8_BAR; PG8_WAIT_L(0); PG8_MMA(1, 0, At, B0); PG8_BAR; PG8_SCHED;
            PG8_STAGE(PG8_SB(1, 1), b3 + hstep, voffB);
            PG8_WAIT_V(6); PG8_BAR; PG8_MMA(1, 1, At, B1); PG8_BAR;
            }
        }
        if constexpr (ALIGN_EPI) { if (wr == 0) PG8_BAR; }
        if constexpr (!Epi::AFTER_DRAIN) { E(acc, cur, wr, wc, fr, fq); S.done(cur); }
        if (!has_next) break;
#pragma unroll
        for (int a = 0; a < 2; ++a)
#pragma unroll
            for (int b = 0; b < 2; ++b)
#pragma unroll
                for (int m = 0; m < 4; ++m)
#pragma unroll
                    for (int n = 0; n < 2; ++n) acc[a][b][m][n] = (f32x4){0.f, 0.f, 0.f, 0.f};
        cur = nxt; cA = nA; cB = nB; ++ui;
        if constexpr (ALIGN_EPI) { if (wr == 1) PG8_BAR; }
    }
    PG8_WAIT_V(0);
    if constexpr (!ALIGN_EPI) { if (wr == 0) PG8_BAR; }
    PG8_BAR;
    if constexpr (Epi::AFTER_DRAIN) { E.fused(acc, cur, wr, wc, fr, fq, lds, wid, lane); S.done(cur); }
#undef PG8_SA
#undef PG8_SB
#undef PG8_STAGE
#undef PG8_LDA
#undef PG8_LDB
#undef PG8_MMA
#undef PG8_WAIT_V
#undef PG8_WAIT_L
#undef PG8_BAR
#undef PG8_SCHED
}
}
using pg8::cvt_pk_bf16;
struct EpiProj {
    static constexpr bool PERM = true, AFTER_DRAIN = false;
    bf16_t* O; bf16_t* svT;
    DI void operator()(const f32x4 (&acc)[2][2][4][2], const pg8::Unit& u, int wr, int wc, int fr, int fq) const {
        const int row0 = u.pm * 256 + wr * 64 + fr, col0 = u.pn * 256 + wc * 32 + 8 * fq;
#pragma unroll
        for (int ai = 0; ai < 2; ++ai)
#pragma unroll
            for (int m = 0; m < 4; ++m) { bf16_t* rowp = O + (size_t)(row0 + ai * 128 + m * 16) * NIN + col0;
#pragma unroll
                for (int bj = 0; bj < 2; ++bj) { const f32x4 v0 = acc[ai][bj][m][0], v1 = acc[ai][bj][m][1];
                    u32x4 w; w.x = cvt_pk_bf16(v0[0], v0[1]); w.y = cvt_pk_bf16(v0[2], v0[3]); w.z = cvt_pk_bf16(v1[0], v1[1]); w.w = cvt_pk_bf16(v1[2], v1[3]);
                    *(u32x4*)(rowp + bj * 128) = w; } }
        if (u.pn == 2) {
#pragma unroll
            for (int ai = 0; ai < 2; ++ai)
#pragma unroll
                for (int m = 0; m < 4; ++m) { const int row = row0 + ai * 128 + m * 16, b = row >> 12, s = row & (SEQ - 1);
#pragma unroll
                    for (int n = 0; n < 2; ++n)
#pragma unroll
                        for (int e = 0; e < 4; ++e) { const int c = wc * 32 + 8 * fq + 4 * n + e;
                            svT[((size_t)(b * 2 + (c >> 6)) * 64 + (c & 63)) * SEQ + s] = (bf16_t)f2bf(acc[ai][1][m][n][e]); } }
        }
    }
};
struct EpiMkv {
    static constexpr bool PERM = true, AFTER_DRAIN = false;
    bf16_t* mk; bf16_t* mvT;
    DI void operator()(const f32x4 (&acc)[2][2][4][2], const pg8::Unit& u, int wr, int wc, int fr, int fq) const {
        const int row0 = u.pm * 256 + wr * 64 + fr;
#pragma unroll
        for (int ai = 0; ai < 2; ++ai)
#pragma unroll
            for (int m = 0; m < 4; ++m) { const int row = row0 + ai * 128 + m * 16;
                if (u.pn == 0) {
#pragma unroll
                    for (int bj = 0; bj < 2; ++bj) { const f32x4 v0 = acc[ai][bj][m][0], v1 = acc[ai][bj][m][1];
                        u32x4 w; w.x = cvt_pk_bf16(v0[0], v0[1]); w.y = cvt_pk_bf16(v0[2], v0[3]); w.z = cvt_pk_bf16(v1[0], v1[1]); w.w = cvt_pk_bf16(v1[2], v1[3]);
                        *(u32x4*)(mk + (size_t)row * 256 + bj * 128 + wc * 32 + 8 * fq) = w; }
                } else { const int b = row >> 8, mm = row & 255;
#pragma unroll
                    for (int bj = 0; bj < 2; ++bj)
#pragma unroll
                        for (int n = 0; n < 2; ++n)
#pragma unroll
                            for (int e = 0; e < 4; ++e) { const int c = bj * 128 + wc * 32 + 8 * fq + 4 * n + e;
                                mvT[((size_t)(b * 4 + (c >> 6)) * 64 + (c & 63)) * NMEM + mm] = (bf16_t)f2bf(acc[ai][bj][m][n][e]); } }
            }
    }
};
struct EpiY {
    static constexpr bool PERM = true, AFTER_DRAIN = false;
    bf16_t* Y; float* stats;
    DI void operator()(const f32x4 (&acc)[2][2][4][2], const pg8::Unit& u, int wr, int wc, int fr, int fq) const {
        const int row0 = u.pm * 256 + wr * 64 + fr, col0 = u.pn * 256 + wc * 32 + 8 * fq;
#pragma unroll
        for (int ai = 0; ai < 2; ++ai)
#pragma unroll
            for (int m = 0; m < 4; ++m) { const int row = row0 + ai * 128 + m * 16; bf16_t* rowp = Y + (size_t)row * DM + col0; float ss = 0.f;
#pragma unroll
                for (int bj = 0; bj < 2; ++bj) { const f32x4 v0 = acc[ai][bj][m][0], v1 = acc[ai][bj][m][1];
                    ss += (v0[0] * v0[0] + v0[1] * v0[1]) + (v0[2] * v0[2] + v0[3] * v0[3]) + (v1[0] * v1[0] + v1[1] * v1[1]) + (v1[2] * v1[2] + v1[3] * v1[3]);
                    u32x4 w; w.x = cvt_pk_bf16(v0[0], v0[1]); w.y = cvt_pk_bf16(v0[2], v0[3]); w.z = cvt_pk_bf16(v1[0], v1[1]); w.w = cvt_pk_bf16(v1[2], v1[3]);
                    *(u32x4*)(rowp + bj * 128) = w; }
                ss += __shfl_xor(ss, 16); ss += __shfl_xor(ss, 32);
                if (fq == 0) stats[(size_t)row * 16 + u.pn * 4 + wc] = ss; }
    }
};

typedef short bf16x8 __attribute__((ext_vector_type(8)));
typedef short s16x4 __attribute__((ext_vector_type(4)));
typedef float f32x16 __attribute__((ext_vector_type(16)));
typedef float f32x2_t __attribute__((ext_vector_type(2)));
typedef __bf16 bf16x2_t __attribute__((ext_vector_type(2)));
DI unsigned cvtpk(float lo, float hi) { f32x2_t v = {lo, hi}; bf16x2_t b = __builtin_convertvector(v, bf16x2_t); return __builtin_bit_cast(unsigned, b); }
#define MFMA32(a, b, c) __builtin_amdgcn_mfma_f32_32x32x16_bf16((a), (b), (c), 0, 0, 0)
#define MFMA16(a, b, c) __builtin_amdgcn_mfma_f32_16x16x32_bf16((a), (b), (c), 0, 0, 0)
constexpr int KROW = 144;
constexpr int SWA_VS = 392, MEM_VS = 520;
constexpr int SWA_IMG = 192 * KROW + 64 * SWA_VS;
constexpr int MEM_IMG = 256 * KROW + 64 * MEM_VS;
constexpr int ATT_STAGE = 2 * SWA_IMG;
static_assert(ATT_STAGE + 8 * 4608 <= 147328 && MEM_IMG <= ATT_STAGE, "attention LDS map");

DI void attn_wave(f32x16& o0, f32x16& o1, float& lsum, float m, const bf16x8 (&qf)[4], const LAS unsigned char* Kimg, const LAS unsigned char* VTimg, int vs,
                  int st0, int st1, int st_lo, int st_hi, int r, int h) {
    constexpr float SC = 0.125f * 1.4426950408889634f;
#pragma unroll
    for (int i = 0; i < 16; ++i) { o0[i] = 0.f; o1[i] = 0.f; }
    for (int st = st0; st < st1; ++st) {
        const LAS unsigned char* kp = Kimg + (32 * st + r) * KROW + 16 * h;
        bf16x8 kf[4];
#pragma unroll
        for (int ks = 0; ks < 4; ++ks) kf[ks] = *(const LAS bf16x8*)(kp + 32 * ks);
        const LAS unsigned char* vp = VTimg + r * vs + (32 * st + 4 * h) * 2;
        s16x4 va[2][2][2];
#pragma unroll
        for (int dt = 0; dt < 2; ++dt)
#pragma unroll
            for (int ss = 0; ss < 2; ++ss)
#pragma unroll
                for (int hf = 0; hf < 2; ++hf) va[dt][ss][hf] = *(const LAS s16x4*)(vp + dt * 32 * vs + (16 * ss + 8 * hf) * 2);
        f32x16 s;
#pragma unroll
        for (int i = 0; i < 16; ++i) s[i] = 0.f;
#pragma unroll
        for (int ks = 0; ks < 4; ++ks) s = MFMA32(kf[ks], qf[ks], s);
        if (st == st_lo || st == st_hi) {
            const bool lo = st == st_lo;
#pragma unroll
            for (int i = 0; i < 16; ++i) { const int c = (i & 3) + 8 * (i >> 2) + 4 * h; const bool ok = lo ? (c > r) : (c <= r); s[i] = ok ? s[i] : -1e30f; }
        }
        float tm = fmaxf(fmaxf(s[0], s[1]), fmaxf(s[2], s[3]));
#pragma unroll
        for (int i = 4; i < 16; i += 4) tm = fmaxf(fmaxf(tm, fmaxf(s[i], s[i + 1])), fmaxf(s[i + 2], s[i + 3]));
        tm = fmaxf(tm, __shfl_xor(tm, 32)) * SC;
        if (__any(tm > m)) {
            const float mn = fmaxf(m, tm), alpha = __builtin_amdgcn_exp2f(m - mn);
            m = mn; lsum *= alpha;
#pragma unroll
            for (int i = 0; i < 16; ++i) { o0[i] *= alpha; o1[i] *= alpha; }
        }
        float ps = 0.f;
#pragma unroll
        for (int i = 0; i < 16; ++i) { s[i] = __builtin_amdgcn_exp2f(__builtin_fmaf(s[i], SC, -m)); ps += s[i]; }
        lsum += ps;
#pragma unroll
        for (int ss = 0; ss < 2; ++ss) {
            u32x4 pw; pw.x = cvtpk(s[8 * ss + 0], s[8 * ss + 1]); pw.y = cvtpk(s[8 * ss + 2], s[8 * ss + 3]); pw.z = cvtpk(s[8 * ss + 4], s[8 * ss + 5]); pw.w = cvtpk(s[8 * ss + 6], s[8 * ss + 7]);
            const bf16x8 pf = __builtin_bit_cast(bf16x8, pw);
            const bf16x8 v0 = __builtin_shufflevector(va[0][ss][0], va[0][ss][1], 0, 1, 2, 3, 4, 5, 6, 7);
            const bf16x8 v1 = __builtin_shufflevector(va[1][ss][0], va[1][ss][1], 0, 1, 2, 3, 4, 5, 6, 7);
            o0 = MFMA32(v0, pf, o0); o1 = MFMA32(v1, pf, o1);
        }
    }
    lsum += __shfl_xor(lsum, 32);
}
DI u32x4 ldg16(const void* base, unsigned off) { return *(const u32x4*)((const char*)base + off); }
DI void stg8(void* base, unsigned off, u32x2 v) { *(u32x2*)((char*)base + off) = v; }
DI void stg16f(void* base, unsigned off, f32x4 v) { *(f32x4*)((char*)base + off) = v; }
DI void attn_gate_load(u32x4 (&gv)[4], const bf16_t* gbase  , int lane) {
    const unsigned off = (unsigned)((lane >> 3) * NIN + 8 * (lane & 7)) * 2u;
#pragma unroll
    for (int i = 0; i < 4; ++i) gv[i] = ldg16(gbase + (size_t)i * 8 * NIN, off);
}
DI void attn_store(const f32x16& o0, const f32x16& o1, float lsum, const u32x4 (&gvv)[4], LAS unsigned char* stg, bf16_t* obase  , int lane) {
    const int r = lane & 31, h = lane >> 5;
    const float inv = 1.f / lsum;
#pragma unroll
    for (int g4 = 0; g4 < 4; ++g4) {
        u32x2 w0, w1;
        w0.x = cvtpk(o0[4 * g4 + 0] * inv, o0[4 * g4 + 1] * inv); w0.y = cvtpk(o0[4 * g4 + 2] * inv, o0[4 * g4 + 3] * inv);
        w1.x = cvtpk(o1[4 * g4 + 0] * inv, o1[4 * g4 + 1] * inv); w1.y = cvtpk(o1[4 * g4 + 2] * inv, o1[4 * g4 + 3] * inv);
        *(LAS u32x2*)(stg + r * 144 + (8 * g4 + 4 * h) * 2) = w0;
        *(LAS u32x2*)(stg + r * 144 + (32 + 8 * g4 + 4 * h) * 2) = w1;
    }
    asm volatile("s_waitcnt lgkmcnt(0)" ::: "memory");
    const unsigned ooff = (unsigned)((lane >> 3) * DM + 8 * (lane & 7)) * 2u;
    const LAS unsigned char* sp = stg + (lane >> 3) * 144 + 16 * (lane & 7);
#pragma unroll
    for (int i = 0; i < 4; ++i) {
        const u32x4 ov = *(const LAS u32x4*)(sp + i * 8 * 144);
        const u32x4 gv = gvv[i];
        u32x4 w;
        w.x = cvtpk(bflo(ov.x) * siluf_(bflo(gv.x)), bfhi(ov.x) * siluf_(bfhi(gv.x)));
        w.y = cvtpk(bflo(ov.y) * siluf_(bflo(gv.y)), bfhi(ov.y) * siluf_(bfhi(gv.y)));
        w.z = cvtpk(bflo(ov.z) * siluf_(bflo(gv.z)), bfhi(ov.z) * siluf_(bfhi(gv.z)));
        w.w = cvtpk(bflo(ov.w) * siluf_(bflo(gv.w)), bfhi(ov.w) * siluf_(bfhi(gv.w)));
        *(u32x4*)((char*)(obase + (size_t)i * 8 * DM) + ooff) = w;
    }
    asm volatile("s_waitcnt lgkmcnt(0)" ::: "memory");
}
DI void attn_phase(const Params& p, int l, LAS unsigned char* lds, int tid, int G, int bx) {
    const int lane = tid & 63, wave = __builtin_amdgcn_readfirstlane(tid >> 6), r = lane & 31, h = lane >> 5;
    const bf16_t* P = (const bf16_t*)(p.ws + WS_P);
    bf16_t* MIX = (bf16_t*)(p.ws + WS_H);
    LAS unsigned char* stg = lds + ATT_STAGE + wave * 4608;
    const unsigned qoff = (unsigned)(r * NIN + 8 * h) * 2u;
    for (int cc = bx; cc < 256; cc += G) {
        {
            const int bk = cc >> 3, b = bk >> 1, kvh = bk & 1, qb0 = (cc & 7) * 8;
            const int g = wave >> 1, qh = wave & 1, head = kvh * 4 + g;
            const bf16_t* Kg = P + (size_t)b * SEQ * NIN + C_SK + kvh * 64;
            const bf16_t* Vg = (const bf16_t*)(p.ws + WS_SVT) + (size_t)(b * 2 + kvh) * 64 * SEQ;
            const bf16_t* Qg = P + ((size_t)b * SEQ + 32 * qh) * NIN + C_SQ + head * 64;
            const bf16_t* Gg = P + ((size_t)b * SEQ + 32 * qh) * NIN + C_GATE + head * 64;
            bf16_t* Og = MIX + ((size_t)b * SEQ + 32 * qh) * DM + head * 64;
            const float sink = p.sinks[l * 8 + head] * 1.4426950408889634f;
            const int krow = tid >> 3, kch = tid & 7, vd = tid / 24, vch = tid % 24;
            u32x4 kreg[3], vreg[3]; bf16x8 qf[4], qn[4];
#define SWA_ISSUE(qb_) do { const int kb0_ = 64 * (qb_) - 128; \
                _Pragma("unroll") for (int i_ = 0; i_ < 3; ++i_) { \
                    { int kr_ = kb0_ + krow + 64 * i_; kr_ = kr_ < 0 ? 0 : kr_; kreg[i_] = ldg16(Kg, (unsigned)(kr_ * NIN + 8 * kch) * 2u); }     \
                    { const int idx_ = tid + 512 * i_, d_ = idx_ / 24, ch_ = idx_ % 24; int k0_ = kb0_ + 8 * ch_; k0_ = k0_ < 0 ? 0 : k0_; vreg[i_] = ldg16(Vg, (unsigned)(d_ * SEQ + k0_) * 2u); } } \
                { const bf16_t* Qp_ = Qg + (size_t)(64 * (qb_)) * NIN; \
                  _Pragma("unroll") for (int ks_ = 0; ks_ < 4; ++ks_) qn[ks_] = __builtin_bit_cast(bf16x8, ldg16(Qp_ + 16 * ks_, qoff)); } } while (0)
#define SWA_WRITE(buf_) do { LAS unsigned char* Ki_ = lds + (buf_) * SWA_IMG; LAS unsigned char* Vi_ = Ki_ + 192 * KROW; \
                _Pragma("unroll") for (int i_ = 0; i_ < 3; ++i_) { const int idx_ = tid + 512 * i_; \
                    *(LAS u32x4*)(Ki_ + (krow + 64 * i_) * KROW + 16 * kch) = kreg[i_]; \
                    { LAS unsigned char* d_ = Vi_ + (idx_ / 24) * SWA_VS + 16 * (idx_ % 24); u32x2 a_, b_; a_.x = vreg[i_].x; a_.y = vreg[i_].y; b_.x = vreg[i_].z; b_.y = vreg[i_].w; \
                      *(LAS u32x2*)d_ = a_; *(LAS u32x2*)(d_ + 8) = b_; } } } while (0)
            (void)vd; (void)vch;
            SWA_ISSUE(qb0);
            SWA_WRITE(0);
#pragma unroll
            for (int ks = 0; ks < 4; ++ks) qf[ks] = qn[ks];
            __syncthreads();
            for (int i = 0; i < 8; ++i) {
                const int qb = qb0 + i;
                if (i < 7) SWA_ISSUE(qb + 1);
                {
                    const LAS unsigned char* Kimg = lds + (i & 1) * SWA_IMG; const LAS unsigned char* VTimg = Kimg + 192 * KROW;
                    const int first = 4 - 2 * qb, st0 = qh > first ? qh : first;
                    f32x16 o0, o1; float lsum = h == 0 ? 1.f : 0.f; u32x4 gv[4];
                    attn_gate_load(gv, Gg + (size_t)(64 * qb) * NIN, lane);
                    attn_wave(o0, o1, lsum, sink, qf, Kimg, VTimg, SWA_VS, st0, qh + 5, qh, qh + 4, r, h);
                    attn_store(o0, o1, lsum, gv, stg, Og + (size_t)(64 * qb) * DM, lane);
                }
                if (i < 7) { SWA_WRITE((i + 1) & 1);
#pragma unroll
                    for (int ks = 0; ks < 4; ++ks) qf[ks] = qn[ks]; }
                __syncthreads();
            }
#undef SWA_ISSUE
#undef SWA_WRITE
        }
        {
            const int bh = cc >> 2, b = bh >> 2, hm = bh & 3, qk0 = (cc & 3) * 4;
            const bf16_t* Kg = (const bf16_t*)(p.ws + WS_MK) + (size_t)l * MEMROWS * 256 + (size_t)b * NMEM * 256 + hm * 64;
            const bf16_t* Vg = (const bf16_t*)(p.ws + WS_MVT) + (size_t)l * MEMROWS * 256 + (size_t)(b * 4 + hm) * 64 * NMEM;
            const bf16_t* Qg = P + ((size_t)b * SEQ + 32 * wave) * NIN + C_MQ + hm * 64;
            const bf16_t* Gg = P + ((size_t)b * SEQ + 32 * wave) * NIN + C_GATE + 768 + hm * 64;
            bf16_t* Og = MIX + ((size_t)b * SEQ + 32 * wave) * DM + 768 + hm * 64;
            LAS unsigned char* Ki = lds; LAS unsigned char* Vi = lds + 256 * KROW;
#pragma unroll
            for (int i = 0; i < 4; ++i) { const int idx = tid + 512 * i;
                *(LAS u32x4*)(Ki + (idx >> 3) * KROW + 16 * (idx & 7)) = ldg16(Kg, (unsigned)((idx >> 3) * 256 + 8 * (idx & 7)) * 2u);
                const u32x4 v = ldg16(Vg, (unsigned)((idx >> 5) * NMEM + 8 * (idx & 31)) * 2u);
                LAS unsigned char* d = Vi + (idx >> 5) * MEM_VS + 16 * (idx & 31); u32x2 a_, b_; a_.x = v.x; a_.y = v.y; b_.x = v.z; b_.y = v.w;
                *(LAS u32x2*)d = a_; *(LAS u32x2*)(d + 8) = b_; }
            bf16x8 qf[4], qn[4];
#pragma unroll
            for (int ks = 0; ks < 4; ++ks) qf[ks] = __builtin_bit_cast(bf16x8, ldg16(Qg + (size_t)(256 * qk0) * NIN + 16 * ks, qoff));
            __syncthreads();
            for (int i = 0; i < 4; ++i) {
                const int qk = qk0 + i;
                if (i < 3) {
#pragma unroll
                    for (int ks = 0; ks < 4; ++ks) qn[ks] = __builtin_bit_cast(bf16x8, ldg16(Qg + (size_t)(256 * (qk + 1)) * NIN + 16 * ks, qoff)); }
                f32x16 o0, o1; float lsum = 0.f; u32x4 gv[4];
                attn_gate_load(gv, Gg + (size_t)(256 * qk) * NIN, lane);
                attn_wave(o0, o1, lsum, -1e30f, qf, Ki, Vi, MEM_VS, 0, 8, -1, -1, r, h);
                attn_store(o0, o1, lsum, gv, stg, Og + (size_t)(256 * qk) * DM, lane);
                if (i < 3) {
#pragma unroll
                    for (int ks = 0; ks < 4; ++ks) qf[ks] = qn[ks]; }
            }
            __syncthreads();
        }
    }
}

constexpr size_t DN_M = WS_DN;
constexpr size_t DN_NT = WS_DN + 32 * MiB;
constexpr size_t DN_UT = WS_DN + 96 * MiB;
constexpr size_t DN_W = WS_DN + 128 * MiB;
constexpr size_t DN_QG = WS_DN + 160 * MiB;
constexpr size_t DN_IN = WS_DN + 192 * MiB;
constexpr size_t DN_ST = WS_DN + 224 * MiB;
constexpr int LDK = 72;

DI void mm16x64(f32x4 (&acc)[4], const LAS bf16_t* A, int r0, const LAS bf16_t* Bt, int fr, int fq) {
    bf16x8 a[2];
#pragma unroll
    for (int ks = 0; ks < 2; ++ks) a[ks] = *(const LAS bf16x8*)(A + (r0 + fr) * LDK + 32 * ks + 8 * fq);
#pragma unroll
    for (int nt = 0; nt < 4; ++nt)
#pragma unroll
        for (int ks = 0; ks < 2; ++ks) { const bf16x8 b = *(const LAS bf16x8*)(Bt + (16 * nt + fr) * LDK + 32 * ks + 8 * fq); acc[nt] = MFMA16(a[ks], b, acc[nt]); }
}
DI void conv16(float (&out)[16], const bf16_t* Pcol, size_t rowb, int s0, const float* cw) {
#pragma unroll
    for (int e = 0; e < 16; ++e) out[e] = 0.f;
#pragma unroll
    for (int j = 0; j < 4; ++j) {
        const int s = s0 + j;
        if (s >= 0) {
            const u32x4 x0 = *(const u32x4*)(Pcol + (rowb + s) * NIN), x1 = *(const u32x4*)(Pcol + (rowb + s) * NIN + 8);
            const f32x4 w0 = *(const f32x4*)(cw + j * 768), w1 = *(const f32x4*)(cw + j * 768 + 4), w2 = *(const f32x4*)(cw + j * 768 + 8), w3 = *(const f32x4*)(cw + j * 768 + 12);
            out[0] += w0.x * bflo(x0.x); out[1] += w0.y * bfhi(x0.x); out[2] += w0.z * bflo(x0.y); out[3] += w0.w * bfhi(x0.y);
            out[4] += w1.x * bflo(x0.z); out[5] += w1.y * bfhi(x0.z); out[6] += w1.z * bflo(x0.w); out[7] += w1.w * bfhi(x0.w);
            out[8] += w2.x * bflo(x1.x); out[9] += w2.y * bfhi(x1.x); out[10] += w2.z * bflo(x1.y); out[11] += w2.w * bfhi(x1.y);
            out[12] += w3.x * bflo(x1.z); out[13] += w3.y * bfhi(x1.z); out[14] += w3.z * bflo(x1.w); out[15] += w3.w * bfhi(x1.w);
        }
    }
#pragma unroll
    for (int e = 0; e < 16; ++e) out[e] = siluf_(out[e]);
}
DI u32x4 pack8(const float* v) { u32x4 w; w.x = cvtpk(v[0], v[1]); w.y = cvtpk(v[2], v[3]); w.z = cvtpk(v[4], v[5]); w.w = cvtpk(v[6], v[7]); return w; }
DI u32x2 pack4(const f32x4 v) { u32x2 w; w.x = cvtpk(v[0], v[1]); w.y = cvtpk(v[2], v[3]); return w; }

constexpr int DNP_SG = 67584;
#define MFMAF32(a, b, c) __builtin_amdgcn_mfma_f32_16x16x4f32((a), (b), (c), 0, 0, 0)
DI void dn_prep_phase(const Params& p, int l, LAS unsigned char* lds, int tid, int G, int bx) {
    const int sg = tid >> 8, ts = tid & 255, lane = tid & 63, wsg = __builtin_amdgcn_readfirstlane((tid >> 6) & 3), fr = lane & 15, fq = lane >> 4;
    LAS unsigned char* base = lds + sg * DNP_SG;
    LAS bf16_t* qs = (LAS bf16_t*)(base); LAS float* Tf = (LAS float*)(base); LAS bf16_t* wT = (LAS bf16_t*)(base);
    LAS bf16_t* ks = (LAS bf16_t*)(base + 9216); LAS bf16_t* uT = ks;
    LAS bf16_t* kdT = (LAS bf16_t*)(base + 18432);
    LAS bf16_t* kbgT = (LAS bf16_t*)(base + 27648);
    LAS bf16_t* vbT = (LAS bf16_t*)(base + 36864);
    LAS float* Lf = (LAS float*)(base + 46080); LAS bf16_t* Tm = (LAS bf16_t*)(base + 46080);
    LAS float* gcs = (LAS float*)(base + 63488); LAS float* betas = gcs + 64;
    LAS float* cws = (LAS float*)(base + 64000);
    const bf16_t* P = (const bf16_t*)(p.ws + WS_P);
    const float* BA = (const float*)(p.ws + WS_BA);
    const int dg = ts & 15, tg = ts >> 4;
    const int xoff = ((4 * tg - 3) * NIN + 4 * dg) * 2;
    u32x2 xr[3][7]; float gL = 0.f, bL = 0.f;
#define DNP_LOAD(ch_) do { const int b_ = (ch_) >> 8, h_ = ((ch_) >> 6) & 3, n_ = (ch_) & 63; const size_t row0_ = (size_t)b_ * SEQ + n_ * 64; \
        const char* xb_ = (const char*)(P + row0_ * NIN + C_DQ + h_ * 64); \
        _Pragma("unroll") for (int t_ = 0; t_ < 3; ++t_) _Pragma("unroll") for (int jj_ = 0; jj_ < 7; ++jj_) xr[t_][jj_] = *(const u32x2*)(xb_ + t_ * 512 + jj_ * (NIN * 2) + xoff); \
        { const float* ba_ = BA + row0_ * 8 + h_; gL = ba_[lane * 8 + 4]; bL = ba_[lane * 8]; } } while (0)
    int it = bx, hcur = -1;
    if (it < 2048) DNP_LOAD(2 * it + sg);
    for (; it < 2048; it += G) {
        const int ch = 2 * it + sg, b = ch >> 8, h = (ch >> 6) & 3, n = ch & 63;
        if (h != hcur) {
            __syncthreads();
            for (int e2 = ts; e2 < 768; e2 += 256) cws[e2] = p.conv_w[(size_t)l * 4 * 768 + ((e2 >> 6) & 3) * 768 + (e2 >> 8) * 256 + h * 64 + (e2 & 63)];
            hcur = h;
            __syncthreads();
        }
        SEC_BEGIN(1)
        float c3[3][4][4];
#pragma unroll
        for (int t3 = 0; t3 < 3; ++t3) {
            f32x4 wv[4];
#pragma unroll
            for (int j = 0; j < 4; ++j) wv[j] = *(const LAS f32x4*)(cws + (t3 * 4 + j) * 64 + 4 * dg);
            float xf[7][4];
#pragma unroll
            for (int jj = 0; jj < 7; ++jj) { u32x2 x = xr[t3][jj]; if (n == 0 && 4 * tg - 3 + jj < 0) { x.x = 0u; x.y = 0u; }
                xf[jj][0] = bflo(x.x); xf[jj][1] = bfhi(x.x); xf[jj][2] = bflo(x.y); xf[jj][3] = bfhi(x.y); }
#pragma unroll
            for (int e = 0; e < 4; ++e)
#pragma unroll
                for (int d = 0; d < 4; ++d) c3[t3][e][d] = siluf_((wv[0][d] * xf[e][d] + wv[1][d] * xf[e + 1][d]) + (wv[2][d] * xf[e + 2][d] + wv[3][d] * xf[e + 3][d]));
        }
        float x = gL; const float betaL = bL;
#pragma unroll
        for (int o = 1; o < 64; o <<= 1) { const float y = __shfl_up(x, o); if (lane >= o) x += y; }
        const float gl = __shfl(x, 63);
        if (wsg == 0) { gcs[lane] = x; betas[lane] = betaL; }
        float eg[4], ed[4], be[4], rq[4], rk[4];
#pragma unroll
        for (int e = 0; e < 4; ++e) { const float gc = __shfl(x, 4 * tg + e); be[e] = __shfl(betaL, 4 * tg + e); eg[e] = __expf(gc); ed[e] = __expf(gl - gc);
            float sq = (c3[0][e][0] * c3[0][e][0] + c3[0][e][1] * c3[0][e][1]) + (c3[0][e][2] * c3[0][e][2] + c3[0][e][3] * c3[0][e][3]);
            float sk = (c3[1][e][0] * c3[1][e][0] + c3[1][e][1] * c3[1][e][1]) + (c3[1][e][2] * c3[1][e][2] + c3[1][e][3] * c3[1][e][3]);
            sq += __shfl_xor(sq, 1); sq += __shfl_xor(sq, 2); sq += __shfl_xor(sq, 4); sq += __shfl_xor(sq, 8);
            sk += __shfl_xor(sk, 1); sk += __shfl_xor(sk, 2); sk += __shfl_xor(sk, 4); sk += __shfl_xor(sk, 8);
            rq[e] = rsqrtf(sq + EPS) * 0.125f; rk[e] = rsqrtf(sk + EPS); }
        { bf16_t* qgd = (bf16_t*)(p.ws + DN_QG) + (size_t)ch * 4096;
#pragma unroll
          for (int e = 0; e < 4; ++e) {
              f32x4 q4, k4, g4;
#pragma unroll
              for (int d = 0; d < 4; ++d) { q4[d] = c3[0][e][d] * rq[e]; k4[d] = c3[1][e][d] * rk[e]; g4[d] = q4[d] * eg[e]; c3[0][e][d] = q4[d]; c3[1][e][d] = k4[d]; }
              *(LAS u32x2*)(qs + (4 * tg + e) * LDK + 4 * dg) = pack4(q4); *(LAS u32x2*)(ks + (4 * tg + e) * LDK + 4 * dg) = pack4(k4);
              stg8(qgd, (unsigned)((4 * tg + e) * 64 + 4 * dg) * 2u, pack4(g4)); }
#pragma unroll
          for (int d = 0; d < 4; ++d) {
              f32x4 a, bb, cvv;
#pragma unroll
              for (int e = 0; e < 4; ++e) { a[e] = c3[1][e][d] * ed[e]; bb[e] = c3[1][e][d] * be[e] * eg[e]; cvv[e] = c3[2][e][d] * be[e]; }
              *(LAS u32x2*)(kdT + (4 * dg + d) * LDK + 4 * tg) = pack4(a); *(LAS u32x2*)(kbgT + (4 * dg + d) * LDK + 4 * tg) = pack4(bb); *(LAS u32x2*)(vbT + (4 * dg + d) * LDK + 4 * tg) = pack4(cvv); } }
        __syncthreads();
        SEC_END(1)
        SEC_BEGIN(3)
        {
            f32x4 acc[4], acc2[4];
#pragma unroll
            for (int nt = 0; nt < 4; ++nt) { acc[nt] = (f32x4){0.f, 0.f, 0.f, 0.f}; acc2[nt] = (f32x4){0.f, 0.f, 0.f, 0.f}; }
            mm16x64(acc, ks, 16 * wsg, ks, fr, fq);
            mm16x64(acc2, ks, 16 * wsg, qs, fr, fq);
            const int r0 = 16 * wsg + 4 * fq;
            float gr[4], br[4];
#pragma unroll
            for (int r = 0; r < 4; ++r) { gr[r] = gcs[r0 + r]; br[r] = betas[r0 + r]; }
#pragma unroll
            for (int nt = 0; nt < 4; ++nt) { const int cc = 16 * nt + fr; const float gcol = gcs[cc];
#pragma unroll
                for (int r = 0; r < 4; ++r) { const int c = r0 + r;
                    Lf[c * 68 + cc] = (cc < c) ? br[r] * acc[nt][r] * __expf(gr[r] - gcol) : 0.f; }
                f32x4 iv;
#pragma unroll
                for (int r = 0; r < 4; ++r) { const int s2 = r0 + r;
                    iv[r] = (s2 <= cc) ? acc2[nt][r] * __expf(gcol - gr[r]) : 0.f; }
                stg8((bf16_t*)(p.ws + DN_IN) + (size_t)ch * 4096, (unsigned)(cc * 64 + r0) * 2u, pack4(iv)); }
        }
        __syncthreads();
        SEC_END(3)
        SEC_BEGIN(4)
        {
            {
                const int a = fq, j = fr; const LAS float* La = Lf + (16 * a) * 68 + 16 * a;
                float T[16];
#pragma unroll
                for (int c = 0; c < 16; ++c) T[c] = 0.f;
                const float jf = (float)j;
#pragma unroll
                for (int c = 0; c < 16; ++c) {
                    float a0 = fmaxf(0.f, 1.f - fabsf(jf - (float)c)), a1 = 0.f, a2 = 0.f, a3 = 0.f;
#pragma unroll
                    for (int s4 = 0; s4 < (c + 3) / 4; ++s4) { const f32x4 Lv = *(const LAS f32x4*)(La + c * 68 + 4 * s4);
                        a0 -= Lv.x * T[4 * s4]; a1 -= Lv.y * T[4 * s4 + 1]; a2 -= Lv.z * T[4 * s4 + 2]; a3 -= Lv.w * T[4 * s4 + 3]; }
                    T[c] = (a0 + a1) + (a2 + a3);
                }
#pragma unroll
                for (int c = 0; c < 16; ++c) Tf[(16 * a + c) * 68 + 16 * a + j] = T[c];
            }
            asm volatile("s_waitcnt lgkmcnt(0)" ::: "memory");
            const int bcol = wsg;
            LAS float* Xs = Tf + 16 * (bcol + 1);
            for (int a = bcol + 1; a < 4; ++a) {
                f32x4 xacc = (f32x4){0.f, 0.f, 0.f, 0.f};
                for (int c = bcol; c < a; ++c) {
#pragma unroll
                    for (int st = 0; st < 4; ++st) xacc = MFMAF32(Lf[(16 * a + fr) * 68 + 16 * c + 4 * st + fq], Tf[(16 * c + 4 * st + fq) * 68 + 16 * bcol + fr], xacc);
                }
#pragma unroll
                for (int r = 0; r < 4; ++r) Xs[(4 * fq + r) * 68 + fr] = xacc[r];
                asm volatile("s_waitcnt lgkmcnt(0)" ::: "memory");
                f32x4 tacc = (f32x4){0.f, 0.f, 0.f, 0.f};
#pragma unroll
                for (int st = 0; st < 4; ++st) tacc = MFMAF32(Tf[(16 * a + fr) * 68 + 16 * a + 4 * st + fq], Xs[(4 * st + fq) * 68 + fr], tacc);
#pragma unroll
                for (int r = 0; r < 4; ++r) Tf[(16 * a + 4 * fq + r) * 68 + 16 * bcol + fr] = -tacc[r];
                asm volatile("s_waitcnt lgkmcnt(0)" ::: "memory");
            }
        }
        __syncthreads();
        {
            const int c = ts >> 2, sgm = ts & 3; float v[16];
#pragma unroll
            for (int q4 = 0; q4 < 4; ++q4) { const f32x4 t4 = *(const LAS f32x4*)(Tf + c * 68 + 16 * sgm + 4 * q4);
#pragma unroll
                for (int e = 0; e < 4; ++e) v[4 * q4 + e] = (16 * sgm + 4 * q4 + e <= c) ? t4[e] : 0.f; }
            *(LAS u32x4*)(Tm + c * LDK + 16 * sgm) = pack8(v); *(LAS u32x4*)(Tm + c * LDK + 16 * sgm + 8) = pack8(v + 8);
        }
        __syncthreads();
        SEC_END(4)
        SEC_BEGIN(5)
        {   f32x4 au[4], aw[4], awr[4];
#pragma unroll
            for (int nt = 0; nt < 4; ++nt) { au[nt] = (f32x4){0.f, 0.f, 0.f, 0.f}; aw[nt] = au[nt]; awr[nt] = au[nt]; }
            mm16x64(au, Tm, 16 * wsg, vbT, fr, fq);
            mm16x64(aw, Tm, 16 * wsg, kbgT, fr, fq);
            mm16x64(awr, kbgT, 16 * wsg, Tm, fr, fq);
            const int r0 = 16 * wsg + 4 * fq;
#pragma unroll
            for (int nt = 0; nt < 4; ++nt) { const int cc = 16 * nt + fr;
                const u32x2 pu = pack4(au[nt]);
                *(LAS u32x2*)(uT + cc * LDK + r0) = pu; stg8((bf16_t*)(p.ws + DN_UT) + (size_t)ch * 4096, (unsigned)(cc * 64 + r0) * 2u, pu);
                *(LAS u32x2*)(wT + cc * LDK + r0) = pack4(aw[nt]);
                stg8((bf16_t*)(p.ws + DN_W) + (size_t)ch * 4096, (unsigned)(cc * 64 + r0) * 2u, pack4(awr[nt])); }
        }
        __syncthreads();
        SEC_END(5)
        if (it + G < 2048) DNP_LOAD(2 * (it + G) + sg);
        {   f32x4 am[4], an[4];
#pragma unroll
            for (int nt = 0; nt < 4; ++nt) { am[nt] = (f32x4){0.f, 0.f, 0.f, 0.f}; an[nt] = am[nt]; }
            mm16x64(am, wT, 16 * wsg, kdT, fr, fq);
            mm16x64(an, kdT, 16 * wsg, uT, fr, fq);
            const int r0 = 16 * wsg + 4 * fq; const float egl = __expf(gl);
#pragma unroll
            for (int nt = 0; nt < 4; ++nt) { const int cc = 16 * nt + fr; f32x4 mv;
#pragma unroll
                for (int r = 0; r < 4; ++r) mv[r] = ((r0 + r) == cc ? egl : 0.f) - am[nt][r];
                stg8((bf16_t*)(p.ws + DN_M) + (size_t)ch * 4096, (unsigned)(cc * 64 + 32 * (wsg >> 1) + 8 * fq + 4 * (wsg & 1)) * 2u, pack4(mv));
                stg16f((float*)(p.ws + DN_NT) + (size_t)ch * 4096, (unsigned)(cc * 64 + r0) * 4u, an[nt]); }
        }
        __syncthreads();
    }
#undef DNP_LOAD
}
#define SCAN_LOAD(A_, C_, n_) do { const bf16_t* M_ = Mb + (size_t)(n_) * 4096; const float* N_ = Nb + (size_t)(n_) * 4096; \
        _Pragma("unroll") for (int mt = 0; mt < 4; ++mt) { C_[mt] = *(const f32x4*)((const char*)(N_ + 16 * mt) + offN); \
            _Pragma("unroll") for (int ks = 0; ks < 2; ++ks) A_[mt][ks] = ldg16(M_ + (16 * mt) * 64 + 32 * ks, offM); } } while (0)
#define SCAN_STORE(n_) do { bf16_t* ST_ = Sb + (size_t)(n_) * 4096; _Pragma("unroll") for (int mt = 0; mt < 4; ++mt) stg8(ST_ + 16 * mt, offS, pack4(S[mt])); } while (0)
#define SCAN_STEP(A_, C_) do { bf16x8 bfr_[2]; \
        _Pragma("unroll") for (int ks = 0; ks < 2; ++ks) { u32x4 w_; const u32x2 lo_ = pack4(S[2 * ks]), hi_ = pack4(S[2 * ks + 1]); w_.x = lo_.x; w_.y = lo_.y; w_.z = hi_.x; w_.w = hi_.y; bfr_[ks] = __builtin_bit_cast(bf16x8, w_); } \
        _Pragma("unroll") for (int mt = 0; mt < 4; ++mt) { f32x4 a_ = C_[mt]; \
            _Pragma("unroll") for (int ks = 0; ks < 2; ++ks) a_ = MFMA16(__builtin_bit_cast(bf16x8, A_[mt][ks]), bfr_[ks], a_); \
            S[mt] = a_; } } while (0)
DI void dn_scan_item(const Params& p, int item, int lane) {
    const int bh = item >> 2, js = item & 3, fr = lane & 15, fq = lane >> 4, j = 16 * js + fr;
    f32x4 S[4];
#pragma unroll
    for (int mt = 0; mt < 4; ++mt) S[mt] = (f32x4){0.f, 0.f, 0.f, 0.f};
    const bf16_t* Mb = (const bf16_t*)(p.ws + DN_M) + (size_t)bh * 64 * 4096;
    const float* Nb = (const float*)(p.ws + DN_NT) + (size_t)bh * 64 * 4096;
    bf16_t* Sb = (bf16_t*)(p.ws + DN_ST) + (size_t)bh * 64 * 4096;
    const unsigned offM = (unsigned)(fr * 64 + 8 * fq) * 2u, offN = (unsigned)(j * 64 + 4 * fq) * 4u, offS = (unsigned)(j * 64 + 4 * fq) * 2u;
    u32x4 aA[4][2], aB[4][2], aC[4][2], aD[4][2]; f32x4 cA[4], cB[4], cC[4], cD[4];
    SCAN_LOAD(aA, cA, 0); SCAN_LOAD(aB, cB, 1); SCAN_LOAD(aC, cC, 2); SCAN_LOAD(aD, cD, 3);
    for (int n = 0; n < 60; n += 4) {
        SCAN_STORE(n);     SCAN_STEP(aA, cA); SCAN_LOAD(aA, cA, n + 4);
        SCAN_STORE(n + 1); SCAN_STEP(aB, cB); SCAN_LOAD(aB, cB, n + 5);
        SCAN_STORE(n + 2); SCAN_STEP(aC, cC); SCAN_LOAD(aC, cC, n + 6);
        SCAN_STORE(n + 3); SCAN_STEP(aD, cD); if (n + 7 < 63) SCAN_LOAD(aD, cD, n + 7);
    }
    SCAN_STORE(60); SCAN_STEP(aA, cA);
    SCAN_STORE(61); SCAN_STEP(aB, cB);
    SCAN_STORE(62); SCAN_STEP(aC, cC);
    SCAN_STORE(63);
}
#undef SCAN_LOAD
#undef SCAN_STORE
#undef SCAN_STEP
DI void dn_out_phase(const Params& p, int l, LAS unsigned char* lds, int tid, int G, int bx) {
    const int sg = tid >> 8, ts = tid & 255, lane = tid & 63, w = __builtin_amdgcn_readfirstlane((tid >> 6) & 3), fr = lane & 15, fq = lane >> 4, r0 = 16 * w;
    LAS unsigned char* base = lds + sg * 40960;
    LAS bf16_t* vT = (LAS bf16_t*)(base + 18432);
    LAS unsigned char* stg = base + 27648 + w * 2304;
    const bf16_t* P = (const bf16_t*)(p.ws + WS_P);
    bf16_t* MIX = (bf16_t*)(p.ws + WS_H);
    float gn[4];
#pragma unroll
    for (int nt = 0; nt < 4; ++nt) gn[nt] = p.dn_g[l * 64 + 16 * nt + fr];
    const unsigned offA = (unsigned)((r0 + fr) * 64 + 8 * fq) * 2u;
    const unsigned offU = (unsigned)(fr * 64 + r0 + 4 * fq) * 2u;
    const unsigned offS0 = (unsigned)((ts >> 3) * 64 + 8 * (ts & 7)) * 2u;
    const unsigned offG = (unsigned)((lane >> 3) * NIN + 8 * (lane & 7)) * 2u, offO = (unsigned)((lane >> 3) * DM + 8 * (lane & 7)) * 2u;
    u32x4 stn[2], wn[2], qn[2], inn[2], gvn[2]; u32x2 un[4];
#define DNO_LOAD(ch_) do { const size_t cb_ = (size_t)(ch_) * 4096; const int b_ = (ch_) >> 8, h_ = ((ch_) >> 6) & 3, n_ = (ch_) & 63; \
        const bf16_t* ST_ = (const bf16_t*)(p.ws + DN_ST) + cb_; stn[0] = ldg16(ST_, offS0); stn[1] = ldg16(ST_ + 32 * 64, offS0); \
        const bf16_t* W_ = (const bf16_t*)(p.ws + DN_W) + cb_; wn[0] = ldg16(W_, offA); wn[1] = ldg16(W_ + 32, offA); \
        const bf16_t* Q_ = (const bf16_t*)(p.ws + DN_QG) + cb_; qn[0] = ldg16(Q_, offA); qn[1] = ldg16(Q_ + 32, offA); \
        const bf16_t* I_ = (const bf16_t*)(p.ws + DN_IN) + cb_; inn[0] = ldg16(I_, offA); inn[1] = ldg16(I_ + 32, offA); \
        const bf16_t* U_ = (const bf16_t*)(p.ws + DN_UT) + cb_; _Pragma("unroll") for (int nt_ = 0; nt_ < 4; ++nt_) un[nt_] = *(const u32x2*)((const char*)(U_ + 16 * nt_ * 64) + offU); \
        const bf16_t* G_ = P + ((size_t)b_ * SEQ + n_ * 64 + r0) * NIN + C_GATE + 512 + h_ * 64; gvn[0] = ldg16(G_, offG); gvn[1] = ldg16(G_ + (size_t)8 * NIN, offG); } while (0)
#define DNO_WRITE_ST(buf_) do { LAS unsigned char* d_ = base + (buf_) * 9216 + (ts >> 3) * 144 + 16 * (ts & 7); *(LAS u32x4*)d_ = stn[0]; *(LAS u32x4*)(d_ + 32 * 144) = stn[1]; } while (0)
    int it = bx, buf = 0;
    if (it < 2048) { DNO_LOAD(2 * it + sg); DNO_WRITE_ST(0); }
    __syncthreads();
    for (; it < 2048; it += G) {
        const int ch = 2 * it + sg, b = ch >> 8, h = (ch >> 6) & 3, n = ch & 63;
        const bf16x8 wA[2] = {__builtin_bit_cast(bf16x8, wn[0]), __builtin_bit_cast(bf16x8, wn[1])}, qA[2] = {__builtin_bit_cast(bf16x8, qn[0]), __builtin_bit_cast(bf16x8, qn[1])};
        const bf16x8 iA[2] = {__builtin_bit_cast(bf16x8, inn[0]), __builtin_bit_cast(bf16x8, inn[1])};
        const u32x4 gv[2] = {gvn[0], gvn[1]}; u32x2 uc[4];
#pragma unroll
        for (int nt = 0; nt < 4; ++nt) uc[nt] = un[nt];
        const bool has_next = it + G < 2048;
        if (has_next) DNO_LOAD(2 * (it + G) + sg);
        const LAS unsigned char* Si = base + buf * 9216;
        bf16x8 bS[4][2];
#pragma unroll
        for (int nt = 0; nt < 4; ++nt)
#pragma unroll
            for (int ks = 0; ks < 2; ++ks) bS[nt][ks] = *(const LAS bf16x8*)(Si + (16 * nt + fr) * 144 + 64 * ks + 16 * fq);
#pragma unroll
        for (int nt = 0; nt < 4; ++nt) { f32x4 a = (f32x4){0.f, 0.f, 0.f, 0.f};
#pragma unroll
            for (int ks = 0; ks < 2; ++ks) a = MFMA16(wA[ks], bS[nt][ks], a);
            const f32x4 vn = (f32x4){bflo(uc[nt].x) - a[0], bfhi(uc[nt].x) - a[1], bflo(uc[nt].y) - a[2], bfhi(uc[nt].y) - a[3]};
            *(LAS u32x2*)(vT + (16 * nt + fr) * LDK + r0 + 4 * fq) = pack4(vn); }
        __syncthreads();
        f32x4 o[4];
#pragma unroll
        for (int nt = 0; nt < 4; ++nt) { f32x4 a = (f32x4){0.f, 0.f, 0.f, 0.f};
#pragma unroll
            for (int ks = 0; ks < 2; ++ks) a = MFMA16(qA[ks], bS[nt][ks], a);
#pragma unroll
            for (int ks = 0; ks < 2; ++ks) a = MFMA16(iA[ks], *(const LAS bf16x8*)(vT + (16 * nt + fr) * LDK + 32 * ks + 8 * fq), a);
            o[nt] = a; }
        float rinv[4];
#pragma unroll
        for (int r = 0; r < 4; ++r) { float q = (o[0][r] * o[0][r] + o[1][r] * o[1][r]) + (o[2][r] * o[2][r] + o[3][r] * o[3][r]);
            q += __shfl_xor(q, 1); q += __shfl_xor(q, 2); q += __shfl_xor(q, 4); q += __shfl_xor(q, 8);
            rinv[r] = rsqrtf(q * (1.f / 64.f) + EPS); }
#pragma unroll
        for (int nt = 0; nt < 4; ++nt)
#pragma unroll
            for (int r = 0; r < 4; ++r) *(LAS bf16_t*)(stg + (4 * fq + r) * 144 + (16 * nt + fr) * 2) = (bf16_t)f2bf(o[nt][r] * rinv[r] * gn[nt]);
        asm volatile("s_waitcnt lgkmcnt(0)" ::: "memory");
        { bf16_t* Ob = MIX + ((size_t)b * SEQ + n * 64 + r0) * DM + 512 + h * 64;
#pragma unroll
          for (int i = 0; i < 2; ++i) {
              const u32x4 ov = *(const LAS u32x4*)(stg + ((lane >> 3) + 8 * i) * 144 + 16 * (lane & 7)); const u32x4 g4 = gv[i];
              u32x4 wv;
              wv.x = cvtpk(bflo(ov.x) * siluf_(bflo(g4.x)), bfhi(ov.x) * siluf_(bfhi(g4.x)));
              wv.y = cvtpk(bflo(ov.y) * siluf_(bflo(g4.y)), bfhi(ov.y) * siluf_(bfhi(g4.y)));
              wv.z = cvtpk(bflo(ov.z) * siluf_(bflo(g4.z)), bfhi(ov.z) * siluf_(bfhi(g4.z)));
              wv.w = cvtpk(bflo(ov.w) * siluf_(bflo(g4.w)), bfhi(ov.w) * siluf_(bfhi(g4.w)));
              *(u32x4*)((char*)(Ob + (size_t)i * 8 * DM) + offO) = wv; } }
        if (has_next) DNO_WRITE_ST(buf ^ 1);
        buf ^= 1;
        __syncthreads();
    }
#undef DNO_LOAD
#undef DNO_WRITE_ST
}

typedef __attribute__((address_space(1))) unsigned gu32;
#define XB_TMO      128
#define XB_XCNT(j)  (256  + 64 * (j))
#define XB_XSUB(j)  (1280 + 64 * (j))
#define XB_XGEN(j)  (2304 + 64 * (j))
#define XB_TOP      3328
#define XB_TOPGEN   3392
#define XCD_BAR_WORDS 3456
#define XB_SPIN_CAP (1u << 18)

__device__ __forceinline__ unsigned xb_ld(unsigned* p)              { return __hip_atomic_load(p, __ATOMIC_RELAXED, __HIP_MEMORY_SCOPE_AGENT); }
__device__ __forceinline__ unsigned xb_add(unsigned* p, unsigned v) { return __hip_atomic_fetch_add(p, v, __ATOMIC_RELAXED, __HIP_MEMORY_SCOPE_AGENT); }
__device__ __forceinline__ unsigned xb_xcc_id() { return (unsigned)__builtin_amdgcn_s_getreg((3 << 11) | 20) & 0xFu; }
#define XB_SPIN(cond, bar) do { unsigned _sp = 0; while (cond) { __builtin_amdgcn_s_sleep(1); \
    if ((++_sp & 255u) == 0u) { if (xb_ld(&(bar)[XB_TMO])) break; if (_sp > XB_SPIN_CAP) { atomicAdd(&(bar)[XB_TMO], 1u); break; } } } } while (0)

struct XcdBarrier {
    unsigned* bar; unsigned x;
    volatile LAS unsigned* st;
};

__device__ __forceinline__ XcdBarrier xcd_barrier_post(unsigned* bar, volatile LAS unsigned* st) {
    XcdBarrier b; b.bar = bar; b.x = xb_xcc_id(); b.st = st;
    if (threadIdx.x == 0) (void)xb_add(&bar[XB_XCNT(b.x)], 1u);
    return b;
}
__device__ __forceinline__ void xcd_barrier_complete(unsigned* bar, unsigned x, unsigned& nloc, unsigned& nx) {
    const unsigned G = gridDim.x * gridDim.y * gridDim.z;
    unsigned sum, cnt, mine, sp = 0u;
    for (;;) {
        sum = 0u; cnt = 0u; mine = 0u;
#pragma unroll
        for (unsigned j = 0; j < 16; ++j) { const unsigned c = xb_ld(&bar[XB_XCNT(j)]); sum += c; cnt += (c > 0u) ? 1u : 0u; mine = (j == x) ? c : mine; }
        if (sum == G) break;
        __builtin_amdgcn_s_sleep(1);
        if ((++sp & 255u) == 0u) { if (xb_ld(&bar[XB_TMO])) break; if (sp > XB_SPIN_CAP) { atomicAdd(&bar[XB_TMO], 1u); break; } }
    }
    nloc = mine > 0u ? mine : 1u; nx = cnt > 0u ? cnt : 1u;
}

__device__ __forceinline__ void xcd_barrier(const XcdBarrier& b, bool leader_thread) {
    asm volatile("s_waitcnt vmcnt(0)" ::: "memory");
    __syncthreads();
    if (leader_thread) {
        unsigned* bar = b.bar;
        __builtin_amdgcn_s_waitcnt(0);
        unsigned nloc = b.st[0], nx = b.st[1];
        if (nloc == 0u) { xcd_barrier_complete(bar, b.x, nloc, nx); b.st[0] = nloc; b.st[1] = nx; }
        const unsigned old = xb_add(&bar[XB_XSUB(b.x)], 1u);
        const unsigned gen = old / nloc;
        if (old + 1u == (gen + 1u) * nloc) {
            __builtin_amdgcn_fence(__ATOMIC_RELEASE, "agent");
            asm volatile("s_waitcnt vmcnt(0)" ::: "memory");
            const unsigned og = xb_add(&bar[XB_TOP], 1u);
            const unsigned tg = og / nx;
            if (og + 1u == (tg + 1u) * nx) xb_add(&bar[XB_TOPGEN], 1u);
            else XB_SPIN(xb_ld(&bar[XB_TOPGEN]) == tg, bar);
            __builtin_amdgcn_fence(__ATOMIC_ACQUIRE, "agent");
            xb_add(&bar[XB_XGEN(b.x)], 1u);
            asm volatile("s_waitcnt vmcnt(0)" ::: "memory");
        } else {
            XB_SPIN(xb_ld(&bar[XB_XGEN(b.x)]) == gen, bar);
            __builtin_amdgcn_fence(__ATOMIC_ACQUIRE, "agent");
            asm volatile("s_waitcnt vmcnt(0)" ::: "memory");
        }
    }
    __syncthreads();
}

enum { K_PREP = 0, K_INPROJ = 1, K_DNPREP = 2, K_ATTN = 3, K_DNOUT = 4, K_OUTPROJ = 5 };
constexpr int N_PHASES = 13;
namespace cg = cooperative_groups;
__global__ void __launch_bounds__(512, 2) mega(Params p0, int ph_lo, int ph_hi) {
    extern __shared__ __attribute__((aligned(16))) unsigned char lds_raw[];
    LAS unsigned char* lds = (LAS unsigned char*)lds_raw;
    cg::grid_group grid = cg::this_grid();
    const int G = gridDim.x;
    const int wave_s = __builtin_amdgcn_readfirstlane(threadIdx.x >> 6);
    volatile LAS unsigned* MISC = (volatile LAS unsigned*)(lds + 147328);
    if (threadIdx.x < 32) MISC[threadIdx.x] = 0u;
    __syncthreads();
    XcdBarrier bar = xcd_barrier_post((unsigned*)(p0.ws + WS_CTL) + 4096, MISC + 8);
    for (int ph = ph_lo; ph < ph_hi; ++ph) {
        const int l = ph / 6, kind = ph % 6;
        const int nrep = (ph != 12 && ((MK_REP >> kind) & 1)) ? 2 : 1;
        for (int rep = 0; rep < nrep; ++rep) {
#define PHASE_IDS unsigned z_ = 0u; asm volatile("" : "+v"(z_)); int tid = wave_s * 64 + (int)__builtin_amdgcn_mbcnt_hi(~0u, __builtin_amdgcn_mbcnt_lo(~0u, z_)); const int lane = tid & 63, wave = wave_s; \
        int bx = blockIdx.x; asm volatile("" : "+s"(bx)); const int gw = bx * 8 + wave, ngw = G * 8; Params q = p0; asm volatile("" : "+s"(q.ws)); unsigned char* ws = q.ws; const Params& p = q; (void)lane; (void)wave; (void)gw; (void)ngw; (void)ws; (void)p;
        if (ph == 12) { PHASE_IDS
            final_rows(p, gw, ngw, lane);
        } else if (kind == K_PREP) { PHASE_IDS
            if (l == 0) { phase_init(p, lds, gw, ngw, wave, lane); __syncthreads(); }
            LAS float* w8s = (LAS float*)lds;
            for (int e = tid; e < 8 * DM; e += 512) { const int c = e & 7, kk = e >> 3; w8s[c * DM + kk] = p.w_in[(size_t)l * DM * INW + (size_t)kk * INW + 1536 + c]; }
            __syncthreads();
            if (l == 0) prep_rows<false>(p, 0, gw, ngw, lane, w8s); else prep_rows<true>(p, l, gw, ngw, lane, w8s);
            __syncthreads();
        } else if (kind == K_INPROJ) { PHASE_IDS
            { pg8::Gemm g{(const bf16_t*)(ws + WS_H), (const bf16_t*)(ws + WS_WIN) + (size_t)l * NIN * DM, NTOK, NIN, DM};
              pg8::StaticOrder S; S.init(NTOK, NIN, G, bx);
              EpiProj E{(bf16_t*)(ws + WS_P), (bf16_t*)(ws + WS_SVT)};
              pg8::gemm_phase<EpiProj, pg8::StaticOrder, true, true>(lds, g, S, E, tid); }
            if (l == 0) {
                for (int ll = 0; ll < DEPTH; ++ll) {
                    pg8::Gemm g{(const bf16_t*)(ws + WS_MEMN) + (size_t)ll * MEMROWS * DM, (const bf16_t*)(ws + WS_WMKV) + (size_t)ll * 512 * DM, MEMROWS, 512, DM};
                    pg8::StaticOrder S; S.init(MEMROWS, 512, G, (int)((bx + G - 32 * ll) % G));
                    EpiMkv E{(bf16_t*)(ws + WS_MK) + (size_t)ll * MEMROWS * 256, (bf16_t*)(ws + WS_MVT) + (size_t)ll * MEMROWS * 256};
                    pg8::gemm_phase<EpiMkv, pg8::StaticOrder, true, true>(lds, g, S, E, tid);
                }
            }
        } else if (kind == K_DNPREP) { PHASE_IDS
            dn_prep_phase(p, l, lds, tid, G, bx);
        } else if (kind == K_ATTN) { PHASE_IDS
            for (int srep = 0; srep < (((MK_REP >> 6) & 1) ? 2 : 1); ++srep)
            if (wave == 0) for (int item = bx; item < 256; item += G) dn_scan_item(p, item, lane);
            attn_phase(p, l, lds, tid, G, bx);
        } else if (kind == K_DNOUT) { PHASE_IDS
            dn_out_phase(p, l, lds, tid, G, bx);
        } else { PHASE_IDS
            pg8::Gemm g{(const bf16_t*)(ws + WS_H), (const bf16_t*)(ws + WS_WOUT) + (size_t)l * DM * DM, NTOK, DM, DM};
            pg8::StaticOrder S; S.init(NTOK, DM, G, bx);
            EpiY E{(bf16_t*)(ws + WS_P), (float*)(ws + WS_STATS)};
            pg8::gemm_phase<EpiY, pg8::StaticOrder, true, true>(lds, g, S, E, tid);
        }
        if (rep + 1 < nrep) __syncthreads();
        }
        if (ph + 1 < ph_hi) { if (ph == ph_lo) grid.sync(); else xcd_barrier(bar, wave_s == 0 && __builtin_amdgcn_mbcnt_hi(~0u, __builtin_amdgcn_mbcnt_lo(~0u, 0u)) == 0u); }
    }
}

#ifndef MK_MULTI
#define MK_MULTI 0
#endif
extern "C" void kernel_launch(void* const* d_in, const int* in_sizes, int n_in, void* d_out, int out_size, void* d_ws, size_t ws_size, hipStream_t stream) {
    static int grid = 0;
    constexpr int LDS_BYTES = 147456;
    if (grid == 0) {
        if (n_in != 13 || ws_size < WS_END || out_size != NTOK * DM) { fprintf(stderr, "kernel_launch: unexpected n_in %d / ws_size %zu / out_size %d\n", n_in, ws_size, out_size); grid = -1; return; }
        int dev = 0, cus = 0, per_cu = 0;
        if (hipGetDevice(&dev) != hipSuccess || hipDeviceGetAttribute(&cus, hipDeviceAttributeMultiprocessorCount, dev) != hipSuccess) { grid = -1; return; }
        if (hipFuncSetAttribute((const void*)mega, hipFuncAttributeMaxDynamicSharedMemorySize, LDS_BYTES) != hipSuccess) { fprintf(stderr, "kernel_launch: hipFuncSetAttribute failed\n"); grid = -1; return; }
        if (hipOccupancyMaxActiveBlocksPerMultiprocessor(&per_cu, (const void*)mega, 512, LDS_BYTES) != hipSuccess || per_cu < 1) { fprintf(stderr, "kernel_launch: occupancy query failed (%d)\n", per_cu); grid = -1; return; }
        grid = cus * 1;
    }
    if (grid < 0) return;
    Params p{};
    p.x = (const float*)d_in[0]; p.mem = (const float*)d_in[1]; p.pre_g = (const float*)d_in[2]; p.w_in = (const float*)d_in[3]; p.conv_w = (const float*)d_in[4];
    p.a_log = (const float*)d_in[5]; p.dt_bias = (const float*)d_in[6]; p.sinks = (const float*)d_in[7]; p.dn_g = (const float*)d_in[8]; p.mem_g = (const float*)d_in[9];
    p.w_mkv = (const float*)d_in[10]; p.w_out = (const float*)d_in[11]; p.post_g = (const float*)d_in[12];
    p.out = (float*)d_out; p.ws = (unsigned char*)d_ws;
    if (hipMemsetAsync((char*)d_ws + WS_CTL, 0, 1 * MiB, stream) != hipSuccess) { fprintf(stderr, "kernel_launch: hipMemsetAsync failed\n"); return; }
#if MK_MULTI
    for (int ph = 0; ph < N_PHASES; ++ph) hipLaunchKernelGGL(mega, dim3(grid), dim3(512), LDS_BYTES, stream, p, ph, ph + 1);
#else
    int lo = 0, hi = N_PHASES;
    void* args[] = {&p, &lo, &hi};
    const hipError_t e = hipLaunchCooperativeKernel((const void*)mega, dim3(grid), dim3(512), args, LDS_BYTES, stream);
    if (e != hipSuccess) fprintf(stderr, "kernel_launch: cooperative launch failed: %s (grid %d)\n", hipGetErrorString(e), grid);
#endif
}
```
